# Optimizing an MI355X kernel written in HIP

```python
import jax, jax.numpy as jnp
from jax import lax
import numpy as np

D_MODEL = 1024
BATCH = 8
SEQ = 2048
DEPTH = 2

CHUNK = 64
MIX_WIDTH = D_MODEL
ATT_HEADS = 8
HEAD_DIM = 64
ATT_WIDTH = ATT_HEADS * HEAD_DIM
LEFT_CHUNKS = 8
BAND = (LEFT_CHUNKS + 1) * CHUNK
MAX_REL = 2 * CHUNK
GMLP_WIDTH = MIX_WIDTH - ATT_WIDTH
GMLP_GROUPS = 8
GMLP_GROUP_DIM = GMLP_WIDTH // GMLP_GROUPS
GMLP_BLOCK = 128
D_FF = ((8 * D_MODEL // 3 + 255) // 256) * 256
IN_WIDTH = 3 * ATT_WIDTH + 2 * GMLP_WIDTH
EPS = 1e-6
NEG_INF = -1e30

kernel_name = "hybrid_bandattn_gmlp_streaming_block"


def rmsnorm(x, g):
    x32 = x.astype(jnp.float32)
    y = x32 * lax.rsqrt(jnp.mean(x32 * x32, axis=-1, keepdims=True) + EPS)
    return (y * g.astype(jnp.float32)).astype(x.dtype)


def band_attention(q, k, v, q_g, k_g, rel_table):
    B, S, _ = q.shape
    nc = S // CHUNK
    shp = (B, nc, CHUNK, ATT_HEADS, HEAD_DIM)
    q = rmsnorm(q.reshape(shp), q_g)
    k = rmsnorm(k.reshape(shp), k_g)
    v = v.reshape(shp)
    pad = ((0, 0), (LEFT_CHUNKS, 0), (0, 0), (0, 0), (0, 0))
    kp = jnp.pad(k, pad)
    vp = jnp.pad(v, pad)
    k_band = jnp.concatenate([kp[:, j:j + nc] for j in range(LEFT_CHUNKS + 1)], axis=2)
    v_band = jnp.concatenate([vp[:, j:j + nc] for j in range(LEFT_CHUNKS + 1)], axis=2)
    scores = jnp.einsum('bnqhd,bnkhd->bhnqk', q, k_band).astype(jnp.float32) * (HEAD_DIM ** -0.5)
    q_pos = LEFT_CHUNKS * CHUNK + jnp.arange(CHUNK)[:, None]
    k_pos = jnp.arange(BAND)[None, :]
    rel_idx = jnp.clip(q_pos - k_pos, -MAX_REL, MAX_REL) + MAX_REL
    bias = rel_table[:, rel_idx].astype(jnp.float32)
    scores = scores + bias[None, :, None, :, :]
    key_chunk = jnp.arange(nc)[:, None] - LEFT_CHUNKS + (jnp.arange(BAND) // CHUNK)[None, :]
    valid = key_chunk >= 0
    scores = jnp.where(valid[None, None, :, None, :], scores, NEG_INF)
    p = jax.nn.softmax(scores, axis=-1).astype(v.dtype)
    out = jnp.einsum('bhnqk,bnkhd->bnqhd', p, v_band)
    return out.reshape(B, S, ATT_WIDTH)


def spatial_gating(u, vg, norm_g, w_s, b_s):
    B, S, _ = u.shape
    nb = S // GMLP_BLOCK
    u = jax.nn.gelu(u)
    vg = rmsnorm(jax.nn.gelu(vg), norm_g)
    vg = vg.reshape(B, nb, GMLP_BLOCK, GMLP_GROUPS, GMLP_GROUP_DIM)
    t = jnp.arange(GMLP_BLOCK)
    mask = (t[:, None] // CHUNK) >= (t[None, :] // CHUNK)
    w = jnp.where(mask[None], w_s, jnp.zeros_like(w_s))
    mixed = jnp.einsum('gts,bnsgc->bntgc', w, vg) + b_s.T[None, None, :, :, None]
    return u * mixed.reshape(B, S, GMLP_WIDTH)


def setup_inputs(seed: int = 0) -> dict:
    key = jax.random.key(seed)
    ks = jax.random.split(key, 16)
    f32 = jnp.float32
    nrm = lambda k, shp, s: jax.random.normal(k, shp, f32) * s
    return {
        "x": nrm(ks[0], (BATCH, SEQ, D_MODEL), 1.0),
        "mix_norm_g": 1.0 + nrm(ks[1], (DEPTH, D_MODEL), 0.02),
        "w_in": nrm(ks[2], (DEPTH, D_MODEL, IN_WIDTH), D_MODEL ** -0.5),
        "q_norm_g": 1.0 + nrm(ks[3], (DEPTH, HEAD_DIM), 0.02),
        "k_norm_g": 1.0 + nrm(ks[4], (DEPTH, HEAD_DIM), 0.02),
        "rel_bias": nrm(ks[5], (DEPTH, ATT_HEADS, 2 * MAX_REL + 1), 0.1),
        "sgu_norm_g": 1.0 + nrm(ks[6], (DEPTH, GMLP_WIDTH), 0.02),
        "w_spatial": nrm(ks[7], (DEPTH, GMLP_GROUPS, GMLP_BLOCK, GMLP_BLOCK), 0.5 * GMLP_BLOCK ** -0.5),
        "b_spatial": 1.0 + nrm(ks[8], (DEPTH, GMLP_GROUPS, GMLP_BLOCK), 0.01),
        "att_out_norm_g": 1.0 + nrm(ks[9], (DEPTH, ATT_WIDTH), 0.02),
        "gmlp_out_norm_g": 1.0 + nrm(ks[10], (DEPTH, GMLP_WIDTH), 0.02),
        "w_out": nrm(ks[11], (DEPTH, MIX_WIDTH, D_MODEL), MIX_WIDTH ** -0.5),
        "ffn_norm_g": 1.0 + nrm(ks[12], (DEPTH, D_MODEL), 0.02),
        "w_ffn_in": nrm(ks[13], (DEPTH, D_MODEL, 2 * D_FF), D_MODEL ** -0.5),
        "w_ffn_out": nrm(ks[14], (DEPTH, D_FF, D_MODEL), D_FF ** -0.5),
    }


def reference(x, mix_norm_g, w_in, q_norm_g, k_norm_g, rel_bias, sgu_norm_g, w_spatial,
              b_spatial, att_out_norm_g, gmlp_out_norm_g, w_out, ffn_norm_g, w_ffn_in,
              w_ffn_out):
    split_pts = [ATT_WIDTH, 2 * ATT_WIDTH, 3 * ATT_WIDTH, 3 * ATT_WIDTH + GMLP_WIDTH]
    for l in range(DEPTH):
        h = rmsnorm(x, mix_norm_g[l])
        proj = jnp.einsum('bsd,de->bse', h, w_in[l])
        q, k, v, u, vg = jnp.split(proj, split_pts, axis=-1)
        a = band_attention(q, k, v, q_norm_g[l], k_norm_g[l], rel_bias[l])
        g = spatial_gating(u, vg, sgu_norm_g[l], w_spatial[l], b_spatial[l])
        mix = jnp.concatenate([rmsnorm(a, att_out_norm_g[l]),
                               rmsnorm(g, gmlp_out_norm_g[l])], axis=-1)
        x = x + jnp.einsum('bse,ed->bsd', mix, w_out[l])
        h = rmsnorm(x, ffn_norm_g[l])
        gate, up = jnp.split(jnp.einsum('bsd,df->bsf', h, w_ffn_in[l]), 2, axis=-1)
        x = x + jnp.einsum('bsf,fd->bsd', jax.nn.silu(gate) * up, w_ffn_out[l])
    return x
```

```cpp
#include <hip/hip_runtime.h>
#include <hip/hip_cooperative_groups.h>
#include <cstdio>
#include <cstdint>
namespace cg = cooperative_groups;
namespace pg8 {
#define PG8_LAS __attribute__((address_space(3)))
typedef unsigned short bf16_t;
typedef short bf16x8 __attribute__((ext_vector_type(8)));
typedef float f32x4 __attribute__((ext_vector_type(4)));
typedef unsigned u32x4 __attribute__((ext_vector_type(4)));
constexpr int BM = 256, BK = 64, HALF = 128, HTB = HALF * BK * 2  , STAGE_BYTES = 8 * HTB, NXCD = 8, WGM = 8;

__host__ __device__ __forceinline__ int lds_byte(int r, int c) { const int st = (r >> 4) * 2 + (c >> 5), rr = r & 15, cc = c & 31, ob = rr * 64 + cc * 2; return st * 1024 + (ob ^ (((ob >> 9) & 1) << 5)); }
__host__ __device__ __forceinline__ void stage_rc(int b, int& R, int& C) { const int st = b / 1024, sb = b % 1024, swz = sb ^ (((sb >> 9) & 1) << 5); R = (st >> 1) * 16 + swz / 64; C = (st & 1) * 32 + (swz % 64) / 2; }
__host__ __device__ __forceinline__ int perm32(int rho) { const int n = rho >> 4, i = rho & 15; return 8 * (i >> 2) + 4 * n + (i & 3); }

struct Unit { int pm, pn; };
struct Gemm { const bf16_t* A; const bf16_t* Bt; int M, N, K; };

struct StaticOrder {
    int nM, nN, nwg, G, c;
    __host__ __device__ void init(int M, int N, int G_, int c_) { nM = M / BM; nN = N / BM; nwg = nM * nN; G = G_; c = c_; }
    __host__ __device__ bool next(int i, Unit& u) const {
        const long L = (long)i * G + c; if (L >= nwg) return false;
        int wgid = (int)L; { const int q = nwg / NXCD, r = nwg % NXCD, xcd = wgid % NXCD, off = wgid / NXCD; wgid = (xcd < r ? xcd * (q + 1) : r * (q + 1) + (xcd - r) * q) + off; }
        const int nig = WGM * nN, gid = wgid / nig, fm = gid * WGM, gsz = (nM - fm) < WGM ? (nM - fm) : WGM;
        u.pm = fm + ((wgid % nig) % gsz); u.pn = (wgid % nig) / gsz; return true;
    }
    __device__ __forceinline__ void a_ready(const Unit&) const {}
    __device__ __forceinline__ void done(const Unit&) const {}
};

__device__ __forceinline__ unsigned cvt_pk_bf16(float lo, float hi) { unsigned r; asm volatile("v_cvt_pk_bf16_f32 %0, %1, %2" : "=v"(r) : "v"(lo), "v"(hi)); return r; }
typedef float f32x2 __attribute__((ext_vector_type(2)));
constexpr float RMS_EPS = 1e-6f;
constexpr float LOG2E = 1.4426950408889634f;
constexpr float QSCALE = 0.125f * 1.4426950408889634f;
__device__ __forceinline__ float gelu_tanh(float x) {
    const float z2 = x * (1.5957691216057308f + 0.07135481627260025f * x * x);
    const float e = __builtin_amdgcn_exp2f(-LOG2E * z2);
    return x * __builtin_amdgcn_rcpf(1.0f + e);
}
__device__ __forceinline__ float row_rs(const float* rowss, int row) {
    const f32x4* pr = (const f32x4*)(rowss + (size_t)row * 16);
    const f32x4 a = pr[0], b = pr[1], c = pr[2], d = pr[3];
    const float ss = ((a[0] + a[1]) + (a[2] + a[3])) + ((b[0] + b[1]) + (b[2] + b[3])) + ((c[0] + c[1]) + (c[2] + c[3])) + ((d[0] + d[1]) + (d[2] + d[3]));
    return __builtin_amdgcn_rsqf(ss * (1.0f / 1024.0f) + RMS_EPS);
}
struct EpiInProj {
    static constexpr bool PERM = true, AFTER_DRAIN = false;
    bf16_t* P; const float* rowss; float* vgss; const float* qg; const float* kg;
    __device__ __forceinline__ void operator()(const f32x4 (&acc)[2][2][4][2], const Unit& u, int wr, int wc, int fr, int fq) const {
        const int region = u.pn >> 1, half = u.pn & 1;
        const int lcol = region * 512 + half * 256 + wc * 64 + fq * 8;
        float gq[2][8];
#pragma unroll
        for (int bj = 0; bj < 2; ++bj)
#pragma unroll
            for (int e = 0; e < 8; ++e) gq[bj][e] = 1.f;
        if (region < 2) { const float* g = region == 0 ? qg : kg; const float sc = region == 0 ? QSCALE : 1.f;
#pragma unroll
            for (int bj = 0; bj < 2; ++bj)
#pragma unroll
                for (int e = 0; e < 8; ++e) gq[bj][e] = g[bj * 32 + fq * 8 + e] * sc; }
#pragma unroll
        for (int ai = 0; ai < 2; ++ai)
#pragma unroll
            for (int m = 0; m < 4; ++m) {
                const int row = u.pm * BM + ai * HALF + wr * 64 + m * 16 + fr;
                const float s = row_rs(rowss, row);
                float v[2][8];
#pragma unroll
                for (int bj = 0; bj < 2; ++bj)
#pragma unroll
                    for (int n = 0; n < 2; ++n)
#pragma unroll
                        for (int i = 0; i < 4; ++i) v[bj][4 * n + i] = acc[ai][bj][m][n][i] * s;
                if (region < 2) {
                    float q = 0.f;
#pragma unroll
                    for (int bj = 0; bj < 2; ++bj)
#pragma unroll
                        for (int e = 0; e < 8; ++e) q += v[bj][e] * v[bj][e];
                    q += __shfl_xor(q, 16); q += __shfl_xor(q, 32);
                    const float r = __builtin_amdgcn_rsqf(q * (1.0f / 64.0f) + RMS_EPS);
#pragma unroll
                    for (int bj = 0; bj < 2; ++bj)
#pragma unroll
                        for (int e = 0; e < 8; ++e) v[bj][e] = v[bj][e] * r * gq[bj][e];
                } else if (region >= 3) {
#pragma unroll
                    for (int bj = 0; bj < 2; ++bj)
#pragma unroll
                        for (int e = 0; e < 8; ++e) v[bj][e] = gelu_tanh(v[bj][e]);
                    if (region == 4) {
                        float q = 0.f;
#pragma unroll
                        for (int bj = 0; bj < 2; ++bj)
#pragma unroll
                            for (int e = 0; e < 8; ++e) q += v[bj][e] * v[bj][e];
                        q += __shfl_xor(q, 16); q += __shfl_xor(q, 32);
                        if (fq == 0) vgss[(size_t)row * 8 + half * 4 + wc] = q;
                    }
                }
                bf16_t* rowp = P + (size_t)row * 2560 + lcol;
#pragma unroll
                for (int bj = 0; bj < 2; ++bj) { u32x4 w; w.x = cvt_pk_bf16(v[bj][0], v[bj][1]); w.y = cvt_pk_bf16(v[bj][2], v[bj][3]); w.z = cvt_pk_bf16(v[bj][4], v[bj][5]); w.w = cvt_pk_bf16(v[bj][6], v[bj][7]);
                    *(u32x4*)(rowp + bj * 32) = w; }
            }
    }
};
struct EpiResid {
    static constexpr bool PERM = true, AFTER_DRAIN = false;
    const float* base; float* out; bf16_t* xb; float* rowss;
    __device__ __forceinline__ void operator()(const f32x4 (&acc)[2][2][4][2], const Unit& u, int wr, int wc, int fr, int fq) const {
        const int col0 = u.pn * BM + wc * 32 + 8 * fq;
#pragma unroll
        for (int ai = 0; ai < 2; ++ai)
#pragma unroll
            for (int m = 0; m < 4; ++m) {
                const int row = u.pm * BM + ai * HALF + wr * 64 + m * 16 + fr;
                const size_t off = (size_t)row * 1024 + col0;
                float q = 0.f;
#pragma unroll
                for (int bj = 0; bj < 2; ++bj) {
                    const f32x4 b0 = *(const f32x4*)(base + off + bj * HALF), b1 = *(const f32x4*)(base + off + bj * HALF + 4);
                    const f32x4 v0 = acc[ai][bj][m][0] + b0, v1 = acc[ai][bj][m][1] + b1;
                    *(f32x4*)(out + off + bj * HALF) = v0; *(f32x4*)(out + off + bj * HALF + 4) = v1;
                    u32x4 w; w.x = cvt_pk_bf16(v0[0], v0[1]); w.y = cvt_pk_bf16(v0[2], v0[3]); w.z = cvt_pk_bf16(v1[0], v1[1]); w.w = cvt_pk_bf16(v1[2], v1[3]);
                    *(u32x4*)(xb + off + bj * HALF) = w;
                    q += (v0[0] * v0[0] + v0[1] * v0[1]) + (v0[2] * v0[2] + v0[3] * v0[3]) + (v1[0] * v1[0] + v1[1] * v1[1]) + (v1[2] * v1[2] + v1[3] * v1[3]);
                }
                q += __shfl_xor(q, 16); q += __shfl_xor(q, 32);
                if (fq == 0) rowss[(size_t)row * 16 + u.pn * 4 + wc] = q;
            }
    }
};
struct EpiSwiGLU {
    static constexpr bool PERM = true, AFTER_DRAIN = false;
    bf16_t* H; const float* rowss;
    __device__ __forceinline__ void operator()(const f32x4 (&acc)[2][2][4][2], const Unit& u, int wr, int wc, int fr, int fq) const {
        const int col0 = u.pn * 128 + wc * 32 + 8 * fq;
#pragma unroll
        for (int ai = 0; ai < 2; ++ai)
#pragma unroll
            for (int m = 0; m < 4; ++m) {
                const int row = u.pm * BM + ai * HALF + wr * 64 + m * 16 + fr;
                const float s = row_rs(rowss, row);
                float h[8];
#pragma unroll
                for (int n = 0; n < 2; ++n)
#pragma unroll
                    for (int i = 0; i < 4; ++i) { const float g = acc[ai][0][m][n][i] * s, up = acc[ai][1][m][n][i] * s;
                        h[4 * n + i] = g * __builtin_amdgcn_rcpf(1.0f + __builtin_amdgcn_exp2f(-LOG2E * g)) * up; }
                u32x4 w; w.x = cvt_pk_bf16(h[0], h[1]); w.y = cvt_pk_bf16(h[2], h[3]); w.z = cvt_pk_bf16(h[4], h[5]); w.w = cvt_pk_bf16(h[6], h[7]);
                *(u32x4*)(H + (size_t)row * 2816 + col0) = w;
            }
    }
};
template <class Epi, class Sched, bool ALIGN_EPI = false, bool SP2 = false>
__device__ __forceinline__ void gemm_phase(PG8_LAS unsigned char* lds, const Gemm g, const Sched& S, const Epi& E) {
    int tid_l = threadIdx.x; asm volatile("" : "+v"(tid_l));
    const int tid = tid_l, wid = __builtin_amdgcn_readfirstlane(tid >> 6), lane = tid & 63, wr = wid >> 2, wc = wid & 3, fr = lane & 15, fq = lane >> 4;
    const int K = g.K, nt = K / BK;
    unsigned voffA[2], voffB[2];
#pragma unroll
    for (int i = 0; i < 2; ++i) { int R, C; stage_rc(tid * 16 + i * 8192, R, C); const int Rb = Epi::PERM ? ((R & ~31) + perm32(R & 31)) : R;
        voffA[i] = (unsigned)(R * K + C) * 2u; voffB[i] = (unsigned)(Rb * K + C) * 2u; }
    const size_t kstep = (size_t)(BK * 2);
    const size_t hstep = (size_t)HALF * K * 2;
    const size_t tstep = 2 * hstep;
    const unsigned ldsw = (unsigned)wid * 1024u;
    const int aoff = lds_byte(wr * 64 + fr, fq * 8), boff = lds_byte(wc * 32 + fr, fq * 8);
#define PG8_SA(b, h) (((b) * 2 + (h)) * HTB)
#define PG8_SB(b, h) ((4 + (b) * 2 + (h)) * HTB)
#define PG8_STAGE(bufoff, gbase, voff) do { _Pragma("unroll") for (int _i = 0; _i < 2; ++_i) \
        __builtin_amdgcn_global_load_lds((const unsigned*)((const char*)(gbase) + (voff)[_i]), (PG8_LAS unsigned*)(lds + (bufoff) + ldsw + _i * 8192), 16, 0, 0); } while (0)
#define PG8_LDA(dst, b, h) do { _Pragma("unroll") for (int m = 0; m < 4; ++m) _Pragma("unroll") for (int k = 0; k < 2; ++k) dst[m][k] = *(const PG8_LAS bf16x8*)(lds + PG8_SA(b, h) + aoff + m * 2048 + k * 1024); } while (0)
#define PG8_LDB(dst, b, h) do { _Pragma("unroll") for (int n = 0; n < 2; ++n) _Pragma("unroll") for (int k = 0; k < 2; ++k) dst[n][k] = *(const PG8_LAS bf16x8*)(lds + PG8_SB(b, h) + boff + n * 2048 + k * 1024); } while (0)
#define PG8_MMA(ai, bj, At, Bt) do { __builtin_amdgcn_s_setprio(1); _Pragma("unroll") for (int m = 0; m < 4; ++m) _Pragma("unroll") for (int n = 0; n < 2; ++n) _Pragma("unroll") for (int k = 0; k < 2; ++k) \
        acc[ai][bj][m][n] = __builtin_amdgcn_mfma_f32_16x16x32_bf16(Bt[n][k], At[m][k], acc[ai][bj][m][n], 0, 0, 0); __builtin_amdgcn_s_setprio(0); } while (0)
#define PG8_WAIT_V(n) asm volatile("s_waitcnt vmcnt(" #n ")" ::: "memory")
#define PG8_WAIT_L(n) asm volatile("s_waitcnt lgkmcnt(" #n ")" ::: "memory")
#define PG8_BAR __builtin_amdgcn_s_barrier()
#define PG8_SCHED __builtin_amdgcn_sched_barrier(0)
    Unit cur, nxt; int ui = 0;
    if (!S.next(0, cur)) return;
    f32x4 acc[2][2][4][2];
#pragma unroll
    for (int a = 0; a < 2; ++a)
#pragma unroll
        for (int b = 0; b < 2; ++b)
#pragma unroll
            for (int m = 0; m < 4; ++m)
#pragma unroll
                for (int n = 0; n < 2; ++n) acc[a][b][m][n] = (f32x4){0.f, 0.f, 0.f, 0.f};
    bf16x8 At[4][2], B0[2][2], B1[2][2];
    const char* cA = (const char*)g.A + (size_t)cur.pm * tstep; const char* cB = (const char*)g.Bt + (size_t)cur.pn * tstep;
    S.a_ready(cur);
    if constexpr (SP2) {
        PG8_STAGE(PG8_SB(0, 0), cB, voffB); PG8_STAGE(PG8_SB(0, 1), cB + hstep, voffB); PG8_STAGE(PG8_SA(0, 0), cA, voffA); PG8_STAGE(PG8_SA(0, 1), cA + hstep, voffA);
        if (wr == 1) PG8_BAR;
        PG8_WAIT_V(2); PG8_BAR;
        PG8_STAGE(PG8_SB(1, 0), cB + kstep, voffB); PG8_STAGE(PG8_SA(1, 0), cA + kstep, voffA); PG8_STAGE(PG8_SB(1, 1), cB + hstep + kstep, voffB);
        PG8_WAIT_V(6); PG8_BAR;
    } else {
        PG8_STAGE(PG8_SB(0, 0), cB, voffB); PG8_STAGE(PG8_SA(0, 0), cA, voffA); PG8_STAGE(PG8_SB(0, 1), cB + hstep, voffB); PG8_STAGE(PG8_SA(0, 1), cA + hstep, voffA);
        if (wr == 1) PG8_BAR;
        PG8_WAIT_V(4); PG8_BAR;
        PG8_STAGE(PG8_SB(1, 0), cB + kstep, voffB); PG8_STAGE(PG8_SA(1, 0), cA + kstep, voffA); PG8_STAGE(PG8_SB(1, 1), cB + hstep + kstep, voffB);
        PG8_WAIT_V(6); PG8_BAR;
    }
    for (;;) {
        const bool has_next = S.next(ui + 1, nxt);
        const char* nA = has_next ? (const char*)g.A + (size_t)nxt.pm * tstep : cA; const char* nB = has_next ? (const char*)g.Bt + (size_t)nxt.pn * tstep : cB;
        for (int t = 0; t < nt; t += 2) {
            const bool last = (t == nt - 2);
            const char* a1 = cA + (size_t)(t + 1) * kstep;
            const char* a2 = last ? nA : cA + (size_t)(t + 2) * kstep; const char* b2 = last ? nB : cB + (size_t)(t + 2) * kstep;
            const char* a3 = a2 + kstep; const char* b3 = b2 + kstep;
            if (last && has_next) S.a_ready(nxt);
            if constexpr (SP2) {
            PG8_LDB(B0, 0, 0); PG8_LDB(B1, 0, 1); PG8_SCHED; PG8_LDA(At, 0, 0); PG8_STAGE(PG8_SA(1, 1), a1 + hstep, voffA);
            PG8_WAIT_V(8); PG8_WAIT_L(0); PG8_BAR; PG8_MMA(0, 0, At, B0); PG8_MMA(0, 1, At, B1); PG8_BAR; PG8_SCHED;
            PG8_LDA(At, 0, 1); PG8_STAGE(PG8_SB(0, 0), b2, voffB); PG8_STAGE(PG8_SB(0, 1), b2 + hstep, voffB); PG8_STAGE(PG8_SA(0, 0), a2, voffA);
            PG8_WAIT_V(8); PG8_WAIT_L(0); PG8_BAR; PG8_MMA(1, 0, At, B0); PG8_MMA(1, 1, At, B1); PG8_BAR; PG8_SCHED;
            PG8_LDB(B0, 1, 0); PG8_LDB(B1, 1, 1); PG8_SCHED; PG8_LDA(At, 1, 0); PG8_STAGE(PG8_SA(0, 1), a2 + hstep, voffA);
            PG8_WAIT_V(8); PG8_WAIT_L(0); PG8_BAR; PG8_MMA(0, 0, At, B0); PG8_MMA(0, 1, At, B1); PG8_BAR; PG8_SCHED;
            PG8_LDA(At, 1, 1); PG8_STAGE(PG8_SB(1, 0), b3, voffB); PG8_STAGE(PG8_SB(1, 1), b3 + hstep, voffB); PG8_STAGE(PG8_SA(1, 0), a3, voffA);
            PG8_WAIT_V(8); PG8_WAIT_L(0); PG8_BAR; PG8_MMA(1, 0, At, B0); PG8_MMA(1, 1, At, B1); PG8_BAR; PG8_SCHED;
            } else {
            PG8_LDB(B0, 0, 0); PG8_SCHED; PG8_LDA(At, 0, 0); PG8_STAGE(PG8_SA(1, 1), a1 + hstep, voffA);
            PG8_WAIT_L(8); PG8_BAR; PG8_WAIT_L(0); PG8_MMA(0, 0, At, B0); PG8_BAR; PG8_SCHED;
            PG8_LDB(B1, 0, 1); PG8_STAGE(PG8_SB(0, 0), b2, voffB);
            PG8_BAR; PG8_WAIT_L(0); PG8_MMA(0, 1, At, B1); PG8_BAR;
            PG8_LDA(At, 0, 1); PG8_STAGE(PG8_SA(0, 0), a2, voffA);
            PG8_BAR; PG8_WAIT_L(0); PG8_MMA(1, 0, At, B0); PG8_BAR; PG8_SCHED;
            PG8_STAGE(PG8_SB(0, 1), b2 + hstep, voffB);
            PG8_WAIT_V(6); PG8_BAR; PG8_MMA(1, 1, At, B1); PG8_BAR;
            PG8_LDB(B0, 1, 0); PG8_SCHED; PG8_LDA(At, 1, 0); PG8_STAGE(PG8_SA(0, 1), a2 + hstep, voffA);
            PG8_WAIT_L(8); PG8_BAR; PG8_WAIT_L(0); PG8_MMA(0, 0, At, B0); PG8_BAR; PG8_SCHED;
            PG8_LDB(B1, 1, 1); PG8_STAGE(PG8_SB(1, 0), b3, voffB);
            PG8_BAR; PG8_WAIT_L(0); PG8_MMA(0, 1, At, B1); PG8_BAR;
            PG8_LDA(At, 1, 1); PG8_STAGE(PG8_SA(1, 0), a3, voffA);
            PG8_BAR; PG8_WAIT_L(0); PG8_MMA(1, 0, At, B0); PG8_BAR; PG8_SCHED;
            PG8_STAGE(PG8_SB(1, 1), b3 + hstep, voffB);
            PG8_WAIT_V(6); PG8_BAR; PG8_MMA(1, 1, At, B1); PG8_BAR;
            }
        }
        if constexpr (ALIGN_EPI) { if (wr == 0) PG8_BAR; }
        if constexpr (!Epi::AFTER_DRAIN) { E(acc, cur, wr, wc, fr, fq); S.done(cur); }
        if (!has_next) break;
#pragma unroll
        for (int a = 0; a < 2; ++a)
#pragma unroll
            for (int b = 0; b < 2; ++b)
#pragma unroll
                for (int m = 0; m < 4; ++m)
#pragma unroll
                    for (int n = 0; n < 2; ++n) acc[a][b][m][n] = (f32x4){0.f, 0.f, 0.f, 0.f};
        cur = nxt; cA = nA; cB = nB; ++ui;
        if constexpr (ALIGN_EPI) { if (wr == 1) PG8_BAR; }
    }
    PG8_WAIT_V(0);
    if constexpr (!ALIGN_EPI) { if (wr == 0) PG8_BAR; }
    PG8_BAR;
    if constexpr (Epi::AFTER_DRAIN) { E.fused(acc, cur, wr, wc, fr, fq, lds, wid, lane); S.done(cur); }
#undef PG8_SA
#undef PG8_SB
#undef PG8_STAGE
#undef PG8_LDA
#undef PG8_LDB
#undef PG8_MMA
#undef PG8_WAIT_V
#undef PG8_WAIT_L
#undef PG8_BAR
#undef PG8_SCHED
}
}
constexpr int NB = 8, SEQ = 2048, DM = 1024, M = NB * SEQ, NIN = 2560, DFF = 2816, NFF2 = 2 * DFF, DEPTH = 2;
constexpr int NWAVES = 8;
constexpr size_t MiB = 1u << 20;
constexpr size_t WS_ROWSS = 1 * MiB;
constexpr size_t WS_VGSS = 2 * MiB;
constexpr size_t WS_WSP = 3 * MiB;
constexpr size_t WS_W0 = 4 * MiB, WS_WSTRIDE = 24 * MiB;
constexpr size_t WOFF_IN = 0, WOFF_OUT = 5 * MiB, WOFF_FIN = 7 * MiB, WOFF_FOUT = 18 * MiB;
constexpr size_t WS_XB = 52 * MiB;
constexpr size_t WS_PROJ = 84 * MiB;
constexpr size_t WS_MIX = 164 * MiB;
constexpr size_t WS_HID = 84 * MiB;
constexpr size_t WS_END = 196 * MiB;
constexpr int LDS_BYTES = 147456;

#define GAS __attribute__((address_space(1)))
#define LAS __attribute__((address_space(3)))
typedef unsigned short bf16;
typedef unsigned v4u __attribute__((ext_vector_type(4)));
typedef float f32x4 __attribute__((ext_vector_type(4)));
__device__ __forceinline__ unsigned f2bf(float f) { unsigned u = __builtin_bit_cast(unsigned, f); return (u + 0x7fffu + ((u >> 16) & 1u)) >> 16; }
__device__ __forceinline__ unsigned pk2(float lo, float hi) { return f2bf(lo) | (f2bf(hi) << 16); }
__device__ __forceinline__ float bf2f(bf16 v) { return __builtin_bit_cast(float, (unsigned)v << 16); }
__device__ __forceinline__ float wave_sum(float v) {
#pragma unroll
    for (int o = 1; o < 64; o <<= 1) v += __shfl_xor(v, o);
    return v;
}
#define LDS_WAIT() asm volatile("s_waitcnt lgkmcnt(0)" ::: "memory")

__device__ __forceinline__ void p0_transpose_item(const float* W, int K, int N, bf16* WT, int k0, int n0, int prow0, const float* gk, LAS float* scr, int lane) {
#pragma unroll 8
    for (int i = 0; i < 32; ++i) { const int kk = 2 * i + (lane >> 5); float w = W[(size_t)(k0 + kk) * N + n0 + (lane & 31)]; if (gk) w *= gk[k0 + kk]; scr[kk * 33 + (lane & 31)] = w; }
    LDS_WAIT(); asm volatile("" ::: "memory");
    const int c = lane & 7;
#pragma unroll
    for (int j = 0; j < 4; ++j) { const int n = (lane >> 3) + 8 * j; const LAS float* s = scr + (8 * c) * 33 + n;
        v4u o; o.x = pk2(s[0 * 33], s[1 * 33]); o.y = pk2(s[2 * 33], s[3 * 33]); o.z = pk2(s[4 * 33], s[5 * 33]); o.w = pk2(s[6 * 33], s[7 * 33]);
        *(v4u*)(WT + (size_t)(prow0 + n) * K + k0 + 8 * c) = o; }
    LDS_WAIT(); asm volatile("" ::: "memory");
}
__host__ __device__ __forceinline__ int map_in(int n) { const int T = n >> 8, nn = n & 255; return 256 * T + 128 * ((nn >> 5) & 1) + 32 * (nn >> 6) + (nn & 31); }
__host__ __device__ __forceinline__ int map_fin(int n) { return n < DFF ? 256 * (n >> 7) + (n & 127) : 256 * ((n - DFF) >> 7) + 128 + ((n - DFF) & 127); }

struct Args { const float* in[15]; float* out; unsigned char* ws; };

__device__ __forceinline__ void prologue(const Args& a, LAS unsigned char* lds, int wave, int lane) {
    LAS float* scr = (LAS float*)(lds + wave * 16384);
    const int gw = blockIdx.x * NWAVES + wave, NGW = gridDim.x * NWAVES;
    constexpr int I_IN = (DM / 64) * (NIN / 32), I_OUT = (DM / 64) * (DM / 32), I_FIN = (DM / 64) * (NFF2 / 32), I_FOUT = (DFF / 64) * (DM / 32);
    constexpr int I_LAYER = I_IN + I_OUT + I_FIN + I_FOUT;
    for (int it = gw; it < DEPTH * I_LAYER; it += NGW) {
        const int l = it / I_LAYER; int r = it % I_LAYER;
        unsigned char* wb = a.ws + WS_W0 + (size_t)l * WS_WSTRIDE;
        if (r < I_IN) { const int nblk = NIN / 32, kb = r / nblk, nb = r % nblk;
            p0_transpose_item(a.in[2] + (size_t)l * DM * NIN, DM, NIN, (bf16*)(wb + WOFF_IN), 64 * kb, 32 * nb, map_in(32 * nb), a.in[1] + l * DM, scr, lane); continue; } r -= I_IN;
        if (r < I_OUT) { const int nblk = DM / 32, kb = r / nblk, nb = r % nblk;
            p0_transpose_item(a.in[11] + (size_t)l * DM * DM, DM, DM, (bf16*)(wb + WOFF_OUT), 64 * kb, 32 * nb, 32 * nb, nullptr, scr, lane); continue; } r -= I_OUT;
        if (r < I_FIN) { const int nblk = NFF2 / 32, kb = r / nblk, nb = r % nblk;
            p0_transpose_item(a.in[13] + (size_t)l * DM * NFF2, DM, NFF2, (bf16*)(wb + WOFF_FIN), 64 * kb, 32 * nb, map_fin(32 * nb), a.in[12] + l * DM, scr, lane); continue; } r -= I_FIN;
        { const int nblk = DM / 32, kb = r / nblk, nb = r % nblk;
            p0_transpose_item(a.in[14] + (size_t)l * DFF * DM, DFF, DM, (bf16*)(wb + WOFF_FOUT), 64 * kb, 32 * nb, 32 * nb, nullptr, scr, lane); }
    }
    float* rowss = (float*)(a.ws + WS_ROWSS); bf16* xb = (bf16*)(a.ws + WS_XB);
    for (int m = gw; m < M; m += NGW) {
        const f32x4* xr = (const f32x4*)(a.in[0] + (size_t)m * DM) + lane; f32x4* orow = (f32x4*)(a.out + (size_t)m * DM) + lane;
        unsigned long long* o8 = (unsigned long long*)(xb + (size_t)m * DM) + lane;
        float s = 0.f;
#pragma unroll
        for (int j = 0; j < 4; ++j) { const f32x4 v = xr[64 * j]; s += (v.x * v.x + v.y * v.y) + (v.z * v.z + v.w * v.w); orow[64 * j] = v;
            o8[64 * j] = (unsigned long long)pk2(v.x, v.y) | ((unsigned long long)pk2(v.z, v.w) << 32); }
        s = wave_sum(s);
        if (lane < 16) rowss[(size_t)m * 16 + lane] = lane == 0 ? s : 0.f;
    }
    { const float* wsp = a.in[7]; bf16* o = (bf16*)(a.ws + WS_WSP); const int gt = blockIdx.x * 512 + threadIdx.x, NT = gridDim.x * 512;
      for (int i = gt; i < DEPTH * 8 * 128 * 128; i += NT) { const int s = i & 127, t = (i >> 7) & 127; o[i] = (bf16)(((t >> 6) >= (s >> 6)) ? f2bf(wsp[i]) : 0u); } }
}

__device__ __forceinline__ void mixer_naive(const Args& a, int l, LAS unsigned char* lds, int wave, int lane) {
    const bf16* P = (const bf16*)(a.ws + WS_PROJ); bf16* MIX = (bf16*)(a.ws + WS_MIX);
    const float* vgss = (const float*)(a.ws + WS_VGSS); const bf16* wsp = (const bf16*)(a.ws + WS_WSP) + (size_t)l * 8 * 128 * 128;
    const float* rel = a.in[5] + (size_t)l * 8 * 257; const float* sgu_g = a.in[6] + l * 512; const float* bsp = a.in[8] + l * 8 * 128;
    const float* ag = a.in[9] + l * 512; const float* gg = a.in[10] + l * 512;
    LAS float* red = (LAS float*)lds;
    for (int tok = blockIdx.x; tok < M; tok += gridDim.x) {
        const int b = tok / SEQ, t = tok % SEQ, c = t >> 6;
        const int h = wave;
        const float q = bf2f(P[(size_t)tok * NIN + h * 64 + lane]);
        float mx = -INFINITY, lsum = 0.f, o = 0.f;
        const int k0 = (c >= 8 ? c - 8 : 0) * 64, k1 = c * 64 + 63;
        for (int kt = k0; kt <= k1; ++kt) {
            const size_t kr = (size_t)(b * SEQ + kt) * NIN;
            float s = wave_sum(q * bf2f(P[kr + 512 + h * 64 + lane]));
            int d = t - kt; d = d < -128 ? -128 : (d > 128 ? 128 : d);
            s += rel[h * 257 + d + 128] * pg8::LOG2E;
            const float mn = fmaxf(mx, s), al = __builtin_amdgcn_exp2f(mx - mn), p = __builtin_amdgcn_exp2f(s - mn);
            lsum = lsum * al + p; o = o * al + p * bf2f(P[kr + 1024 + h * 64 + lane]); mx = mn;
        }
        o = o / lsum;
        const int g = wave, nb = t >> 7, tp = t & 127, ns = tp < 64 ? 64 : 128;
        float mixd = 0.f;
        for (int s = 0; s < ns; ++s) {
            const int srow = b * SEQ + nb * 128 + s;
            const f32x4* pv = (const f32x4*)(vgss + (size_t)srow * 8); const f32x4 p0 = pv[0], p1 = pv[1];
            const float rs = __builtin_amdgcn_rsqf((((p0[0] + p0[1]) + (p0[2] + p0[3])) + ((p1[0] + p1[1]) + (p1[2] + p1[3]))) * (1.0f / 512.0f) + pg8::RMS_EPS);
            mixd += bf2f(wsp[(g * 128 + tp) * 128 + s]) * (bf2f(P[(size_t)srow * NIN + 2048 + g * 64 + lane]) * rs * sgu_g[g * 64 + lane]);
        }
        const float gv = bf2f(P[(size_t)tok * NIN + 1536 + g * 64 + lane]) * (mixd + bsp[g * 128 + tp]);
        const float so = wave_sum(o * o), sg = wave_sum(gv * gv);
        __syncthreads();
        if (lane == 0) { red[wave] = so; red[8 + wave] = sg; }
        __syncthreads();
        float ta = 0.f, tg = 0.f;
#pragma unroll
        for (int w = 0; w < 8; ++w) { ta += red[w]; tg += red[8 + w]; }
        const float ra = __builtin_amdgcn_rsqf(ta * (1.0f / 512.0f) + pg8::RMS_EPS), rg = __builtin_amdgcn_rsqf(tg * (1.0f / 512.0f) + pg8::RMS_EPS);
        MIX[(size_t)tok * DM + h * 64 + lane] = (bf16)f2bf(o * ra * ag[h * 64 + lane]);
        MIX[(size_t)tok * DM + 512 + g * 64 + lane] = (bf16)f2bf(gv * rg * gg[g * 64 + lane]);
    }
    __syncthreads();
}

#ifndef PHM
#define PHM 31
#endif
#ifndef FAST_MIXER
#define FAST_MIXER 0
#endif

__global__ void __launch_bounds__(NWAVES * 64, 2) fwd_megakernel(Args a) {
    extern __shared__ __attribute__((aligned(16))) unsigned char lds_raw[];
    LAS unsigned char* lds = (LAS unsigned char*)lds_raw;
    cg::grid_group grid = cg::this_grid();
    const int tid = threadIdx.x, lane = tid & 63, wave = __builtin_amdgcn_readfirstlane(tid >> 6);
    const int G = gridDim.x, bx = blockIdx.x;
    prologue(a, lds, wave, lane);
    grid.sync();
    float* rowss = (float*)(a.ws + WS_ROWSS); float* vgss = (float*)(a.ws + WS_VGSS);
    bf16* xb = (bf16*)(a.ws + WS_XB); bf16* proj = (bf16*)(a.ws + WS_PROJ); bf16* mix = (bf16*)(a.ws + WS_MIX); bf16* hid = (bf16*)(a.ws + WS_HID);
#pragma nounroll
    for (int l = 0; l < DEPTH; ++l) {
        unsigned char* wb = a.ws + WS_W0 + (size_t)l * WS_WSTRIDE;
#if PHM & 1
        {
            pg8::Gemm g{xb, (const bf16*)(wb + WOFF_IN), M, NIN, DM}; pg8::StaticOrder S; S.init(M, NIN, G, bx);
            pg8::EpiInProj E{proj, rowss, vgss, a.in[3] + l * 64, a.in[4] + l * 64};
            pg8::gemm_phase<pg8::EpiInProj, pg8::StaticOrder, true, true>(lds, g, S, E);
        }
#endif
        grid.sync();
#if PHM & 2
        mixer_naive(a, l, lds, wave, lane);
#endif
        grid.sync();
#if PHM & 4
        {
            pg8::Gemm g{mix, (const bf16*)(wb + WOFF_OUT), M, DM, DM}; pg8::StaticOrder S; S.init(M, DM, G, bx);
            pg8::EpiResid E{a.out, a.out, xb, rowss};
            pg8::gemm_phase<pg8::EpiResid, pg8::StaticOrder, true, true>(lds, g, S, E);
        }
#endif
        grid.sync();
#if PHM & 8
        {
            pg8::Gemm g{xb, (const bf16*)(wb + WOFF_FIN), M, NFF2, DM}; pg8::StaticOrder S; S.init(M, NFF2, G, bx);
            pg8::EpiSwiGLU E{hid, rowss};
            pg8::gemm_phase<pg8::EpiSwiGLU, pg8::StaticOrder, true, true>(lds, g, S, E);
        }
#endif
        grid.sync();
#if PHM & 16
        {
            pg8::Gemm g{hid, (const bf16*)(wb + WOFF_FOUT), M, DM, DFF}; pg8::StaticOrder S; S.init(M, DM, G, bx);
            pg8::EpiResid E{a.out, a.out, xb, rowss};
            pg8::gemm_phase<pg8::EpiResid, pg8::StaticOrder, true, true>(lds, g, S, E);
        }
#endif
        if (l + 1 < DEPTH) grid.sync();
    }
}

extern "C" void kernel_launch(void* const* d_in, const int* in_sizes, int n_in, void* d_out, int out_size, void* d_ws, size_t ws_size, hipStream_t stream) {
    static int grid = 0;
    if (grid == 0) {
        if (n_in != 15 || in_sizes[0] != M * DM || out_size != M * DM || ws_size < WS_END) { fprintf(stderr, "kernel_launch: unexpected shapes (n_in %d, ws %zu)\n", n_in, ws_size); grid = -1; return; }
        int dev = 0, cus = 0, per_cu = 0;
        hipGetDevice(&dev); hipDeviceGetAttribute(&cus, hipDeviceAttributeMultiprocessorCount, dev);
        if (hipFuncSetAttribute((const void*)fwd_megakernel, hipFuncAttributeMaxDynamicSharedMemorySize, LDS_BYTES) != hipSuccess) { fprintf(stderr, "kernel_launch: hipFuncSetAttribute failed\n"); grid = -1; return; }
        if (hipOccupancyMaxActiveBlocksPerMultiprocessor(&per_cu, (const void*)fwd_megakernel, NWAVES * 64, LDS_BYTES) != hipSuccess || per_cu < 1) { fprintf(stderr, "kernel_launch: occupancy query failed (%d)\n", per_cu); (void)hipGetLastError(); per_cu = 1; }
        grid = cus * (per_cu > 1 ? 1 : per_cu);
    }
    if (grid < 0) return;
    Args a{};
    for (int i = 0; i < 15; ++i) a.in[i] = (const float*)d_in[i];
    a.out = (float*)d_out; a.ws = (unsigned char*)d_ws;
    void* args[] = {&a};
    hipError_t e = hipLaunchCooperativeKernel((const void*)fwd_megakernel, dim3(grid), dim3(NWAVES * 64), args, LDS_BYTES, stream);
    if (e != hipSuccess) fprintf(stderr, "cooperative launch failed: %s (grid %d)\n", hipGetErrorString(e), grid);
}
```

```cpp
#include <hip/hip_runtime.h>
#include <hip/hip_cooperative_groups.h>
#include <cstdio>
#include <cstdint>
namespace cg = cooperative_groups;
namespace pg8 {
#define PG8_LAS __attribute__((address_space(3)))
typedef unsigned short bf16_t;
typedef short bf16x8 __attribute__((ext_vector_type(8)));
typedef float f32x4 __attribute__((ext_vector_type(4)));
typedef unsigned u32x4 __attribute__((ext_vector_type(4)));
constexpr int BM = 256, BK = 64, HALF = 128, HTB = HALF * BK * 2  , STAGE_BYTES = 8 * HTB, NXCD = 8, WGM = 8;

__host__ __device__ __forceinline__ int lds_byte(int r, int c) { const int st = (r >> 4) * 2 + (c >> 5), rr = r & 15, cc = c & 31, ob = rr * 64 + cc * 2; return st * 1024 + (ob ^ (((ob >> 9) & 1) << 5)); }
__host__ __device__ __forceinline__ void stage_rc(int b, int& R, int& C) { const int st = b / 1024, sb = b % 1024, swz = sb ^ (((sb >> 9) & 1) << 5); R = (st >> 1) * 16 + swz / 64; C = (st & 1) * 32 + (swz % 64) / 2; }
__host__ __device__ __forceinline__ int perm32(int rho) { const int n = rho >> 4, i = rho & 15; return 8 * (i >> 2) + 4 * n + (i & 3); }

struct Unit { int pm, pn; };
struct Gemm { const bf16_t* A; const bf16_t* Bt; int M, N, K; };

struct StaticOrder {
    int nM, nN, nwg, G, c;
    __host__ __device__ void init(int M, int N, int G_, int c_) { nM = M / BM; nN = N / BM; nwg = nM * nN; G = G_; c = c_; }
    __host__ __device__ bool next(int i, Unit& u) const {
        const long L = (long)i * G + c; if (L >= nwg) return false;
        int wgid = (int)L; { const int q = nwg / NXCD, r = nwg % NXCD, xcd = wgid % NXCD, off = wgid / NXCD; wgid = (xcd < r ? xcd * (q + 1) : r * (q + 1) + (xcd - r) * q) + off; }
        const int nig = WGM * nN, gid = wgid / nig, fm = gid * WGM, gsz = (nM - fm) < WGM ? (nM - fm) : WGM;
        u.pm = fm + ((wgid % nig) % gsz); u.pn = (wgid % nig) / gsz; return true;
    }
    __device__ __forceinline__ void a_ready(const Unit&) const {}
    __device__ __forceinline__ void done(const Unit&) const {}
};

__device__ __forceinline__ unsigned cvt_pk_bf16(float lo, float hi) { unsigned r; asm volatile("v_cvt_pk_bf16_f32 %0, %1, %2" : "=v"(r) : "v"(lo), "v"(hi)); return r; }
typedef float f32x2 __attribute__((ext_vector_type(2)));
constexpr float RMS_EPS = 1e-6f;
constexpr float LOG2E = 1.4426950408889634f;
constexpr float QSCALE = 0.125f * 1.4426950408889634f;
__device__ __forceinline__ float gelu_tanh(float x) {
    const float z2 = x * (1.5957691216057308f + 0.07135481627260025f * x * x);
    const float e = __builtin_amdgcn_exp2f(-LOG2E * z2);
    return x * __builtin_amdgcn_rcpf(1.0f + e);
}
__device__ __forceinline__ float row_rs(const float* rowss, int row) {
    const f32x4* pr = (const f32x4*)(rowss + (size_t)row * 16);
    const f32x4 a = pr[0], b = pr[1], c = pr[2], d = pr[3];
    const float ss = ((a[0] + a[1]) + (a[2] + a[3])) + ((b[0] + b[1]) + (b[2] + b[3])) + ((c[0] + c[1]) + (c[2] + c[3])) + ((d[0] + d[1]) + (d[2] + d[3]));
    return __builtin_amdgcn_rsqf(ss * (1.0f / 1024.0f) + RMS_EPS);
}
struct EpiInProj {
    static constexpr bool PERM = true, AFTER_DRAIN = false;
    bf16_t* P; const float* rowss; float* vgss; const float* qg; const float* kg;
    __device__ __forceinline__ void operator()(const f32x4 (&acc)[2][2][4][2], const Unit& u, int wr, int wc, int fr, int fq) const {
        const int region = u.pn >> 1, half = u.pn & 1;
        const int lcol = region * 512 + half * 256 + wc * 64 + fq * 8;
        float gq[2][8];
#pragma unroll
        for (int bj = 0; bj < 2; ++bj)
#pragma unroll
            for (int e = 0; e < 8; ++e) gq[bj][e] = 1.f;
        if (region < 2) { const float* g = region == 0 ? qg : kg; const float sc = region == 0 ? QSCALE : 1.f;
#pragma unroll
            for (int bj = 0; bj < 2; ++bj)
#pragma unroll
                for (int e = 0; e < 8; ++e) gq[bj][e] = g[bj * 32 + fq * 8 + e] * sc; }
#pragma unroll
        for (int ai = 0; ai < 2; ++ai)
#pragma unroll
            for (int m = 0; m < 4; ++m) {
                const int row = u.pm * BM + ai * HALF + wr * 64 + m * 16 + fr;
                const float s = row_rs(rowss, row);
                float v[2][8];
#pragma unroll
                for (int bj = 0; bj < 2; ++bj)
#pragma unroll
                    for (int n = 0; n < 2; ++n)
#pragma unroll
                        for (int i = 0; i < 4; ++i) v[bj][4 * n + i] = acc[ai][bj][m][n][i] * s;
                if (region < 2) {
                    float q = 0.f;
#pragma unroll
                    for (int bj = 0; bj < 2; ++bj)
#pragma unroll
                        for (int e = 0; e < 8; ++e) q += v[bj][e] * v[bj][e];
                    q += __shfl_xor(q, 16); q += __shfl_xor(q, 32);
                    const float r = __builtin_amdgcn_rsqf(q * (1.0f / 64.0f) + RMS_EPS);
#pragma unroll
                    for (int bj = 0; bj < 2; ++bj)
#pragma unroll
                        for (int e = 0; e < 8; ++e) v[bj][e] = v[bj][e] * r * gq[bj][e];
                } else if (region >= 3) {
#pragma unroll
                    for (int bj = 0; bj < 2; ++bj)
#pragma unroll
                        for (int e = 0; e < 8; ++e) v[bj][e] = gelu_tanh(v[bj][e]);
                    if (region == 4) {
                        float q = 0.f;
#pragma unroll
                        for (int bj = 0; bj < 2; ++bj)
#pragma unroll
                            for (int e = 0; e < 8; ++e) q += v[bj][e] * v[bj][e];
                        q += __shfl_xor(q, 16); q += __shfl_xor(q, 32);
                        if (fq == 0) vgss[(size_t)row * 8 + half * 4 + wc] = q;
                    }
                }
                bf16_t* rowp = P + (size_t)row * 2560 + lcol;
#pragma unroll
                for (int bj = 0; bj < 2; ++bj) { u32x4 w; w.x = cvt_pk_bf16(v[bj][0], v[bj][1]); w.y = cvt_pk_bf16(v[bj][2], v[bj][3]); w.z = cvt_pk_bf16(v[bj][4], v[bj][5]); w.w = cvt_pk_bf16(v[bj][6], v[bj][7]);
                    *(u32x4*)(rowp + bj * 32) = w; }
            }
    }
};
struct EpiResid {
    static constexpr bool PERM = true, AFTER_DRAIN = false;
    const float* base; float* out; bf16_t* xb; float* rowss;
    __device__ __forceinline__ void operator()(const f32x4 (&acc)[2][2][4][2], const Unit& u, int wr, int wc, int fr, int fq) const {
        const int col0 = u.pn * BM + wc * 32 + 8 * fq;
#pragma unroll
        for (int ai = 0; ai < 2; ++ai)
#pragma unroll
            for (int m = 0; m < 4; ++m) {
                const int row = u.pm * BM + ai * HALF + wr * 64 + m * 16 + fr;
                const size_t off = (size_t)row * 1024 + col0;
                float q = 0.f;
#pragma unroll
                for (int bj = 0; bj < 2; ++bj) {
                    const f32x4 b0 = *(const f32x4*)(base + off + bj * HALF), b1 = *(const f32x4*)(base + off + bj * HALF + 4);
                    const f32x4 v0 = acc[ai][bj][m][0] + b0, v1 = acc[ai][bj][m][1] + b1;
                    *(f32x4*)(out + off + bj * HALF) = v0; *(f32x4*)(out + off + bj * HALF + 4) = v1;
                    u32x4 w; w.x = cvt_pk_bf16(v0[0], v0[1]); w.y = cvt_pk_bf16(v0[2], v0[3]); w.z = cvt_pk_bf16(v1[0], v1[1]); w.w = cvt_pk_bf16(v1[2], v1[3]);
                    *(u32x4*)(xb + off + bj * HALF) = w;
                    q += (v0[0] * v0[0] + v0[1] * v0[1]) + (v0[2] * v0[2] + v0[3] * v0[3]) + (v1[0] * v1[0] + v1[1] * v1[1]) + (v1[2] * v1[2] + v1[3] * v1[3]);
                }
                q += __shfl_xor(q, 16); q += __shfl_xor(q, 32);
                if (fq == 0) rowss[(size_t)row * 16 + u.pn * 4 + wc] = q;
            }
    }
};
struct EpiSwiGLU {
    static constexpr bool PERM = true, AFTER_DRAIN = false;
    bf16_t* H; const float* rowss;
    __device__ __forceinline__ void operator()(const f32x4 (&acc)[2][2][4][2], const Unit& u, int wr, int wc, int fr, int fq) const {
        const int col0 = u.pn * 128 + wc * 32 + 8 * fq;
#pragma unroll
        for (int ai = 0; ai < 2; ++ai)
#pragma unroll
            for (int m = 0; m < 4; ++m) {
                const int row = u.pm * BM + ai * HALF + wr * 64 + m * 16 + fr;
                const float s = row_rs(rowss, row);
                float h[8];
#pragma unroll
                for (int n = 0; n < 2; ++n)
#pragma unroll
                    for (int i = 0; i < 4; ++i) { const float g = acc[ai][0][m][n][i] * s, up = acc[ai][1][m][n][i] * s;
                        h[4 * n + i] = g * __builtin_amdgcn_rcpf(1.0f + __builtin_amdgcn_exp2f(-LOG2E * g)) * up; }
                u32x4 w; w.x = cvt_pk_bf16(h[0], h[1]); w.y = cvt_pk_bf16(h[2], h[3]); w.z = cvt_pk_bf16(h[4], h[5]); w.w = cvt_pk_bf16(h[6], h[7]);
                *(u32x4*)(H + (size_t)row * 2816 + col0) = w;
            }
    }
};
template <class Epi, class Sched, bool ALIGN_EPI = false, bool SP2 = false>
__device__ __forceinline__ void gemm_phase(PG8_LAS unsigned char* lds, const Gemm g, const Sched& S, const Epi& E) {
    int tid_l = threadIdx.x; asm volatile("" : "+v"(tid_l));
    const int tid = tid_l, wid = __builtin_amdgcn_readfirstlane(tid >> 6), lane = tid & 63, wr = wid >> 2, wc = wid & 3, fr = lane & 15, fq = lane >> 4;
    const int K = g.K, nt = K / BK;
    unsigned voffA[2], voffB[2];
#pragma unroll
    for (int i = 0; i < 2; ++i) { int R, C; stage_rc(tid * 16 + i * 8192, R, C); const int Rb = Epi::PERM ? ((R & ~31) + perm32(R & 31)) : R;
        voffA[i] = (unsigned)(R * K + C) * 2u; voffB[i] = (unsigned)(Rb * K + C) * 2u; }
    const size_t kstep = (size_t)(BK * 2);
    const size_t hstep = (size_t)HALF * K * 2;
    const size_t tstep = 2 * hstep;
    const unsigned ldsw = (unsigned)wid * 1024u;
    const int aoff = lds_byte(wr * 64 + fr, fq * 8), boff = lds_byte(wc * 32 + fr, fq * 8);
#define PG8_SA(b, h) (((b) * 2 + (h)) * HTB)
#define PG8_SB(b, h) ((4 + (b) * 2 + (h)) * HTB)
#define PG8_STAGE(bufoff, gbase, voff) do { _Pragma("unroll") for (int _i = 0; _i < 2; ++_i) \
        __builtin_amdgcn_global_load_lds((const unsigned*)((const char*)(gbase) + (voff)[_i]), (PG8_LAS unsigned*)(lds + (bufoff) + ldsw + _i * 8192), 16, 0, 0); } while (0)
#define PG8_LDA(dst, b, h) do { _Pragma("unroll") for (int m = 0; m < 4; ++m) _Pragma("unroll") for (int k = 0; k < 2; ++k) dst[m][k] = *(const PG8_LAS bf16x8*)(lds + PG8_SA(b, h) + aoff + m * 2048 + k * 1024); } while (0)
#define PG8_LDB(dst, b, h) do { _Pragma("unroll") for (int n = 0; n < 2; ++n) _Pragma("unroll") for (int k = 0; k < 2; ++k) dst[n][k] = *(const PG8_LAS bf16x8*)(lds + PG8_SB(b, h) + boff + n * 2048 + k * 1024); } while (0)
#define PG8_MMA(ai, bj, At, Bt) do { __builtin_amdgcn_s_setprio(1); _Pragma("unroll") for (int m = 0; m < 4; ++m) _Pragma("unroll") for (int n = 0; n < 2; ++n) _Pragma("unroll") for (int k = 0; k < 2; ++k) \
        acc[ai][bj][m][n] = __builtin_amdgcn_mfma_f32_16x16x32_bf16(Bt[n][k], At[m][k], acc[ai][bj][m][n], 0, 0, 0); __builtin_amdgcn_s_setprio(0); } while (0)
#define PG8_WAIT_V(n) asm volatile("s_waitcnt vmcnt(" #n ")" ::: "memory")
#define PG8_WAIT_L(n) asm volatile("s_waitcnt lgkmcnt(" #n ")" ::: "memory")
#define PG8_BAR __builtin_amdgcn_s_barrier()
#define PG8_SCHED __builtin_amdgcn_sched_barrier(0)
    Unit cur, nxt; int ui = 0;
    if (!S.next(0, cur)) return;
    f32x4 acc[2][2][4][2];
#pragma unroll
    for (int a = 0; a < 2; ++a)
#pragma unroll
        for (int b = 0; b < 2; ++b)
#pragma unroll
            for (int m = 0; m < 4; ++m)
#pragma unroll
                for (int n = 0; n < 2; ++n) acc[a][b][m][n] = (f32x4){0.f, 0.f, 0.f, 0.f};
    bf16x8 At[4][2], B0[2][2], B1[2][2];
    const char* cA = (const char*)g.A + (size_t)cur.pm * tstep; const char* cB = (const char*)g.Bt + (size_t)cur.pn * tstep;
    S.a_ready(cur);
    if constexpr (SP2) {
        PG8_STAGE(PG8_SB(0, 0), cB, voffB); PG8_STAGE(PG8_SB(0, 1), cB + hstep, voffB); PG8_STAGE(PG8_SA(0, 0), cA, voffA); PG8_STAGE(PG8_SA(0, 1), cA + hstep, voffA);
        if (wr == 1) PG8_BAR;
        PG8_WAIT_V(2); PG8_BAR;
        PG8_STAGE(PG8_SB(1, 0), cB + kstep, voffB); PG8_STAGE(PG8_SA(1, 0), cA + kstep, voffA); PG8_STAGE(PG8_SB(1, 1), cB + hstep + kstep, voffB);
        PG8_WAIT_V(6); PG8_BAR;
    } else {
        PG8_STAGE(PG8_SB(0, 0), cB, voffB); PG8_STAGE(PG8_SA(0, 0), cA, voffA); PG8_STAGE(PG8_SB(0, 1), cB + hstep, voffB); PG8_STAGE(PG8_SA(0, 1), cA + hstep, voffA);
        if (wr == 1) PG8_BAR;
        PG8_WAIT_V(4); PG8_BAR;
        PG8_STAGE(PG8_SB(1, 0), cB + kstep, voffB); PG8_STAGE(PG8_SA(1, 0), cA + kstep, voffA); PG8_STAGE(PG8_SB(1, 1), cB + hstep + kstep, voffB);
        PG8_WAIT_V(6); PG8_BAR;
    }
    for (;;) {
        const bool has_next = S.next(ui + 1, nxt);
        const char* nA = has_next ? (const char*)g.A + (size_t)nxt.pm * tstep : cA; const char* nB = has_next ? (const char*)g.Bt + (size_t)nxt.pn * tstep : cB;
        for (int t = 0; t < nt; t += 2) {
            const bool last = (t == nt - 2);
            const char* a1 = cA + (size_t)(t + 1) * kstep;
            const char* a2 = last ? nA : cA + (size_t)(t + 2) * kstep; const char* b2 = last ? nB : cB + (size_t)(t + 2) * kstep;
            const char* a3 = a2 + kstep; const char* b3 = b2 + kstep;
            if (last && has_next) S.a_ready(nxt);
            if constexpr (SP2) {
            PG8_LDB(B0, 0, 0); PG8_LDB(B1, 0, 1); PG8_SCHED; PG8_LDA(At, 0, 0); PG8_STAGE(PG8_SA(1, 1), a1 + hstep, voffA);
            PG8_WAIT_V(8); PG8_WAIT_L(0); PG8_BAR; PG8_MMA(0, 0, At, B0); PG8_MMA(0, 1, At, B1); PG8_BAR; PG8_SCHED;
            PG8_LDA(At, 0, 1); PG8_STAGE(PG8_SB(0, 0), b2, voffB); PG8_STAGE(PG8_SB(0, 1), b2 + hstep, voffB); PG8_STAGE(PG8_SA(0, 0), a2, voffA);
            PG8_WAIT_V(8); PG8_WAIT_L(0); PG8_BAR; PG8_MMA(1, 0, At, B0); PG8_MMA(1, 1, At, B1); PG8_BAR; PG8_SCHED;
            PG8_LDB(B0, 1, 0); PG8_LDB(B1, 1, 1); PG8_SCHED; PG8_LDA(At, 1, 0); PG8_STAGE(PG8_SA(0, 1), a2 + hstep, voffA);
            PG8_WAIT_V(8); PG8_WAIT_L(0); PG8_BAR; PG8_MMA(0, 0, At, B0); PG8_MMA(0, 1, At, B1); PG8_BAR; PG8_SCHED;
            PG8_LDA(At, 1, 1); PG8_STAGE(PG8_SB(1, 0), b3, voffB); PG8_STAGE(PG8_SB(1, 1), b3 + hstep, voffB); PG8_STAGE(PG8_SA(1, 0), a3, voffA);
            PG8_WAIT_V(8); PG8_WAIT_L(0); PG8_BAR; PG8_MMA(1, 0, At, B0); PG8_MMA(1, 1, At, B1); PG8_BAR; PG8_SCHED;
            } else {
            PG8_LDB(B0, 0, 0); PG8_SCHED; PG8_LDA(At, 0, 0); PG8_STAGE(PG8_SA(1, 1), a1 + hstep, voffA);
            PG8_WAIT_L(8); PG8_BAR; PG8_WAIT_L(0); PG8_MMA(0, 0, At, B0); PG8_BAR; PG8_SCHED;
            PG8_LDB(B1, 0, 1); PG8_STAGE(PG8_SB(0, 0), b2, voffB);
            PG8_BAR; PG8_WAIT_L(0); PG8_MMA(0, 1, At, B1); PG8_BAR;
            PG8_LDA(At, 0, 1); PG8_STAGE(PG8_SA(0, 0), a2, voffA);
            PG8_BAR; PG8_WAIT_L(0); PG8_MMA(1, 0, At, B0); PG8_BAR; PG8_SCHED;
            PG8_STAGE(PG8_SB(0, 1), b2 + hstep, voffB);
            PG8_WAIT_V(6); PG8_BAR; PG8_MMA(1, 1, At, B1); PG8_BAR;
            PG8_LDB(B0, 1, 0); PG8_SCHED; PG8_LDA(At, 1, 0); PG8_STAGE(PG8_SA(0, 1), a2 + hstep, voffA);
            PG8_WAIT_L(8); PG8_BAR; PG8_WAIT_L(0); PG8_MMA(0, 0, At, B0); PG8_BAR; PG8_SCHED;
            PG8_LDB(B1, 1, 1); PG8_STAGE(PG8_SB(1, 0), b3, voffB);
            PG8_BAR; PG8_WAIT_L(0); PG8_MMA(0, 1, At, B1); PG8_BAR;
            PG8_LDA(At, 1, 1); PG8_STAGE(PG8_SA(1, 0), a3, voffA);
            PG8_BAR; PG8_WAIT_L(0); PG8_MMA(1, 0, At, B0); PG8_BAR; PG8_SCHED;
            PG8_STAGE(PG8_SB(1, 1), b3 + hstep, voffB);
            PG8_WAIT_V(6); PG8_BAR; PG8_MMA(1, 1, At, B1); PG8_BAR;
            }
        }
        if constexpr (ALIGN_EPI) { if (wr == 0) PG8_BAR; }
        if constexpr (!Epi::AFTER_DRAIN) { E(acc, cur, wr, wc, fr, fq); S.done(cur); }
        if (!has_next) break;
#pragma unroll
        for (int a = 0; a < 2; ++a)
#pragma unroll
            for (int b = 0; b < 2; ++b)
#pragma unroll
                for (int m = 0; m < 4; ++m)
#pragma unroll
                    for (int n = 0; n < 2; ++n) acc[a][b][m][n] = (f32x4){0.f, 0.f, 0.f, 0.f};
        cur = nxt; cA = nA; cB = nB; ++ui;
        if constexpr (ALIGN_EPI) { if (wr == 1) PG8_BAR; }
    }
    PG8_WAIT_V(0);
    if constexpr (!ALIGN_EPI) { if (wr == 0) PG8_BAR; }
    PG8_BAR;
    if constexpr (Epi::AFTER_DRAIN) { E.fused(acc, cur, wr, wc, fr, fq, lds, wid, lane); S.done(cur); }
#undef PG8_SA
#undef PG8_SB
#undef PG8_STAGE
#undef PG8_LDA
#undef PG8_LDB
#undef PG8_MMA
#undef PG8_WAIT_V
#undef PG8_WAIT_L
#undef PG8_BAR
#undef PG8_SCHED
}
}
constexpr int NB = 8, SEQ = 2048, DM = 1024, M = NB * SEQ, NIN = 2560, DFF = 2816, NFF2 = 2 * DFF, DEPTH = 2;
constexpr int NWAVES = 8;
constexpr size_t MiB = 1u << 20;
constexpr size_t WS_ROWSS = 1 * MiB;
constexpr size_t WS_VGSS = 2 * MiB;
constexpr size_t WS_WSP = 3 * MiB;
constexpr size_t WS_W0 = 4 * MiB, WS_WSTRIDE = 24 * MiB;
constexpr size_t WOFF_IN = 0, WOFF_OUT = 5 * MiB, WOFF_FIN = 7 * MiB, WOFF_FOUT = 18 * MiB;
constexpr size_t WS_XB = 52 * MiB;
constexpr size_t WS_PROJ = 84 * MiB;
constexpr size_t WS_MIX = 164 * MiB;
constexpr size_t WS_HID = 84 * MiB;
constexpr size_t WS_END = 196 * MiB;
constexpr int LDS_BYTES = 147456;

#define GAS __attribute__((address_space(1)))
#define LAS __attribute__((address_space(3)))
typedef unsigned short bf16;
typedef unsigned v4u __attribute__((ext_vector_type(4)));
typedef float f32x4 __attribute__((ext_vector_type(4)));
__device__ __forceinline__ unsigned f2bf(float f) { unsigned u = __builtin_bit_cast(unsigned, f); return (u + 0x7fffu + ((u >> 16) & 1u)) >> 16; }
__device__ __forceinline__ unsigned pk2(float lo, float hi) { return f2bf(lo) | (f2bf(hi) << 16); }
__device__ __forceinline__ float bf2f(bf16 v) { return __builtin_bit_cast(float, (unsigned)v << 16); }
__device__ __forceinline__ float wave_sum(float v) {
#pragma unroll
    for (int o = 1; o < 64; o <<= 1) v += __shfl_xor(v, o);
    return v;
}
#define LDS_WAIT() asm volatile("s_waitcnt lgkmcnt(0)" ::: "memory")

__device__ __forceinline__ void p0_transpose_item(const float* W, int K, int N, bf16* WT, int k0, int n0, int prow0, const float* gk, LAS float* scr, int lane) {
#pragma unroll 8
    for (int i = 0; i < 32; ++i) { const int kk = 2 * i + (lane >> 5); float w = W[(size_t)(k0 + kk) * N + n0 + (lane & 31)]; if (gk) w *= gk[k0 + kk]; scr[kk * 33 + (lane & 31)] = w; }
    LDS_WAIT(); asm volatile("" ::: "memory");
    const int c = lane & 7;
#pragma unroll
    for (int j = 0; j < 4; ++j) { const int n = (lane >> 3) + 8 * j; const LAS float* s = scr + (8 * c) * 33 + n;
        v4u o; o.x = pk2(s[0 * 33], s[1 * 33]); o.y = pk2(s[2 * 33], s[3 * 33]); o.z = pk2(s[4 * 33], s[5 * 33]); o.w = pk2(s[6 * 33], s[7 * 33]);
        *(v4u*)(WT + (size_t)(prow0 + n) * K + k0 + 8 * c) = o; }
    LDS_WAIT(); asm volatile("" ::: "memory");
}
__host__ __device__ __forceinline__ int map_in(int n) { const int T = n >> 8, nn = n & 255; return 256 * T + 128 * ((nn >> 5) & 1) + 32 * (nn >> 6) + (nn & 31); }
__host__ __device__ __forceinline__ int map_fin(int n) { return n < DFF ? 256 * (n >> 7) + (n & 127) : 256 * ((n - DFF) >> 7) + 128 + ((n - DFF) & 127); }

struct Args { const float* in[15]; float* out; unsigned char* ws; };
typedef const __attribute__((address_space(4))) Args CArgs;
__device__ __forceinline__ CArgs* kargs() { CArgs* p = (CArgs*)__builtin_amdgcn_kernarg_segment_ptr(); asm volatile("" : "+s"(p)); return p; }

__device__ __forceinline__ void prologue(CArgs* a, LAS unsigned char* lds, int wave, int lane) {
    LAS float* scr = (LAS float*)(lds + wave * 16384);
    const int gw = blockIdx.x * NWAVES + wave, NGW = gridDim.x * NWAVES;
    constexpr int I_IN = (DM / 64) * (NIN / 32), I_OUT = (DM / 64) * (DM / 32), I_FIN = (DM / 64) * (NFF2 / 32), I_FOUT = (DFF / 64) * (DM / 32);
    constexpr int I_LAYER = I_IN + I_OUT + I_FIN + I_FOUT;
    for (int it = gw; it < DEPTH * I_LAYER; it += NGW) {
        const int l = it / I_LAYER; int r = it % I_LAYER;
        unsigned char* wb = a->ws + WS_W0 + (size_t)l * WS_WSTRIDE;
        if (r < I_IN) { const int nblk = NIN / 32, kb = r / nblk, nb = r % nblk;
            p0_transpose_item(a->in[2] + (size_t)l * DM * NIN, DM, NIN, (bf16*)(wb + WOFF_IN), 64 * kb, 32 * nb, map_in(32 * nb), a->in[1] + l * DM, scr, lane); continue; } r -= I_IN;
        if (r < I_OUT) { const int nblk = DM / 32, kb = r / nblk, nb = r % nblk;
            p0_transpose_item(a->in[11] + (size_t)l * DM * DM, DM, DM, (bf16*)(wb + WOFF_OUT), 64 * kb, 32 * nb, 32 * nb, nullptr, scr, lane); continue; } r -= I_OUT;
        if (r < I_FIN) { const int nblk = NFF2 / 32, kb = r / nblk, nb = r % nblk;
            p0_transpose_item(a->in[13] + (size_t)l * DM * NFF2, DM, NFF2, (bf16*)(wb + WOFF_FIN), 64 * kb, 32 * nb, map_fin(32 * nb), a->in[12] + l * DM, scr, lane); continue; } r -= I_FIN;
        { const int nblk = DM / 32, kb = r / nblk, nb = r % nblk;
            p0_transpose_item(a->in[14] + (size_t)l * DFF * DM, DFF, DM, (bf16*)(wb + WOFF_FOUT), 64 * kb, 32 * nb, 32 * nb, nullptr, scr, lane); }
    }
    float* rowss = (float*)(a->ws + WS_ROWSS); bf16* xb = (bf16*)(a->ws + WS_XB);
    for (int m = gw; m < M; m += NGW) {
        const f32x4* xr = (const f32x4*)(a->in[0] + (size_t)m * DM) + lane; f32x4* orow = (f32x4*)(a->out + (size_t)m * DM) + lane;
        unsigned long long* o8 = (unsigned long long*)(xb + (size_t)m * DM) + lane;
        float s = 0.f;
#pragma unroll
        for (int j = 0; j < 4; ++j) { const f32x4 v = xr[64 * j]; s += (v.x * v.x + v.y * v.y) + (v.z * v.z + v.w * v.w); orow[64 * j] = v;
            o8[64 * j] = (unsigned long long)pk2(v.x, v.y) | ((unsigned long long)pk2(v.z, v.w) << 32); }
        s = wave_sum(s);
        if (lane < 16) rowss[(size_t)m * 16 + lane] = lane == 0 ? s : 0.f;
    }
    { const float* wsp = a->in[7]; bf16* o = (bf16*)(a->ws + WS_WSP); const int gt = blockIdx.x * 512 + threadIdx.x, NT = gridDim.x * 512;
      for (int i = gt; i < DEPTH * 8 * 128 * 128; i += NT) { const int s = i & 127, t = (i >> 7) & 127; o[i] = (bf16)(((t >> 6) >= (s >> 6)) ? f2bf(wsp[i]) : 0u); } }
}

__device__ __forceinline__ void mixer_naive(CArgs* a, int l, LAS unsigned char* lds, int wave, int lane) {
    const bf16* P = (const bf16*)(a->ws + WS_PROJ); bf16* MIX = (bf16*)(a->ws + WS_MIX);
    const float* vgss = (const float*)(a->ws + WS_VGSS); const bf16* wsp = (const bf16*)(a->ws + WS_WSP) + (size_t)l * 8 * 128 * 128;
    const float* rel = a->in[5] + (size_t)l * 8 * 257; const float* sgu_g = a->in[6] + l * 512; const float* bsp = a->in[8] + l * 8 * 128;
    const float* ag = a->in[9] + l * 512; const float* gg = a->in[10] + l * 512;
    LAS float* red = (LAS float*)lds;
    for (int tok = blockIdx.x; tok < M; tok += gridDim.x) {
        const int b = tok / SEQ, t = tok % SEQ, c = t >> 6;
        const int h = wave;
        const float q = bf2f(P[(size_t)tok * NIN + h * 64 + lane]);
        float mx = -INFINITY, lsum = 0.f, o = 0.f;
        const int k0 = (c >= 8 ? c - 8 : 0) * 64, k1 = c * 64 + 63;
        for (int kt = k0; kt <= k1; ++kt) {
            const size_t kr = (size_t)(b * SEQ + kt) * NIN;
            float s = wave_sum(q * bf2f(P[kr + 512 + h * 64 + lane]));
            int d = t - kt; d = d < -128 ? -128 : (d > 128 ? 128 : d);
            s += rel[h * 257 + d + 128] * pg8::LOG2E;
            const float mn = fmaxf(mx, s), al = __builtin_amdgcn_exp2f(mx - mn), p = __builtin_amdgcn_exp2f(s - mn);
            lsum = lsum * al + p; o = o * al + p * bf2f(P[kr + 1024 + h * 64 + lane]); mx = mn;
        }
        o = o / lsum;
        const int g = wave, nb = t >> 7, tp = t & 127, ns = tp < 64 ? 64 : 128;
        float mixd = 0.f;
        for (int s = 0; s < ns; ++s) {
            const int srow = b * SEQ + nb * 128 + s;
            const f32x4* pv = (const f32x4*)(vgss + (size_t)srow * 8); const f32x4 p0 = pv[0], p1 = pv[1];
            const float rs = __builtin_amdgcn_rsqf((((p0[0] + p0[1]) + (p0[2] + p0[3])) + ((p1[0] + p1[1]) + (p1[2] + p1[3]))) * (1.0f / 512.0f) + pg8::RMS_EPS);
            mixd += bf2f(wsp[(g * 128 + tp) * 128 + s]) * (bf2f(P[(size_t)srow * NIN + 2048 + g * 64 + lane]) * rs * sgu_g[g * 64 + lane]);
        }
        const float gv = bf2f(P[(size_t)tok * NIN + 1536 + g * 64 + lane]) * (mixd + bsp[g * 128 + tp]);
        const float so = wave_sum(o * o), sg = wave_sum(gv * gv);
        __syncthreads();
        if (lane == 0) { red[wave] = so; red[8 + wave] = sg; }
        __syncthreads();
        float ta = 0.f, tg = 0.f;
#pragma unroll
        for (int w = 0; w < 8; ++w) { ta += red[w]; tg += red[8 + w]; }
        const float ra = __builtin_amdgcn_rsqf(ta * (1.0f / 512.0f) + pg8::RMS_EPS), rg = __builtin_amdgcn_rsqf(tg * (1.0f / 512.0f) + pg8::RMS_EPS);
        MIX[(size_t)tok * DM + h * 64 + lane] = (bf16)f2bf(o * ra * ag[h * 64 + lane]);
        MIX[(size_t)tok * DM + 512 + g * 64 + lane] = (bf16)f2bf(gv * rg * gg[g * 64 + lane]);
    }
    __syncthreads();
}

#ifndef FAST_MIXER
#define FAST_MIXER 1
#endif
#ifndef PHM
#define PHM 31
#endif
namespace mx {
typedef float f32x16 __attribute__((ext_vector_type(16)));
typedef short bf16x8 __attribute__((ext_vector_type(8)));
typedef short s16x4 __attribute__((ext_vector_type(4)));
typedef unsigned u32x2 __attribute__((ext_vector_type(2)));
constexpr int TBL_OFF = 131072;
constexpr int RED_OFF = TBL_OFF + 8 * 260 * 4;
__device__ __forceinline__ int crow(int r, int hi) { return (r & 3) + 8 * (r >> 2) + 4 * hi; }
__device__ __forceinline__ int vimg(int row, int chunk) { return row * 128 + ((chunk * 16) ^ (((row >> 1) & 1) << 6)); }
__device__ __forceinline__ s16x4 tr64(LAS unsigned char* p) { return __builtin_bit_cast(s16x4, __builtin_amdgcn_ds_read_tr16_b64_v4i16((LAS s16x4*)p)); }
__device__ __forceinline__ bf16x8 cat8(s16x4 a, s16x4 b) { return (bf16x8){a[0], a[1], a[2], a[3], b[0], b[1], b[2], b[3]}; }
__device__ __forceinline__ unsigned cvtpk(float lo, float hi) { unsigned r; asm("v_cvt_pk_bf16_f32 %0, %1, %2" : "=v"(r) : "v"(lo), "v"(hi)); return r; }
#define MX_FENCE() asm volatile("" ::: "memory")

__device__ __forceinline__ void attn_task(const bf16* P, int b, int c, int half, int h, LAS unsigned char* wl, const LAS float* tbl, int lane, f32x16 (&o)[2]) {
    const int r32 = lane & 31, hi = lane >> 5;
    const size_t tok0 = (size_t)b * SEQ + c * 64 + half * 32;
    bf16x8 qf[4];
#pragma unroll
    for (int d0 = 0; d0 < 4; ++d0) qf[d0] = *(const bf16x8*)(P + (tok0 + r32) * NIN + h * 64 + d0 * 16 + hi * 8);
#pragma unroll
    for (int r = 0; r < 16; ++r) { o[0][r] = 0.f; o[1][r] = 0.f; }
    float m = -INFINITY, l = 0.f;
    const int kc0 = c >= 8 ? c - 8 : 0;
    const int dhalf = (lane >> 4) & 1, qq = (lane & 15) >> 2, p4 = lane & 3;
    int vb[2];
#pragma unroll
    for (int dt = 0; dt < 2; ++dt) vb[dt] = (4 * hi + qq) * 128 + ((64 * dt + 32 * dhalf + 8 * p4) ^ ((qq >> 1) << 6));
    const int prow = lane >> 3, pch = lane & 7;
    bf16x8 kf[2][4];
    const unsigned koff = (unsigned)(r32 * NIN + hi * 8) * 2u, voff = (unsigned)(prow * NIN + (pch ^ (((lane >> 4) & 1) << 2)) * 8) * 2u;
#define MX_LOADK(kc) do { const char* kp_ = (const char*)(P + ((size_t)b * SEQ + (kc) * 64) * NIN + 512 + h * 64); \
        _Pragma("unroll") for (int kt = 0; kt < 2; ++kt) _Pragma("unroll") for (int d0 = 0; d0 < 4; ++d0) kf[kt][d0] = *(const bf16x8*)(kp_ + (size_t)(kt * 32 * NIN + d0 * 16) * 2 + koff); } while (0)
#define MX_LOADV(kc, bufo) do { const char* vp_ = (const char*)(P + ((size_t)b * SEQ + (kc) * 64) * NIN + 1024 + h * 64); \
        _Pragma("unroll") for (int i = 0; i < 8; ++i) __builtin_amdgcn_global_load_lds((const unsigned*)(vp_ + (size_t)(i * 8 * NIN) * 2 + voff), (LAS unsigned*)(wl + (bufo) + i * 1024), 16, 0, 0); } while (0)
    MX_LOADK(kc0); MX_LOADV(kc0, 0);
    int buf = 0;
    for (int kc = kc0; kc <= c; ++kc) {
        const int j = kc - c + 8;
        LAS unsigned char* vt = wl + buf * 8192;
        asm volatile("s_waitcnt vmcnt(0)" ::: "memory");
        if (kc < c) MX_LOADV(kc + 1, (buf ^ 1) * 8192);
        f32x16 st[2];
        if (j <= 5) { const float bc = tbl[256];
#pragma unroll
            for (int r = 0; r < 16; ++r) { st[0][r] = bc; st[1][r] = bc; } }
        else { int D0 = 64 * (8 - j) + half * 32 + r32 - 4 * hi; asm volatile("" : "+v"(D0));
#pragma unroll
            for (int kt = 0; kt < 2; ++kt)
#pragma unroll
                for (int r = 0; r < 16; ++r) { int idx = D0 - (32 * kt + (r & 3) + 8 * (r >> 2)); idx = idx < -128 ? -128 : (idx > 128 ? 128 : idx); st[kt][r] = tbl[idx + 128]; } }
#pragma unroll
        for (int kt = 0; kt < 2; ++kt)
#pragma unroll
            for (int d0 = 0; d0 < 4; ++d0) st[kt] = __builtin_amdgcn_mfma_f32_32x32x16_bf16(kf[kt][d0], qf[d0], st[kt], 0, 0, 0);
        if (kc < c) { MX_LOADK(kc + 1); }
        float mxv = fmaxf(st[0][0], st[1][0]);
#pragma unroll
        for (int r = 1; r < 16; ++r) mxv = fmaxf(mxv, fmaxf(st[0][r], st[1][r]));
        mxv = fmaxf(mxv, __shfl_xor(mxv, 32));
        const float mn = fmaxf(m, mxv), al = __builtin_amdgcn_exp2f(m - mn); m = mn;
        float rs = 0.f;
#pragma unroll
        for (int kt = 0; kt < 2; ++kt)
#pragma unroll
            for (int r = 0; r < 16; ++r) { const float p = __builtin_amdgcn_exp2f(st[kt][r] - mn); st[kt][r] = p; rs += p; }
        l = l * al + rs;
#pragma unroll
        for (int r = 0; r < 16; ++r) { o[0][r] *= al; o[1][r] *= al; }
        bf16x8 pf[4];
#pragma unroll
        for (int s = 0; s < 4; ++s) { v4u w; const int kt = s >> 1, r0 = 8 * (s & 1);
            w.x = cvtpk(st[kt][r0 + 0], st[kt][r0 + 1]); w.y = cvtpk(st[kt][r0 + 2], st[kt][r0 + 3]); w.z = cvtpk(st[kt][r0 + 4], st[kt][r0 + 5]); w.w = cvtpk(st[kt][r0 + 6], st[kt][r0 + 7]);
            pf[s] = __builtin_bit_cast(bf16x8, w); }
#pragma unroll
        for (int dt = 0; dt < 2; ++dt)
#pragma unroll
            for (int s = 0; s < 4; ++s) { const s16x4 a0 = tr64(vt + vb[dt] + (16 * s) * 128), a1 = tr64(vt + vb[dt] + (16 * s + 8) * 128);
                o[dt] = __builtin_amdgcn_mfma_f32_32x32x16_bf16(cat8(a0, a1), pf[s], o[dt], 0, 0, 0); }
        MX_FENCE();
        buf ^= 1;
    }
#undef MX_LOADK
#undef MX_LOADV
    l += __shfl_xor(l, 32);
    const float inv = 1.0f / l;
#pragma unroll
    for (int r = 0; r < 16; ++r) { o[0][r] *= inv; o[1][r] *= inv; }
}

__device__ __forceinline__ void sgu_task(const bf16* P, const float* vgss, const bf16* wsp_l, const float* sgu_g, const float* bsp_l, int b, int c, int half, int g, LAS unsigned char* wl, int lane, f32x16 (&o)[2]) {
    const int r32 = lane & 31, hi = lane >> 5;
    const int nb = c >> 1, cb = c & 1, tpos0 = cb * 64 + half * 32, ns = cb ? 128 : 64;
    const size_t srow0 = (size_t)b * SEQ + nb * 128, tok0 = (size_t)b * SEQ + c * 64 + half * 32;
    const int prow = lane >> 3, pch = lane & 7;
    const f32x4 g0 = *(const f32x4*)(sgu_g + g * 64 + pch * 8), g1 = *(const f32x4*)(sgu_g + g * 64 + pch * 8 + 4);
    MX_FENCE();
#pragma unroll 4
    for (int i = 0; i < ns / 8; ++i) {
        const int row = prow + 8 * i; const size_t srow = srow0 + row;
        const f32x4 p0 = *(const f32x4*)(vgss + srow * 8), p1 = *(const f32x4*)(vgss + srow * 8 + 4);
        const float rs = __builtin_amdgcn_rsqf((((p0[0] + p0[1]) + (p0[2] + p0[3])) + ((p1[0] + p1[1]) + (p1[2] + p1[3]))) * (1.0f / 512.0f) + pg8::RMS_EPS);
        const v4u raw = *(const v4u*)(P + srow * NIN + 2048 + g * 64 + pch * 8);
        v4u w;
        w.x = cvtpk(__builtin_bit_cast(float, raw.x << 16) * rs * g0[0], __builtin_bit_cast(float, raw.x & 0xffff0000u) * rs * g0[1]);
        w.y = cvtpk(__builtin_bit_cast(float, raw.y << 16) * rs * g0[2], __builtin_bit_cast(float, raw.y & 0xffff0000u) * rs * g0[3]);
        w.z = cvtpk(__builtin_bit_cast(float, raw.z << 16) * rs * g1[0], __builtin_bit_cast(float, raw.z & 0xffff0000u) * rs * g1[1]);
        w.w = cvtpk(__builtin_bit_cast(float, raw.w << 16) * rs * g1[2], __builtin_bit_cast(float, raw.w & 0xffff0000u) * rs * g1[3]);
        *(LAS v4u*)(wl + vimg(row, pch)) = w;
    }
    MX_FENCE();
#pragma unroll
    for (int r = 0; r < 16; ++r) { o[0][r] = 0.f; o[1][r] = 0.f; }
    const int dhalf = (lane >> 4) & 1, qq = (lane & 15) >> 2, p4 = lane & 3;
    int vbs[2];
#pragma unroll
    for (int ct = 0; ct < 2; ++ct) vbs[ct] = (8 * hi + qq) * 128 + ((64 * ct + 32 * dhalf + 8 * p4) ^ ((qq >> 1) << 6));
    const bf16* wrow = wsp_l + ((size_t)g * 128 + tpos0 + r32) * 128 + hi * 8;
#pragma unroll 4
    for (int step = 0; step < ns / 16; ++step) {
        const bf16x8 wf = *(const bf16x8*)(wrow + 16 * step);
#pragma unroll
        for (int ct = 0; ct < 2; ++ct) { const s16x4 a0 = tr64(wl + vbs[ct] + (16 * step) * 128), a1 = tr64(wl + vbs[ct] + (16 * step + 4) * 128);
            o[ct] = __builtin_amdgcn_mfma_f32_32x32x16_bf16(cat8(a0, a1), wf, o[ct], 0, 0, 0); }
    }
    MX_FENCE();
    const float bt = bsp_l[g * 128 + tpos0 + r32];
    const bf16* up = P + (tok0 + r32) * NIN + 1536 + g * 64 + 4 * hi;
#pragma unroll
    for (int ct = 0; ct < 2; ++ct)
#pragma unroll
        for (int rg = 0; rg < 4; ++rg) { const u32x2 uu = *(const u32x2*)(up + 32 * ct + 8 * rg);
            o[ct][4 * rg + 0] = __builtin_bit_cast(float, uu.x << 16) * (o[ct][4 * rg + 0] + bt); o[ct][4 * rg + 1] = __builtin_bit_cast(float, uu.x & 0xffff0000u) * (o[ct][4 * rg + 1] + bt);
            o[ct][4 * rg + 2] = __builtin_bit_cast(float, uu.y << 16) * (o[ct][4 * rg + 2] + bt); o[ct][4 * rg + 3] = __builtin_bit_cast(float, uu.y & 0xffff0000u) * (o[ct][4 * rg + 3] + bt); }
}

__device__ __forceinline__ void norm_store(const f32x16 (&o)[2], LAS float* red, int wave, int lane, const float* gain, bf16* dst) {
    const int r32 = lane & 31, hi = lane >> 5;
    float ss = 0.f;
#pragma unroll
    for (int r = 0; r < 16; ++r) ss += o[0][r] * o[0][r] + o[1][r] * o[1][r];
    ss += __shfl_xor(ss, 32);
    if (hi == 0) red[wave * 32 + r32] = ss;
    __syncthreads();
    float tot = 0.f;
#pragma unroll
    for (int w = 0; w < 8; ++w) tot += red[w * 32 + r32];
    const float rn = __builtin_amdgcn_rsqf(tot * (1.0f / 512.0f) + pg8::RMS_EPS);
#pragma unroll
    for (int ct = 0; ct < 2; ++ct)
#pragma unroll
        for (int rg = 0; rg < 4; ++rg) { const int ch = 32 * ct + 8 * rg + 4 * hi; const f32x4 gv = *(const f32x4*)(gain + ch);
            u32x2 w; w.x = cvtpk(o[ct][4 * rg + 0] * rn * gv[0], o[ct][4 * rg + 1] * rn * gv[1]); w.y = cvtpk(o[ct][4 * rg + 2] * rn * gv[2], o[ct][4 * rg + 3] * rn * gv[3]);
            *(u32x2*)(dst + (size_t)r32 * DM + ch) = w; }
}

__device__ __forceinline__ void mixer_fast(CArgs* a, int l, LAS unsigned char* lds, int wave, int lane) {
    const bf16* P = (const bf16*)(a->ws + WS_PROJ); bf16* MIX = (bf16*)(a->ws + WS_MIX);
    const float* vgss = (const float*)(a->ws + WS_VGSS); const bf16* wsp_l = (const bf16*)(a->ws + WS_WSP) + (size_t)l * 8 * 128 * 128;
    const float* rel = a->in[5] + (size_t)l * 8 * 257; const float* sgu_g = a->in[6] + l * 512; const float* bsp_l = a->in[8] + l * 8 * 128;
    const float* ag = a->in[9] + l * 512; const float* gg = a->in[10] + l * 512;
    LAS float* tbl = (LAS float*)(lds + TBL_OFF); LAS float* red = (LAS float*)(lds + RED_OFF);
    for (int i = threadIdx.x; i < 8 * 257; i += NWAVES * 64) { const int h = i / 257, k = i % 257; tbl[h * 260 + k] = rel[i] * pg8::LOG2E; }
    __syncthreads();
    LAS unsigned char* wl = lds + wave * 16384;
    for (int u = blockIdx.x; u < NB * (SEQ / 64); u += gridDim.x) {
        const int b = u & 7, c = u >> 3;
#pragma nounroll
        for (int half = 0; half < 2; ++half) {
            const size_t tok0 = (size_t)b * SEQ + c * 64 + half * 32;
            f32x16 o[2];
            attn_task(P, b, c, half, wave, wl, tbl + wave * 260, lane, o);
            norm_store(o, red, wave, lane, ag + wave * 64, MIX + tok0 * DM + wave * 64);
            sgu_task(P, vgss, wsp_l, sgu_g, bsp_l, b, c, half, wave, wl, lane, o);
            norm_store(o, red + 256, wave, lane, gg + wave * 64, MIX + tok0 * DM + 512 + wave * 64);
        }
    }
    __syncthreads();
}
}

__global__ void __launch_bounds__(NWAVES * 64, 2) fwd_megakernel(Args a_unused) {
    extern __shared__ __attribute__((aligned(16))) unsigned char lds_raw[];
    LAS unsigned char* lds = (LAS unsigned char*)lds_raw;
    cg::grid_group grid = cg::this_grid();
    { const int tid = threadIdx.x, lane = tid & 63, wave = __builtin_amdgcn_readfirstlane(tid >> 6);
      prologue(kargs(), lds, wave, lane); }
    grid.sync();
#pragma nounroll
    for (int l = 0; l < DEPTH; ++l) {
#if PHM & 1
        {
            CArgs* a = kargs(); unsigned char* ws = a->ws; unsigned char* wb = ws + WS_W0 + (size_t)l * WS_WSTRIDE;
            pg8::Gemm g{(const bf16*)(ws + WS_XB), (const bf16*)(wb + WOFF_IN), M, NIN, DM}; pg8::StaticOrder S; S.init(M, NIN, (int)gridDim.x, (int)blockIdx.x);
            pg8::EpiInProj E{(bf16*)(ws + WS_PROJ), (const float*)(ws + WS_ROWSS), (float*)(ws + WS_VGSS), a->in[3] + l * 64, a->in[4] + l * 64};
            pg8::gemm_phase<pg8::EpiInProj, pg8::StaticOrder, true, true>(lds, g, S, E);
        }
#endif
        grid.sync();
#if PHM & 2
        { int tid = threadIdx.x; asm volatile("" : "+v"(tid)); const int lane = tid & 63, wave = __builtin_amdgcn_readfirstlane(tid >> 6);
#if FAST_MIXER
          mx::mixer_fast(kargs(), l, lds, wave, lane);
#else
          mixer_naive(kargs(), l, lds, wave, lane);
#endif
        }
#endif
        grid.sync();
#if PHM & 4
        {
            CArgs* a = kargs(); unsigned char* ws = a->ws; unsigned char* wb = ws + WS_W0 + (size_t)l * WS_WSTRIDE; float* xo = a->out;
            pg8::Gemm g{(const bf16*)(ws + WS_MIX), (const bf16*)(wb + WOFF_OUT), M, DM, DM}; pg8::StaticOrder S; S.init(M, DM, (int)gridDim.x, (int)blockIdx.x);
            pg8::EpiResid E{xo, xo, (bf16*)(ws + WS_XB), (float*)(ws + WS_ROWSS)};
            pg8::gemm_phase<pg8::EpiResid, pg8::StaticOrder, true, true>(lds, g, S, E);
        }
#endif
        grid.sync();
#if PHM & 8
        {
            CArgs* a = kargs(); unsigned char* ws = a->ws; unsigned char* wb = ws + WS_W0 + (size_t)l * WS_WSTRIDE;
            pg8::Gemm g{(const bf16*)(ws + WS_XB), (const bf16*)(wb + WOFF_FIN), M, NFF2, DM}; pg8::StaticOrder S; S.init(M, NFF2, (int)gridDim.x, (int)blockIdx.x);
            pg8::EpiSwiGLU E{(bf16*)(ws + WS_HID), (const float*)(ws + WS_ROWSS)};
            pg8::gemm_phase<pg8::EpiSwiGLU, pg8::StaticOrder, true, true>(lds, g, S, E);
        }
#endif
        grid.sync();
#if PHM & 16
        {
            CArgs* a = kargs(); unsigned char* ws = a->ws; unsigned char* wb = ws + WS_W0 + (size_t)l * WS_WSTRIDE; float* xo = a->out;
            pg8::Gemm g{(const bf16*)(ws + WS_HID), (const bf16*)(wb + WOFF_FOUT), M, DM, DFF}; pg8::StaticOrder S; S.init(M, DM, (int)gridDim.x, (int)blockIdx.x);
            pg8::EpiResid E{xo, xo, (bf16*)(ws + WS_XB), (float*)(ws + WS_ROWSS)};
            pg8::gemm_phase<pg8::EpiResid, pg8::StaticOrder, true, true>(lds, g, S, E);
        }
#endif
        if (l + 1 < DEPTH) grid.sync();
    }
}

extern "C" void kernel_launch(void* const* d_in, const int* in_sizes, int n_in, void* d_out, int out_size, void* d_ws, size_t ws_size, hipStream_t stream) {
    static int grid = 0;
    if (grid == 0) {
        if (n_in != 15 || in_sizes[0] != M * DM || out_size != M * DM || ws_size < WS_END) { fprintf(stderr, "kernel_launch: unexpected shapes (n_in %d, ws %zu)\n", n_in, ws_size); grid = -1; return; }
        int dev = 0, cus = 0, per_cu = 0;
        hipGetDevice(&dev); hipDeviceGetAttribute(&cus, hipDeviceAttributeMultiprocessorCount, dev);
        if (hipFuncSetAttribute((const void*)fwd_megakernel, hipFuncAttributeMaxDynamicSharedMemorySize, LDS_BYTES) != hipSuccess) { fprintf(stderr, "kernel_launch: hipFuncSetAttribute failed\n"); grid = -1; return; }
        if (hipOccupancyMaxActiveBlocksPerMultiprocessor(&per_cu, (const void*)fwd_megakernel, NWAVES * 64, LDS_BYTES) != hipSuccess || per_cu < 1) { fprintf(stderr, "kernel_launch: occupancy query failed (%d)\n", per_cu); (void)hipGetLastError(); per_cu = 1; }
        grid = cus * (per_cu > 1 ? 1 : per_cu);
    }
    if (grid < 0) return;
    Args a{};
    for (int i = 0; i < 15; ++i) a.in[i] = (const float*)d_in[i];
    a.out = (float*)d_out; a.ws = (unsigned char*)d_ws;
    void* args[] = {&a};
    hipError_t e = hipLaunchCooperativeKernel((const void*)fwd_megakernel, dim3(grid), dim3(NWAVES * 64), args, LDS_BYTES, stream);
    if (e != hipSuccess) fprintf(stderr, "cooperative launch failed: %s (grid %d)\n", hipGetErrorString(e), grid);
}
```

```cpp
#include <hip/hip_runtime.h>
#include <hip/hip_cooperative_groups.h>
#include <cstdio>
#include <cstdint>
namespace cg = cooperative_groups;
namespace pg8 {
#define PG8_LAS __attribute__((address_space(3)))
typedef unsigned short bf16_t;
typedef short bf16x8 __attribute__((ext_vector_type(8)));
typedef float f32x4 __attribute__((ext_vector_type(4)));
typedef unsigned u32x4 __attribute__((ext_vector_type(4)));
constexpr int BM = 256, BK = 64, HALF = 128, HTB = HALF * BK * 2  , STAGE_BYTES = 8 * HTB, NXCD = 8, WGM = 8;

__host__ __device__ __forceinline__ int lds_byte(int r, int c) { const int st = (r >> 4) * 2 + (c >> 5), rr = r & 15, cc = c & 31, ob = rr * 64 + cc * 2; return st * 1024 + (ob ^ (((ob >> 9) & 1) << 5)); }
__host__ __device__ __forceinline__ void stage_rc(int b, int& R, int& C) { const int st = b / 1024, sb = b % 1024, swz = sb ^ (((sb >> 9) & 1) << 5); R = (st >> 1) * 16 + swz / 64; C = (st & 1) * 32 + (swz % 64) / 2; }
__host__ __device__ __forceinline__ int perm32(int rho) { const int n = rho >> 4, i = rho & 15; return 8 * (i >> 2) + 4 * n + (i & 3); }

struct Unit { int pm, pn; };
struct Gemm { const bf16_t* A; const bf16_t* Bt; int M, N, K; };

struct StaticOrder {
    int nM, nN, nwg, G, c;
    __host__ __device__ void init(int M, int N, int G_, int c_) { nM = M / BM; nN = N / BM; nwg = nM * nN; G = G_; c = c_; }
    __host__ __device__ bool next(int i, Unit& u) const {
        const long L = (long)i * G + c; if (L >= nwg) return false;
        int wgid = (int)L; { const int q = nwg / NXCD, r = nwg % NXCD, xcd = wgid % NXCD, off = wgid / NXCD; wgid = (xcd < r ? xcd * (q + 1) : r * (q + 1) + (xcd - r) * q) + off; }
        const int nig = WGM * nN, gid = wgid / nig, fm = gid * WGM, gsz = (nM - fm) < WGM ? (nM - fm) : WGM;
        u.pm = fm + ((wgid % nig) % gsz); u.pn = (wgid % nig) / gsz; return true;
    }
    __device__ __forceinline__ void a_ready(const Unit&) const {}
    __device__ __forceinline__ void done(const Unit&) const {}
};

__device__ __forceinline__ unsigned cvt_pk_bf16(float lo, float hi) { unsigned r; asm volatile("v_cvt_pk_bf16_f32 %0, %1, %2" : "=v"(r) : "v"(lo), "v"(hi)); return r; }
typedef float f32x2 __attribute__((ext_vector_type(2)));
constexpr float RMS_EPS = 1e-6f;
constexpr float LOG2E = 1.4426950408889634f;
constexpr float QSCALE = 0.125f * 1.4426950408889634f;
__device__ __forceinline__ float gelu_tanh(float x) {
    const float z2 = x * (1.5957691216057308f + 0.07135481627260025f * x * x);
    const float e = __builtin_amdgcn_exp2f(-LOG2E * z2);
    return x * __builtin_amdgcn_rcpf(1.0f + e);
}
__device__ __forceinline__ float row_rs(const float* rowss, int row) {
    const f32x4* pr = (const f32x4*)(rowss + (size_t)row * 16);
    const f32x4 a = pr[0], b = pr[1], c = pr[2], d = pr[3];
    const float ss = ((a[0] + a[1]) + (a[2] + a[3])) + ((b[0] + b[1]) + (b[2] + b[3])) + ((c[0] + c[1]) + (c[2] + c[3])) + ((d[0] + d[1]) + (d[2] + d[3]));
    return __builtin_amdgcn_rsqf(ss * (1.0f / 1024.0f) + RMS_EPS);
}
struct EpiInProj {
    static constexpr bool PERM = true, AFTER_DRAIN = false;
    bf16_t* P; const float* rowss; float* vgss; const float* qg; const float* kg;
    __device__ __forceinline__ void operator()(const f32x4 (&acc)[2][2][4][2], const Unit& u, int wr, int wc, int fr, int fq) const {
        const int region = u.pn >> 1, half = u.pn & 1;
        const int lcol = region * 512 + half * 256 + wc * 64 + fq * 8;
        float gq[2][8];
#pragma unroll
        for (int bj = 0; bj < 2; ++bj)
#pragma unroll
            for (int e = 0; e < 8; ++e) gq[bj][e] = 1.f;
        if (region < 2) { const float* g = region == 0 ? qg : kg; const float sc = region == 0 ? QSCALE : 1.f;
#pragma unroll
            for (int bj = 0; bj < 2; ++bj)
#pragma unroll
                for (int e = 0; e < 8; ++e) gq[bj][e] = g[bj * 32 + fq * 8 + e] * sc; }
#pragma unroll
        for (int ai = 0; ai < 2; ++ai)
#pragma unroll
            for (int m = 0; m < 4; ++m) {
                const int row = u.pm * BM + ai * HALF + wr * 64 + m * 16 + fr;
                const float s = row_rs(rowss, row);
                float v[2][8];
#pragma unroll
                for (int bj = 0; bj < 2; ++bj)
#pragma unroll
                    for (int n = 0; n < 2; ++n)
#pragma unroll
                        for (int i = 0; i < 4; ++i) v[bj][4 * n + i] = acc[ai][bj][m][n][i] * s;
                if (region < 2) {
                    float q = 0.f;
#pragma unroll
                    for (int bj = 0; bj < 2; ++bj)
#pragma unroll
                        for (int e = 0; e < 8; ++e) q += v[bj][e] * v[bj][e];
                    q += __shfl_xor(q, 16); q += __shfl_xor(q, 32);
                    const float r = __builtin_amdgcn_rsqf(q * (1.0f / 64.0f) + RMS_EPS);
#pragma unroll
                    for (int bj = 0; bj < 2; ++bj)
#pragma unroll
                        for (int e = 0; e < 8; ++e) v[bj][e] = v[bj][e] * r * gq[bj][e];
                } else if (region >= 3) {
#pragma unroll
                    for (int bj = 0; bj < 2; ++bj)
#pragma unroll
                        for (int e = 0; e < 8; ++e) v[bj][e] = gelu_tanh(v[bj][e]);
                    if (region == 4) {
                        float q = 0.f;
#pragma unroll
                        for (int bj = 0; bj < 2; ++bj)
#pragma unroll
                            for (int e = 0; e < 8; ++e) q += v[bj][e] * v[bj][e];
                        q += __shfl_xor(q, 16); q += __shfl_xor(q, 32);
                        if (fq == 0) vgss[(size_t)row * 8 + half * 4 + wc] = q;
                    }
                }
                bf16_t* rowp = P + (size_t)row * 2560 + lcol;
#pragma unroll
                for (int bj = 0; bj < 2; ++bj) { u32x4 w; w.x = cvt_pk_bf16(v[bj][0], v[bj][1]); w.y = cvt_pk_bf16(v[bj][2], v[bj][3]); w.z = cvt_pk_bf16(v[bj][4], v[bj][5]); w.w = cvt_pk_bf16(v[bj][6], v[bj][7]);
                    *(u32x4*)(rowp + bj * 32) = w; }
            }
    }
};
struct EpiResid {
    static constexpr bool PERM = true, AFTER_DRAIN = false;
    const float* base; float* out; bf16_t* xb; float* rowss;
    __device__ __forceinline__ void operator()(const f32x4 (&acc)[2][2][4][2], const Unit& u, int wr, int wc, int fr, int fq) const {
        const int col0 = u.pn * BM + wc * 32 + 8 * fq;
#pragma unroll
        for (int ai = 0; ai < 2; ++ai)
#pragma unroll
            for (int m = 0; m < 4; ++m) {
                const int row = u.pm * BM + ai * HALF + wr * 64 + m * 16 + fr;
                const size_t off = (size_t)row * 1024 + col0;
                float q = 0.f;
#pragma unroll
                for (int bj = 0; bj < 2; ++bj) {
                    const f32x4 b0 = *(const f32x4*)(base + off + bj * HALF), b1 = *(const f32x4*)(base + off + bj * HALF + 4);
                    const f32x4 v0 = acc[ai][bj][m][0] + b0, v1 = acc[ai][bj][m][1] + b1;
                    *(f32x4*)(out + off + bj * HALF) = v0; *(f32x4*)(out + off + bj * HALF + 4) = v1;
                    u32x4 w; w.x = cvt_pk_bf16(v0[0], v0[1]); w.y = cvt_pk_bf16(v0[2], v0[3]); w.z = cvt_pk_bf16(v1[0], v1[1]); w.w = cvt_pk_bf16(v1[2], v1[3]);
                    *(u32x4*)(xb + off + bj * HALF) = w;
                    q += (v0[0] * v0[0] + v0[1] * v0[1]) + (v0[2] * v0[2] + v0[3] * v0[3]) + (v1[0] * v1[0] + v1[1] * v1[1]) + (v1[2] * v1[2] + v1[3] * v1[3]);
                }
                q += __shfl_xor(q, 16); q += __shfl_xor(q, 32);
                if (fq == 0) rowss[(size_t)row * 16 + u.pn * 4 + wc] = q;
            }
    }
};
struct EpiSwiGLU {
    static constexpr bool PERM = true, AFTER_DRAIN = false;
    bf16_t* H; const float* rowss;
    __device__ __forceinline__ void operator()(const f32x4 (&acc)[2][2][4][2], const Unit& u, int wr, int wc, int fr, int fq) const {
        const int col0 = u.pn * 128 + wc * 32 + 8 * fq;
#pragma unroll
        for (int ai = 0; ai < 2; ++ai)
#pragma unroll
            for (int m = 0; m < 4; ++m) {
                const int row = u.pm * BM + ai * HALF + wr * 64 + m * 16 + fr;
                const float s = row_rs(rowss, row);
                float h[8];
#pragma unroll
                for (int n = 0; n < 2; ++n)
#pragma unroll
                    for (int i = 0; i < 4; ++i) { const float g = acc[ai][0][m][n][i] * s, up = acc[ai][1][m][n][i] * s;
                        h[4 * n + i] = g * __builtin_amdgcn_rcpf(1.0f + __builtin_amdgcn_exp2f(-LOG2E * g)) * up; }
                u32x4 w; w.x = cvt_pk_bf16(h[0], h[1]); w.y = cvt_pk_bf16(h[2], h[3]); w.z = cvt_pk_bf16(h[4], h[5]); w.w = cvt_pk_bf16(h[6], h[7]);
                *(u32x4*)(H + (size_t)row * 2816 + col0) = w;
            }
    }
};
template <class Epi, class Sched, bool ALIGN_EPI = false, bool SP2 = false>
__device__ __forceinline__ void gemm_phase(PG8_LAS unsigned char* lds, const Gemm g, const Sched& S, const Epi& E) {
    int tid_l = threadIdx.x; asm volatile("" : "+v"(tid_l));
    const int tid = tid_l, wid = __builtin_amdgcn_readfirstlane(tid >> 6), lane = tid & 63, wr = wid >> 2, wc = wid & 3, fr = lane & 15, fq = lane >> 4;
    const int K = g.K, nt = K / BK;
    unsigned voffA[2], voffB[2];
#pragma unroll
    for (int i = 0; i < 2; ++i) { int R, C; stage_rc(tid * 16 + i * 8192, R, C); const int Rb = Epi::PERM ? ((R & ~31) + perm32(R & 31)) : R;
        voffA[i] = (unsigned)(R * K + C) * 2u; voffB[i] = (unsigned)(Rb * K + C) * 2u; }
    const size_t kstep = (size_t)(BK * 2);
    const size_t hstep = (size_t)HALF * K * 2;
    const size_t tstep = 2 * hstep;
    const unsigned ldsw = (unsigned)wid * 1024u;
    const int aoff = lds_byte(wr * 64 + fr, fq * 8), boff = lds_byte(wc * 32 + fr, fq * 8);
#define PG8_SA(b, h) (((b) * 2 + (h)) * HTB)
#define PG8_SB(b, h) ((4 + (b) * 2 + (h)) * HTB)
#define PG8_STAGE(bufoff, gbase, voff) do { _Pragma("unroll") for (int _i = 0; _i < 2; ++_i) \
        __builtin_amdgcn_global_load_lds((const unsigned*)((const char*)(gbase) + (voff)[_i]), (PG8_LAS unsigned*)(lds + (bufoff) + ldsw + _i * 8192), 16, 0, 0); } while (0)
#define PG8_LDA(dst, b, h) do { _Pragma("unroll") for (int m = 0; m < 4; ++m) _Pragma("unroll") for (int k = 0; k < 2; ++k) dst[m][k] = *(const PG8_LAS bf16x8*)(lds + PG8_SA(b, h) + aoff + m * 2048 + k * 1024); } while (0)
#define PG8_LDB(dst, b, h) do { _Pragma("unroll") for (int n = 0; n < 2; ++n) _Pragma("unroll") for (int k = 0; k < 2; ++k) dst[n][k] = *(const PG8_LAS bf16x8*)(lds + PG8_SB(b, h) + boff + n * 2048 + k * 1024); } while (0)
#define PG8_MMA(ai, bj, At, Bt) do { __builtin_amdgcn_s_setprio(1); _Pragma("unroll") for (int m = 0; m < 4; ++m) _Pragma("unroll") for (int n = 0; n < 2; ++n) _Pragma("unroll") for (int k = 0; k < 2; ++k) \
        acc[ai][bj][m][n] = __builtin_amdgcn_mfma_f32_16x16x32_bf16(Bt[n][k], At[m][k], acc[ai][bj][m][n], 0, 0, 0); __builtin_amdgcn_s_setprio(0); } while (0)
#define PG8_WAIT_V(n) asm volatile("s_waitcnt vmcnt(" #n ")" ::: "memory")
#define PG8_WAIT_L(n) asm volatile("s_waitcnt lgkmcnt(" #n ")" ::: "memory")
#define PG8_BAR __builtin_amdgcn_s_barrier()
#define PG8_SCHED __builtin_amdgcn_sched_barrier(0)
    Unit cur, nxt; int ui = 0;
    if (!S.next(0, cur)) return;
    f32x4 acc[2][2][4][2];
#pragma unroll
    for (int a = 0; a < 2; ++a)
#pragma unroll
        for (int b = 0; b < 2; ++b)
#pragma unroll
            for (int m = 0; m < 4; ++m)
#pragma unroll
                for (int n = 0; n < 2; ++n) acc[a][b][m][n] = (f32x4){0.f, 0.f, 0.f, 0.f};
    bf16x8 At[4][2], B0[2][2], B1[2][2];
    const char* cA = (const char*)g.A + (size_t)cur.pm * tstep; const char* cB = (const char*)g.Bt + (size_t)cur.pn * tstep;
    S.a_ready(cur);
    if constexpr (SP2) {
        PG8_STAGE(PG8_SB(0, 0), cB, voffB); PG8_STAGE(PG8_SB(0, 1), cB + hstep, voffB); PG8_STAGE(PG8_SA(0, 0), cA, voffA); PG8_STAGE(PG8_SA(0, 1), cA + hstep, voffA);
        if (wr == 1) PG8_BAR;
        PG8_WAIT_V(2); PG8_BAR;
        PG8_STAGE(PG8_SB(1, 0), cB + kstep, voffB); PG8_STAGE(PG8_SA(1, 0), cA + kstep, voffA); PG8_STAGE(PG8_SB(1, 1), cB + hstep + kstep, voffB);
        PG8_WAIT_V(6); PG8_BAR;
    } else {
        PG8_STAGE(PG8_SB(0, 0), cB, voffB); PG8_STAGE(PG8_SA(0, 0), cA, voffA); PG8_STAGE(PG8_SB(0, 1), cB + hstep, voffB); PG8_STAGE(PG8_SA(0, 1), cA + hstep, voffA);
        if (wr == 1) PG8_BAR;
        PG8_WAIT_V(4); PG8_BAR;
        PG8_STAGE(PG8_SB(1, 0), cB + kstep, voffB); PG8_STAGE(PG8_SA(1, 0), cA + kstep, voffA); PG8_STAGE(PG8_SB(1, 1), cB + hstep + kstep, voffB);
        PG8_WAIT_V(6); PG8_BAR;
    }
    for (;;) {
        const bool has_next = S.next(ui + 1, nxt);
        const char* nA = has_next ? (const char*)g.A + (size_t)nxt.pm * tstep : cA; const char* nB = has_next ? (const char*)g.Bt + (size_t)nxt.pn * tstep : cB;
        for (int t = 0; t < nt; t += 2) {
            const bool last = (t == nt - 2);
            const char* a1 = cA + (size_t)(t + 1) * kstep;
            const char* a2 = last ? nA : cA + (size_t)(t + 2) * kstep; const char* b2 = last ? nB : cB + (size_t)(t + 2) * kstep;
            const char* a3 = a2 + kstep; const char* b3 = b2 + kstep;
            if (last && has_next) S.a_ready(nxt);
            if constexpr (SP2) {
            PG8_LDB(B0, 0, 0); PG8_LDB(B1, 0, 1); PG8_SCHED; PG8_LDA(At, 0, 0); PG8_STAGE(PG8_SA(1, 1), a1 + hstep, voffA);
            PG8_WAIT_V(8); PG8_WAIT_L(0); PG8_BAR; PG8_MMA(0, 0, At, B0); PG8_MMA(0, 1, At, B1); PG8_BAR; PG8_SCHED;
            PG8_LDA(At, 0, 1); PG8_STAGE(PG8_SB(0, 0), b2, voffB); PG8_STAGE(PG8_SB(0, 1), b2 + hstep, voffB); PG8_STAGE(PG8_SA(0, 0), a2, voffA);
            PG8_WAIT_V(8); PG8_WAIT_L(0); PG8_BAR; PG8_MMA(1, 0, At, B0); PG8_MMA(1, 1, At, B1); PG8_BAR; PG8_SCHED;
            PG8_LDB(B0, 1, 0); PG8_LDB(B1, 1, 1); PG8_SCHED; PG8_LDA(At, 1, 0); PG8_STAGE(PG8_SA(0, 1), a2 + hstep, voffA);
            PG8_WAIT_V(8); PG8_WAIT_L(0); PG8_BAR; PG8_MMA(0, 0, At, B0); PG8_MMA(0, 1, At, B1); PG8_BAR; PG8_SCHED;
            PG8_LDA(At, 1, 1); PG8_STAGE(PG8_SB(1, 0), b3, voffB); PG8_STAGE(PG8_SB(1, 1), b3 + hstep, voffB); PG8_STAGE(PG8_SA(1, 0), a3, voffA);
            PG8_WAIT_V(8); PG8_WAIT_L(0); PG8_BAR; PG8_MMA(1, 0, At, B0); PG8_MMA(1, 1, At, B1); PG8_BAR; PG8_SCHED;
            } else {
            PG8_LDB(B0, 0, 0); PG8_SCHED; PG8_LDA(At, 0, 0); PG8_STAGE(PG8_SA(1, 1), a1 + hstep, voffA);
            PG8_WAIT_L(8); PG8_BAR; PG8_WAIT_L(0); PG8_MMA(0, 0, At, B0); PG8_BAR; PG8_SCHED;
            PG8_LDB(B1, 0, 1); PG8_STAGE(PG8_SB(0, 0), b2, voffB);
            PG8_BAR; PG8_WAIT_L(0); PG8_MMA(0, 1, At, B1); PG8_BAR;
            PG8_LDA(At, 0, 1); PG8_STAGE(PG8_SA(0, 0), a2, voffA);
            PG8_BAR; PG8_WAIT_L(0); PG8_MMA(1, 0, At, B0); PG8_BAR; PG8_SCHED;
            PG8_STAGE(PG8_SB(0, 1), b2 + hstep, voffB);
            PG8_WAIT_V(6); PG8_BAR; PG8_MMA(1, 1, At, B1); PG8_BAR;
            PG8_LDB(B0, 1, 0); PG8_SCHED; PG8_LDA(At, 1, 0); PG8_STAGE(PG8_SA(0, 1), a2 + hstep, voffA);
            PG8_WAIT_L(8); PG8_BAR; PG8_WAIT_L(0); PG8_MMA(0, 0, At, B0); PG8_BAR; PG8_SCHED;
            PG8_LDB(B1, 1, 1); PG8_STAGE(PG8_SB(1, 0), b3, voffB);
            PG8_BAR; PG8_WAIT_L(0); PG8_MMA(0, 1, At, B1); PG8_BAR;
            PG8_LDA(At, 1, 1); PG8_STAGE(PG8_SA(1, 0), a3, voffA);
            PG8_BAR; PG8_WAIT_L(0); PG8_MMA(1, 0, At, B0); PG8_BAR; PG8_SCHED;
            PG8_STAGE(PG8_SB(1, 1), b3 + hstep, voffB);
            PG8_WAIT_V(6); PG8_BAR; PG8_MMA(1, 1, At, B1); PG8_BAR;
            }
        }
        if constexpr (ALIGN_EPI) { if (wr == 0) PG8_BAR; }
        if constexpr (!Epi::AFTER_DRAIN) { E(acc, cur, wr, wc, fr, fq); S.done(cur); }
        if (!has_next) break;
#pragma unroll
        for (int a = 0; a < 2; ++a)
#pragma unroll
            for (int b = 0; b < 2; ++b)
#pragma unroll
                for (int m = 0; m < 4; ++m)
#pragma unroll
                    for (int n = 0; n < 2; ++n) acc[a][b][m][n] = (f32x4){0.f, 0.f, 0.f, 0.f};
        cur = nxt; cA = nA; cB = nB; ++ui;
        if constexpr (ALIGN_EPI) { if (wr == 1) PG8_BAR; }
    }
    PG8_WAIT_V(0);
    if constexpr (!ALIGN_EPI) { if (wr == 0) PG8_BAR; }
    PG8_BAR;
    if constexpr (Epi::AFTER_DRAIN) { E.fused(acc, cur, wr, wc, fr, fq, lds, wid, lane); S.done(cur); }
#undef PG8_SA
#undef PG8_SB
#undef PG8_STAGE
#undef PG8_LDA
#undef PG8_LDB
#undef PG8_MMA
#undef PG8_WAIT_V
#undef PG8_WAIT_L
#undef PG8_BAR
#undef PG8_SCHED
}
}
constexpr int NB = 8, SEQ = 2048, DM = 1024, M = NB * SEQ, NIN = 2560, DFF = 2816, NFF2 = 2 * DFF, DEPTH = 2;
constexpr int NWAVES = 8;
constexpr size_t MiB = 1u << 20;
constexpr size_t WS_ROWSS = 1 * MiB;
constexpr size_t WS_VGSS = 2 * MiB;
constexpr size_t WS_WSP = 3 * MiB;
constexpr size_t WS_W0 = 4 * MiB, WS_WSTRIDE = 24 * MiB;
constexpr size_t WOFF_IN = 0, WOFF_OUT = 5 * MiB, WOFF_FIN = 7 * MiB, WOFF_FOUT = 18 * MiB;
constexpr size_t WS_XB = 52 * MiB;
constexpr size_t WS_PROJ = 84 * MiB;
constexpr size_t WS_MIX = 164 * MiB;
constexpr size_t WS_HID = 84 * MiB;
constexpr size_t WS_END = 196 * MiB;
constexpr int LDS_BYTES = 147456;

#define GAS __attribute__((address_space(1)))
#define LAS __attribute__((address_space(3)))
typedef unsigned short bf16;
typedef unsigned v4u __attribute__((ext_vector_type(4)));
typedef float f32x4 __attribute__((ext_vector_type(4)));
__device__ __forceinline__ unsigned f2bf(float f) { unsigned u = __builtin_bit_cast(unsigned, f); return (u + 0x7fffu + ((u >> 16) & 1u)) >> 16; }
__device__ __forceinline__ unsigned pk2(float lo, float hi) { return f2bf(lo) | (f2bf(hi) << 16); }
__device__ __forceinline__ float bf2f(bf16 v) { return __builtin_bit_cast(float, (unsigned)v << 16); }
__device__ __forceinline__ float wave_sum(float v) {
#pragma unroll
    for (int o = 1; o < 64; o <<= 1) v += __shfl_xor(v, o);
    return v;
}
#define LDS_WAIT() asm volatile("s_waitcnt lgkmcnt(0)" ::: "memory")

__device__ __forceinline__ void p0_transpose_item(const float* W, int K, int N, bf16* WT, int k0, int n0, int prow0, const float* gk, LAS float* scr, int lane) {
#pragma unroll 8
    for (int i = 0; i < 32; ++i) { const int kk = 2 * i + (lane >> 5); float w = W[(size_t)(k0 + kk) * N + n0 + (lane & 31)]; if (gk) w *= gk[k0 + kk]; scr[kk * 33 + (lane & 31)] = w; }
    LDS_WAIT(); asm volatile("" ::: "memory");
    const int c = lane & 7;
#pragma unroll
    for (int j = 0; j < 4; ++j) { const int n = (lane >> 3) + 8 * j; const LAS float* s = scr + (8 * c) * 33 + n;
        v4u o; o.x = pk2(s[0 * 33], s[1 * 33]); o.y = pk2(s[2 * 33], s[3 * 33]); o.z = pk2(s[4 * 33], s[5 * 33]); o.w = pk2(s[6 * 33], s[7 * 33]);
        *(v4u*)(WT + (size_t)(prow0 + n) * K + k0 + 8 * c) = o; }
    LDS_WAIT(); asm volatile("" ::: "memory");
}
__host__ __device__ __forceinline__ int map_in(int n) { const int T = n >> 8, nn = n & 255; return 256 * T + 128 * ((nn >> 5) & 1) + 32 * (nn >> 6) + (nn & 31); }
__host__ __device__ __forceinline__ int map_fin(int n) { return n < DFF ? 256 * (n >> 7) + (n & 127) : 256 * ((n - DFF) >> 7) + 128 + ((n - DFF) & 127); }

typedef GAS unsigned gu32;
#define RLX_AGENT __ATOMIC_RELAXED, __HIP_MEMORY_SCOPE_AGENT
constexpr int MISC_OFF = LDS_BYTES - 64;
constexpr size_t WS_BAR = 0;
constexpr size_t BAR_ZERO_BYTES = 16384;
#define XB_TMO      128
#define XB_XCNT(j)  (256  + 64 * (j))
#define XB_XSUB(j)  (1280 + 64 * (j))
#define XB_XGEN(j)  (2304 + 64 * (j))
#define XB_TOP      3328
#define XB_TOPGEN   3392
#define XCD_BAR_WORDS 3456
#define XB_SPIN_CAP (1u << 18)

__device__ __forceinline__ unsigned xb_ld(unsigned* p)              { return __hip_atomic_load(p, __ATOMIC_RELAXED, __HIP_MEMORY_SCOPE_AGENT); }
__device__ __forceinline__ unsigned xb_add(unsigned* p, unsigned v) { return __hip_atomic_fetch_add(p, v, __ATOMIC_RELAXED, __HIP_MEMORY_SCOPE_AGENT); }
__device__ __forceinline__ unsigned xb_xcc_id() { return (unsigned)__builtin_amdgcn_s_getreg((3 << 11) | 20) & 0xFu; }
#define XB_SPIN(cond, bar) do { unsigned _sp = 0; while (cond) { __builtin_amdgcn_s_sleep(1); \
    if ((++_sp & 255u) == 0u) { if (xb_ld(&(bar)[XB_TMO])) break; if (_sp > XB_SPIN_CAP) { atomicAdd(&(bar)[XB_TMO], 1u); break; } } } } while (0)

struct XcdBarrier {
    unsigned* bar; unsigned x;
    volatile LAS unsigned* st;
};

__device__ __forceinline__ XcdBarrier xcd_barrier_post(unsigned* bar, volatile LAS unsigned* st) {
    XcdBarrier b; b.bar = bar; b.x = xb_xcc_id(); b.st = st;
    if (threadIdx.x == 0) (void)xb_add(&bar[XB_XCNT(b.x)], 1u);
    return b;
}
__device__ __forceinline__ void xcd_barrier_complete(unsigned* bar, unsigned x, unsigned& nloc, unsigned& nx) {
    const unsigned G = gridDim.x * gridDim.y * gridDim.z;
    unsigned sum, cnt, mine, sp = 0u;
    for (;;) {
        sum = 0u; cnt = 0u; mine = 0u;
#pragma unroll
        for (unsigned j = 0; j < 16; ++j) { const unsigned c = xb_ld(&bar[XB_XCNT(j)]); sum += c; cnt += (c > 0u) ? 1u : 0u; mine = (j == x) ? c : mine; }
        if (sum == G) break;
        __builtin_amdgcn_s_sleep(1);
        if ((++sp & 255u) == 0u) { if (xb_ld(&bar[XB_TMO])) break; if (sp > XB_SPIN_CAP) { atomicAdd(&bar[XB_TMO], 1u); break; } }
    }
    nloc = mine > 0u ? mine : 1u; nx = cnt > 0u ? cnt : 1u;
}

__device__ __forceinline__ void xcd_barrier(const XcdBarrier& b) {
    asm volatile("s_waitcnt vmcnt(0)" ::: "memory");
    __syncthreads();
    if (threadIdx.x == 0) {
        unsigned* bar = b.bar;
        __builtin_amdgcn_s_waitcnt(0);
        unsigned nloc = b.st[0], nx = b.st[1];
        if (nloc == 0u) { xcd_barrier_complete(bar, b.x, nloc, nx); b.st[0] = nloc; b.st[1] = nx; }
        const unsigned old = xb_add(&bar[XB_XSUB(b.x)], 1u);
        const unsigned gen = old / nloc;
        if (old + 1u == (gen + 1u) * nloc) {
            __builtin_amdgcn_fence(__ATOMIC_RELEASE, "agent");
            asm volatile("s_waitcnt vmcnt(0)" ::: "memory");
            const unsigned og = xb_add(&bar[XB_TOP], 1u);
            const unsigned tg = og / nx;
            if (og + 1u == (tg + 1u) * nx) xb_add(&bar[XB_TOPGEN], 1u);
            else XB_SPIN(xb_ld(&bar[XB_TOPGEN]) == tg, bar);
            __builtin_amdgcn_fence(__ATOMIC_ACQUIRE, "agent");
            xb_add(&bar[XB_XGEN(b.x)], 1u);
            asm volatile("s_waitcnt vmcnt(0)" ::: "memory");
        } else {
            XB_SPIN(xb_ld(&bar[XB_XGEN(b.x)]) == gen, bar);
            __builtin_amdgcn_fence(__ATOMIC_ACQUIRE, "agent");
            asm volatile("s_waitcnt vmcnt(0)" ::: "memory");
        }
    }
    __syncthreads();
}

#define GRID_BAR() do { XcdBarrier bar_; bar_.bar = (unsigned*)(kargs_ws() + WS_BAR); bar_.x = xb_xcc_id(); bar_.st = (volatile LAS unsigned*)(lds + MISC_OFF); xcd_barrier(bar_); } while (0)
struct Args { const float* in[15]; float* out; unsigned char* ws; };
typedef const __attribute__((address_space(4))) Args CArgs;
__device__ __forceinline__ CArgs* kargs();
__device__ __forceinline__ unsigned char* kargs_ws();
__device__ __forceinline__ CArgs* kargs() { CArgs* p = (CArgs*)__builtin_amdgcn_kernarg_segment_ptr(); asm volatile("" : "+s"(p)); return p; }
__device__ __forceinline__ unsigned char* kargs_ws() { return kargs()->ws; }

__device__ __forceinline__ void prologue(CArgs* a, LAS unsigned char* lds, int wave, int lane) {
    LAS float* scr = (LAS float*)(lds + wave * 16384);
    const int gw = blockIdx.x * NWAVES + wave, NGW = gridDim.x * NWAVES;
    constexpr int I_IN = (DM / 64) * (NIN / 32), I_OUT = (DM / 64) * (DM / 32), I_FIN = (DM / 64) * (NFF2 / 32), I_FOUT = (DFF / 64) * (DM / 32);
    constexpr int I_LAYER = I_IN + I_OUT + I_FIN + I_FOUT;
    for (int it = gw; it < DEPTH * I_LAYER; it += NGW) {
        const int l = it / I_LAYER; int r = it % I_LAYER;
        unsigned char* wb = a->ws + WS_W0 + (size_t)l * WS_WSTRIDE;
        if (r < I_IN) { const int nblk = NIN / 32, kb = r / nblk, nb = r % nblk;
            p0_transpose_item(a->in[2] + (size_t)l * DM * NIN, DM, NIN, (bf16*)(wb + WOFF_IN), 64 * kb, 32 * nb, map_in(32 * nb), a->in[1] + l * DM, scr, lane); continue; } r -= I_IN;
        if (r < I_OUT) { const int nblk = DM / 32, kb = r / nblk, nb = r % nblk;
            p0_transpose_item(a->in[11] + (size_t)l * DM * DM, DM, DM, (bf16*)(wb + WOFF_OUT), 64 * kb, 32 * nb, 32 * nb, nullptr, scr, lane); continue; } r -= I_OUT;
        if (r < I_FIN) { const int nblk = NFF2 / 32, kb = r / nblk, nb = r % nblk;
            p0_transpose_item(a->in[13] + (size_t)l * DM * NFF2, DM, NFF2, (bf16*)(wb + WOFF_FIN), 64 * kb, 32 * nb, map_fin(32 * nb), a->in[12] + l * DM, scr, lane); continue; } r -= I_FIN;
        { const int nblk = DM / 32, kb = r / nblk, nb = r % nblk;
            p0_transpose_item(a->in[14] + (size_t)l * DFF * DM, DFF, DM, (bf16*)(wb + WOFF_FOUT), 64 * kb, 32 * nb, 32 * nb, nullptr, scr, lane); }
    }
    float* rowss = (float*)(a->ws + WS_ROWSS); bf16* xb = (bf16*)(a->ws + WS_XB);
    for (int m = gw; m < M; m += NGW) {
        const f32x4* xr = (const f32x4*)(a->in[0] + (size_t)m * DM) + lane; f32x4* orow = (f32x4*)(a->out + (size_t)m * DM) + lane;
        unsigned long long* o8 = (unsigned long long*)(xb + (size_t)m * DM) + lane;
        float s = 0.f;
#pragma unroll
        for (int j = 0; j < 4; ++j) { const f32x4 v = xr[64 * j]; s += (v.x * v.x + v.y * v.y) + (v.z * v.z + v.w * v.w); orow[64 * j] = v;
            o8[64 * j] = (unsigned long long)pk2(v.x, v.y) | ((unsigned long long)pk2(v.z, v.w) << 32); }
        s = wave_sum(s);
        if (lane < 16) rowss[(size_t)m * 16 + lane] = lane == 0 ? s : 0.f;
    }
    { const float* wsp = a->in[7]; bf16* o = (bf16*)(a->ws + WS_WSP); const int gt = blockIdx.x * 512 + threadIdx.x, NT = gridDim.x * 512;
      for (int i = gt; i < DEPTH * 8 * 128 * 128; i += NT) { const int s = i & 127, t = (i >> 7) & 127; o[i] = (bf16)(((t >> 6) >= (s >> 6)) ? f2bf(wsp[i]) : 0u); } }
}

__device__ __forceinline__ void mixer_naive(CArgs* a, int l, LAS unsigned char* lds, int wave, int lane) {
    const bf16* P = (const bf16*)(a->ws + WS_PROJ); bf16* MIX = (bf16*)(a->ws + WS_MIX);
    const float* vgss = (const float*)(a->ws + WS_VGSS); const bf16* wsp = (const bf16*)(a->ws + WS_WSP) + (size_t)l * 8 * 128 * 128;
    const float* rel = a->in[5] + (size_t)l * 8 * 257; const float* sgu_g = a->in[6] + l * 512; const float* bsp = a->in[8] + l * 8 * 128;
    const float* ag = a->in[9] + l * 512; const float* gg = a->in[10] + l * 512;
    LAS float* red = (LAS float*)lds;
    for (int tok = blockIdx.x; tok < M; tok += gridDim.x) {
        const int b = tok / SEQ, t = tok % SEQ, c = t >> 6;
        const int h = wave;
        const float q = bf2f(P[(size_t)tok * NIN + h * 64 + lane]);
        float mx = -INFINITY, lsum = 0.f, o = 0.f;
        const int k0 = (c >= 8 ? c - 8 : 0) * 64, k1 = c * 64 + 63;
        for (int kt = k0; kt <= k1; ++kt) {
            const size_t kr = (size_t)(b * SEQ + kt) * NIN;
            float s = wave_sum(q * bf2f(P[kr + 512 + h * 64 + lane]));
            int d = t - kt; d = d < -128 ? -128 : (d > 128 ? 128 : d);
            s += rel[h * 257 + d + 128] * pg8::LOG2E;
            const float mn = fmaxf(mx, s), al = __builtin_amdgcn_exp2f(mx - mn), p = __builtin_amdgcn_exp2f(s - mn);
            lsum = lsum * al + p; o = o * al + p * bf2f(P[kr + 1024 + h * 64 + lane]); mx = mn;
        }
        o = o / lsum;
        const int g = wave, nb = t >> 7, tp = t & 127, ns = tp < 64 ? 64 : 128;
        float mixd = 0.f;
        for (int s = 0; s < ns; ++s) {
            const int srow = b * SEQ + nb * 128 + s;
            const f32x4* pv = (const f32x4*)(vgss + (size_t)srow * 8); const f32x4 p0 = pv[0], p1 = pv[1];
            const float rs = __builtin_amdgcn_rsqf((((p0[0] + p0[1]) + (p0[2] + p0[3])) + ((p1[0] + p1[1]) + (p1[2] + p1[3]))) * (1.0f / 512.0f) + pg8::RMS_EPS);
            mixd += bf2f(wsp[(g * 128 + tp) * 128 + s]) * (bf2f(P[(size_t)srow * NIN + 2048 + g * 64 + lane]) * rs * sgu_g[g * 64 + lane]);
        }
        const float gv = bf2f(P[(size_t)tok * NIN + 1536 + g * 64 + lane]) * (mixd + bsp[g * 128 + tp]);
        const float so = wave_sum(o * o), sg = wave_sum(gv * gv);
        __syncthreads();
        if (lane == 0) { red[wave] = so; red[8 + wave] = sg; }
        __syncthreads();
        float ta = 0.f, tg = 0.f;
#pragma unroll
        for (int w = 0; w < 8; ++w) { ta += red[w]; tg += red[8 + w]; }
        const float ra = __builtin_amdgcn_rsqf(ta * (1.0f / 512.0f) + pg8::RMS_EPS), rg = __builtin_amdgcn_rsqf(tg * (1.0f / 512.0f) + pg8::RMS_EPS);
        MIX[(size_t)tok * DM + h * 64 + lane] = (bf16)f2bf(o * ra * ag[h * 64 + lane]);
        MIX[(size_t)tok * DM + 512 + g * 64 + lane] = (bf16)f2bf(gv * rg * gg[g * 64 + lane]);
    }
    __syncthreads();
}

#ifndef FAST_MIXER
#define FAST_MIXER 1
#endif
#ifndef PHM
#define PHM 31
#endif
#ifndef REPM
#define REPM 0
#endif
#define REPEAT(bit) for (int rep_ = 0; rep_ < (((REPM) >> (bit)) & 1) + 1; ++rep_)
namespace mx {
typedef float f32x16 __attribute__((ext_vector_type(16)));
typedef short bf16x8 __attribute__((ext_vector_type(8)));
typedef short s16x4 __attribute__((ext_vector_type(4)));
typedef unsigned u32x2 __attribute__((ext_vector_type(2)));
constexpr int TBL_OFF = 131072;
constexpr int RED_OFF = TBL_OFF + 8 * 260 * 4;
__device__ __forceinline__ int crow(int r, int hi) { return (r & 3) + 8 * (r >> 2) + 4 * hi; }
__device__ __forceinline__ int vimg(int row, int chunk) { return row * 128 + ((chunk * 16) ^ (((row >> 1) & 1) << 6)); }
__device__ __forceinline__ s16x4 tr64(LAS unsigned char* p) { return __builtin_bit_cast(s16x4, __builtin_amdgcn_ds_read_tr16_b64_v4i16((LAS s16x4*)p)); }
__device__ __forceinline__ bf16x8 cat8(s16x4 a, s16x4 b) { return (bf16x8){a[0], a[1], a[2], a[3], b[0], b[1], b[2], b[3]}; }
__device__ __forceinline__ unsigned cvtpk(float lo, float hi) { unsigned r; asm("v_cvt_pk_bf16_f32 %0, %1, %2" : "=v"(r) : "v"(lo), "v"(hi)); return r; }
#define MX_FENCE() asm volatile("" ::: "memory")

__device__ __forceinline__ void attn_task(const bf16* P, int b, int c, int half, int h, LAS unsigned char* wl, const LAS float* tbl, int lane, f32x16 (&o)[2]) {
    const int r32 = lane & 31, hi = lane >> 5;
    const size_t tok0 = (size_t)b * SEQ + c * 64 + half * 32;
    bf16x8 qf[4];
#pragma unroll
    for (int d0 = 0; d0 < 4; ++d0) qf[d0] = *(const bf16x8*)(P + (tok0 + r32) * NIN + h * 64 + d0 * 16 + hi * 8);
#pragma unroll
    for (int r = 0; r < 16; ++r) { o[0][r] = 0.f; o[1][r] = 0.f; }
    float m = -INFINITY, l = 0.f;
    const int kc0 = c >= 8 ? c - 8 : 0;
    const int dhalf = (lane >> 4) & 1, qq = (lane & 15) >> 2, p4 = lane & 3;
    int vb[2];
#pragma unroll
    for (int dt = 0; dt < 2; ++dt) vb[dt] = (4 * hi + qq) * 128 + ((64 * dt + 32 * dhalf + 8 * p4) ^ ((qq >> 1) << 6));
    const int prow = lane >> 3, pch = lane & 7;
    bf16x8 kf[2][4];
    const unsigned koff = (unsigned)(r32 * NIN + hi * 8) * 2u, voff = (unsigned)(prow * NIN + (pch ^ (((lane >> 4) & 1) << 2)) * 8) * 2u;
#define MX_LOADK(kc) do { const char* kp_ = (const char*)(P + ((size_t)b * SEQ + (kc) * 64) * NIN + 512 + h * 64); \
        _Pragma("unroll") for (int kt = 0; kt < 2; ++kt) _Pragma("unroll") for (int d0 = 0; d0 < 4; ++d0) kf[kt][d0] = *(const bf16x8*)(kp_ + (size_t)(kt * 32 * NIN + d0 * 16) * 2 + koff); } while (0)
#define MX_LOADV(kc, bufo) do { const char* vp_ = (const char*)(P + ((size_t)b * SEQ + (kc) * 64) * NIN + 1024 + h * 64); \
        _Pragma("unroll") for (int i = 0; i < 8; ++i) __builtin_amdgcn_global_load_lds((const unsigned*)(vp_ + (size_t)(i * 8 * NIN) * 2 + voff), (LAS unsigned*)(wl + (bufo) + i * 1024), 16, 0, 0); } while (0)
    MX_LOADK(kc0); MX_LOADV(kc0, 0);
    int buf = 0;
    for (int kc = kc0; kc <= c; ++kc) {
        const int j = kc - c + 8;
        LAS unsigned char* vt = wl + buf * 8192;
        asm volatile("s_waitcnt vmcnt(0)" ::: "memory");
        if (kc < c) MX_LOADV(kc + 1, (buf ^ 1) * 8192);
        f32x16 st[2];
        if (j <= 5) { const float bc = tbl[256];
#pragma unroll
            for (int r = 0; r < 16; ++r) { st[0][r] = bc; st[1][r] = bc; } }
        else { int D0 = 64 * (8 - j) + half * 32 + r32 - 4 * hi; asm volatile("" : "+v"(D0));
#pragma unroll
            for (int kt = 0; kt < 2; ++kt)
#pragma unroll
                for (int r = 0; r < 16; ++r) { int idx = D0 - (32 * kt + (r & 3) + 8 * (r >> 2)); idx = idx < -128 ? -128 : (idx > 128 ? 128 : idx); st[kt][r] = tbl[idx + 128]; } }
#pragma unroll
        for (int kt = 0; kt < 2; ++kt)
#pragma unroll
            for (int d0 = 0; d0 < 4; ++d0) st[kt] = __builtin_amdgcn_mfma_f32_32x32x16_bf16(kf[kt][d0], qf[d0], st[kt], 0, 0, 0);
        if (kc < c) { MX_LOADK(kc + 1); }
        float mxv = fmaxf(st[0][0], st[1][0]);
#pragma unroll
        for (int r = 1; r < 16; ++r) mxv = fmaxf(mxv, fmaxf(st[0][r], st[1][r]));
        mxv = fmaxf(mxv, __shfl_xor(mxv, 32));
        const float mn = fmaxf(m, mxv), al = __builtin_amdgcn_exp2f(m - mn); m = mn;
        float rs = 0.f;
#pragma unroll
        for (int kt = 0; kt < 2; ++kt)
#pragma unroll
            for (int r = 0; r < 16; ++r) { const float p = __builtin_amdgcn_exp2f(st[kt][r] - mn); st[kt][r] = p; rs += p; }
        l = l * al + rs;
#pragma unroll
        for (int r = 0; r < 16; ++r) { o[0][r] *= al; o[1][r] *= al; }
        bf16x8 pf[4];
#pragma unroll
        for (int s = 0; s < 4; ++s) { v4u w; const int kt = s >> 1, r0 = 8 * (s & 1);
            w.x = cvtpk(st[kt][r0 + 0], st[kt][r0 + 1]); w.y = cvtpk(st[kt][r0 + 2], st[kt][r0 + 3]); w.z = cvtpk(st[kt][r0 + 4], st[kt][r0 + 5]); w.w = cvtpk(st[kt][r0 + 6], st[kt][r0 + 7]);
            pf[s] = __builtin_bit_cast(bf16x8, w); }
#pragma unroll
        for (int dt = 0; dt < 2; ++dt)
#pragma unroll
            for (int s = 0; s < 4; ++s) { const s16x4 a0 = tr64(vt + vb[dt] + (16 * s) * 128), a1 = tr64(vt + vb[dt] + (16 * s + 8) * 128);
                o[dt] = __builtin_amdgcn_mfma_f32_32x32x16_bf16(cat8(a0, a1), pf[s], o[dt], 0, 0, 0); }
        MX_FENCE();
        buf ^= 1;
    }
#undef MX_LOADK
#undef MX_LOADV
    l += __shfl_xor(l, 32);
    const float inv = 1.0f / l;
#pragma unroll
    for (int r = 0; r < 16; ++r) { o[0][r] *= inv; o[1][r] *= inv; }
}

__device__ __forceinline__ void sgu_task(const bf16* P, const float* vgss, const bf16* wsp_l, const float* sgu_g, const float* bsp_l, int b, int c, int half, int g, LAS unsigned char* wl, int lane, f32x16 (&o)[2]) {
    const int r32 = lane & 31, hi = lane >> 5;
    const int nb = c >> 1, cb = c & 1, tpos0 = cb * 64 + half * 32, ns = cb ? 128 : 64;
    const size_t srow0 = (size_t)b * SEQ + nb * 128, tok0 = (size_t)b * SEQ + c * 64 + half * 32;
    const int prow = lane >> 3, pch = lane & 7;
    const f32x4 g0 = *(const f32x4*)(sgu_g + g * 64 + pch * 8), g1 = *(const f32x4*)(sgu_g + g * 64 + pch * 8 + 4);
    MX_FENCE();
#pragma unroll 4
    for (int i = 0; i < ns / 8; ++i) {
        const int row = prow + 8 * i; const size_t srow = srow0 + row;
        const f32x4 p0 = *(const f32x4*)(vgss + srow * 8), p1 = *(const f32x4*)(vgss + srow * 8 + 4);
        const float rs = __builtin_amdgcn_rsqf((((p0[0] + p0[1]) + (p0[2] + p0[3])) + ((p1[0] + p1[1]) + (p1[2] + p1[3]))) * (1.0f / 512.0f) + pg8::RMS_EPS);
        const v4u raw = *(const v4u*)(P + srow * NIN + 2048 + g * 64 + pch * 8);
        v4u w;
        w.x = cvtpk(__builtin_bit_cast(float, raw.x << 16) * rs * g0[0], __builtin_bit_cast(float, raw.x & 0xffff0000u) * rs * g0[1]);
        w.y = cvtpk(__builtin_bit_cast(float, raw.y << 16) * rs * g0[2], __builtin_bit_cast(float, raw.y & 0xffff0000u) * rs * g0[3]);
        w.z = cvtpk(__builtin_bit_cast(float, raw.z << 16) * rs * g1[0], __builtin_bit_cast(float, raw.z & 0xffff0000u) * rs * g1[1]);
        w.w = cvtpk(__builtin_bit_cast(float, raw.w << 16) * rs * g1[2], __builtin_bit_cast(float, raw.w & 0xffff0000u) * rs * g1[3]);
        *(LAS v4u*)(wl + vimg(row, pch)) = w;
    }
    MX_FENCE();
#pragma unroll
    for (int r = 0; r < 16; ++r) { o[0][r] = 0.f; o[1][r] = 0.f; }
    const int dhalf = (lane >> 4) & 1, qq = (lane & 15) >> 2, p4 = lane & 3;
    int vbs[2];
#pragma unroll
    for (int ct = 0; ct < 2; ++ct) vbs[ct] = (8 * hi + qq) * 128 + ((64 * ct + 32 * dhalf + 8 * p4) ^ ((qq >> 1) << 6));
    const bf16* wrow = wsp_l + ((size_t)g * 128 + tpos0 + r32) * 128 + hi * 8;
#pragma unroll 4
    for (int step = 0; step < ns / 16; ++step) {
        const bf16x8 wf = *(const bf16x8*)(wrow + 16 * step);
#pragma unroll
        for (int ct = 0; ct < 2; ++ct) { const s16x4 a0 = tr64(wl + vbs[ct] + (16 * step) * 128), a1 = tr64(wl + vbs[ct] + (16 * step + 4) * 128);
            o[ct] = __builtin_amdgcn_mfma_f32_32x32x16_bf16(cat8(a0, a1), wf, o[ct], 0, 0, 0); }
    }
    MX_FENCE();
    const float bt = bsp_l[g * 128 + tpos0 + r32];
    const bf16* up = P + (tok0 + r32) * NIN + 1536 + g * 64 + 4 * hi;
#pragma unroll
    for (int ct = 0; ct < 2; ++ct)
#pragma unroll
        for (int rg = 0; rg < 4; ++rg) { const u32x2 uu = *(const u32x2*)(up + 32 * ct + 8 * rg);
            o[ct][4 * rg + 0] = __builtin_bit_cast(float, uu.x << 16) * (o[ct][4 * rg + 0] + bt); o[ct][4 * rg + 1] = __builtin_bit_cast(float, uu.x & 0xffff0000u) * (o[ct][4 * rg + 1] + bt);
            o[ct][4 * rg + 2] = __builtin_bit_cast(float, uu.y << 16) * (o[ct][4 * rg + 2] + bt); o[ct][4 * rg + 3] = __builtin_bit_cast(float, uu.y & 0xffff0000u) * (o[ct][4 * rg + 3] + bt); }
}

__device__ __forceinline__ void norm_store(const f32x16 (&o)[2], LAS float* red, int wave, int lane, const float* gain, bf16* dst) {
    const int r32 = lane & 31, hi = lane >> 5;
    float ss = 0.f;
#pragma unroll
    for (int r = 0; r < 16; ++r) ss += o[0][r] * o[0][r] + o[1][r] * o[1][r];
    ss += __shfl_xor(ss, 32);
    if (hi == 0) red[wave * 32 + r32] = ss;
    __syncthreads();
    float tot = 0.f;
#pragma unroll
    for (int w = 0; w < 8; ++w) tot += red[w * 32 + r32];
    const float rn = __builtin_amdgcn_rsqf(tot * (1.0f / 512.0f) + pg8::RMS_EPS);
#pragma unroll
    for (int ct = 0; ct < 2; ++ct)
#pragma unroll
        for (int rg = 0; rg < 4; ++rg) { const int ch = 32 * ct + 8 * rg + 4 * hi; const f32x4 gv = *(const f32x4*)(gain + ch);
            u32x2 w; w.x = cvtpk(o[ct][4 * rg + 0] * rn * gv[0], o[ct][4 * rg + 1] * rn * gv[1]); w.y = cvtpk(o[ct][4 * rg + 2] * rn * gv[2], o[ct][4 * rg + 3] * rn * gv[3]);
            *(u32x2*)(dst + (size_t)r32 * DM + ch) = w; }
}

__device__ __forceinline__ void mixer_fast(CArgs* a, int l, LAS unsigned char* lds, int wave, int lane) {
    const bf16* P = (const bf16*)(a->ws + WS_PROJ); bf16* MIX = (bf16*)(a->ws + WS_MIX);
    const float* vgss = (const float*)(a->ws + WS_VGSS); const bf16* wsp_l = (const bf16*)(a->ws + WS_WSP) + (size_t)l * 8 * 128 * 128;
    const float* rel = a->in[5] + (size_t)l * 8 * 257; const float* sgu_g = a->in[6] + l * 512; const float* bsp_l = a->in[8] + l * 8 * 128;
    const float* ag = a->in[9] + l * 512; const float* gg = a->in[10] + l * 512;
    LAS float* tbl = (LAS float*)(lds + TBL_OFF); LAS float* red = (LAS float*)(lds + RED_OFF);
    for (int i = threadIdx.x; i < 8 * 257; i += NWAVES * 64) { const int h = i / 257, k = i % 257; tbl[h * 260 + k] = rel[i] * pg8::LOG2E; }
    __syncthreads();
    LAS unsigned char* wl = lds + wave * 16384;
    for (int u = blockIdx.x; u < NB * (SEQ / 64); u += gridDim.x) {
        const int b = u & 7, c = u >> 3;
#pragma nounroll
        for (int half = 0; half < 2; ++half) {
            const size_t tok0 = (size_t)b * SEQ + c * 64 + half * 32;
            f32x16 o[2];
            attn_task(P, b, c, half, wave, wl, tbl + wave * 260, lane, o);
            norm_store(o, red, wave, lane, ag + wave * 64, MIX + tok0 * DM + wave * 64);
            sgu_task(P, vgss, wsp_l, sgu_g, bsp_l, b, c, half, wave, wl, lane, o);
            norm_store(o, red + 256, wave, lane, gg + wave * 64, MIX + tok0 * DM + 512 + wave * 64);
        }
    }
    __syncthreads();
}
}

__global__ void __launch_bounds__(NWAVES * 64, 2) fwd_megakernel(Args a_unused) {
    extern __shared__ __attribute__((aligned(16))) unsigned char lds_raw[];
    LAS unsigned char* lds = (LAS unsigned char*)lds_raw;
    if (threadIdx.x < 16) ((LAS unsigned*)(lds + MISC_OFF))[threadIdx.x] = 0u;
    __syncthreads();
    (void)xcd_barrier_post((unsigned*)(kargs_ws() + WS_BAR), (volatile LAS unsigned*)(lds + MISC_OFF));
    { const int tid = threadIdx.x, lane = tid & 63, wave = __builtin_amdgcn_readfirstlane(tid >> 6);
      REPEAT(0) prologue(kargs(), lds, wave, lane); }
    GRID_BAR();
#if (REPM >> 6) & 1
    for (int i_ = 0; i_ < 10; ++i_) GRID_BAR();
#endif
#pragma nounroll
    for (int l = 0; l < DEPTH; ++l) {
#if PHM & 1
        REPEAT(1) {
            CArgs* a = kargs(); unsigned char* ws = a->ws; unsigned char* wb = ws + WS_W0 + (size_t)l * WS_WSTRIDE;
            pg8::Gemm g{(const bf16*)(ws + WS_XB), (const bf16*)(wb + WOFF_IN), M, NIN, DM}; pg8::StaticOrder S; S.init(M, NIN, (int)gridDim.x, (int)blockIdx.x);
            pg8::EpiInProj E{(bf16*)(ws + WS_PROJ), (const float*)(ws + WS_ROWSS), (float*)(ws + WS_VGSS), a->in[3] + l * 64, a->in[4] + l * 64};
            pg8::gemm_phase<pg8::EpiInProj, pg8::StaticOrder, true, true>(lds, g, S, E);
        }
#endif
        GRID_BAR();
#if PHM & 2
        REPEAT(2) { int tid = threadIdx.x; asm volatile("" : "+v"(tid)); const int lane = tid & 63, wave = __builtin_amdgcn_readfirstlane(tid >> 6);
#if FAST_MIXER
          mx::mixer_fast(kargs(), l, lds, wave, lane);
#else
          mixer_naive(kargs(), l, lds, wave, lane);
#endif
        }
#endif
        GRID_BAR();
#if PHM & 4
        REPEAT(3) {
            CArgs* a = kargs(); unsigned char* ws = a->ws; unsigned char* wb = ws + WS_W0 + (size_t)l * WS_WSTRIDE; float* xo = a->out;
            float* xw = (((REPM >> 3) & 1) && rep_ == 0) ? (float*)(ws + 84 * MiB) : xo;
            pg8::Gemm g{(const bf16*)(ws + WS_MIX), (const bf16*)(wb + WOFF_OUT), M, DM, DM}; pg8::StaticOrder S; S.init(M, DM, (int)gridDim.x, (int)blockIdx.x);
            pg8::EpiResid E{xo, xw, (bf16*)(ws + WS_XB), (float*)(ws + WS_ROWSS)};
            pg8::gemm_phase<pg8::EpiResid, pg8::StaticOrder, true, true>(lds, g, S, E);
        }
#endif
        GRID_BAR();
#if PHM & 8
        REPEAT(4) {
            CArgs* a = kargs(); unsigned char* ws = a->ws; unsigned char* wb = ws + WS_W0 + (size_t)l * WS_WSTRIDE;
            pg8::Gemm g{(const bf16*)(ws + WS_XB), (const bf16*)(wb + WOFF_FIN), M, NFF2, DM}; pg8::StaticOrder S; S.init(M, NFF2, (int)gridDim.x, (int)blockIdx.x);
            pg8::EpiSwiGLU E{(bf16*)(ws + WS_HID), (const float*)(ws + WS_ROWSS)};
            pg8::gemm_phase<pg8::EpiSwiGLU, pg8::StaticOrder, true, true>(lds, g, S, E);
        }
#endif
        GRID_BAR();
#if PHM & 16
        REPEAT(5) {
            CArgs* a = kargs(); unsigned char* ws = a->ws; unsigned char* wb = ws + WS_W0 + (size_t)l * WS_WSTRIDE; float* xo = a->out;
            float* xw = (((REPM >> 5) & 1) && rep_ == 0) ? (float*)(ws + 192 * MiB) : xo;
            pg8::Gemm g{(const bf16*)(ws + WS_HID), (const bf16*)(wb + WOFF_FOUT), M, DM, DFF}; pg8::StaticOrder S; S.init(M, DM, (int)gridDim.x, (int)blockIdx.x);
            pg8::EpiResid E{xo, xw, (bf16*)(ws + WS_XB), (float*)(ws + WS_ROWSS)};
            pg8::gemm_phase<pg8::EpiResid, pg8::StaticOrder, true, true>(lds, g, S, E);
        }
#endif
        if (l + 1 < DEPTH) GRID_BAR();
    }
}

extern "C" void kernel_launch(void* const* d_in, const int* in_sizes, int n_in, void* d_out, int out_size, void* d_ws, size_t ws_size, hipStream_t stream) {
    static int grid = 0;
    if (grid == 0) {
        if (n_in != 15 || in_sizes[0] != M * DM || out_size != M * DM || ws_size < WS_END) { fprintf(stderr, "kernel_launch: unexpected shapes (n_in %d, ws %zu)\n", n_in, ws_size); grid = -1; return; }
        int dev = 0, cus = 0, per_cu = 0;
        hipGetDevice(&dev); hipDeviceGetAttribute(&cus, hipDeviceAttributeMultiprocessorCount, dev);
        if (hipFuncSetAttribute((const void*)fwd_megakernel, hipFuncAttributeMaxDynamicSharedMemorySize, LDS_BYTES) != hipSuccess) { fprintf(stderr, "kernel_launch: hipFuncSetAttribute failed\n"); grid = -1; return; }
        if (hipOccupancyMaxActiveBlocksPerMultiprocessor(&per_cu, (const void*)fwd_megakernel, NWAVES * 64, LDS_BYTES) != hipSuccess || per_cu < 1) { fprintf(stderr, "kernel_launch: occupancy query failed (%d)\n", per_cu); (void)hipGetLastError(); per_cu = 1; }
        grid = cus * (per_cu > 1 ? 1 : per_cu);
    }
    if (grid < 0) return;
    if (hipMemsetAsync((char*)d_ws + WS_BAR, 0, BAR_ZERO_BYTES, stream) != hipSuccess) { fprintf(stderr, "kernel_launch: hipMemsetAsync failed\n"); return; }
    Args a{};
    for (int i = 0; i < 15; ++i) a.in[i] = (const float*)d_in[i];
    a.out = (float*)d_out; a.ws = (unsigned char*)d_ws;
    void* args[] = {&a};
    hipError_t e = hipLaunchCooperativeKernel((const void*)fwd_megakernel, dim3(grid), dim3(NWAVES * 64), args, LDS_BYTES, stream);
    if (e != hipSuccess) fprintf(stderr, "cooperative launch failed: %s (grid %d)\n", hipGetErrorString(e), grid);
}
```

```cpp
#include <hip/hip_runtime.h>
#include <hip/hip_cooperative_groups.h>
#include <cstdio>
#include <cstdint>
namespace cg = cooperative_groups;
namespace pg8 {
#define PG8_LAS __attribute__((address_space(3)))
typedef unsigned short bf16_t;
typedef short bf16x8 __attribute__((ext_vector_type(8)));
typedef float f32x4 __attribute__((ext_vector_type(4)));
typedef unsigned u32x4 __attribute__((ext_vector_type(4)));
constexpr int BM = 256, BK = 64, HALF = 128, HTB = HALF * BK * 2  , STAGE_BYTES = 8 * HTB, NXCD = 8, WGM = 8;

__host__ __device__ __forceinline__ int lds_byte(int r, int c) { const int st = (r >> 4) * 2 + (c >> 5), rr = r & 15, cc = c & 31, ob = rr * 64 + cc * 2; return st * 1024 + (ob ^ (((ob >> 9) & 1) << 5)); }
__host__ __device__ __forceinline__ void stage_rc(int b, int& R, int& C) { const int st = b / 1024, sb = b % 1024, swz = sb ^ (((sb >> 9) & 1) << 5); R = (st >> 1) * 16 + swz / 64; C = (st & 1) * 32 + (swz % 64) / 2; }
__host__ __device__ __forceinline__ int perm32(int rho) { const int n = rho >> 4, i = rho & 15; return 8 * (i >> 2) + 4 * n + (i & 3); }

struct Unit { int pm, pn; };
struct Gemm { const bf16_t* A; const bf16_t* Bt; int M, N, K; };

struct StaticOrder {
    int nM, nN, nwg, G, c;
    __host__ __device__ void init(int M, int N, int G_, int c_) { nM = M / BM; nN = N / BM; nwg = nM * nN; G = G_; c = c_; }
    __host__ __device__ bool next(int i, Unit& u) const {
        const long L = (long)i * G + c; if (L >= nwg) return false;
        int wgid = (int)L; { const int q = nwg / NXCD, r = nwg % NXCD, xcd = wgid % NXCD, off = wgid / NXCD; wgid = (xcd < r ? xcd * (q + 1) : r * (q + 1) + (xcd - r) * q) + off; }
        const int nig = WGM * nN, gid = wgid / nig, fm = gid * WGM, gsz = (nM - fm) < WGM ? (nM - fm) : WGM;
        u.pm = fm + ((wgid % nig) % gsz); u.pn = (wgid % nig) / gsz; return true;
    }
    __device__ __forceinline__ void a_ready(const Unit&) const {}
    __device__ __forceinline__ void done(const Unit&) const {}
};

__device__ __forceinline__ unsigned cvt_pk_bf16(float lo, float hi) { unsigned r; asm volatile("v_cvt_pk_bf16_f32 %0, %1, %2" : "=v"(r) : "v"(lo), "v"(hi)); return r; }
typedef float f32x2 __attribute__((ext_vector_type(2)));
constexpr float RMS_EPS = 1e-6f;
constexpr float LOG2E = 1.4426950408889634f;
constexpr float QSCALE = 0.125f * 1.4426950408889634f;
__device__ __forceinline__ float gelu_tanh(float x) {
    const float z2 = x * (1.5957691216057308f + 0.07135481627260025f * x * x);
    const float e = __builtin_amdgcn_exp2f(-LOG2E * z2);
    return x * __builtin_amdgcn_rcpf(1.0f + e);
}
__device__ __forceinline__ float row_rs(const float* rowss, int row) {
    const f32x4* pr = (const f32x4*)(rowss + (size_t)row * 16);
    const f32x4 a = pr[0], b = pr[1], c = pr[2], d = pr[3];
    const float ss = ((a[0] + a[1]) + (a[2] + a[3])) + ((b[0] + b[1]) + (b[2] + b[3])) + ((c[0] + c[1]) + (c[2] + c[3])) + ((d[0] + d[1]) + (d[2] + d[3]));
    return __builtin_amdgcn_rsqf(ss * (1.0f / 1024.0f) + RMS_EPS);
}
struct EpiInProj {
    static constexpr bool PERM = true, AFTER_DRAIN = false;
    bf16_t* P; const float* rowss; float* vgss; const float* qg; const float* kg;
    __device__ __forceinline__ void operator()(const f32x4 (&acc)[2][2][4][2], const Unit& u, int wr, int wc, int fr, int fq) const {
        const int region = u.pn >> 1, half = u.pn & 1;
        const int lcol = region * 512 + half * 256 + wc * 64 + fq * 8;
        float gq[2][8];
#pragma unroll
        for (int bj = 0; bj < 2; ++bj)
#pragma unroll
            for (int e = 0; e < 8; ++e) gq[bj][e] = 1.f;
        if (region < 2) { const float* g = region == 0 ? qg : kg; const float sc = region == 0 ? QSCALE : 1.f;
#pragma unroll
            for (int bj = 0; bj < 2; ++bj)
#pragma unroll
                for (int e = 0; e < 8; ++e) gq[bj][e] = g[bj * 32 + fq * 8 + e] * sc; }
#pragma unroll
        for (int ai = 0; ai < 2; ++ai)
#pragma unroll
            for (int m = 0; m < 4; ++m) {
                const int row = u.pm * BM + ai * HALF + wr * 64 + m * 16 + fr;
                const float s = row_rs(rowss, row);
                float v[2][8];
#pragma unroll
                for (int bj = 0; bj < 2; ++bj)
#pragma unroll
                    for (int n = 0; n < 2; ++n)
#pragma unroll
                        for (int i = 0; i < 4; ++i) v[bj][4 * n + i] = acc[ai][bj][m][n][i] * s;
                if (region < 2) {
                    float q = 0.f;
#pragma unroll
                    for (int bj = 0; bj < 2; ++bj)
#pragma unroll
                        for (int e = 0; e < 8; ++e) q += v[bj][e] * v[bj][e];
                    q += __shfl_xor(q, 16); q += __shfl_xor(q, 32);
                    const float r = __builtin_amdgcn_rsqf(q * (1.0f / 64.0f) + RMS_EPS);
#pragma unroll
                    for (int bj = 0; bj < 2; ++bj)
#pragma unroll
                        for (int e = 0; e < 8; ++e) v[bj][e] = v[bj][e] * r * gq[bj][e];
                } else if (region >= 3) {
#pragma unroll
                    for (int bj = 0; bj < 2; ++bj)
#pragma unroll
                        for (int e = 0; e < 8; ++e) v[bj][e] = gelu_tanh(v[bj][e]);
                    if (region == 4) {
                        float q = 0.f;
#pragma unroll
                        for (int bj = 0; bj < 2; ++bj)
#pragma unroll
                            for (int e = 0; e < 8; ++e) q += v[bj][e] * v[bj][e];
                        q += __shfl_xor(q, 16); q += __shfl_xor(q, 32);
                        if (fq == 0) vgss[(size_t)row * 8 + half * 4 + wc] = q;
                    }
                }
                bf16_t* rowp = P + (size_t)row * 2560 + lcol;
#pragma unroll
                for (int bj = 0; bj < 2; ++bj) { u32x4 w; w.x = cvt_pk_bf16(v[bj][0], v[bj][1]); w.y = cvt_pk_bf16(v[bj][2], v[bj][3]); w.z = cvt_pk_bf16(v[bj][4], v[bj][5]); w.w = cvt_pk_bf16(v[bj][6], v[bj][7]);
                    *(u32x4*)(rowp + bj * 32) = w; }
            }
    }
};
struct EpiResid {
    static constexpr bool PERM = true, AFTER_DRAIN = false;
    const float* base; float* out; bf16_t* xb; float* rowss;
    __device__ __forceinline__ void operator()(const f32x4 (&acc)[2][2][4][2], const Unit& u, int wr, int wc, int fr, int fq) const {
        const int col0 = u.pn * BM + wc * 32 + 8 * fq;
#pragma unroll
        for (int ai = 0; ai < 2; ++ai)
#pragma unroll
            for (int m = 0; m < 4; ++m) {
                const int row = u.pm * BM + ai * HALF + wr * 64 + m * 16 + fr;
                const size_t off = (size_t)row * 1024 + col0;
                float q = 0.f;
#pragma unroll
                for (int bj = 0; bj < 2; ++bj) {
                    const f32x4 b0 = *(const f32x4*)(base + off + bj * HALF), b1 = *(const f32x4*)(base + off + bj * HALF + 4);
                    const f32x4 v0 = acc[ai][bj][m][0] + b0, v1 = acc[ai][bj][m][1] + b1;
                    *(f32x4*)(out + off + bj * HALF) = v0; *(f32x4*)(out + off + bj * HALF + 4) = v1;
                    u32x4 w; w.x = cvt_pk_bf16(v0[0], v0[1]); w.y = cvt_pk_bf16(v0[2], v0[3]); w.z = cvt_pk_bf16(v1[0], v1[1]); w.w = cvt_pk_bf16(v1[2], v1[3]);
                    *(u32x4*)(xb + off + bj * HALF) = w;
                    q += (v0[0] * v0[0] + v0[1] * v0[1]) + (v0[2] * v0[2] + v0[3] * v0[3]) + (v1[0] * v1[0] + v1[1] * v1[1]) + (v1[2] * v1[2] + v1[3] * v1[3]);
                }
                q += __shfl_xor(q, 16); q += __shfl_xor(q, 32);
                if (fq == 0) rowss[(size_t)row * 16 + u.pn * 4 + wc] = q;
            }
    }
};
struct EpiSwiGLU {
    static constexpr bool PERM = true, AFTER_DRAIN = false;
    bf16_t* H; const float* rowss;
    __device__ __forceinline__ void operator()(const f32x4 (&acc)[2][2][4][2], const Unit& u, int wr, int wc, int fr, int fq) const {
        const int col0 = u.pn * 128 + wc * 32 + 8 * fq;
#pragma unroll
        for (int ai = 0; ai < 2; ++ai)
#pragma unroll
            for (int m = 0; m < 4; ++m) {
                const int row = u.pm * BM + ai * HALF + wr * 64 + m * 16 + fr;
                const float s = row_rs(rowss, row);
                float h[8];
#pragma unroll
                for (int n = 0; n < 2; ++n)
#pragma unroll
                    for (int i = 0; i < 4; ++i) { const float g = acc[ai][0][m][n][i] * s, up = acc[ai][1][m][n][i] * s;
                        h[4 * n + i] = g * __builtin_amdgcn_rcpf(1.0f + __builtin_amdgcn_exp2f(-LOG2E * g)) * up; }
                u32x4 w; w.x = cvt_pk_bf16(h[0], h[1]); w.y = cvt_pk_bf16(h[2], h[3]); w.z = cvt_pk_bf16(h[4], h[5]); w.w = cvt_pk_bf16(h[6], h[7]);
                *(u32x4*)(H + (size_t)row * 2816 + col0) = w;
            }
    }
};
template <class Epi, class Sched, bool ALIGN_EPI = false, bool SP2 = false>
__device__ __forceinline__ void gemm_phase(PG8_LAS unsigned char* lds, const Gemm g, const Sched& S, const Epi& E) {
    int tid_l = threadIdx.x; asm volatile("" : "+v"(tid_l));
    const int tid = tid_l, wid = __builtin_amdgcn_readfirstlane(tid >> 6), lane = tid & 63, wr = wid >> 2, wc = wid & 3, fr = lane & 15, fq = lane >> 4;
    const int K = g.K, nt = K / BK;
    unsigned voffA[2], voffB[2];
#pragma unroll
    for (int i = 0; i < 2; ++i) { int R, C; stage_rc(tid * 16 + i * 8192, R, C); const int Rb = Epi::PERM ? ((R & ~31) + perm32(R & 31)) : R;
        voffA[i] = (unsigned)(R * K + C) * 2u; voffB[i] = (unsigned)(Rb * K + C) * 2u; }
    const size_t kstep = (size_t)(BK * 2);
    const size_t hstep = (size_t)HALF * K * 2;
    const size_t tstep = 2 * hstep;
    const unsigned ldsw = (unsigned)wid * 1024u;
    const int aoff = lds_byte(wr * 64 + fr, fq * 8), boff = lds_byte(wc * 32 + fr, fq * 8);
#define PG8_SA(b, h) (((b) * 2 + (h)) * HTB)
#define PG8_SB(b, h) ((4 + (b) * 2 + (h)) * HTB)
#define PG8_STAGE(bufoff, gbase, voff) do { _Pragma("unroll") for (int _i = 0; _i < 2; ++_i) \
        __builtin_amdgcn_global_load_lds((const unsigned*)((const char*)(gbase) + (voff)[_i]), (PG8_LAS unsigned*)(lds + (bufoff) + ldsw + _i * 8192), 16, 0, 0); } while (0)
#define PG8_LDA(dst, b, h) do { _Pragma("unroll") for (int m = 0; m < 4; ++m) _Pragma("unroll") for (int k = 0; k < 2; ++k) dst[m][k] = *(const PG8_LAS bf16x8*)(lds + PG8_SA(b, h) + aoff + m * 2048 + k * 1024); } while (0)
#define PG8_LDB(dst, b, h) do { _Pragma("unroll") for (int n = 0; n < 2; ++n) _Pragma("unroll") for (int k = 0; k < 2; ++k) dst[n][k] = *(const PG8_LAS bf16x8*)(lds + PG8_SB(b, h) + boff + n * 2048 + k * 1024); } while (0)
#define PG8_MMA(ai, bj, At, Bt) do { __builtin_amdgcn_s_setprio(1); _Pragma("unroll") for (int m = 0; m < 4; ++m) _Pragma("unroll") for (int n = 0; n < 2; ++n) _Pragma("unroll") for (int k = 0; k < 2; ++k) \
        acc[ai][bj][m][n] = __builtin_amdgcn_mfma_f32_16x16x32_bf16(Bt[n][k], At[m][k], acc[ai][bj][m][n], 0, 0, 0); __builtin_amdgcn_s_setprio(0); } while (0)
#define PG8_WAIT_V(n) asm volatile("s_waitcnt vmcnt(" #n ")" ::: "memory")
#define PG8_WAIT_L(n) asm volatile("s_waitcnt lgkmcnt(" #n ")" ::: "memory")
#define PG8_BAR __builtin_amdgcn_s_barrier()
#define PG8_SCHED __builtin_amdgcn_sched_barrier(0)
    Unit cur, nxt; int ui = 0;
    if (!S.next(0, cur)) return;
    f32x4 acc[2][2][4][2];
#pragma unroll
    for (int a = 0; a < 2; ++a)
#pragma unroll
        for (int b = 0; b < 2; ++b)
#pragma unroll
            for (int m = 0; m < 4; ++m)
#pragma unroll
                for (int n = 0; n < 2; ++n) acc[a][b][m][n] = (f32x4){0.f, 0.f, 0.f, 0.f};
    bf16x8 At[4][2], B0[2][2], B1[2][2];
    const char* cA = (const char*)g.A + (size_t)cur.pm * tstep; const char* cB = (const char*)g.Bt + (size_t)cur.pn * tstep;
    S.a_ready(cur);
    if constexpr (SP2) {
        PG8_STAGE(PG8_SB(0, 0), cB, voffB); PG8_STAGE(PG8_SB(0, 1), cB + hstep, voffB); PG8_STAGE(PG8_SA(0, 0), cA, voffA); PG8_STAGE(PG8_SA(0, 1), cA + hstep, voffA);
        if (wr == 1) PG8_BAR;
        PG8_WAIT_V(2); PG8_BAR;
        PG8_STAGE(PG8_SB(1, 0), cB + kstep, voffB); PG8_STAGE(PG8_SA(1, 0), cA + kstep, voffA); PG8_STAGE(PG8_SB(1, 1), cB + hstep + kstep, voffB);
        PG8_WAIT_V(6); PG8_BAR;
    } else {
        PG8_STAGE(PG8_SB(0, 0), cB, voffB); PG8_STAGE(PG8_SA(0, 0), cA, voffA); PG8_STAGE(PG8_SB(0, 1), cB + hstep, voffB); PG8_STAGE(PG8_SA(0, 1), cA + hstep, voffA);
        if (wr == 1) PG8_BAR;
        PG8_WAIT_V(4); PG8_BAR;
        PG8_STAGE(PG8_SB(1, 0), cB + kstep, voffB); PG8_STAGE(PG8_SA(1, 0), cA + kstep, voffA); PG8_STAGE(PG8_SB(1, 1), cB + hstep + kstep, voffB);
        PG8_WAIT_V(6); PG8_BAR;
    }
    for (;;) {
        const bool has_next = S.next(ui + 1, nxt);
        const char* nA = has_next ? (const char*)g.A + (size_t)nxt.pm * tstep : cA; const char* nB = has_next ? (const char*)g.Bt + (size_t)nxt.pn * tstep : cB;
        for (int t = 0; t < nt; t += 2) {
            const bool last = (t == nt - 2);
            const char* a1 = cA + (size_t)(t + 1) * kstep;
            const char* a2 = last ? nA : cA + (size_t)(t + 2) * kstep; const char* b2 = last ? nB : cB + (size_t)(t + 2) * kstep;
            const char* a3 = a2 + kstep; const char* b3 = b2 + kstep;
            if (last && has_next) S.a_ready(nxt);
            if constexpr (SP2) {
            PG8_LDB(B0, 0, 0); PG8_LDB(B1, 0, 1); PG8_SCHED; PG8_LDA(At, 0, 0); PG8_STAGE(PG8_SA(1, 1), a1 + hstep, voffA);
            PG8_WAIT_V(8); PG8_WAIT_L(0); PG8_BAR; PG8_MMA(0, 0, At, B0); PG8_MMA(0, 1, At, B1); PG8_BAR; PG8_SCHED;
            PG8_LDA(At, 0, 1); PG8_STAGE(PG8_SB(0, 0), b2, voffB); PG8_STAGE(PG8_SB(0, 1), b2 + hstep, voffB); PG8_STAGE(PG8_SA(0, 0), a2, voffA);
            PG8_WAIT_V(8); PG8_WAIT_L(0); PG8_BAR; PG8_MMA(1, 0, At, B0); PG8_MMA(1, 1, At, B1); PG8_BAR; PG8_SCHED;
            PG8_LDB(B0, 1, 0); PG8_LDB(B1, 1, 1); PG8_SCHED; PG8_LDA(At, 1, 0); PG8_STAGE(PG8_SA(0, 1), a2 + hstep, voffA);
            PG8_WAIT_V(8); PG8_WAIT_L(0); PG8_BAR; PG8_MMA(0, 0, At, B0); PG8_MMA(0, 1, At, B1); PG8_BAR; PG8_SCHED;
            PG8_LDA(At, 1, 1); PG8_STAGE(PG8_SB(1, 0), b3, voffB); PG8_STAGE(PG8_SB(1, 1), b3 + hstep, voffB); PG8_STAGE(PG8_SA(1, 0), a3, voffA);
            PG8_WAIT_V(8); PG8_WAIT_L(0); PG8_BAR; PG8_MMA(1, 0, At, B0); PG8_MMA(1, 1, At, B1); PG8_BAR; PG8_SCHED;
            } else {
            PG8_LDB(B0, 0, 0); PG8_SCHED; PG8_LDA(At, 0, 0); PG8_STAGE(PG8_SA(1, 1), a1 + hstep, voffA);
            PG8_WAIT_L(8); PG8_BAR; PG8_WAIT_L(0); PG8_MMA(0, 0, At, B0); PG8_BAR; PG8_SCHED;
            PG8_LDB(B1, 0, 1); PG8_STAGE(PG8_SB(0, 0), b2, voffB);
            PG8_BAR; PG8_WAIT_L(0); PG8_MMA(0, 1, At, B1); PG8_BAR;
            PG8_LDA(At, 0, 1); PG8_STAGE(PG8_SA(0, 0), a2, voffA);
            PG8_BAR; PG8_WAIT_L(0); PG8_MMA(1, 0, At, B0); PG8_BAR; PG8_SCHED;
            PG8_STAGE(PG8_SB(0, 1), b2 + hstep, voffB);
            PG8_WAIT_V(6); PG8_BAR; PG8_MMA(1, 1, At, B1); PG8_BAR;
            PG8_LDB(B0, 1, 0); PG8_SCHED; PG8_LDA(At, 1, 0); PG8_STAGE(PG8_SA(0, 1), a2 + hstep, voffA);
            PG8_WAIT_L(8); PG8_BAR; PG8_WAIT_L(0); PG8_MMA(0, 0, At, B0); PG8_BAR; PG8_SCHED;
            PG8_LDB(B1, 1, 1); PG8_STAGE(PG8_SB(1, 0), b3, voffB);
            PG8_BAR; PG8_WAIT_L(0); PG8_MMA(0, 1, At, B1); PG8_BAR;
            PG8_LDA(At, 1, 1); PG8_STAGE(PG8_SA(1, 0), a3, voffA);
            PG8_BAR; PG8_WAIT_L(0); PG8_MMA(1, 0, At, B0); PG8_BAR; PG8_SCHED;
            PG8_STAGE(PG8_SB(1, 1), b3 + hstep, voffB);
            PG8_WAIT_V(6); PG8_BAR; PG8_MMA(1, 1, At, B1); PG8_BAR;
            }
        }
        if constexpr (ALIGN_EPI) { if (wr == 0) PG8_BAR; }
        if constexpr (!Epi::AFTER_DRAIN) { E(acc, cur, wr, wc, fr, fq); S.done(cur); }
        if (!has_next) break;
#pragma unroll
        for (int a = 0; a < 2; ++a)
#pragma unroll
            for (int b = 0; b < 2; ++b)
#pragma unroll
                for (int m = 0; m < 4; ++m)
#pragma unroll
                    for (int n = 0; n < 2; ++n) acc[a][b][m][n] = (f32x4){0.f, 0.f, 0.f, 0.f};
        cur = nxt; cA = nA; cB = nB; ++ui;
        if constexpr (ALIGN_EPI) { if (wr == 1) PG8_BAR; }
    }
    PG8_WAIT_V(0);
    if constexpr (!ALIGN_EPI) { if (wr == 0) PG8_BAR; }
    PG8_BAR;
    if constexpr (Epi::AFTER_DRAIN) { E.fused(acc, cur, wr, wc, fr, fq, lds, wid, lane); S.done(cur); }
#undef PG8_SA
#undef PG8_SB
#undef PG8_STAGE
#undef PG8_LDA
#undef PG8_LDB
#undef PG8_MMA
#undef PG8_WAIT_V
#undef PG8_WAIT_L
#undef PG8_BAR
#undef PG8_SCHED
}
}
constexpr int NB = 8, SEQ = 2048, DM = 1024, M = NB * SEQ, NIN = 2560, DFF = 2816, NFF2 = 2 * DFF, DEPTH = 2;
constexpr int NWAVES = 8;
constexpr size_t MiB = 1u << 20;
constexpr size_t WS_ROWSS = 1 * MiB;
constexpr size_t WS_VGSS = 2 * MiB;
constexpr size_t WS_WSP = 3 * MiB;
constexpr size_t WS_W0 = 4 * MiB, WS_WSTRIDE = 24 * MiB;
constexpr size_t WOFF_IN = 0, WOFF_OUT = 5 * MiB, WOFF_FIN = 7 * MiB, WOFF_FOUT = 18 * MiB;
constexpr size_t WS_XB = 52 * MiB;
constexpr size_t WS_PROJ = 84 * MiB;
constexpr size_t WS_MIX = 164 * MiB;
constexpr size_t WS_HID = 84 * MiB;
constexpr size_t WS_END = 196 * MiB;
constexpr int LDS_BYTES = 147456;

#define GAS __attribute__((address_space(1)))
#define LAS __attribute__((address_space(3)))
typedef unsigned short bf16;
typedef unsigned v4u __attribute__((ext_vector_type(4)));
typedef float f32x4 __attribute__((ext_vector_type(4)));
__device__ __forceinline__ unsigned f2bf(float f) { unsigned u = __builtin_bit_cast(unsigned, f); return (u + 0x7fffu + ((u >> 16) & 1u)) >> 16; }
__device__ __forceinline__ unsigned pk2(float lo, float hi) { return f2bf(lo) | (f2bf(hi) << 16); }
__device__ __forceinline__ float bf2f(bf16 v) { return __builtin_bit_cast(float, (unsigned)v << 16); }
__device__ __forceinline__ float wave_sum(float v) {
#pragma unroll
    for (int o = 1; o < 64; o <<= 1) v += __shfl_xor(v, o);
    return v;
}
#define LDS_WAIT() asm volatile("s_waitcnt lgkmcnt(0)" ::: "memory")

typedef short tp_s16x4 __attribute__((ext_vector_type(4)));
__device__ __forceinline__ void p0_transpose_item(const float* W, int K, int N, bf16* WT, int k0, int n0, int prow0, int prow1, const float* gk, LAS unsigned char* scr, int lane) {
    const int lr = lane >> 4, n4 = (lane & 15) * 4;
    f32x4 v[16];
#pragma unroll
    for (int i = 0; i < 16; ++i) v[i] = *(const f32x4*)(W + (size_t)(k0 + 4 * i + lr) * N + n0 + n4);
#pragma unroll
    for (int i = 0; i < 16; ++i) { const int k = 4 * i + lr; const float gg = gk ? gk[k0 + k] : 1.f;
        unsigned long long w = (unsigned long long)pk2(v[i].x * gg, v[i].y * gg) | ((unsigned long long)pk2(v[i].z * gg, v[i].w * gg) << 32);
        *(LAS unsigned long long*)(scr + k * 128 + ((n4 * 2) ^ (((k >> 1) & 1) << 6))) = w; }
    asm volatile("" ::: "memory");
    const int hh = lane >> 5, g2 = (lane >> 4) & 1, i16 = lane & 15, qq = i16 >> 2, p4 = i16 & 3;
#pragma unroll
    for (int j = 0; j < 8; ++j) { const int c = 2 * (j >> 1) + hh, nb = 32 * (j & 1) + 16 * g2;
        const int a0 = (8 * c + qq) * 128 + (((nb + 4 * p4) * 2) ^ ((qq >> 1) << 6));
        const tp_s16x4 lo = __builtin_bit_cast(tp_s16x4, __builtin_amdgcn_ds_read_tr16_b64_v4i16((LAS tp_s16x4*)(scr + a0)));
        const tp_s16x4 hi4 = __builtin_bit_cast(tp_s16x4, __builtin_amdgcn_ds_read_tr16_b64_v4i16((LAS tp_s16x4*)(scr + a0 + 4 * 128)));
        typedef short s16x8_t __attribute__((ext_vector_type(8)));
        const s16x8_t o = (s16x8_t){lo[0], lo[1], lo[2], lo[3], hi4[0], hi4[1], hi4[2], hi4[3]};
        const int prow = ((j & 1) ? prow1 : prow0) + 16 * g2 + i16;
        *(s16x8_t*)(WT + (size_t)prow * K + k0 + 8 * c) = o; }
    LDS_WAIT(); asm volatile("" ::: "memory");
}
__host__ __device__ __forceinline__ int map_in(int n) { const int T = n >> 8, nn = n & 255; return 256 * T + 128 * ((nn >> 5) & 1) + 32 * (nn >> 6) + (nn & 31); }
__host__ __device__ __forceinline__ int map_fin(int n) { return n < DFF ? 256 * (n >> 7) + (n & 127) : 256 * ((n - DFF) >> 7) + 128 + ((n - DFF) & 127); }

typedef GAS unsigned gu32;
#define RLX_AGENT __ATOMIC_RELAXED, __HIP_MEMORY_SCOPE_AGENT
constexpr int MISC_OFF = LDS_BYTES - 64;
constexpr size_t WS_BAR = 0;
constexpr size_t BAR_ZERO_BYTES = 16384;
#define XB_TMO      128
#define XB_XCNT(j)  (256  + 64 * (j))
#define XB_XSUB(j)  (1280 + 64 * (j))
#define XB_XGEN(j)  (2304 + 64 * (j))
#define XB_TOP      3328
#define XB_TOPGEN   3392
#define XCD_BAR_WORDS 3456
#define XB_SPIN_CAP (1u << 18)

__device__ __forceinline__ unsigned xb_ld(unsigned* p)              { return __hip_atomic_load(p, __ATOMIC_RELAXED, __HIP_MEMORY_SCOPE_AGENT); }
__device__ __forceinline__ unsigned xb_add(unsigned* p, unsigned v) { return __hip_atomic_fetch_add(p, v, __ATOMIC_RELAXED, __HIP_MEMORY_SCOPE_AGENT); }
__device__ __forceinline__ unsigned xb_xcc_id() { return (unsigned)__builtin_amdgcn_s_getreg((3 << 11) | 20) & 0xFu; }
#define XB_SPIN(cond, bar) do { unsigned _sp = 0; while (cond) { __builtin_amdgcn_s_sleep(1); \
    if ((++_sp & 255u) == 0u) { if (xb_ld(&(bar)[XB_TMO])) break; if (_sp > XB_SPIN_CAP) { atomicAdd(&(bar)[XB_TMO], 1u); break; } } } } while (0)

struct XcdBarrier {
    unsigned* bar; unsigned x;
    volatile LAS unsigned* st;
};

__device__ __forceinline__ XcdBarrier xcd_barrier_post(unsigned* bar, volatile LAS unsigned* st) {
    XcdBarrier b; b.bar = bar; b.x = xb_xcc_id(); b.st = st;
    if (threadIdx.x == 0) (void)xb_add(&bar[XB_XCNT(b.x)], 1u);
    return b;
}
__device__ __forceinline__ void xcd_barrier_complete(unsigned* bar, unsigned x, unsigned& nloc, unsigned& nx) {
    const unsigned G = gridDim.x * gridDim.y * gridDim.z;
    unsigned sum, cnt, mine, sp = 0u;
    for (;;) {
        sum = 0u; cnt = 0u; mine = 0u;
#pragma unroll
        for (unsigned j = 0; j < 16; ++j) { const unsigned c = xb_ld(&bar[XB_XCNT(j)]); sum += c; cnt += (c > 0u) ? 1u : 0u; mine = (j == x) ? c : mine; }
        if (sum == G) break;
        __builtin_amdgcn_s_sleep(1);
        if ((++sp & 255u) == 0u) { if (xb_ld(&bar[XB_TMO])) break; if (sp > XB_SPIN_CAP) { atomicAdd(&bar[XB_TMO], 1u); break; } }
    }
    nloc = mine > 0u ? mine : 1u; nx = cnt > 0u ? cnt : 1u;
}

__device__ __forceinline__ void xcd_barrier(const XcdBarrier& b) {
    asm volatile("s_waitcnt vmcnt(0)" ::: "memory");
    __syncthreads();
    if (threadIdx.x == 0) {
        unsigned* bar = b.bar;
        __builtin_amdgcn_s_waitcnt(0);
        unsigned nloc = b.st[0], nx = b.st[1];
        if (nloc == 0u) { xcd_barrier_complete(bar, b.x, nloc, nx); b.st[0] = nloc; b.st[1] = nx; }
        const unsigned old = xb_add(&bar[XB_XSUB(b.x)], 1u);
        const unsigned gen = old / nloc;
        if (old + 1u == (gen + 1u) * nloc) {
            __builtin_amdgcn_fence(__ATOMIC_RELEASE, "agent");
            asm volatile("s_waitcnt vmcnt(0)" ::: "memory");
            const unsigned og = xb_add(&bar[XB_TOP], 1u);
            const unsigned tg = og / nx;
            if (og + 1u == (tg + 1u) * nx) xb_add(&bar[XB_TOPGEN], 1u);
            else XB_SPIN(xb_ld(&bar[XB_TOPGEN]) == tg, bar);
            __builtin_amdgcn_fence(__ATOMIC_ACQUIRE, "agent");
            xb_add(&bar[XB_XGEN(b.x)], 1u);
            asm volatile("s_waitcnt vmcnt(0)" ::: "memory");
        } else {
            XB_SPIN(xb_ld(&bar[XB_XGEN(b.x)]) == gen, bar);
            __builtin_amdgcn_fence(__ATOMIC_ACQUIRE, "agent");
            asm volatile("s_waitcnt vmcnt(0)" ::: "memory");
        }
    }
    __syncthreads();
}

#define GRID_BAR() do { XcdBarrier bar_; bar_.bar = (unsigned*)(kargs_ws() + WS_BAR); bar_.x = xb_xcc_id(); bar_.st = (volatile LAS unsigned*)(lds + MISC_OFF); xcd_barrier(bar_); } while (0)
struct Args { const float* in[15]; float* out; unsigned char* ws; };
typedef const __attribute__((address_space(4))) Args CArgs;
__device__ __forceinline__ CArgs* kargs();
__device__ __forceinline__ unsigned char* kargs_ws();
__device__ __forceinline__ CArgs* kargs() { CArgs* p = (CArgs*)__builtin_amdgcn_kernarg_segment_ptr(); asm volatile("" : "+s"(p)); return p; }
__device__ __forceinline__ unsigned char* kargs_ws() { return kargs()->ws; }

__device__ __forceinline__ void prologue(CArgs* a, LAS unsigned char* lds, int wave, int lane) {
    LAS unsigned char* scr = lds + wave * 16384;
    const int gw = blockIdx.x * NWAVES + wave, NGW = gridDim.x * NWAVES;
    constexpr int I_IN = (DM / 64) * (NIN / 64), I_OUT = (DM / 64) * (DM / 64), I_FIN = (DM / 64) * (NFF2 / 64), I_FOUT = (DFF / 64) * (DM / 64);
    constexpr int I_LAYER = I_IN + I_OUT + I_FIN + I_FOUT;
    for (int it = gw; it < DEPTH * I_LAYER; it += NGW) {
        const int l = it / I_LAYER; int r = it % I_LAYER;
        unsigned char* wb = a->ws + WS_W0 + (size_t)l * WS_WSTRIDE;
        if (r < I_IN) { const int nblk = NIN / 64, kb = r / nblk, nb = r % nblk;
            p0_transpose_item(a->in[2] + (size_t)l * DM * NIN, DM, NIN, (bf16*)(wb + WOFF_IN), 64 * kb, 64 * nb, map_in(64 * nb), map_in(64 * nb + 32), a->in[1] + l * DM, scr, lane); continue; } r -= I_IN;
        if (r < I_OUT) { const int nblk = DM / 64, kb = r / nblk, nb = r % nblk;
            p0_transpose_item(a->in[11] + (size_t)l * DM * DM, DM, DM, (bf16*)(wb + WOFF_OUT), 64 * kb, 64 * nb, 64 * nb, 64 * nb + 32, nullptr, scr, lane); continue; } r -= I_OUT;
        if (r < I_FIN) { const int nblk = NFF2 / 64, kb = r / nblk, nb = r % nblk;
            p0_transpose_item(a->in[13] + (size_t)l * DM * NFF2, DM, NFF2, (bf16*)(wb + WOFF_FIN), 64 * kb, 64 * nb, map_fin(64 * nb), map_fin(64 * nb + 32), a->in[12] + l * DM, scr, lane); continue; } r -= I_FIN;
        { const int nblk = DM / 64, kb = r / nblk, nb = r % nblk;
            p0_transpose_item(a->in[14] + (size_t)l * DFF * DM, DFF, DM, (bf16*)(wb + WOFF_FOUT), 64 * kb, 64 * nb, 64 * nb, 64 * nb + 32, nullptr, scr, lane); }
    }
    float* rowss = (float*)(a->ws + WS_ROWSS); bf16* xb = (bf16*)(a->ws + WS_XB);
    for (int m = gw; m < M; m += NGW) {
        const f32x4* xr = (const f32x4*)(a->in[0] + (size_t)m * DM) + lane;
        unsigned long long* o8 = (unsigned long long*)(xb + (size_t)m * DM) + lane;
        float s = 0.f;
#pragma unroll
        for (int j = 0; j < 4; ++j) { const f32x4 v = xr[64 * j]; s += (v.x * v.x + v.y * v.y) + (v.z * v.z + v.w * v.w);
            o8[64 * j] = (unsigned long long)pk2(v.x, v.y) | ((unsigned long long)pk2(v.z, v.w) << 32); }
        s = wave_sum(s);
        if (lane < 16) rowss[(size_t)m * 16 + lane] = lane == 0 ? s : 0.f;
    }
    { const float* wsp = a->in[7]; bf16* o = (bf16*)(a->ws + WS_WSP); const int gt = blockIdx.x * 512 + threadIdx.x, NT = gridDim.x * 512;
      for (int i = gt; i < DEPTH * 8 * 128 * 128; i += NT) { const int s = i & 127, t = (i >> 7) & 127; o[i] = (bf16)(((t >> 6) >= (s >> 6)) ? f2bf(wsp[i]) : 0u); } }
}

__device__ __forceinline__ void mixer_naive(CArgs* a, int l, LAS unsigned char* lds, int wave, int lane) {
    const bf16* P = (const bf16*)(a->ws + WS_PROJ); bf16* MIX = (bf16*)(a->ws + WS_MIX);
    const float* vgss = (const float*)(a->ws + WS_VGSS); const bf16* wsp = (const bf16*)(a->ws + WS_WSP) + (size_t)l * 8 * 128 * 128;
    const float* rel = a->in[5] + (size_t)l * 8 * 257; const float* sgu_g = a->in[6] + l * 512; const float* bsp = a->in[8] + l * 8 * 128;
    const float* ag = a->in[9] + l * 512; const float* gg = a->in[10] + l * 512;
    LAS float* red = (LAS float*)lds;
    for (int tok = blockIdx.x; tok < M; tok += gridDim.x) {
        const int b = tok / SEQ, t = tok % SEQ, c = t >> 6;
        const int h = wave;
        const float q = bf2f(P[(size_t)tok * NIN + h * 64 + lane]);
        float mx = -INFINITY, lsum = 0.f, o = 0.f;
        const int k0 = (c >= 8 ? c - 8 : 0) * 64, k1 = c * 64 + 63;
        for (int kt = k0; kt <= k1; ++kt) {
            const size_t kr = (size_t)(b * SEQ + kt) * NIN;
            float s = wave_sum(q * bf2f(P[kr + 512 + h * 64 + lane]));
            int d = t - kt; d = d < -128 ? -128 : (d > 128 ? 128 : d);
            s += rel[h * 257 + d + 128] * pg8::LOG2E;
            const float mn = fmaxf(mx, s), al = __builtin_amdgcn_exp2f(mx - mn), p = __builtin_amdgcn_exp2f(s - mn);
            lsum = lsum * al + p; o = o * al + p * bf2f(P[kr + 1024 + h * 64 + lane]); mx = mn;
        }
        o = o / lsum;
        const int g = wave, nb = t >> 7, tp = t & 127, ns = tp < 64 ? 64 : 128;
        float mixd = 0.f;
        for (int s = 0; s < ns; ++s) {
            const int srow = b * SEQ + nb * 128 + s;
            const f32x4* pv = (const f32x4*)(vgss + (size_t)srow * 8); const f32x4 p0 = pv[0], p1 = pv[1];
            const float rs = __builtin_amdgcn_rsqf((((p0[0] + p0[1]) + (p0[2] + p0[3])) + ((p1[0] + p1[1]) + (p1[2] + p1[3]))) * (1.0f / 512.0f) + pg8::RMS_EPS);
            mixd += bf2f(wsp[(g * 128 + tp) * 128 + s]) * (bf2f(P[(size_t)srow * NIN + 2048 + g * 64 + lane]) * rs * sgu_g[g * 64 + lane]);
        }
        const float gv = bf2f(P[(size_t)tok * NIN + 1536 + g * 64 + lane]) * (mixd + bsp[g * 128 + tp]);
        const float so = wave_sum(o * o), sg = wave_sum(gv * gv);
        __syncthreads();
        if (lane == 0) { red[wave] = so; red[8 + wave] = sg; }
        __syncthreads();
        float ta = 0.f, tg = 0.f;
#pragma unroll
        for (int w = 0; w < 8; ++w) { ta += red[w]; tg += red[8 + w]; }
        const float ra = __builtin_amdgcn_rsqf(ta * (1.0f / 512.0f) + pg8::RMS_EPS), rg = __builtin_amdgcn_rsqf(tg * (1.0f / 512.0f) + pg8::RMS_EPS);
        MIX[(size_t)tok * DM + h * 64 + lane] = (bf16)f2bf(o * ra * ag[h * 64 + lane]);
        MIX[(size_t)tok * DM + 512 + g * 64 + lane] = (bf16)f2bf(gv * rg * gg[g * 64 + lane]);
    }
    __syncthreads();
}

#ifndef FAST_MIXER
#define FAST_MIXER 1
#endif
#ifndef PHM
#define PHM 31
#endif
#ifndef REPM
#define REPM 0
#endif
#define REPEAT(bit) for (int rep_ = 0; rep_ < (((REPM) >> (bit)) & 1) + 1; ++rep_)
namespace mx {
typedef float f32x16 __attribute__((ext_vector_type(16)));
typedef short bf16x8 __attribute__((ext_vector_type(8)));
typedef short s16x4 __attribute__((ext_vector_type(4)));
typedef unsigned u32x2 __attribute__((ext_vector_type(2)));
constexpr int TBL_OFF = 131072;
constexpr int RED_OFF = TBL_OFF + 8 * 260 * 4;
__device__ __forceinline__ int crow(int r, int hi) { return (r & 3) + 8 * (r >> 2) + 4 * hi; }
__device__ __forceinline__ int vimg(int row, int chunk) { return row * 128 + ((chunk * 16) ^ (((row >> 1) & 1) << 6)); }
__device__ __forceinline__ s16x4 tr64(LAS unsigned char* p) { return __builtin_bit_cast(s16x4, __builtin_amdgcn_ds_read_tr16_b64_v4i16((LAS s16x4*)p)); }
__device__ __forceinline__ bf16x8 cat8(s16x4 a, s16x4 b) { return (bf16x8){a[0], a[1], a[2], a[3], b[0], b[1], b[2], b[3]}; }
__device__ __forceinline__ unsigned cvtpk(float lo, float hi) { unsigned r; asm("v_cvt_pk_bf16_f32 %0, %1, %2" : "=v"(r) : "v"(lo), "v"(hi)); return r; }
#define MX_FENCE() asm volatile("" ::: "memory")

__device__ __forceinline__ void attn_task(const bf16* P, int b, int c, int half, int h, LAS unsigned char* wl, const LAS float* tbl, int lane, f32x16 (&o)[2]) {
    const int r32 = lane & 31, hi = lane >> 5;
    const size_t tok0 = (size_t)b * SEQ + c * 64 + half * 32;
    bf16x8 qf[4];
#pragma unroll
    for (int d0 = 0; d0 < 4; ++d0) qf[d0] = *(const bf16x8*)(P + (tok0 + r32) * NIN + h * 64 + d0 * 16 + hi * 8);
#pragma unroll
    for (int r = 0; r < 16; ++r) { o[0][r] = 0.f; o[1][r] = 0.f; }
    float m = -INFINITY, l = 0.f;
    const int kc0 = c >= 8 ? c - 8 : 0;
    const int dhalf = (lane >> 4) & 1, qq = (lane & 15) >> 2, p4 = lane & 3;
    int vb[2];
#pragma unroll
    for (int dt = 0; dt < 2; ++dt) vb[dt] = (4 * hi + qq) * 128 + ((64 * dt + 32 * dhalf + 8 * p4) ^ ((qq >> 1) << 6));
    const int prow = lane >> 3, pch = lane & 7;
    bf16x8 kf[2][4];
    const unsigned koff = (unsigned)(r32 * NIN + hi * 8) * 2u, voff = (unsigned)(prow * NIN + (pch ^ (((lane >> 4) & 1) << 2)) * 8) * 2u;
#define MX_LOADK(kc) do { const char* kp_ = (const char*)(P + ((size_t)b * SEQ + (kc) * 64) * NIN + 512 + h * 64); \
        _Pragma("unroll") for (int kt = 0; kt < 2; ++kt) _Pragma("unroll") for (int d0 = 0; d0 < 4; ++d0) kf[kt][d0] = *(const bf16x8*)(kp_ + (size_t)(kt * 32 * NIN + d0 * 16) * 2 + koff); } while (0)
#define MX_LOADV(kc, bufo) do { const char* vp_ = (const char*)(P + ((size_t)b * SEQ + (kc) * 64) * NIN + 1024 + h * 64); \
        _Pragma("unroll") for (int i = 0; i < 8; ++i) __builtin_amdgcn_global_load_lds((const unsigned*)(vp_ + (size_t)(i * 8 * NIN) * 2 + voff), (LAS unsigned*)(wl + (bufo) + i * 1024), 16, 0, 0); } while (0)
    MX_LOADK(kc0); MX_LOADV(kc0, 0);
    int buf = 0;
    for (int kc = kc0; kc <= c; ++kc) {
        const int j = kc - c + 8;
        LAS unsigned char* vt = wl + buf * 8192;
        asm volatile("s_waitcnt vmcnt(0)" ::: "memory");
        if (kc < c) MX_LOADV(kc + 1, (buf ^ 1) * 8192);
        f32x16 st[2];
        if (j <= 5) { const float bc = tbl[256];
#pragma unroll
            for (int r = 0; r < 16; ++r) { st[0][r] = bc; st[1][r] = bc; } }
        else { int D0 = 64 * (8 - j) + half * 32 + r32 - 4 * hi; asm volatile("" : "+v"(D0));
#pragma unroll
            for (int kt = 0; kt < 2; ++kt)
#pragma unroll
                for (int r = 0; r < 16; ++r) { int idx = D0 - (32 * kt + (r & 3) + 8 * (r >> 2)); idx = idx < -128 ? -128 : (idx > 128 ? 128 : idx); st[kt][r] = tbl[idx + 128]; } }
#pragma unroll
        for (int kt = 0; kt < 2; ++kt)
#pragma unroll
            for (int d0 = 0; d0 < 4; ++d0) st[kt] = __builtin_amdgcn_mfma_f32_32x32x16_bf16(kf[kt][d0], qf[d0], st[kt], 0, 0, 0);
        if (kc < c) { MX_LOADK(kc + 1); }
        float mxv = fmaxf(st[0][0], st[1][0]);
#pragma unroll
        for (int r = 1; r < 16; ++r) mxv = fmaxf(mxv, fmaxf(st[0][r], st[1][r]));
        mxv = fmaxf(mxv, __shfl_xor(mxv, 32));
        const float mn = fmaxf(m, mxv), al = __builtin_amdgcn_exp2f(m - mn); m = mn;
        float rs = 0.f;
#pragma unroll
        for (int kt = 0; kt < 2; ++kt)
#pragma unroll
            for (int r = 0; r < 16; ++r) { const float p = __builtin_amdgcn_exp2f(st[kt][r] - mn); st[kt][r] = p; rs += p; }
        l = l * al + rs;
#pragma unroll
        for (int r = 0; r < 16; ++r) { o[0][r] *= al; o[1][r] *= al; }
        bf16x8 pf[4];
#pragma unroll
        for (int s = 0; s < 4; ++s) { v4u w; const int kt = s >> 1, r0 = 8 * (s & 1);
            w.x = cvtpk(st[kt][r0 + 0], st[kt][r0 + 1]); w.y = cvtpk(st[kt][r0 + 2], st[kt][r0 + 3]); w.z = cvtpk(st[kt][r0 + 4], st[kt][r0 + 5]); w.w = cvtpk(st[kt][r0 + 6], st[kt][r0 + 7]);
            pf[s] = __builtin_bit_cast(bf16x8, w); }
#pragma unroll
        for (int dt = 0; dt < 2; ++dt)
#pragma unroll
            for (int s = 0; s < 4; ++s) { const s16x4 a0 = tr64(vt + vb[dt] + (16 * s) * 128), a1 = tr64(vt + vb[dt] + (16 * s + 8) * 128);
                o[dt] = __builtin_amdgcn_mfma_f32_32x32x16_bf16(cat8(a0, a1), pf[s], o[dt], 0, 0, 0); }
        MX_FENCE();
        buf ^= 1;
    }
#undef MX_LOADK
#undef MX_LOADV
    l += __shfl_xor(l, 32);
    const float inv = 1.0f / l;
#pragma unroll
    for (int r = 0; r < 16; ++r) { o[0][r] *= inv; o[1][r] *= inv; }
}

__device__ __forceinline__ void sgu_task(const bf16* P, const float* vgss, const bf16* wsp_l, const float* sgu_g, const float* bsp_l, int b, int c, int half, int g, LAS unsigned char* wl, int lane, f32x16 (&o)[2]) {
    const int r32 = lane & 31, hi = lane >> 5;
    const int nb = c >> 1, cb = c & 1, tpos0 = cb * 64 + half * 32, ns = cb ? 128 : 64;
    const size_t srow0 = (size_t)b * SEQ + nb * 128, tok0 = (size_t)b * SEQ + c * 64 + half * 32;
    const int prow = lane >> 3, pch = lane & 7;
    const f32x4 g0 = *(const f32x4*)(sgu_g + g * 64 + pch * 8), g1 = *(const f32x4*)(sgu_g + g * 64 + pch * 8 + 4);
    MX_FENCE();
#pragma unroll 4
    for (int i = 0; i < ns / 8; ++i) {
        const int row = prow + 8 * i; const size_t srow = srow0 + row;
        const f32x4 p0 = *(const f32x4*)(vgss + srow * 8), p1 = *(const f32x4*)(vgss + srow * 8 + 4);
        const float rs = __builtin_amdgcn_rsqf((((p0[0] + p0[1]) + (p0[2] + p0[3])) + ((p1[0] + p1[1]) + (p1[2] + p1[3]))) * (1.0f / 512.0f) + pg8::RMS_EPS);
        const v4u raw = *(const v4u*)(P + srow * NIN + 2048 + g * 64 + pch * 8);
        v4u w;
        w.x = cvtpk(__builtin_bit_cast(float, raw.x << 16) * rs * g0[0], __builtin_bit_cast(float, raw.x & 0xffff0000u) * rs * g0[1]);
        w.y = cvtpk(__builtin_bit_cast(float, raw.y << 16) * rs * g0[2], __builtin_bit_cast(float, raw.y & 0xffff0000u) * rs * g0[3]);
        w.z = cvtpk(__builtin_bit_cast(float, raw.z << 16) * rs * g1[0], __builtin_bit_cast(float, raw.z & 0xffff0000u) * rs * g1[1]);
        w.w = cvtpk(__builtin_bit_cast(float, raw.w << 16) * rs * g1[2], __builtin_bit_cast(float, raw.w & 0xffff0000u) * rs * g1[3]);
        *(LAS v4u*)(wl + vimg(row, pch)) = w;
    }
    MX_FENCE();
#pragma unroll
    for (int r = 0; r < 16; ++r) { o[0][r] = 0.f; o[1][r] = 0.f; }
    const int dhalf = (lane >> 4) & 1, qq = (lane & 15) >> 2, p4 = lane & 3;
    int vbs[2];
#pragma unroll
    for (int ct = 0; ct < 2; ++ct) vbs[ct] = (8 * hi + qq) * 128 + ((64 * ct + 32 * dhalf + 8 * p4) ^ ((qq >> 1) << 6));
    const bf16* wrow = wsp_l + ((size_t)g * 128 + tpos0 + r32) * 128 + hi * 8;
#pragma unroll 4
    for (int step = 0; step < ns / 16; ++step) {
        const bf16x8 wf = *(const bf16x8*)(wrow + 16 * step);
#pragma unroll
        for (int ct = 0; ct < 2; ++ct) { const s16x4 a0 = tr64(wl + vbs[ct] + (16 * step) * 128), a1 = tr64(wl + vbs[ct] + (16 * step + 4) * 128);
            o[ct] = __builtin_amdgcn_mfma_f32_32x32x16_bf16(cat8(a0, a1), wf, o[ct], 0, 0, 0); }
    }
    MX_FENCE();
    const float bt = bsp_l[g * 128 + tpos0 + r32];
    const bf16* up = P + (tok0 + r32) * NIN + 1536 + g * 64 + 4 * hi;
#pragma unroll
    for (int ct = 0; ct < 2; ++ct)
#pragma unroll
        for (int rg = 0; rg < 4; ++rg) { const u32x2 uu = *(const u32x2*)(up + 32 * ct + 8 * rg);
            o[ct][4 * rg + 0] = __builtin_bit_cast(float, uu.x << 16) * (o[ct][4 * rg + 0] + bt); o[ct][4 * rg + 1] = __builtin_bit_cast(float, uu.x & 0xffff0000u) * (o[ct][4 * rg + 1] + bt);
            o[ct][4 * rg + 2] = __builtin_bit_cast(float, uu.y << 16) * (o[ct][4 * rg + 2] + bt); o[ct][4 * rg + 3] = __builtin_bit_cast(float, uu.y & 0xffff0000u) * (o[ct][4 * rg + 3] + bt); }
}

__device__ __forceinline__ void norm_store(const f32x16 (&o)[2], LAS float* red, int wave, int lane, const float* gain, bf16* dst) {
    const int r32 = lane & 31, hi = lane >> 5;
    float ss = 0.f;
#pragma unroll
    for (int r = 0; r < 16; ++r) ss += o[0][r] * o[0][r] + o[1][r] * o[1][r];
    ss += __shfl_xor(ss, 32);
    if (hi == 0) red[wave * 32 + r32] = ss;
    __syncthreads();
    float tot = 0.f;
#pragma unroll
    for (int w = 0; w < 8; ++w) tot += red[w * 32 + r32];
    const float rn = __builtin_amdgcn_rsqf(tot * (1.0f / 512.0f) + pg8::RMS_EPS);
#pragma unroll
    for (int ct = 0; ct < 2; ++ct)
#pragma unroll
        for (int rg = 0; rg < 4; ++rg) { const int ch = 32 * ct + 8 * rg + 4 * hi; const f32x4 gv = *(const f32x4*)(gain + ch);
            u32x2 w; w.x = cvtpk(o[ct][4 * rg + 0] * rn * gv[0], o[ct][4 * rg + 1] * rn * gv[1]); w.y = cvtpk(o[ct][4 * rg + 2] * rn * gv[2], o[ct][4 * rg + 3] * rn * gv[3]);
            *(u32x2*)(dst + (size_t)r32 * DM + ch) = w; }
}

__device__ __forceinline__ void mixer_fast(CArgs* a, int l, LAS unsigned char* lds, int wave, int lane) {
    const bf16* P = (const bf16*)(a->ws + WS_PROJ); bf16* MIX = (bf16*)(a->ws + WS_MIX);
    const float* vgss = (const float*)(a->ws + WS_VGSS); const bf16* wsp_l = (const bf16*)(a->ws + WS_WSP) + (size_t)l * 8 * 128 * 128;
    const float* rel = a->in[5] + (size_t)l * 8 * 257; const float* sgu_g = a->in[6] + l * 512; const float* bsp_l = a->in[8] + l * 8 * 128;
    const float* ag = a->in[9] + l * 512; const float* gg = a->in[10] + l * 512;
    LAS float* tbl = (LAS float*)(lds + TBL_OFF); LAS float* red = (LAS float*)(lds + RED_OFF);
    for (int i = threadIdx.x; i < 8 * 257; i += NWAVES * 64) { const int h = i / 257, k = i % 257; tbl[h * 260 + k] = rel[i] * pg8::LOG2E; }
    __syncthreads();
    LAS unsigned char* wl = lds + wave * 16384;
    for (int u = blockIdx.x; u < NB * (SEQ / 64); u += gridDim.x) {
        const int b = u & 7, c = u >> 3;
#pragma nounroll
        for (int half = 0; half < 2; ++half) {
            const size_t tok0 = (size_t)b * SEQ + c * 64 + half * 32;
            f32x16 o[2];
            attn_task(P, b, c, half, wave, wl, tbl + wave * 260, lane, o);
            norm_store(o, red, wave, lane, ag + wave * 64, MIX + tok0 * DM + wave * 64);
            sgu_task(P, vgss, wsp_l, sgu_g, bsp_l, b, c, half, wave, wl, lane, o);
            norm_store(o, red + 256, wave, lane, gg + wave * 64, MIX + tok0 * DM + 512 + wave * 64);
        }
    }
    __syncthreads();
}
}

__global__ void __launch_bounds__(NWAVES * 64, 2) fwd_megakernel(Args a_unused) {
    extern __shared__ __attribute__((aligned(16))) unsigned char lds_raw[];
    LAS unsigned char* lds = (LAS unsigned char*)lds_raw;
    if (threadIdx.x < 16) ((LAS unsigned*)(lds + MISC_OFF))[threadIdx.x] = 0u;
    __syncthreads();
    (void)xcd_barrier_post((unsigned*)(kargs_ws() + WS_BAR), (volatile LAS unsigned*)(lds + MISC_OFF));
    { const int tid = threadIdx.x, lane = tid & 63, wave = __builtin_amdgcn_readfirstlane(tid >> 6);
      REPEAT(0) prologue(kargs(), lds, wave, lane); }
    GRID_BAR();
#if (REPM >> 6) & 1
    for (int i_ = 0; i_ < 10; ++i_) GRID_BAR();
#endif
#pragma nounroll
    for (int l = 0; l < DEPTH; ++l) {
#if PHM & 1
        REPEAT(1) {
            CArgs* a = kargs(); unsigned char* ws = a->ws; unsigned char* wb = ws + WS_W0 + (size_t)l * WS_WSTRIDE;
            pg8::Gemm g{(const bf16*)(ws + WS_XB), (const bf16*)(wb + WOFF_IN), M, NIN, DM}; pg8::StaticOrder S; S.init(M, NIN, (int)gridDim.x, (int)blockIdx.x);
            pg8::EpiInProj E{(bf16*)(ws + WS_PROJ), (const float*)(ws + WS_ROWSS), (float*)(ws + WS_VGSS), a->in[3] + l * 64, a->in[4] + l * 64};
            pg8::gemm_phase<pg8::EpiInProj, pg8::StaticOrder, true, true>(lds, g, S, E);
        }
#endif
        GRID_BAR();
#if PHM & 2
        REPEAT(2) { int tid = threadIdx.x; asm volatile("" : "+v"(tid)); const int lane = tid & 63, wave = __builtin_amdgcn_readfirstlane(tid >> 6);
#if FAST_MIXER
          mx::mixer_fast(kargs(), l, lds, wave, lane);
#else
          mixer_naive(kargs(), l, lds, wave, lane);
#endif
        }
#endif
        GRID_BAR();
#if PHM & 4
        REPEAT(3) {
            CArgs* a = kargs(); unsigned char* ws = a->ws; unsigned char* wb = ws + WS_W0 + (size_t)l * WS_WSTRIDE; float* xo = a->out;
            float* xw = (((REPM >> 3) & 1) && rep_ == 0) ? (float*)(ws + 84 * MiB) : xo;
            pg8::Gemm g{(const bf16*)(ws + WS_MIX), (const bf16*)(wb + WOFF_OUT), M, DM, DM}; pg8::StaticOrder S; S.init(M, DM, (int)gridDim.x, (int)blockIdx.x);
            pg8::EpiResid E{l == 0 ? a->in[0] : (const float*)xo, xw, (bf16*)(ws + WS_XB), (float*)(ws + WS_ROWSS)};
            pg8::gemm_phase<pg8::EpiResid, pg8::StaticOrder, true, true>(lds, g, S, E);
        }
#endif
        GRID_BAR();
#if PHM & 8
        REPEAT(4) {
            CArgs* a = kargs(); unsigned char* ws = a->ws; unsigned char* wb = ws + WS_W0 + (size_t)l * WS_WSTRIDE;
            pg8::Gemm g{(const bf16*)(ws + WS_XB), (const bf16*)(wb + WOFF_FIN), M, NFF2, DM}; pg8::StaticOrder S; S.init(M, NFF2, (int)gridDim.x, (int)blockIdx.x);
            pg8::EpiSwiGLU E{(bf16*)(ws + WS_HID), (const float*)(ws + WS_ROWSS)};
            pg8::gemm_phase<pg8::EpiSwiGLU, pg8::StaticOrder, true, true>(lds, g, S, E);
        }
#endif
        GRID_BAR();
#if PHM & 16
        REPEAT(5) {
            CArgs* a = kargs(); unsigned char* ws = a->ws; unsigned char* wb = ws + WS_W0 + (size_t)l * WS_WSTRIDE; float* xo = a->out;
            float* xw = (((REPM >> 5) & 1) && rep_ == 0) ? (float*)(ws + 192 * MiB) : xo;
            pg8::Gemm g{(const bf16*)(ws + WS_HID), (const bf16*)(wb + WOFF_FOUT), M, DM, DFF}; pg8::StaticOrder S; S.init(M, DM, (int)gridDim.x, (int)blockIdx.x);
            pg8::EpiResid E{xo, xw, (bf16*)(ws + WS_XB), (float*)(ws + WS_ROWSS)};
            pg8::gemm_phase<pg8::EpiResid, pg8::StaticOrder, true, true>(lds, g, S, E);
        }
#endif
        if (l + 1 < DEPTH) GRID_BAR();
    }
}

extern "C" void kernel_launch(void* const* d_in, const int* in_sizes, int n_in, void* d_out, int out_size, void* d_ws, size_t ws_size, hipStream_t stream) {
    static int grid = 0;
    if (grid == 0) {
        if (n_in != 15 || in_sizes[0] != M * DM || out_size != M * DM || ws_size < WS_END) { fprintf(stderr, "kernel_launch: unexpected shapes (n_in %d, ws %zu)\n", n_in, ws_size); grid = -1; return; }
        int dev = 0, cus = 0, per_cu = 0;
        hipGetDevice(&dev); hipDeviceGetAttribute(&cus, hipDeviceAttributeMultiprocessorCount, dev);
        if (hipFuncSetAttribute((const void*)fwd_megakernel, hipFuncAttributeMaxDynamicSharedMemorySize, LDS_BYTES) != hipSuccess) { fprintf(stderr, "kernel_launch: hipFuncSetAttribute failed\n"); grid = -1; return; }
        if (hipOccupancyMaxActiveBlocksPerMultiprocessor(&per_cu, (const void*)fwd_megakernel, NWAVES * 64, LDS_BYTES) != hipSuccess || per_cu < 1) { fprintf(stderr, "kernel_launch: occupancy query failed (%d)\n", per_cu); (void)hipGetLastError(); per_cu = 1; }
        grid = cus * (per_cu > 1 ? 1 : per_cu);
    }
    if (grid < 0) return;
    if (hipMemsetAsync((char*)d_ws + WS_BAR, 0, BAR_ZERO_BYTES, stream) != hipSuccess) { fprintf(stderr, "kernel_launch: hipMemsetAsync failed\n"); return; }
    Args a{};
    for (int i = 0; i < 15; ++i) a.in[i] = (const float*)d_in[i];
    a.out = (float*)d_out; a.ws = (unsigned char*)d_ws;
    void* args[] = {&a};
    hipError_t e = hipLaunchCooperativeKernel((const void*)fwd_megakernel, dim3(grid), dim3(NWAVES * 64), args, LDS_BYTES, stream);
    if (e != hipSuccess) fprintf(stderr, "cooperative launch failed: %s (grid %d)\n", hipGetErrorString(e), grid);
}
```

```cpp
#include <hip/hip_runtime.h>
#include <hip/hip_cooperative_groups.h>
#include <cstdio>
#include <cstdint>
namespace cg = cooperative_groups;
namespace pg8 {
#define PG8_LAS __attribute__((address_space(3)))
typedef unsigned short bf16_t;
typedef short bf16x8 __attribute__((ext_vector_type(8)));
typedef float f32x4 __attribute__((ext_vector_type(4)));
typedef unsigned u32x4 __attribute__((ext_vector_type(4)));
constexpr int BM = 256, BK = 64, HALF = 128, HTB = HALF * BK * 2  , STAGE_BYTES = 8 * HTB, NXCD = 8, WGM = 8;

__host__ __device__ __forceinline__ int lds_byte(int r, int c) { const int st = (r >> 4) * 2 + (c >> 5), rr = r & 15, cc = c & 31, ob = rr * 64 + cc * 2; return st * 1024 + (ob ^ (((ob >> 9) & 1) << 5)); }
__host__ __device__ __forceinline__ void stage_rc(int b, int& R, int& C) { const int st = b / 1024, sb = b % 1024, swz = sb ^ (((sb >> 9) & 1) << 5); R = (st >> 1) * 16 + swz / 64; C = (st & 1) * 32 + (swz % 64) / 2; }
__host__ __device__ __forceinline__ int perm32(int rho) { const int n = rho >> 4, i = rho & 15; return 8 * (i >> 2) + 4 * n + (i & 3); }

struct Unit { int pm, pn; };
struct Gemm { const bf16_t* A; const bf16_t* Bt; int M, N, K; };

struct StaticOrder {
    int nM, nN, nwg, G, c;
    __host__ __device__ void init(int M, int N, int G_, int c_) { nM = M / BM; nN = N / BM; nwg = nM * nN; G = G_; c = c_; }
    __host__ __device__ bool next(int i, Unit& u) const {
        const long L = (long)i * G + c; if (L >= nwg) return false;
        int wgid = (int)L; { const int q = nwg / NXCD, r = nwg % NXCD, xcd = wgid % NXCD, off = wgid / NXCD; wgid = (xcd < r ? xcd * (q + 1) : r * (q + 1) + (xcd - r) * q) + off; }
        const int nig = WGM * nN, gid = wgid / nig, fm = gid * WGM, gsz = (nM - fm) < WGM ? (nM - fm) : WGM;
        u.pm = fm + ((wgid % nig) % gsz); u.pn = (wgid % nig) / gsz; return true;
    }
    __device__ __forceinline__ void a_ready(const Unit&) const {}
    __device__ __forceinline__ void done(const Unit&) const {}
};

__device__ __forceinline__ unsigned cvt_pk_bf16(float lo, float hi) { unsigned r; asm volatile("v_cvt_pk_bf16_f32 %0, %1, %2" : "=v"(r) : "v"(lo), "v"(hi)); return r; }
typedef float f32x2 __attribute__((ext_vector_type(2)));
constexpr float RMS_EPS = 1e-6f;
constexpr float LOG2E = 1.4426950408889634f;
constexpr float QSCALE = 0.125f * 1.4426950408889634f;
__device__ __forceinline__ float gelu_tanh(float x) {
    const float z2 = x * (1.5957691216057308f + 0.07135481627260025f * x * x);
    const float e = __builtin_amdgcn_exp2f(-LOG2E * z2);
    return x * __builtin_amdgcn_rcpf(1.0f + e);
}
__device__ __forceinline__ float row_rs(const float* rowss, int row) {
    const f32x4* pr = (const f32x4*)(rowss + (size_t)row * 16);
    const f32x4 a = pr[0], b = pr[1], c = pr[2], d = pr[3];
    const float ss = ((a[0] + a[1]) + (a[2] + a[3])) + ((b[0] + b[1]) + (b[2] + b[3])) + ((c[0] + c[1]) + (c[2] + c[3])) + ((d[0] + d[1]) + (d[2] + d[3]));
    return __builtin_amdgcn_rsqf(ss * (1.0f / 1024.0f) + RMS_EPS);
}
struct EpiInProj {
    static constexpr bool PERM = true, AFTER_DRAIN = false;
    bf16_t* P; const float* rowss; float* vgss; const float* qg; const float* kg;
    __device__ __forceinline__ void operator()(const f32x4 (&acc)[2][2][4][2], const Unit& u, int wr, int wc, int fr, int fq) const {
        const int region = u.pn >> 1, half = u.pn & 1;
        const int lcol = region * 512 + half * 256 + wc * 64 + fq * 8;
        float gq[2][8];
#pragma unroll
        for (int bj = 0; bj < 2; ++bj)
#pragma unroll
            for (int e = 0; e < 8; ++e) gq[bj][e] = 1.f;
        if (region < 2) { const float* g = region == 0 ? qg : kg; const float sc = region == 0 ? QSCALE : 1.f;
#pragma unroll
            for (int bj = 0; bj < 2; ++bj)
#pragma unroll
                for (int e = 0; e < 8; ++e) gq[bj][e] = g[bj * 32 + fq * 8 + e] * sc; }
#pragma unroll
        for (int ai = 0; ai < 2; ++ai)
#pragma unroll
            for (int m = 0; m < 4; ++m) {
                const int row = u.pm * BM + ai * HALF + wr * 64 + m * 16 + fr;
                const float s = row_rs(rowss, row);
                float v[2][8];
#pragma unroll
                for (int bj = 0; bj < 2; ++bj)
#pragma unroll
                    for (int n = 0; n < 2; ++n)
#pragma unroll
                        for (int i = 0; i < 4; ++i) v[bj][4 * n + i] = acc[ai][bj][m][n][i] * s;
                if (region < 2) {
                    float q = 0.f;
#pragma unroll
                    for (int bj = 0; bj < 2; ++bj)
#pragma unroll
                        for (int e = 0; e < 8; ++e) q += v[bj][e] * v[bj][e];
                    q += __shfl_xor(q, 16); q += __shfl_xor(q, 32);
                    const float r = __builtin_amdgcn_rsqf(q * (1.0f / 64.0f) + RMS_EPS);
#pragma unroll
                    for (int bj = 0; bj < 2; ++bj)
#pragma unroll
                        for (int e = 0; e < 8; ++e) v[bj][e] = v[bj][e] * r * gq[bj][e];
                } else if (region >= 3) {
#pragma unroll
                    for (int bj = 0; bj < 2; ++bj)
#pragma unroll
                        for (int e = 0; e < 8; ++e) v[bj][e] = gelu_tanh(v[bj][e]);
                    if (region == 4) {
                        float q = 0.f;
#pragma unroll
                        for (int bj = 0; bj < 2; ++bj)
#pragma unroll
                            for (int e = 0; e < 8; ++e) q += v[bj][e] * v[bj][e];
                        q += __shfl_xor(q, 16); q += __shfl_xor(q, 32);
                        if (fq == 0) vgss[(size_t)row * 8 + half * 4 + wc] = q;
                    }
                }
                bf16_t* rowp = P + (size_t)row * 2560 + lcol;
#pragma unroll
                for (int bj = 0; bj < 2; ++bj) { u32x4 w; w.x = cvt_pk_bf16(v[bj][0], v[bj][1]); w.y = cvt_pk_bf16(v[bj][2], v[bj][3]); w.z = cvt_pk_bf16(v[bj][4], v[bj][5]); w.w = cvt_pk_bf16(v[bj][6], v[bj][7]);
                    *(u32x4*)(rowp + bj * 32) = w; }
            }
    }
};
struct EpiResid {
    static constexpr bool PERM = true, AFTER_DRAIN = false;
    const float* base; float* out; bf16_t* xb; float* rowss;
    __device__ __forceinline__ void operator()(const f32x4 (&acc)[2][2][4][2], const Unit& u, int wr, int wc, int fr, int fq) const {
        const int col0 = u.pn * BM + wc * 32 + 8 * fq;
#pragma unroll
        for (int ai = 0; ai < 2; ++ai)
#pragma unroll
            for (int m = 0; m < 4; ++m) {
                const int row = u.pm * BM + ai * HALF + wr * 64 + m * 16 + fr;
                const size_t off = (size_t)row * 1024 + col0;
                float q = 0.f;
#pragma unroll
                for (int bj = 0; bj < 2; ++bj) {
                    const f32x4 b0 = *(const f32x4*)(base + off + bj * HALF), b1 = *(const f32x4*)(base + off + bj * HALF + 4);
                    const f32x4 v0 = acc[ai][bj][m][0] + b0, v1 = acc[ai][bj][m][1] + b1;
                    *(f32x4*)(out + off + bj * HALF) = v0; *(f32x4*)(out + off + bj * HALF + 4) = v1;
                    u32x4 w; w.x = cvt_pk_bf16(v0[0], v0[1]); w.y = cvt_pk_bf16(v0[2], v0[3]); w.z = cvt_pk_bf16(v1[0], v1[1]); w.w = cvt_pk_bf16(v1[2], v1[3]);
                    *(u32x4*)(xb + off + bj * HALF) = w;
                    q += (v0[0] * v0[0] + v0[1] * v0[1]) + (v0[2] * v0[2] + v0[3] * v0[3]) + (v1[0] * v1[0] + v1[1] * v1[1]) + (v1[2] * v1[2] + v1[3] * v1[3]);
                }
                q += __shfl_xor(q, 16); q += __shfl_xor(q, 32);
                if (fq == 0) rowss[(size_t)row * 16 + u.pn * 4 + wc] = q;
            }
    }
};
struct EpiSwiGLU {
    static constexpr bool PERM = true, AFTER_DRAIN = false;
    bf16_t* H; const float* rowss;
    __device__ __forceinline__ void operator()(const f32x4 (&acc)[2][2][4][2], const Unit& u, int wr, int wc, int fr, int fq) const {
        const int col0 = u.pn * 128 + wc * 32 + 8 * fq;
#pragma unroll
        for (int ai = 0; ai < 2; ++ai)
#pragma unroll
            for (int m = 0; m < 4; ++m) {
                const int row = u.pm * BM + ai * HALF + wr * 64 + m * 16 + fr;
                const float s = row_rs(rowss, row);
                float h[8];
#pragma unroll
                for (int n = 0; n < 2; ++n)
#pragma unroll
                    for (int i = 0; i < 4; ++i) { const float g = acc[ai][0][m][n][i] * s, up = acc[ai][1][m][n][i] * s;
                        h[4 * n + i] = g * __builtin_amdgcn_rcpf(1.0f + __builtin_amdgcn_exp2f(-LOG2E * g)) * up; }
                u32x4 w; w.x = cvt_pk_bf16(h[0], h[1]); w.y = cvt_pk_bf16(h[2], h[3]); w.z = cvt_pk_bf16(h[4], h[5]); w.w = cvt_pk_bf16(h[6], h[7]);
                *(u32x4*)(H + (size_t)row * 2816 + col0) = w;
            }
    }
};
template <class Epi, class Sched, bool ALIGN_EPI = false, bool SP2 = false>
__device__ __forceinline__ void gemm_phase(PG8_LAS unsigned char* lds, const Gemm g, const Sched& S, const Epi& E) {
    int tid_l = threadIdx.x; asm volatile("" : "+v"(tid_l));
    const int tid = tid_l, wid = __builtin_amdgcn_readfirstlane(tid >> 6), lane = tid & 63, wr = wid >> 2, wc = wid & 3, fr = lane & 15, fq = lane >> 4;
    const int K = g.K, nt = K / BK;
    unsigned voffA[2], voffB[2];
#pragma unroll
    for (int i = 0; i < 2; ++i) { int R, C; stage_rc(tid * 16 + i * 8192, R, C); const int Rb = Epi::PERM ? ((R & ~31) + perm32(R & 31)) : R;
        voffA[i] = (unsigned)(R * K + C) * 2u; voffB[i] = (unsigned)(Rb * K + C) * 2u; }
    const size_t kstep = (size_t)(BK * 2);
    const size_t hstep = (size_t)HALF * K * 2;
    const size_t tstep = 2 * hstep;
    const unsigned ldsw = (unsigned)wid * 1024u;
    const int aoff = lds_byte(wr * 64 + fr, fq * 8), boff = lds_byte(wc * 32 + fr, fq * 8);
#define PG8_SA(b, h) (((b) * 2 + (h)) * HTB)
#define PG8_SB(b, h) ((4 + (b) * 2 + (h)) * HTB)
#define PG8_STAGE(bufoff, gbase, voff) do { _Pragma("unroll") for (int _i = 0; _i < 2; ++_i) \
        __builtin_amdgcn_global_load_lds((const unsigned*)((const char*)(gbase) + (voff)[_i]), (PG8_LAS unsigned*)(lds + (bufoff) + ldsw + _i * 8192), 16, 0, 0); } while (0)
#define PG8_LDA(dst, b, h) do { _Pragma("unroll") for (int m = 0; m < 4; ++m) _Pragma("unroll") for (int k = 0; k < 2; ++k) dst[m][k] = *(const PG8_LAS bf16x8*)(lds + PG8_SA(b, h) + aoff + m * 2048 + k * 1024); } while (0)
#define PG8_LDB(dst, b, h) do { _Pragma("unroll") for (int n = 0; n < 2; ++n) _Pragma("unroll") for (int k = 0; k < 2; ++k) dst[n][k] = *(const PG8_LAS bf16x8*)(lds + PG8_SB(b, h) + boff + n * 2048 + k * 1024); } while (0)
#define PG8_MMA(ai, bj, At, Bt) do { __builtin_amdgcn_s_setprio(1); _Pragma("unroll") for (int m = 0; m < 4; ++m) _Pragma("unroll") for (int n = 0; n < 2; ++n) _Pragma("unroll") for (int k = 0; k < 2; ++k) \
        acc[ai][bj][m][n] = __builtin_amdgcn_mfma_f32_16x16x32_bf16(Bt[n][k], At[m][k], acc[ai][bj][m][n], 0, 0, 0); __builtin_amdgcn_s_setprio(0); } while (0)
#define PG8_WAIT_V(n) asm volatile("s_waitcnt vmcnt(" #n ")" ::: "memory")
#define PG8_WAIT_L(n) asm volatile("s_waitcnt lgkmcnt(" #n ")" ::: "memory")
#define PG8_BAR __builtin_amdgcn_s_barrier()
#define PG8_SCHED __builtin_amdgcn_sched_barrier(0)
    Unit cur, nxt; int ui = 0;
    if (!S.next(0, cur)) return;
    f32x4 acc[2][2][4][2];
#pragma unroll
    for (int a = 0; a < 2; ++a)
#pragma unroll
        for (int b = 0; b < 2; ++b)
#pragma unroll
            for (int m = 0; m < 4; ++m)
#pragma unroll
                for (int n = 0; n < 2; ++n) acc[a][b][m][n] = (f32x4){0.f, 0.f, 0.f, 0.f};
    bf16x8 At[4][2], B0[2][2], B1[2][2];
    const char* cA = (const char*)g.A + (size_t)cur.pm * tstep; const char* cB = (const char*)g.Bt + (size_t)cur.pn * tstep;
    S.a_ready(cur);
    if constexpr (SP2) {
        PG8_STAGE(PG8_SB(0, 0), cB, voffB); PG8_STAGE(PG8_SB(0, 1), cB + hstep, voffB); PG8_STAGE(PG8_SA(0, 0), cA, voffA); PG8_STAGE(PG8_SA(0, 1), cA + hstep, voffA);
        if (wr == 1) PG8_BAR;
        PG8_WAIT_V(2); PG8_BAR;
        PG8_STAGE(PG8_SB(1, 0), cB + kstep, voffB); PG8_STAGE(PG8_SA(1, 0), cA + kstep, voffA); PG8_STAGE(PG8_SB(1, 1), cB + hstep + kstep, voffB);
        PG8_WAIT_V(6); PG8_BAR;
    } else {
        PG8_STAGE(PG8_SB(0, 0), cB, voffB); PG8_STAGE(PG8_SA(0, 0), cA, voffA); PG8_STAGE(PG8_SB(0, 1), cB + hstep, voffB); PG8_STAGE(PG8_SA(0, 1), cA + hstep, voffA);
        if (wr == 1) PG8_BAR;
        PG8_WAIT_V(4); PG8_BAR;
        PG8_STAGE(PG8_SB(1, 0), cB + kstep, voffB); PG8_STAGE(PG8_SA(1, 0), cA + kstep, voffA); PG8_STAGE(PG8_SB(1, 1), cB + hstep + kstep, voffB);
        PG8_WAIT_V(6); PG8_BAR;
    }
    for (;;) {
        const bool has_next = S.next(ui + 1, nxt);
        const char* nA = has_next ? (const char*)g.A + (size_t)nxt.pm * tstep : cA; const char* nB = has_next ? (const char*)g.Bt + (size_t)nxt.pn * tstep : cB;
        for (int t = 0; t < nt; t += 2) {
            const bool last = (t == nt - 2);
            const char* a1 = cA + (size_t)(t + 1) * kstep;
            const char* a2 = last ? nA : cA + (size_t)(t + 2) * kstep; const char* b2 = last ? nB : cB + (size_t)(t + 2) * kstep;
            const char* a3 = a2 + kstep; const char* b3 = b2 + kstep;
            if (last && has_next) S.a_ready(nxt);
            if constexpr (SP2) {
            PG8_LDB(B0, 0, 0); PG8_LDB(B1, 0, 1); PG8_SCHED; PG8_LDA(At, 0, 0); PG8_STAGE(PG8_SA(1, 1), a1 + hstep, voffA);
            PG8_WAIT_V(8); PG8_WAIT_L(0); PG8_BAR; PG8_MMA(0, 0, At, B0); PG8_MMA(0, 1, At, B1); PG8_BAR; PG8_SCHED;
            PG8_LDA(At, 0, 1); PG8_STAGE(PG8_SB(0, 0), b2, voffB); PG8_STAGE(PG8_SB(0, 1), b2 + hstep, voffB); PG8_STAGE(PG8_SA(0, 0), a2, voffA);
            PG8_WAIT_V(8); PG8_WAIT_L(0); PG8_BAR; PG8_MMA(1, 0, At, B0); PG8_MMA(1, 1, At, B1); PG8_BAR; PG8_SCHED;
            PG8_LDB(B0, 1, 0); PG8_LDB(B1, 1, 1); PG8_SCHED; PG8_LDA(At, 1, 0); PG8_STAGE(PG8_SA(0, 1), a2 + hstep, voffA);
            PG8_WAIT_V(8); PG8_WAIT_L(0); PG8_BAR; PG8_MMA(0, 0, At, B0); PG8_MMA(0, 1, At, B1); PG8_BAR; PG8_SCHED;
            PG8_LDA(At, 1, 1); PG8_STAGE(PG8_SB(1, 0), b3, voffB); PG8_STAGE(PG8_SB(1, 1), b3 + hstep, voffB); PG8_STAGE(PG8_SA(1, 0), a3, voffA);
            PG8_WAIT_V(8); PG8_WAIT_L(0); PG8_BAR; PG8_MMA(1, 0, At, B0); PG8_MMA(1, 1, At, B1); PG8_BAR; PG8_SCHED;
            } else {
            PG8_LDB(B0, 0, 0); PG8_SCHED; PG8_LDA(At, 0, 0); PG8_STAGE(PG8_SA(1, 1), a1 + hstep, voffA);
            PG8_WAIT_L(8); PG8_BAR; PG8_WAIT_L(0); PG8_MMA(0, 0, At, B0); PG8_BAR; PG8_SCHED;
            PG8_LDB(B1, 0, 1); PG8_STAGE(PG8_SB(0, 0), b2, voffB);
            PG8_BAR; PG8_WAIT_L(0); PG8_MMA(0, 1, At, B1); PG8_BAR;
            PG8_LDA(At, 0, 1); PG8_STAGE(PG8_SA(0, 0), a2, voffA);
            PG8_BAR; PG8_WAIT_L(0); PG8_MMA(1, 0, At, B0); PG8_BAR; PG8_SCHED;
            PG8_STAGE(PG8_SB(0, 1), b2 + hstep, voffB);
            PG8_WAIT_V(6); PG8_BAR; PG8_MMA(1, 1, At, B1); PG8_BAR;
            PG8_LDB(B0, 1, 0); PG8_SCHED; PG8_LDA(At, 1, 0); PG8_STAGE(PG8_SA(0, 1), a2 + hstep, voffA);
            PG8_WAIT_L(8); PG8_BAR; PG8_WAIT_L(0); PG8_MMA(0, 0, At, B0); PG8_BAR; PG8_SCHED;
            PG8_LDB(B1, 1, 1); PG8_STAGE(PG8_SB(1, 0), b3, voffB);
            PG8_BAR; PG8_WAIT_L(0); PG8_MMA(0, 1, At, B1); PG8_BAR;
            PG8_LDA(At, 1, 1); PG8_STAGE(PG8_SA(1, 0), a3, voffA);
            PG8_BAR; PG8_WAIT_L(0); PG8_MMA(1, 0, At, B0); PG8_BAR; PG8_SCHED;
            PG8_STAGE(PG8_SB(1, 1), b3 + hstep, voffB);
            PG8_WAIT_V(6); PG8_BAR; PG8_MMA(1, 1, At, B1); PG8_BAR;
            }
        }
        if constexpr (ALIGN_EPI) { if (wr == 0) PG8_BAR; }
        if constexpr (!Epi::AFTER_DRAIN) { E(acc, cur, wr, wc, fr, fq); S.done(cur); }
        if (!has_next) break;
#pragma unroll
        for (int a = 0; a < 2; ++a)
#pragma unroll
            for (int b = 0; b < 2; ++b)
#pragma unroll
                for (int m = 0; m < 4; ++m)
#pragma unroll
                    for (int n = 0; n < 2; ++n) acc[a][b][m][n] = (f32x4){0.f, 0.f, 0.f, 0.f};
        cur = nxt; cA = nA; cB = nB; ++ui;
        if constexpr (ALIGN_EPI) { if (wr == 1) PG8_BAR; }
    }
    PG8_WAIT_V(0);
    if constexpr (!ALIGN_EPI) { if (wr == 0) PG8_BAR; }
    PG8_BAR;
    if constexpr (Epi::AFTER_DRAIN) { E.fused(acc, cur, wr, wc, fr, fq, lds, wid, lane); S.done(cur); }
#undef PG8_SA
#undef PG8_SB
#undef PG8_STAGE
#undef PG8_LDA
#undef PG8_LDB
#undef PG8_MMA
#undef PG8_WAIT_V
#undef PG8_WAIT_L
#undef PG8_BAR
#undef PG8_SCHED
}
}
constexpr int NB = 8, SEQ = 2048, DM = 1024, M = NB * SEQ, NIN = 2560, DFF = 2816, NFF2 = 2 * DFF, DEPTH = 2;
constexpr int NWAVES = 8;
constexpr size_t MiB = 1u << 20;
constexpr size_t WS_ROWSS = 1 * MiB;
constexpr size_t WS_VGSS = 2 * MiB;
constexpr size_t WS_WSP = 3 * MiB;
constexpr size_t WS_W0 = 4 * MiB, WS_WSTRIDE = 24 * MiB;
constexpr size_t WOFF_IN = 0, WOFF_OUT = 5 * MiB, WOFF_FIN = 7 * MiB, WOFF_FOUT = 18 * MiB;
constexpr size_t WS_XB = 52 * MiB;
constexpr size_t WS_PROJ = 84 * MiB;
constexpr size_t WS_MIX = 164 * MiB;
constexpr size_t WS_HID = 84 * MiB;
constexpr size_t WS_END = 196 * MiB;
constexpr int LDS_BYTES = 147456;

#define GAS __attribute__((address_space(1)))
#define LAS __attribute__((address_space(3)))
typedef unsigned short bf16;
typedef unsigned v4u __attribute__((ext_vector_type(4)));
typedef float f32x4 __attribute__((ext_vector_type(4)));
__device__ __forceinline__ unsigned f2bf(float f) { unsigned u = __builtin_bit_cast(unsigned, f); return (u + 0x7fffu + ((u >> 16) & 1u)) >> 16; }
__device__ __forceinline__ unsigned pk2(float lo, float hi) { return f2bf(lo) | (f2bf(hi) << 16); }
__device__ __forceinline__ float bf2f(bf16 v) { return __builtin_bit_cast(float, (unsigned)v << 16); }
__device__ __forceinline__ float wave_sum(float v) {
#pragma unroll
    for (int o = 1; o < 64; o <<= 1) v += __shfl_xor(v, o);
    return v;
}
#define LDS_WAIT() asm volatile("s_waitcnt lgkmcnt(0)" ::: "memory")

typedef short tp_s16x4 __attribute__((ext_vector_type(4)));
__device__ __forceinline__ void p0_transpose_item(const float* W, int K, int N, bf16* WT, int k0, int n0, int prow0, int prow1, const float* gk, LAS unsigned char* scr, int lane) {
    const int lr = lane >> 4, n4 = (lane & 15) * 4;
    f32x4 v[16];
#pragma unroll
    for (int i = 0; i < 16; ++i) v[i] = *(const f32x4*)(W + (size_t)(k0 + 4 * i + lr) * N + n0 + n4);
#pragma unroll
    for (int i = 0; i < 16; ++i) { const int k = 4 * i + lr; const float gg = gk ? gk[k0 + k] : 1.f;
        unsigned long long w = (unsigned long long)pk2(v[i].x * gg, v[i].y * gg) | ((unsigned long long)pk2(v[i].z * gg, v[i].w * gg) << 32);
        *(LAS unsigned long long*)(scr + k * 128 + ((n4 * 2) ^ (((k >> 1) & 1) << 6))) = w; }
    asm volatile("" ::: "memory");
    const int hh = lane >> 5, g2 = (lane >> 4) & 1, i16 = lane & 15, qq = i16 >> 2, p4 = i16 & 3;
#pragma unroll
    for (int j = 0; j < 8; ++j) { const int c = 2 * (j >> 1) + hh, nb = 32 * (j & 1) + 16 * g2;
        const int a0 = (8 * c + qq) * 128 + (((nb + 4 * p4) * 2) ^ ((qq >> 1) << 6));
        const tp_s16x4 lo = __builtin_bit_cast(tp_s16x4, __builtin_amdgcn_ds_read_tr16_b64_v4i16((LAS tp_s16x4*)(scr + a0)));
        const tp_s16x4 hi4 = __builtin_bit_cast(tp_s16x4, __builtin_amdgcn_ds_read_tr16_b64_v4i16((LAS tp_s16x4*)(scr + a0 + 4 * 128)));
        typedef short s16x8_t __attribute__((ext_vector_type(8)));
        const s16x8_t o = (s16x8_t){lo[0], lo[1], lo[2], lo[3], hi4[0], hi4[1], hi4[2], hi4[3]};
        const int prow = ((j & 1) ? prow1 : prow0) + 16 * g2 + i16;
        *(s16x8_t*)(WT + (size_t)prow * K + k0 + 8 * c) = o; }
    LDS_WAIT(); asm volatile("" ::: "memory");
}
__host__ __device__ __forceinline__ int map_in(int n) { const int T = n >> 8, nn = n & 255; return 256 * T + 128 * ((nn >> 5) & 1) + 32 * (nn >> 6) + (nn & 31); }
__host__ __device__ __forceinline__ int map_fin(int n) { return n < DFF ? 256 * (n >> 7) + (n & 127) : 256 * ((n - DFF) >> 7) + 128 + ((n - DFF) & 127); }

typedef GAS unsigned gu32;
#define RLX_AGENT __ATOMIC_RELAXED, __HIP_MEMORY_SCOPE_AGENT
constexpr int MISC_OFF = LDS_BYTES - 64;
constexpr size_t WS_BAR = 0;
constexpr size_t BAR_ZERO_BYTES = 16384;
#define XB_TMO      128
#define XB_XCNT(j)  (256  + 64 * (j))
#define XB_XSUB(j)  (1280 + 64 * (j))
#define XB_XGEN(j)  (2304 + 64 * (j))
#define XB_TOP      3328
#define XB_TOPGEN   3392
#define XCD_BAR_WORDS 3456
#define XB_SPIN_CAP (1u << 18)

__device__ __forceinline__ unsigned xb_ld(unsigned* p)              { return __hip_atomic_load(p, __ATOMIC_RELAXED, __HIP_MEMORY_SCOPE_AGENT); }
__device__ __forceinline__ unsigned xb_add(unsigned* p, unsigned v) { return __hip_atomic_fetch_add(p, v, __ATOMIC_RELAXED, __HIP_MEMORY_SCOPE_AGENT); }
__device__ __forceinline__ unsigned xb_xcc_id() { return (unsigned)__builtin_amdgcn_s_getreg((3 << 11) | 20) & 0xFu; }
#define XB_SPIN(cond, bar) do { unsigned _sp = 0; while (cond) { __builtin_amdgcn_s_sleep(1); \
    if ((++_sp & 255u) == 0u) { if (xb_ld(&(bar)[XB_TMO])) break; if (_sp > XB_SPIN_CAP) { atomicAdd(&(bar)[XB_TMO], 1u); break; } } } } while (0)

struct XcdBarrier {
    unsigned* bar; unsigned x;
    volatile LAS unsigned* st;
};

__device__ __forceinline__ XcdBarrier xcd_barrier_post(unsigned* bar, volatile LAS unsigned* st) {
    XcdBarrier b; b.bar = bar; b.x = xb_xcc_id(); b.st = st;
    if (threadIdx.x == 0) (void)xb_add(&bar[XB_XCNT(b.x)], 1u);
    return b;
}
__device__ __forceinline__ void xcd_barrier_complete(unsigned* bar, unsigned x, unsigned& nloc, unsigned& nx) {
    const unsigned G = gridDim.x * gridDim.y * gridDim.z;
    unsigned sum, cnt, mine, sp = 0u;
    for (;;) {
        sum = 0u; cnt = 0u; mine = 0u;
#pragma unroll
        for (unsigned j = 0; j < 16; ++j) { const unsigned c = xb_ld(&bar[XB_XCNT(j)]); sum += c; cnt += (c > 0u) ? 1u : 0u; mine = (j == x) ? c : mine; }
        if (sum == G) break;
        __builtin_amdgcn_s_sleep(1);
        if ((++sp & 255u) == 0u) { if (xb_ld(&bar[XB_TMO])) break; if (sp > XB_SPIN_CAP) { atomicAdd(&bar[XB_TMO], 1u); break; } }
    }
    nloc = mine > 0u ? mine : 1u; nx = cnt > 0u ? cnt : 1u;
}

__device__ __forceinline__ void xcd_barrier(const XcdBarrier& b) {
    asm volatile("s_waitcnt vmcnt(0)" ::: "memory");
    __syncthreads();
    if (threadIdx.x == 0) {
        unsigned* bar = b.bar;
        __builtin_amdgcn_s_waitcnt(0);
        unsigned nloc = b.st[0], nx = b.st[1];
        if (nloc == 0u) { xcd_barrier_complete(bar, b.x, nloc, nx); b.st[0] = nloc; b.st[1] = nx; }
        const unsigned old = xb_add(&bar[XB_XSUB(b.x)], 1u);
        const unsigned gen = old / nloc;
        if (old + 1u == (gen + 1u) * nloc) {
            __builtin_amdgcn_fence(__ATOMIC_RELEASE, "agent");
            asm volatile("s_waitcnt vmcnt(0)" ::: "memory");
            const unsigned og = xb_add(&bar[XB_TOP], 1u);
            const unsigned tg = og / nx;
            if (og + 1u == (tg + 1u) * nx) xb_add(&bar[XB_TOPGEN], 1u);
            else XB_SPIN(xb_ld(&bar[XB_TOPGEN]) == tg, bar);
            __builtin_amdgcn_fence(__ATOMIC_ACQUIRE, "agent");
            xb_add(&bar[XB_XGEN(b.x)], 1u);
            asm volatile("s_waitcnt vmcnt(0)" ::: "memory");
        } else {
            XB_SPIN(xb_ld(&bar[XB_XGEN(b.x)]) == gen, bar);
            __builtin_amdgcn_fence(__ATOMIC_ACQUIRE, "agent");
            asm volatile("s_waitcnt vmcnt(0)" ::: "memory");
        }
    }
    __syncthreads();
}

#define GRID_BAR() do { XcdBarrier bar_; bar_.bar = (unsigned*)(kargs_ws() + WS_BAR); bar_.x = xb_xcc_id(); bar_.st = (volatile LAS unsigned*)(lds + MISC_OFF); xcd_barrier(bar_); } while (0)
struct Args { const float* in[15]; float* out; unsigned char* ws; };
typedef const __attribute__((address_space(4))) Args CArgs;
__device__ __forceinline__ CArgs* kargs();
__device__ __forceinline__ unsigned char* kargs_ws();
__device__ __forceinline__ CArgs* kargs() { CArgs* p = (CArgs*)__builtin_amdgcn_kernarg_segment_ptr(); asm volatile("" : "+s"(p)); return p; }
__device__ __forceinline__ unsigned char* kargs_ws() { return kargs()->ws; }

__device__ __forceinline__ void prologue(CArgs* a, LAS unsigned char* lds, int wave, int lane) {
    LAS unsigned char* scr = lds + wave * 16384;
    const int gw = blockIdx.x * NWAVES + wave, NGW = gridDim.x * NWAVES;
    constexpr int I_IN = (DM / 64) * (NIN / 64), I_OUT = (DM / 64) * (DM / 64), I_FIN = (DM / 64) * (NFF2 / 64), I_FOUT = (DFF / 64) * (DM / 64);
    constexpr int I_LAYER = I_IN + I_OUT + I_FIN + I_FOUT;
    for (int it = gw; it < DEPTH * I_LAYER; it += NGW) {
        const int l = it / I_LAYER; int r = it % I_LAYER;
        unsigned char* wb = a->ws + WS_W0 + (size_t)l * WS_WSTRIDE;
        if (r < I_IN) { const int nblk = NIN / 64, kb = r / nblk, nb = r % nblk;
            p0_transpose_item(a->in[2] + (size_t)l * DM * NIN, DM, NIN, (bf16*)(wb + WOFF_IN), 64 * kb, 64 * nb, map_in(64 * nb), map_in(64 * nb + 32), a->in[1] + l * DM, scr, lane); continue; } r -= I_IN;
        if (r < I_OUT) { const int nblk = DM / 64, kb = r / nblk, nb = r % nblk;
            p0_transpose_item(a->in[11] + (size_t)l * DM * DM, DM, DM, (bf16*)(wb + WOFF_OUT), 64 * kb, 64 * nb, 64 * nb, 64 * nb + 32, nullptr, scr, lane); continue; } r -= I_OUT;
        if (r < I_FIN) { const int nblk = NFF2 / 64, kb = r / nblk, nb = r % nblk;
            p0_transpose_item(a->in[13] + (size_t)l * DM * NFF2, DM, NFF2, (bf16*)(wb + WOFF_FIN), 64 * kb, 64 * nb, map_fin(64 * nb), map_fin(64 * nb + 32), a->in[12] + l * DM, scr, lane); continue; } r -= I_FIN;
        { const int nblk = DM / 64, kb = r / nblk, nb = r % nblk;
            p0_transpose_item(a->in[14] + (size_t)l * DFF * DM, DFF, DM, (bf16*)(wb + WOFF_FOUT), 64 * kb, 64 * nb, 64 * nb, 64 * nb + 32, nullptr, scr, lane); }
    }
    float* rowss = (float*)(a->ws + WS_ROWSS); bf16* xb = (bf16*)(a->ws + WS_XB);
    for (int m = gw; m < M; m += NGW) {
        const f32x4* xr = (const f32x4*)(a->in[0] + (size_t)m * DM) + lane;
        unsigned long long* o8 = (unsigned long long*)(xb + (size_t)m * DM) + lane;
        float s = 0.f;
#pragma unroll
        for (int j = 0; j < 4; ++j) { const f32x4 v = xr[64 * j]; s += (v.x * v.x + v.y * v.y) + (v.z * v.z + v.w * v.w);
            o8[64 * j] = (unsigned long long)pk2(v.x, v.y) | ((unsigned long long)pk2(v.z, v.w) << 32); }
        s = wave_sum(s);
        if (lane < 16) rowss[(size_t)m * 16 + lane] = lane == 0 ? s : 0.f;
    }
    { const float* wsp = a->in[7]; bf16* o = (bf16*)(a->ws + WS_WSP); const int gt = blockIdx.x * 512 + threadIdx.x, NT = gridDim.x * 512;
      for (int i = gt; i < DEPTH * 8 * 128 * 128; i += NT) { const int s = i & 127, t = (i >> 7) & 127; o[i] = (bf16)(((t >> 6) >= (s >> 6)) ? f2bf(wsp[i]) : 0u); } }
}

__device__ __forceinline__ void mixer_naive(CArgs* a, int l, LAS unsigned char* lds, int wave, int lane) {
    const bf16* P = (const bf16*)(a->ws + WS_PROJ); bf16* MIX = (bf16*)(a->ws + WS_MIX);
    const float* vgss = (const float*)(a->ws + WS_VGSS); const bf16* wsp = (const bf16*)(a->ws + WS_WSP) + (size_t)l * 8 * 128 * 128;
    const float* rel = a->in[5] + (size_t)l * 8 * 257; const float* sgu_g = a->in[6] + l * 512; const float* bsp = a->in[8] + l * 8 * 128;
    const float* ag = a->in[9] + l * 512; const float* gg = a->in[10] + l * 512;
    LAS float* red = (LAS float*)lds;
    for (int tok = blockIdx.x; tok < M; tok += gridDim.x) {
        const int b = tok / SEQ, t = tok % SEQ, c = t >> 6;
        const int h = wave;
        const float q = bf2f(P[(size_t)tok * NIN + h * 64 + lane]);
        float mx = -INFINITY, lsum = 0.f, o = 0.f;
        const int k0 = (c >= 8 ? c - 8 : 0) * 64, k1 = c * 64 + 63;
        for (int kt = k0; kt <= k1; ++kt) {
            const size_t kr = (size_t)(b * SEQ + kt) * NIN;
            float s = wave_sum(q * bf2f(P[kr + 512 + h * 64 + lane]));
            int d = t - kt; d = d < -128 ? -128 : (d > 128 ? 128 : d);
            s += rel[h * 257 + d + 128] * pg8::LOG2E;
            const float mn = fmaxf(mx, s), al = __builtin_amdgcn_exp2f(mx - mn), p = __builtin_amdgcn_exp2f(s - mn);
            lsum = lsum * al + p; o = o * al + p * bf2f(P[kr + 1024 + h * 64 + lane]); mx = mn;
        }
        o = o / lsum;
        const int g = wave, nb = t >> 7, tp = t & 127, ns = tp < 64 ? 64 : 128;
        float mixd = 0.f;
        for (int s = 0; s < ns; ++s) {
            const int srow = b * SEQ + nb * 128 + s;
            const f32x4* pv = (const f32x4*)(vgss + (size_t)srow * 8); const f32x4 p0 = pv[0], p1 = pv[1];
            const float rs = __builtin_amdgcn_rsqf((((p0[0] + p0[1]) + (p0[2] + p0[3])) + ((p1[0] + p1[1]) + (p1[2] + p1[3]))) * (1.0f / 512.0f) + pg8::RMS_EPS);
            mixd += bf2f(wsp[(g * 128 + tp) * 128 + s]) * (bf2f(P[(size_t)srow * NIN + 2048 + g * 64 + lane]) * rs * sgu_g[g * 64 + lane]);
        }
        const float gv = bf2f(P[(size_t)tok * NIN + 1536 + g * 64 + lane]) * (mixd + bsp[g * 128 + tp]);
        const float so = wave_sum(o * o), sg = wave_sum(gv * gv);
        __syncthreads();
        if (lane == 0) { red[wave] = so; red[8 + wave] = sg; }
        __syncthreads();
        float ta = 0.f, tg = 0.f;
#pragma unroll
        for (int w = 0; w < 8; ++w) { ta += red[w]; tg += red[8 + w]; }
        const float ra = __builtin_amdgcn_rsqf(ta * (1.0f / 512.0f) + pg8::RMS_EPS), rg = __builtin_amdgcn_rsqf(tg * (1.0f / 512.0f) + pg8::RMS_EPS);
        MIX[(size_t)tok * DM + h * 64 + lane] = (bf16)f2bf(o * ra * ag[h * 64 + lane]);
        MIX[(size_t)tok * DM + 512 + g * 64 + lane] = (bf16)f2bf(gv * rg * gg[g * 64 + lane]);
    }
    __syncthreads();
}

#ifndef FAST_MIXER
#define FAST_MIXER 1
#endif
#ifndef PHM
#define PHM 31
#endif
#ifndef REPM
#define REPM 0
#endif
#define REPEAT(bit) for (int rep_ = 0; rep_ < (((REPM) >> (bit)) & 1) + 1; ++rep_)
namespace mx {
typedef float f32x16 __attribute__((ext_vector_type(16)));
typedef short bf16x8 __attribute__((ext_vector_type(8)));
typedef short s16x4 __attribute__((ext_vector_type(4)));
typedef unsigned u32x2 __attribute__((ext_vector_type(2)));
constexpr int TBL_OFF = 131072;
constexpr int RED_OFF = TBL_OFF + 8 * 260 * 4;
__device__ __forceinline__ int crow(int r, int hi) { return (r & 3) + 8 * (r >> 2) + 4 * hi; }
__device__ __forceinline__ int vimg(int row, int chunk) { return row * 128 + ((chunk * 16) ^ (((row >> 1) & 1) << 6)); }
__device__ __forceinline__ s16x4 tr64(LAS unsigned char* p) { return __builtin_bit_cast(s16x4, __builtin_amdgcn_ds_read_tr16_b64_v4i16((LAS s16x4*)p)); }
__device__ __forceinline__ bf16x8 cat8(s16x4 a, s16x4 b) { return (bf16x8){a[0], a[1], a[2], a[3], b[0], b[1], b[2], b[3]}; }
__device__ __forceinline__ unsigned cvtpk(float lo, float hi) { unsigned r; asm("v_cvt_pk_bf16_f32 %0, %1, %2" : "=v"(r) : "v"(lo), "v"(hi)); return r; }
#define MX_FENCE() asm volatile("" ::: "memory")

__device__ __forceinline__ void attn_task(const bf16* P, int b, int c, int h, LAS unsigned char* wl, const LAS float* tbl, int lane, f32x16 (&o)[2][2]) {
    const int r32 = lane & 31, hi = lane >> 5;
    const size_t tok0 = (size_t)b * SEQ + c * 64;
    bf16x8 qf[2][4];
#pragma unroll
    for (int qt = 0; qt < 2; ++qt)
#pragma unroll
        for (int d0 = 0; d0 < 4; ++d0) qf[qt][d0] = *(const bf16x8*)(P + (tok0 + 32 * qt + r32) * NIN + h * 64 + d0 * 16 + hi * 8);
#pragma unroll
    for (int r = 0; r < 16; ++r) { o[0][0][r] = 0.f; o[0][1][r] = 0.f; o[1][0][r] = 0.f; o[1][1][r] = 0.f; }
    float m[2] = {-INFINITY, -INFINITY}, l[2] = {0.f, 0.f};
    const int kc0 = c >= 8 ? c - 8 : 0;
    const int dhalf = (lane >> 4) & 1, qq = (lane & 15) >> 2, p4 = lane & 3;
    int vb[2];
#pragma unroll
    for (int dt = 0; dt < 2; ++dt) vb[dt] = 8192 + (4 * hi + qq) * 128 + ((64 * dt + 32 * dhalf + 8 * p4) ^ ((qq >> 1) << 6));
    const int prow = lane >> 3, pch = lane & 7;
    const unsigned voff = (unsigned)(prow * NIN + (pch ^ (((lane >> 4) & 1) << 2)) * 8) * 2u;
    const unsigned koff0 = (unsigned)(prow * NIN + (pch ^ (lane >> 4)) * 8) * 2u, koff1 = (unsigned)(prow * NIN + (pch ^ (lane >> 4) ^ 4) * 8) * 2u;
    const int swz = (r32 >> 1) & 7;
    int ka[4];
#pragma unroll
    for (int d0 = 0; d0 < 4; ++d0) ka[d0] = r32 * 128 + (((2 * d0 + hi) ^ swz) * 16);
#define MX_DMAK(kc) do { const char* kp_ = (const char*)(P + ((size_t)b * SEQ + (kc) * 64) * NIN + 512 + h * 64); \
        _Pragma("unroll") for (int i = 0; i < 8; ++i) __builtin_amdgcn_global_load_lds((const unsigned*)(kp_ + (size_t)(i * 8 * NIN) * 2 + ((i & 1) ? koff1 : koff0)), (LAS unsigned*)(wl + i * 1024), 16, 0, 0); } while (0)
#define MX_DMAV(kc) do { const char* vp_ = (const char*)(P + ((size_t)b * SEQ + (kc) * 64) * NIN + 1024 + h * 64); \
        _Pragma("unroll") for (int i = 0; i < 8; ++i) __builtin_amdgcn_global_load_lds((const unsigned*)(vp_ + (size_t)(i * 8 * NIN) * 2 + voff), (LAS unsigned*)(wl + 8192 + i * 1024), 16, 0, 0); } while (0)
    MX_DMAK(kc0);
    for (int kc = kc0; kc <= c; ++kc) {
        const int j = kc - c + 8;
        MX_DMAV(kc);
        asm volatile("s_waitcnt vmcnt(8)" ::: "memory");
        bf16x8 kf[2][4];
#pragma unroll
        for (int kt = 0; kt < 2; ++kt)
#pragma unroll
            for (int d0 = 0; d0 < 4; ++d0) kf[kt][d0] = *(const LAS bf16x8*)(wl + kt * 4096 + ka[d0]);
        asm volatile("s_waitcnt lgkmcnt(0)" ::: "memory");
        if (kc < c) MX_DMAK(kc + 1);
#pragma unroll
        for (int qt = 0; qt < 2; ++qt) {
            f32x16 st[2];
            if (j <= 5) { const float bc = tbl[256];
#pragma unroll
                for (int r = 0; r < 16; ++r) { st[0][r] = bc; st[1][r] = bc; } }
            else { int D0 = 64 * (8 - j) + 32 * qt + r32 - 4 * hi; asm volatile("" : "+v"(D0));
#pragma unroll
                for (int kt = 0; kt < 2; ++kt)
#pragma unroll
                    for (int r = 0; r < 16; ++r) { int idx = D0 - (32 * kt + (r & 3) + 8 * (r >> 2)); idx = idx < -128 ? -128 : (idx > 128 ? 128 : idx); st[kt][r] = tbl[idx + 128]; } }
#pragma unroll
            for (int kt = 0; kt < 2; ++kt)
#pragma unroll
                for (int d0 = 0; d0 < 4; ++d0) st[kt] = __builtin_amdgcn_mfma_f32_32x32x16_bf16(kf[kt][d0], qf[qt][d0], st[kt], 0, 0, 0);
            float mxv = fmaxf(st[0][0], st[1][0]);
#pragma unroll
            for (int r = 1; r < 16; ++r) mxv = fmaxf(mxv, fmaxf(st[0][r], st[1][r]));
            mxv = fmaxf(mxv, __shfl_xor(mxv, 32));
            const float mn = fmaxf(m[qt], mxv), al = __builtin_amdgcn_exp2f(m[qt] - mn); m[qt] = mn;
            float rs = 0.f;
#pragma unroll
            for (int kt = 0; kt < 2; ++kt)
#pragma unroll
                for (int r = 0; r < 16; ++r) { const float p = __builtin_amdgcn_exp2f(st[kt][r] - mn); st[kt][r] = p; rs += p; }
            l[qt] = l[qt] * al + rs;
#pragma unroll
            for (int r = 0; r < 16; ++r) { o[qt][0][r] *= al; o[qt][1][r] *= al; }
            bf16x8 pf[4];
#pragma unroll
            for (int s = 0; s < 4; ++s) { v4u w; const int kt = s >> 1, r0 = 8 * (s & 1);
                w.x = cvtpk(st[kt][r0 + 0], st[kt][r0 + 1]); w.y = cvtpk(st[kt][r0 + 2], st[kt][r0 + 3]); w.z = cvtpk(st[kt][r0 + 4], st[kt][r0 + 5]); w.w = cvtpk(st[kt][r0 + 6], st[kt][r0 + 7]);
                pf[s] = __builtin_bit_cast(bf16x8, w); }
            if (qt == 0) { if (kc < c) asm volatile("s_waitcnt vmcnt(8)" ::: "memory"); else asm volatile("s_waitcnt vmcnt(0)" ::: "memory"); }
#pragma unroll
            for (int dt = 0; dt < 2; ++dt) { s16x4 va[4], vc[4]; const unsigned vaddr = (unsigned)(uintptr_t)(wl + vb[dt]);
#pragma unroll
                for (int s = 0; s < 4; ++s) { asm volatile("ds_read_b64_tr_b16 %0, %1 offset:%c2" : "=&v"(va[s]) : "v"(vaddr), "i"(16 * s * 128) : "memory");
                                              asm volatile("ds_read_b64_tr_b16 %0, %1 offset:%c2" : "=&v"(vc[s]) : "v"(vaddr), "i"((16 * s + 8) * 128) : "memory"); }
                asm volatile("s_waitcnt lgkmcnt(0)" : "+v"(va[0]), "+v"(va[1]), "+v"(va[2]), "+v"(va[3]), "+v"(vc[0]), "+v"(vc[1]), "+v"(vc[2]), "+v"(vc[3]) :: "memory");
#pragma unroll
                for (int s = 0; s < 4; ++s) o[qt][dt] = __builtin_amdgcn_mfma_f32_32x32x16_bf16(cat8(va[s], vc[s]), pf[s], o[qt][dt], 0, 0, 0); }
        }
        MX_FENCE();
    }
#undef MX_DMAK
#undef MX_DMAV
#pragma unroll
    for (int qt = 0; qt < 2; ++qt) { float lt = l[qt]; lt += __shfl_xor(lt, 32); const float inv = 1.0f / lt;
#pragma unroll
        for (int r = 0; r < 16; ++r) { o[qt][0][r] *= inv; o[qt][1][r] *= inv; } }
}

__device__ __forceinline__ void sgu_task(const bf16* P, const float* vgss, const bf16* wsp_l, const float* sgu_g, const float* bsp_l, int b, int c, int g, LAS unsigned char* wl, int lane_in, f32x16 (&o)[2][2]) {
    int lane = lane_in; asm volatile("" : "+v"(lane));
    const int r32 = lane & 31, hi = lane >> 5;
    const int nb = c >> 1, cb = c & 1, ns = cb ? 128 : 64;
    const size_t srow0 = (size_t)b * SEQ + nb * 128, tok0 = (size_t)b * SEQ + c * 64;
    const int prow = lane >> 3, pch = lane & 7;
    const f32x4 g0 = *(const f32x4*)(sgu_g + g * 64 + pch * 8), g1 = *(const f32x4*)(sgu_g + g * 64 + pch * 8 + 4);
    MX_FENCE();
#pragma unroll 4
    for (int i = 0; i < ns / 8; ++i) {
        const int row = prow + 8 * i; const size_t srow = srow0 + row;
        const f32x4 p0 = *(const f32x4*)(vgss + srow * 8), p1 = *(const f32x4*)(vgss + srow * 8 + 4);
        const float rs = __builtin_amdgcn_rsqf((((p0[0] + p0[1]) + (p0[2] + p0[3])) + ((p1[0] + p1[1]) + (p1[2] + p1[3]))) * (1.0f / 512.0f) + pg8::RMS_EPS);
        const v4u raw = *(const v4u*)(P + srow * NIN + 2048 + g * 64 + pch * 8);
        v4u w;
        w.x = cvtpk(__builtin_bit_cast(float, raw.x << 16) * rs * g0[0], __builtin_bit_cast(float, raw.x & 0xffff0000u) * rs * g0[1]);
        w.y = cvtpk(__builtin_bit_cast(float, raw.y << 16) * rs * g0[2], __builtin_bit_cast(float, raw.y & 0xffff0000u) * rs * g0[3]);
        w.z = cvtpk(__builtin_bit_cast(float, raw.z << 16) * rs * g1[0], __builtin_bit_cast(float, raw.z & 0xffff0000u) * rs * g1[1]);
        w.w = cvtpk(__builtin_bit_cast(float, raw.w << 16) * rs * g1[2], __builtin_bit_cast(float, raw.w & 0xffff0000u) * rs * g1[3]);
        *(LAS v4u*)(wl + vimg(row, pch)) = w;
    }
    MX_FENCE();
#pragma unroll
    for (int r = 0; r < 16; ++r) { o[0][0][r] = 0.f; o[0][1][r] = 0.f; o[1][0][r] = 0.f; o[1][1][r] = 0.f; }
    const int dhalf = (lane >> 4) & 1, qq = (lane & 15) >> 2, p4 = lane & 3;
    int vbs[2];
#pragma unroll
    for (int ct = 0; ct < 2; ++ct) vbs[ct] = (8 * hi + qq) * 128 + ((64 * ct + 32 * dhalf + 8 * p4) ^ ((qq >> 1) << 6));
    const bf16* wrow = wsp_l + ((size_t)g * 128 + cb * 64 + r32) * 128 + hi * 8;
#pragma unroll 2
    for (int step = 0; step < ns / 16; ++step) {
        const bf16x8 wf0 = *(const bf16x8*)(wrow + 16 * step), wf1 = *(const bf16x8*)(wrow + 32 * 128 + 16 * step);
#pragma unroll
        for (int ct = 0; ct < 2; ++ct) { const s16x4 a0 = tr64(wl + vbs[ct] + (16 * step) * 128), a1 = tr64(wl + vbs[ct] + (16 * step + 4) * 128);
            const bf16x8 af = cat8(a0, a1);
            o[0][ct] = __builtin_amdgcn_mfma_f32_32x32x16_bf16(af, wf0, o[0][ct], 0, 0, 0);
            o[1][ct] = __builtin_amdgcn_mfma_f32_32x32x16_bf16(af, wf1, o[1][ct], 0, 0, 0); }
    }
    MX_FENCE();
#pragma unroll
    for (int tt = 0; tt < 2; ++tt) {
        const float bt = bsp_l[g * 128 + cb * 64 + 32 * tt + r32];
        const bf16* up = P + (tok0 + 32 * tt + r32) * NIN + 1536 + g * 64 + 4 * hi;
#pragma unroll
        for (int ct = 0; ct < 2; ++ct)
#pragma unroll
            for (int rg = 0; rg < 4; ++rg) { const u32x2 uu = *(const u32x2*)(up + 32 * ct + 8 * rg);
                o[tt][ct][4 * rg + 0] = __builtin_bit_cast(float, uu.x << 16) * (o[tt][ct][4 * rg + 0] + bt); o[tt][ct][4 * rg + 1] = __builtin_bit_cast(float, uu.x & 0xffff0000u) * (o[tt][ct][4 * rg + 1] + bt);
                o[tt][ct][4 * rg + 2] = __builtin_bit_cast(float, uu.y << 16) * (o[tt][ct][4 * rg + 2] + bt); o[tt][ct][4 * rg + 3] = __builtin_bit_cast(float, uu.y & 0xffff0000u) * (o[tt][ct][4 * rg + 3] + bt); }
    }
}

__device__ __forceinline__ void norm_store(const f32x16 (&o)[2][2], LAS float* red, int wave, int lane_in, const float* gain, bf16* dst) {
    int lane = lane_in; asm volatile("" : "+v"(lane));
    const int r32 = lane & 31, hi = lane >> 5;
#pragma unroll
    for (int tt = 0; tt < 2; ++tt) { float ss = 0.f;
#pragma unroll
        for (int r = 0; r < 16; ++r) ss += o[tt][0][r] * o[tt][0][r] + o[tt][1][r] * o[tt][1][r];
        ss += __shfl_xor(ss, 32);
        if (hi == 0) red[wave * 64 + tt * 32 + r32] = ss; }
    __syncthreads();
#pragma unroll
    for (int tt = 0; tt < 2; ++tt) { float tot = 0.f;
#pragma unroll
        for (int w = 0; w < 8; ++w) tot += red[w * 64 + tt * 32 + r32];
        const float rn = __builtin_amdgcn_rsqf(tot * (1.0f / 512.0f) + pg8::RMS_EPS);
#pragma unroll
        for (int ct = 0; ct < 2; ++ct)
#pragma unroll
            for (int rg = 0; rg < 4; ++rg) { const int ch = 32 * ct + 8 * rg + 4 * hi; const f32x4 gv = *(const f32x4*)(gain + ch);
                u32x2 w; w.x = cvtpk(o[tt][ct][4 * rg + 0] * rn * gv[0], o[tt][ct][4 * rg + 1] * rn * gv[1]); w.y = cvtpk(o[tt][ct][4 * rg + 2] * rn * gv[2], o[tt][ct][4 * rg + 3] * rn * gv[3]);
                *(u32x2*)(dst + (size_t)(32 * tt + r32) * DM + ch) = w; } }
}

__device__ __forceinline__ void mixer_fast(CArgs* a, int l, LAS unsigned char* lds, int wave, int lane) {
    const bf16* P = (const bf16*)(a->ws + WS_PROJ); bf16* MIX = (bf16*)(a->ws + WS_MIX);
    const float* vgss = (const float*)(a->ws + WS_VGSS); const bf16* wsp_l = (const bf16*)(a->ws + WS_WSP) + (size_t)l * 8 * 128 * 128;
    const float* rel = a->in[5] + (size_t)l * 8 * 257; const float* sgu_g = a->in[6] + l * 512; const float* bsp_l = a->in[8] + l * 8 * 128;
    const float* ag = a->in[9] + l * 512; const float* gg = a->in[10] + l * 512;
    LAS float* tbl = (LAS float*)(lds + TBL_OFF); LAS float* red = (LAS float*)(lds + RED_OFF);
    for (int i = threadIdx.x; i < 8 * 257; i += NWAVES * 64) { const int h = i / 257, k = i % 257; tbl[h * 260 + k] = rel[i] * pg8::LOG2E; }
    __syncthreads();
    LAS unsigned char* wl = lds + wave * 16384;
    for (int u = blockIdx.x; u < NB * (SEQ / 64); u += gridDim.x) {
        const int b = u & 7, c = u >> 3;
        const size_t tok0 = (size_t)b * SEQ + c * 64;
        f32x16 o[2][2];
        attn_task(P, b, c, wave, wl, tbl + wave * 260, lane, o);
        norm_store(o, red, wave, lane, ag + wave * 64, MIX + tok0 * DM + wave * 64);
        sgu_task(P, vgss, wsp_l, sgu_g, bsp_l, b, c, wave, wl, lane, o);
        norm_store(o, red + 512, wave, lane, gg + wave * 64, MIX + tok0 * DM + 512 + wave * 64);
    }
    __syncthreads();
}
}

__global__ void __launch_bounds__(NWAVES * 64, 2) fwd_megakernel(Args a_unused) {
    extern __shared__ __attribute__((aligned(16))) unsigned char lds_raw[];
    LAS unsigned char* lds = (LAS unsigned char*)lds_raw;
    if (threadIdx.x < 16) ((LAS unsigned*)(lds + MISC_OFF))[threadIdx.x] = 0u;
    __syncthreads();
    (void)xcd_barrier_post((unsigned*)(kargs_ws() + WS_BAR), (volatile LAS unsigned*)(lds + MISC_OFF));
    { const int tid = threadIdx.x, lane = tid & 63, wave = __builtin_amdgcn_readfirstlane(tid >> 6);
      REPEAT(0) prologue(kargs(), lds, wave, lane); }
    GRID_BAR();
#if (REPM >> 6) & 1
    for (int i_ = 0; i_ < 10; ++i_) GRID_BAR();
#endif
#pragma nounroll
    for (int l = 0; l < DEPTH; ++l) {
#if PHM & 1
        REPEAT(1) {
            CArgs* a = kargs(); unsigned char* ws = a->ws; unsigned char* wb = ws + WS_W0 + (size_t)l * WS_WSTRIDE;
            pg8::Gemm g{(const bf16*)(ws + WS_XB), (const bf16*)(wb + WOFF_IN), M, NIN, DM}; pg8::StaticOrder S; S.init(M, NIN, (int)gridDim.x, (int)blockIdx.x);
            pg8::EpiInProj E{(bf16*)(ws + WS_PROJ), (const float*)(ws + WS_ROWSS), (float*)(ws + WS_VGSS), a->in[3] + l * 64, a->in[4] + l * 64};
            pg8::gemm_phase<pg8::EpiInProj, pg8::StaticOrder, true, true>(lds, g, S, E);
        }
#endif
        GRID_BAR();
#if PHM & 2
        REPEAT(2) { int tid = threadIdx.x; asm volatile("" : "+v"(tid)); const int lane = tid & 63, wave = __builtin_amdgcn_readfirstlane(tid >> 6);
#if FAST_MIXER
          mx::mixer_fast(kargs(), l, lds, wave, lane);
#else
          mixer_naive(kargs(), l, lds, wave, lane);
#endif
        }
#endif
        GRID_BAR();
#if PHM & 4
        REPEAT(3) {
            CArgs* a = kargs(); unsigned char* ws = a->ws; unsigned char* wb = ws + WS_W0 + (size_t)l * WS_WSTRIDE; float* xo = a->out;
            float* xw = (((REPM >> 3) & 1) && rep_ == 0) ? (float*)(ws + 84 * MiB) : xo;
            pg8::Gemm g{(const bf16*)(ws + WS_MIX), (const bf16*)(wb + WOFF_OUT), M, DM, DM}; pg8::StaticOrder S; S.init(M, DM, (int)gridDim.x, (int)blockIdx.x);
            pg8::EpiResid E{l == 0 ? a->in[0] : (const float*)xo, xw, (bf16*)(ws + WS_XB), (float*)(ws + WS_ROWSS)};
            pg8::gemm_phase<pg8::EpiResid, pg8::StaticOrder, true, true>(lds, g, S, E);
        }
#endif
        GRID_BAR();
#if PHM & 8
        REPEAT(4) {
            CArgs* a = kargs(); unsigned char* ws = a->ws; unsigned char* wb = ws + WS_W0 + (size_t)l * WS_WSTRIDE;
            pg8::Gemm g{(const bf16*)(ws + WS_XB), (const bf16*)(wb + WOFF_FIN), M, NFF2, DM}; pg8::StaticOrder S; S.init(M, NFF2, (int)gridDim.x, (int)blockIdx.x);
            pg8::EpiSwiGLU E{(bf16*)(ws + WS_HID), (const float*)(ws + WS_ROWSS)};
            pg8::gemm_phase<pg8::EpiSwiGLU, pg8::StaticOrder, true, true>(lds, g, S, E);
        }
#endif
        GRID_BAR();
#if PHM & 16
        REPEAT(5) {
            CArgs* a = kargs(); unsigned char* ws = a->ws; unsigned char* wb = ws + WS_W0 + (size_t)l * WS_WSTRIDE; float* xo = a->out;
            float* xw = (((REPM >> 5) & 1) && rep_ == 0) ? (float*)(ws + 192 * MiB) : xo;
            pg8::Gemm g{(const bf16*)(ws + WS_HID), (const bf16*)(wb + WOFF_FOUT), M, DM, DFF}; pg8::StaticOrder S; S.init(M, DM, (int)gridDim.x, (int)blockIdx.x);
            pg8::EpiResid E{xo, xw, (bf16*)(ws + WS_XB), (float*)(ws + WS_ROWSS)};
            pg8::gemm_phase<pg8::EpiResid, pg8::StaticOrder, true, true>(lds, g, S, E);
        }
#endif
        if (l + 1 < DEPTH) GRID_BAR();
    }
}

extern "C" void kernel_launch(void* const* d_in, const int* in_sizes, int n_in, void* d_out, int out_size, void* d_ws, size_t ws_size, hipStream_t stream) {
    static int grid = 0;
    if (grid == 0) {
        if (n_in != 15 || in_sizes[0] != M * DM || out_size != M * DM || ws_size < WS_END) { fprintf(stderr, "kernel_launch: unexpected shapes (n_in %d, ws %zu)\n", n_in, ws_size); grid = -1; return; }
        int dev = 0, cus = 0, per_cu = 0;
        hipGetDevice(&dev); hipDeviceGetAttribute(&cus, hipDeviceAttributeMultiprocessorCount, dev);
        if (hipFuncSetAttribute((const void*)fwd_megakernel, hipFuncAttributeMaxDynamicSharedMemorySize, LDS_BYTES) != hipSuccess) { fprintf(stderr, "kernel_launch: hipFuncSetAttribute failed\n"); grid = -1; return; }
        if (hipOccupancyMaxActiveBlocksPerMultiprocessor(&per_cu, (const void*)fwd_megakernel, NWAVES * 64, LDS_BYTES) != hipSuccess || per_cu < 1) { fprintf(stderr, "kernel_launch: occupancy query failed (%d)\n", per_cu); (void)hipGetLastError(); per_cu = 1; }
        grid = cus * (per_cu > 1 ? 1 : per_cu);
    }
    if (grid < 0) return;
    if (hipMemsetAsync((char*)d_ws + WS_BAR, 0, BAR_ZERO_BYTES, stream) != hipSuccess) { fprintf(stderr, "kernel_launch: hipMemsetAsync failed\n"); return; }
    Args a{};
    for (int i = 0; i < 15; ++i) a.in[i] = (const float*)d_in[i];
    a.out = (float*)d_out; a.ws = (unsigned char*)d_ws;
    void* args[] = {&a};
    hipError_t e = hipLaunchCooperativeKernel((const void*)fwd_megakernel, dim3(grid), dim3(NWAVES * 64), args, LDS_BYTES, stream);
    if (e != hipSuccess) fprintf(stderr, "cooperative launch failed: %s (grid %d)\n", hipGetErrorString(e), grid);
}
```

```cpp
#include <hip/hip_runtime.h>
#include <hip/hip_cooperative_groups.h>
#include <cstdio>
#include <cstdint>
namespace cg = cooperative_groups;
namespace pg8 {
#define PG8_LAS __attribute__((address_space(3)))
typedef unsigned short bf16_t;
typedef short bf16x8 __attribute__((ext_vector_type(8)));
typedef float f32x4 __attribute__((ext_vector_type(4)));
typedef unsigned u32x4 __attribute__((ext_vector_type(4)));
constexpr int BM = 256, BK = 64, HALF = 128, HTB = HALF * BK * 2  , STAGE_BYTES = 8 * HTB, NXCD = 8, WGM = 8;

__host__ __device__ __forceinline__ int lds_byte(int r, int c) { const int st = (r >> 4) * 2 + (c >> 5), rr = r & 15, cc = c & 31, ob = rr * 64 + cc * 2; return st * 1024 + (ob ^ (((ob >> 9) & 1) << 5)); }
__host__ __device__ __forceinline__ void stage_rc(int b, int& R, int& C) { const int st = b / 1024, sb = b % 1024, swz = sb ^ (((sb >> 9) & 1) << 5); R = (st >> 1) * 16 + swz / 64; C = (st & 1) * 32 + (swz % 64) / 2; }
__host__ __device__ __forceinline__ int perm32(int rho) { const int n = rho >> 4, i = rho & 15; return 8 * (i >> 2) + 4 * n + (i & 3); }

struct Unit { int pm, pn; };
struct Gemm { const bf16_t* A; const bf16_t* Bt; int M, N, K; };

struct StaticOrder {
    int nM, nN, nwg, G, c;
    __host__ __device__ void init(int M, int N, int G_, int c_) { nM = M / BM; nN = N / BM; nwg = nM * nN; G = G_; c = c_; }
    __host__ __device__ bool next(int i, Unit& u) const {
        const long L = (long)i * G + c; if (L >= nwg) return false;
        int wgid = (int)L; { const int q = nwg / NXCD, r = nwg % NXCD, xcd = wgid % NXCD, off = wgid / NXCD; wgid = (xcd < r ? xcd * (q + 1) : r * (q + 1) + (xcd - r) * q) + off; }
        const int nig = WGM * nN, gid = wgid / nig, fm = gid * WGM, gsz = (nM - fm) < WGM ? (nM - fm) : WGM;
        u.pm = fm + ((wgid % nig) % gsz); u.pn = (wgid % nig) / gsz; return true;
    }
    __device__ __forceinline__ void a_ready(const Unit&) const {}
    __device__ __forceinline__ void done(const Unit&) const {}
};

__device__ __forceinline__ unsigned cvt_pk_bf16(float lo, float hi) { unsigned r; asm volatile("v_cvt_pk_bf16_f32 %0, %1, %2" : "=v"(r) : "v"(lo), "v"(hi)); return r; }
typedef float f32x2 __attribute__((ext_vector_type(2)));
constexpr float RMS_EPS = 1e-6f;
constexpr float LOG2E = 1.4426950408889634f;
constexpr float QSCALE = 0.125f * 1.4426950408889634f;
__device__ __forceinline__ float gelu_tanh(float x) {
    const float z2 = x * (1.5957691216057308f + 0.07135481627260025f * x * x);
    const float e = __builtin_amdgcn_exp2f(-LOG2E * z2);
    return x * __builtin_amdgcn_rcpf(1.0f + e);
}
__device__ __forceinline__ float row_rs(const float* rowss, int row) {
    const f32x4* pr = (const f32x4*)(rowss + (size_t)row * 16);
    const f32x4 a = pr[0], b = pr[1], c = pr[2], d = pr[3];
    const float ss = ((a[0] + a[1]) + (a[2] + a[3])) + ((b[0] + b[1]) + (b[2] + b[3])) + ((c[0] + c[1]) + (c[2] + c[3])) + ((d[0] + d[1]) + (d[2] + d[3]));
    return __builtin_amdgcn_rsqf(ss * (1.0f / 1024.0f) + RMS_EPS);
}
struct EpiInProj {
    static constexpr bool PERM = true, AFTER_DRAIN = false;
    bf16_t* P; const float* rowss; float* vgss; const float* qg; const float* kg;
    __device__ __forceinline__ void operator()(const f32x4 (&acc)[2][2][4][2], const Unit& u, int wr, int wc, int fr, int fq) const {
        const int region = u.pn >> 1, half = u.pn & 1;
        const int lcol = region * 512 + half * 256 + wc * 64 + fq * 8;
        float gq[2][8];
#pragma unroll
        for (int bj = 0; bj < 2; ++bj)
#pragma unroll
            for (int e = 0; e < 8; ++e) gq[bj][e] = 1.f;
        if (region < 2) { const float* g = region == 0 ? qg : kg; const float sc = region == 0 ? QSCALE : 1.f;
#pragma unroll
            for (int bj = 0; bj < 2; ++bj)
#pragma unroll
                for (int e = 0; e < 8; ++e) gq[bj][e] = g[bj * 32 + fq * 8 + e] * sc; }
#pragma unroll
        for (int ai = 0; ai < 2; ++ai)
#pragma unroll
            for (int m = 0; m < 4; ++m) {
                const int row = u.pm * BM + ai * HALF + wr * 64 + m * 16 + fr;
                const float s = row_rs(rowss, row);
                float v[2][8];
#pragma unroll
                for (int bj = 0; bj < 2; ++bj)
#pragma unroll
                    for (int n = 0; n < 2; ++n)
#pragma unroll
                        for (int i = 0; i < 4; ++i) v[bj][4 * n + i] = acc[ai][bj][m][n][i] * s;
                if (region < 2) {
                    float q = 0.f;
#pragma unroll
                    for (int bj = 0; bj < 2; ++bj)
#pragma unroll
                        for (int e = 0; e < 8; ++e) q += v[bj][e] * v[bj][e];
                    q += __shfl_xor(q, 16); q += __shfl_xor(q, 32);
                    const float r = __builtin_amdgcn_rsqf(q * (1.0f / 64.0f) + RMS_EPS);
#pragma unroll
                    for (int bj = 0; bj < 2; ++bj)
#pragma unroll
                        for (int e = 0; e < 8; ++e) v[bj][e] = v[bj][e] * r * gq[bj][e];
                } else if (region >= 3) {
#pragma unroll
                    for (int bj = 0; bj < 2; ++bj)
#pragma unroll
                        for (int e = 0; e < 8; ++e) v[bj][e] = gelu_tanh(v[bj][e]);
                    if (region == 4) {
                        float q = 0.f;
#pragma unroll
                        for (int bj = 0; bj < 2; ++bj)
#pragma unroll
                            for (int e = 0; e < 8; ++e) q += v[bj][e] * v[bj][e];
                        q += __shfl_xor(q, 16); q += __shfl_xor(q, 32);
                        if (fq == 0) vgss[(size_t)row * 8 + half * 4 + wc] = q;
                    }
                }
                bf16_t* rowp = P + (size_t)row * 2560 + lcol;
#pragma unroll
                for (int bj = 0; bj < 2; ++bj) { u32x4 w; w.x = cvt_pk_bf16(v[bj][0], v[bj][1]); w.y = cvt_pk_bf16(v[bj][2], v[bj][3]); w.z = cvt_pk_bf16(v[bj][4], v[bj][5]); w.w = cvt_pk_bf16(v[bj][6], v[bj][7]);
                    *(u32x4*)(rowp + bj * 32) = w; }
            }
    }
};
struct EpiResid {
    static constexpr bool PERM = true, AFTER_DRAIN = false;
    const float* base; float* out; bf16_t* xb; float* rowss;
    __device__ __forceinline__ void operator()(const f32x4 (&acc)[2][2][4][2], const Unit& u, int wr, int wc, int fr, int fq) const {
        const int col0 = u.pn * BM + wc * 32 + 8 * fq;
#pragma unroll
        for (int ai = 0; ai < 2; ++ai)
#pragma unroll
            for (int m = 0; m < 4; ++m) {
                const int row = u.pm * BM + ai * HALF + wr * 64 + m * 16 + fr;
                const size_t off = (size_t)row * 1024 + col0;
                float q = 0.f;
#pragma unroll
                for (int bj = 0; bj < 2; ++bj) {
                    const f32x4 b0 = *(const f32x4*)(base + off + bj * HALF), b1 = *(const f32x4*)(base + off + bj * HALF + 4);
                    const f32x4 v0 = acc[ai][bj][m][0] + b0, v1 = acc[ai][bj][m][1] + b1;
                    *(f32x4*)(out + off + bj * HALF) = v0; *(f32x4*)(out + off + bj * HALF + 4) = v1;
                    u32x4 w; w.x = cvt_pk_bf16(v0[0], v0[1]); w.y = cvt_pk_bf16(v0[2], v0[3]); w.z = cvt_pk_bf16(v1[0], v1[1]); w.w = cvt_pk_bf16(v1[2], v1[3]);
                    *(u32x4*)(xb + off + bj * HALF) = w;
                    q += (v0[0] * v0[0] + v0[1] * v0[1]) + (v0[2] * v0[2] + v0[3] * v0[3]) + (v1[0] * v1[0] + v1[1] * v1[1]) + (v1[2] * v1[2] + v1[3] * v1[3]);
                }
                q += __shfl_xor(q, 16); q += __shfl_xor(q, 32);
                if (fq == 0) rowss[(size_t)row * 16 + u.pn * 4 + wc] = q;
            }
    }
};
struct EpiSwiGLU {
    static constexpr bool PERM = true, AFTER_DRAIN = false;
    bf16_t* H; const float* rowss;
    __device__ __forceinline__ void operator()(const f32x4 (&acc)[2][2][4][2], const Unit& u, int wr, int wc, int fr, int fq) const {
        const int col0 = u.pn * 128 + wc * 32 + 8 * fq;
#pragma unroll
        for (int ai = 0; ai < 2; ++ai)
#pragma unroll
            for (int m = 0; m < 4; ++m) {
                const int row = u.pm * BM + ai * HALF + wr * 64 + m * 16 + fr;
                const float s = row_rs(rowss, row);
                float h[8];
#pragma unroll
                for (int n = 0; n < 2; ++n)
#pragma unroll
                    for (int i = 0; i < 4; ++i) { const float g = acc[ai][0][m][n][i] * s, up = acc[ai][1][m][n][i] * s;
                        h[4 * n + i] = g * __builtin_amdgcn_rcpf(1.0f + __builtin_amdgcn_exp2f(-LOG2E * g)) * up; }
                u32x4 w; w.x = cvt_pk_bf16(h[0], h[1]); w.y = cvt_pk_bf16(h[2], h[3]); w.z = cvt_pk_bf16(h[4], h[5]); w.w = cvt_pk_bf16(h[6], h[7]);
                *(u32x4*)(H + (size_t)row * 2816 + col0) = w;
            }
    }
};
template <class Epi, class Sched, bool ALIGN_EPI = false, bool SP2 = false>
__device__ __forceinline__ void gemm_phase(PG8_LAS unsigned char* lds, const Gemm g, const Sched& S, const Epi& E) {
    int tid_l = threadIdx.x; asm volatile("" : "+v"(tid_l));
    const int tid = tid_l, wid = __builtin_amdgcn_readfirstlane(tid >> 6), lane = tid & 63, wr = wid >> 2, wc = wid & 3, fr = lane & 15, fq = lane >> 4;
    const int K = g.K, nt = K / BK;
    unsigned voffA[2], voffB[2];
#pragma unroll
    for (int i = 0; i < 2; ++i) { int R, C; stage_rc(tid * 16 + i * 8192, R, C); const int Rb = Epi::PERM ? ((R & ~31) + perm32(R & 31)) : R;
        voffA[i] = (unsigned)(R * K + C) * 2u; voffB[i] = (unsigned)(Rb * K + C) * 2u; }
    const size_t kstep = (size_t)(BK * 2);
    const size_t hstep = (size_t)HALF * K * 2;
    const size_t tstep = 2 * hstep;
    const unsigned ldsw = (unsigned)wid * 1024u;
    const int aoff = lds_byte(wr * 64 + fr, fq * 8), boff = lds_byte(wc * 32 + fr, fq * 8);
#define PG8_SA(b, h) (((b) * 2 + (h)) * HTB)
#define PG8_SB(b, h) ((4 + (b) * 2 + (h)) * HTB)
#define PG8_STAGE(bufoff, gbase, voff) do { _Pragma("unroll") for (int _i = 0; _i < 2; ++_i) \
        __builtin_amdgcn_global_load_lds((const unsigned*)((const char*)(gbase) + (voff)[_i]), (PG8_LAS unsigned*)(lds + (bufoff) + ldsw + _i * 8192), 16, 0, 0); } while (0)
#define PG8_LDA(dst, b, h) do { _Pragma("unroll") for (int m = 0; m < 4; ++m) _Pragma("unroll") for (int k = 0; k < 2; ++k) dst[m][k] = *(const PG8_LAS bf16x8*)(lds + PG8_SA(b, h) + aoff + m * 2048 + k * 1024); } while (0)
#define PG8_LDB(dst, b, h) do { _Pragma("unroll") for (int n = 0; n < 2; ++n) _Pragma("unroll") for (int k = 0; k < 2; ++k) dst[n][k] = *(const PG8_LAS bf16x8*)(lds + PG8_SB(b, h) + boff + n * 2048 + k * 1024); } while (0)
#define PG8_MMA(ai, bj, At, Bt) do { __builtin_amdgcn_s_setprio(1); _Pragma("unroll") for (int m = 0; m < 4; ++m) _Pragma("unroll") for (int n = 0; n < 2; ++n) _Pragma("unroll") for (int k = 0; k < 2; ++k) \
        acc[ai][bj][m][n] = __builtin_amdgcn_mfma_f32_16x16x32_bf16(Bt[n][k], At[m][k], acc[ai][bj][m][n], 0, 0, 0); __builtin_amdgcn_s_setprio(0); } while (0)
#define PG8_WAIT_V(n) asm volatile("s_waitcnt vmcnt(" #n ")" ::: "memory")
#define PG8_WAIT_L(n) asm volatile("s_waitcnt lgkmcnt(" #n ")" ::: "memory")
#define PG8_BAR __builtin_amdgcn_s_barrier()
#define PG8_SCHED __builtin_amdgcn_sched_barrier(0)
    Unit cur, nxt; int ui = 0;
    if (!S.next(0, cur)) return;
    f32x4 acc[2][2][4][2];
#pragma unroll
    for (int a = 0; a < 2; ++a)
#pragma unroll
        for (int b = 0; b < 2; ++b)
#pragma unroll
            for (int m = 0; m < 4; ++m)
#pragma unroll
                for (int n = 0; n < 2; ++n) acc[a][b][m][n] = (f32x4){0.f, 0.f, 0.f, 0.f};
    bf16x8 At[4][2], B0[2][2], B1[2][2];
    const char* cA = (const char*)g.A + (size_t)cur.pm * tstep; const char* cB = (const char*)g.Bt + (size_t)cur.pn * tstep;
    S.a_ready(cur);
    if constexpr (SP2) {
        PG8_STAGE(PG8_SB(0, 0), cB, voffB); PG8_STAGE(PG8_SB(0, 1), cB + hstep, voffB); PG8_STAGE(PG8_SA(0, 0), cA, voffA); PG8_STAGE(PG8_SA(0, 1), cA + hstep, voffA);
        if (wr == 1) PG8_BAR;
        PG8_WAIT_V(2); PG8_BAR;
        PG8_STAGE(PG8_SB(1, 0), cB + kstep, voffB); PG8_STAGE(PG8_SA(1, 0), cA + kstep, voffA); PG8_STAGE(PG8_SB(1, 1), cB + hstep + kstep, voffB);
        PG8_WAIT_V(6); PG8_BAR;
    } else {
        PG8_STAGE(PG8_SB(0, 0), cB, voffB); PG8_STAGE(PG8_SA(0, 0), cA, voffA); PG8_STAGE(PG8_SB(0, 1), cB + hstep, voffB); PG8_STAGE(PG8_SA(0, 1), cA + hstep, voffA);
        if (wr == 1) PG8_BAR;
        PG8_WAIT_V(4); PG8_BAR;
        PG8_STAGE(PG8_SB(1, 0), cB + kstep, voffB); PG8_STAGE(PG8_SA(1, 0), cA + kstep, voffA); PG8_STAGE(PG8_SB(1, 1), cB + hstep + kstep, voffB);
        PG8_WAIT_V(6); PG8_BAR;
    }
    for (;;) {
        const bool has_next = S.next(ui + 1, nxt);
        const char* nA = has_next ? (const char*)g.A + (size_t)nxt.pm * tstep : cA; const char* nB = has_next ? (const char*)g.Bt + (size_t)nxt.pn * tstep : cB;
        for (int t = 0; t < nt; t += 2) {
            const bool last = (t == nt - 2);
            const char* a1 = cA + (size_t)(t + 1) * kstep;
            const char* a2 = last ? nA : cA + (size_t)(t + 2) * kstep; const char* b2 = last ? nB : cB + (size_t)(t + 2) * kstep;
            const char* a3 = a2 + kstep; const char* b3 = b2 + kstep;
            if (last && has_next) S.a_ready(nxt);
            if constexpr (SP2) {
            PG8_LDB(B0, 0, 0); PG8_LDB(B1, 0, 1); PG8_SCHED; PG8_LDA(At, 0, 0); PG8_STAGE(PG8_SA(1, 1), a1 + hstep, voffA);
            PG8_WAIT_V(8); PG8_WAIT_L(0); PG8_BAR; PG8_MMA(0, 0, At, B0); PG8_MMA(0, 1, At, B1); PG8_BAR; PG8_SCHED;
            PG8_LDA(At, 0, 1); PG8_STAGE(PG8_SB(0, 0), b2, voffB); PG8_STAGE(PG8_SB(0, 1), b2 + hstep, voffB); PG8_STAGE(PG8_SA(0, 0), a2, voffA);
            PG8_WAIT_V(8); PG8_WAIT_L(0); PG8_BAR; PG8_MMA(1, 0, At, B0); PG8_MMA(1, 1, At, B1); PG8_BAR; PG8_SCHED;
            PG8_LDB(B0, 1, 0); PG8_LDB(B1, 1, 1); PG8_SCHED; PG8_LDA(At, 1, 0); PG8_STAGE(PG8_SA(0, 1), a2 + hstep, voffA);
            PG8_WAIT_V(8); PG8_WAIT_L(0); PG8_BAR; PG8_MMA(0, 0, At, B0); PG8_MMA(0, 1, At, B1); PG8_BAR; PG8_SCHED;
            PG8_LDA(At, 1, 1); PG8_STAGE(PG8_SB(1, 0), b3, voffB); PG8_STAGE(PG8_SB(1, 1), b3 + hstep, voffB); PG8_STAGE(PG8_SA(1, 0), a3, voffA);
            PG8_WAIT_V(8); PG8_WAIT_L(0); PG8_BAR; PG8_MMA(1, 0, At, B0); PG8_MMA(1, 1, At, B1); PG8_BAR; PG8_SCHED;
            } else {
            PG8_LDB(B0, 0, 0); PG8_SCHED; PG8_LDA(At, 0, 0); PG8_STAGE(PG8_SA(1, 1), a1 + hstep, voffA);
            PG8_WAIT_L(8); PG8_BAR; PG8_WAIT_L(0); PG8_MMA(0, 0, At, B0); PG8_BAR; PG8_SCHED;
            PG8_LDB(B1, 0, 1); PG8_STAGE(PG8_SB(0, 0), b2, voffB);
            PG8_BAR; PG8_WAIT_L(0); PG8_MMA(0, 1, At, B1); PG8_BAR;
            PG8_LDA(At, 0, 1); PG8_STAGE(PG8_SA(0, 0), a2, voffA);
            PG8_BAR; PG8_WAIT_L(0); PG8_MMA(1, 0, At, B0); PG8_BAR; PG8_SCHED;
            PG8_STAGE(PG8_SB(0, 1), b2 + hstep, voffB);
            PG8_WAIT_V(6); PG8_BAR; PG8_MMA(1, 1, At, B1); PG8_BAR;
            PG8_LDB(B0, 1, 0); PG8_SCHED; PG8_LDA(At, 1, 0); PG8_STAGE(PG8_SA(0, 1), a2 + hstep, voffA);
            PG8_WAIT_L(8); PG8_BAR; PG8_WAIT_L(0); PG8_MMA(0, 0, At, B0); PG8_BAR; PG8_SCHED;
            PG8_LDB(B1, 1, 1); PG8_STAGE(PG8_SB(1, 0), b3, voffB);
            PG8_BAR; PG8_WAIT_L(0); PG8_MMA(0, 1, At, B1); PG8_BAR;
            PG8_LDA(At, 1, 1); PG8_STAGE(PG8_SA(1, 0), a3, voffA);
            PG8_BAR; PG8_WAIT_L(0); PG8_MMA(1, 0, At, B0); PG8_BAR; PG8_SCHED;
            PG8_STAGE(PG8_SB(1, 1), b3 + hstep, voffB);
            PG8_WAIT_V(6); PG8_BAR; PG8_MMA(1, 1, At, B1); PG8_BAR;
            }
        }
        if constexpr (ALIGN_EPI) { if (wr == 0) PG8_BAR; }
        if constexpr (!Epi::AFTER_DRAIN) { E(acc, cur, wr, wc, fr, fq); S.done(cur); }
        if (!has_next) break;
#pragma unroll
        for (int a = 0; a < 2; ++a)
#pragma unroll
            for (int b = 0; b < 2; ++b)
#pragma unroll
                for (int m = 0; m < 4; ++m)
#pragma unroll
                    for (int n = 0; n < 2; ++n) acc[a][b][m][n] = (f32x4){0.f, 0.f, 0.f, 0.f};
        cur = nxt; cA = nA; cB = nB; ++ui;
        if constexpr (ALIGN_EPI) { if (wr == 1) PG8_BAR; }
    }
    PG8_WAIT_V(0);
    if constexpr (!ALIGN_EPI) { if (wr == 0) PG8_BAR; }
    PG8_BAR;
    if constexpr (Epi::AFTER_DRAIN) { E.fused(acc, cur, wr, wc, fr, fq, lds, wid, lane); S.done(cur); }
#undef PG8_SA
#undef PG8_SB
#undef PG8_STAGE
#undef PG8_LDA
#undef PG8_LDB
#undef PG8_MMA
#undef PG8_WAIT_V
#undef PG8_WAIT_L
#undef PG8_BAR
#undef PG8_SCHED
}
}
constexpr int NB = 8, SEQ = 2048, DM = 1024, M = NB * SEQ, NIN = 2560, DFF = 2816, NFF2 = 2 * DFF, DEPTH = 2;
constexpr int NWAVES = 8;
constexpr size_t MiB = 1u << 20;
constexpr size_t WS_ROWSS = 1 * MiB;
constexpr size_t WS_VGSS = 2 * MiB;
constexpr size_t WS_WSP = 3 * MiB;
constexpr size_t WS_W0 = 4 * MiB, WS_WSTRIDE = 24 * MiB;
constexpr size_t WOFF_IN = 0, WOFF_OUT = 5 * MiB, WOFF_FIN = 7 * MiB, WOFF_FOUT = 18 * MiB;
constexpr size_t WS_XB = 52 * MiB;
constexpr size_t WS_PROJ = 84 * MiB;
constexpr size_t WS_MIX = 164 * MiB;
constexpr size_t WS_HID = 84 * MiB;
constexpr size_t WS_END = 196 * MiB;
constexpr int LDS_BYTES = 147456;

#define GAS __attribute__((address_space(1)))
#define LAS __attribute__((address_space(3)))
typedef unsigned short bf16;
typedef unsigned v4u __attribute__((ext_vector_type(4)));
typedef float f32x4 __attribute__((ext_vector_type(4)));
__device__ __forceinline__ unsigned f2bf(float f) { unsigned u = __builtin_bit_cast(unsigned, f); return (u + 0x7fffu + ((u >> 16) & 1u)) >> 16; }
__device__ __forceinline__ unsigned pk2(float lo, float hi) { return f2bf(lo) | (f2bf(hi) << 16); }
__device__ __forceinline__ float bf2f(bf16 v) { return __builtin_bit_cast(float, (unsigned)v << 16); }
__device__ __forceinline__ float wave_sum(float v) {
#pragma unroll
    for (int o = 1; o < 64; o <<= 1) v += __shfl_xor(v, o);
    return v;
}
#define LDS_WAIT() asm volatile("s_waitcnt lgkmcnt(0)" ::: "memory")

typedef short tp_s16x4 __attribute__((ext_vector_type(4)));
__device__ __forceinline__ void p0_transpose_item(const float* W, int K, int N, bf16* WT, int k0, int n0, int prow0, int prow1, const float* gk, LAS unsigned char* scr, int lane) {
    const int lr = lane >> 4, n4 = (lane & 15) * 4;
    f32x4 v[16];
#pragma unroll
    for (int i = 0; i < 16; ++i) v[i] = *(const f32x4*)(W + (size_t)(k0 + 4 * i + lr) * N + n0 + n4);
#pragma unroll
    for (int i = 0; i < 16; ++i) { const int k = 4 * i + lr; const float gg = gk ? gk[k0 + k] : 1.f;
        unsigned long long w = (unsigned long long)pk2(v[i].x * gg, v[i].y * gg) | ((unsigned long long)pk2(v[i].z * gg, v[i].w * gg) << 32);
        *(LAS unsigned long long*)(scr + k * 128 + ((n4 * 2) ^ (((k >> 1) & 1) << 6))) = w; }
    asm volatile("" ::: "memory");
    const int hh = lane >> 5, g2 = (lane >> 4) & 1, i16 = lane & 15, qq = i16 >> 2, p4 = i16 & 3;
#pragma unroll
    for (int j = 0; j < 8; ++j) { const int c = 2 * (j >> 1) + hh, nb = 32 * (j & 1) + 16 * g2;
        const int a0 = (8 * c + qq) * 128 + (((nb + 4 * p4) * 2) ^ ((qq >> 1) << 6));
        const tp_s16x4 lo = __builtin_bit_cast(tp_s16x4, __builtin_amdgcn_ds_read_tr16_b64_v4i16((LAS tp_s16x4*)(scr + a0)));
        const tp_s16x4 hi4 = __builtin_bit_cast(tp_s16x4, __builtin_amdgcn_ds_read_tr16_b64_v4i16((LAS tp_s16x4*)(scr + a0 + 4 * 128)));
        typedef short s16x8_t __attribute__((ext_vector_type(8)));
        const s16x8_t o = (s16x8_t){lo[0], lo[1], lo[2], lo[3], hi4[0], hi4[1], hi4[2], hi4[3]};
        const int prow = ((j & 1) ? prow1 : prow0) + 16 * g2 + i16;
        *(s16x8_t*)(WT + (size_t)prow * K + k0 + 8 * c) = o; }
    LDS_WAIT(); asm volatile("" ::: "memory");
}
__host__ __device__ __forceinline__ int map_in(int n) { const int T = n >> 8, nn = n & 255; return 256 * T + 128 * ((nn >> 5) & 1) + 32 * (nn >> 6) + (nn & 31); }
__host__ __device__ __forceinline__ int map_fin(int n) { return n < DFF ? 256 * (n >> 7) + (n & 127) : 256 * ((n - DFF) >> 7) + 128 + ((n - DFF) & 127); }

typedef GAS unsigned gu32;
#define RLX_AGENT __ATOMIC_RELAXED, __HIP_MEMORY_SCOPE_AGENT
constexpr int MISC_OFF = LDS_BYTES - 64;
constexpr size_t WS_BAR = 0;
constexpr size_t BAR_ZERO_BYTES = 16384;
#define XB_TMO      128
#define XB_XCNT(j)  (256  + 64 * (j))
#define XB_XSUB(j)  (1280 + 64 * (j))
#define XB_XGEN(j)  (2304 + 64 * (j))
#define XB_TOP      3328
#define XB_TOPGEN   3392
#define XCD_BAR_WORDS 3456
#define XB_SPIN_CAP (1u << 18)

__device__ __forceinline__ unsigned xb_ld(unsigned* p)              { return __hip_atomic_load(p, __ATOMIC_RELAXED, __HIP_MEMORY_SCOPE_AGENT); }
__device__ __forceinline__ unsigned xb_add(unsigned* p, unsigned v) { return __hip_atomic_fetch_add(p, v, __ATOMIC_RELAXED, __HIP_MEMORY_SCOPE_AGENT); }
__device__ __forceinline__ unsigned xb_xcc_id() { return (unsigned)__builtin_amdgcn_s_getreg((3 << 11) | 20) & 0xFu; }
#define XB_SPIN(cond, bar) do { unsigned _sp = 0; while (cond) { __builtin_amdgcn_s_sleep(1); \
    if ((++_sp & 255u) == 0u) { if (xb_ld(&(bar)[XB_TMO])) break; if (_sp > XB_SPIN_CAP) { atomicAdd(&(bar)[XB_TMO], 1u); break; } } } } while (0)

struct XcdBarrier {
    unsigned* bar; unsigned x;
    volatile LAS unsigned* st;
};

__device__ __forceinline__ XcdBarrier xcd_barrier_post(unsigned* bar, volatile LAS unsigned* st) {
    XcdBarrier b; b.bar = bar; b.x = xb_xcc_id(); b.st = st;
    if (threadIdx.x == 0) (void)xb_add(&bar[XB_XCNT(b.x)], 1u);
    return b;
}
__device__ __forceinline__ void xcd_barrier_complete(unsigned* bar, unsigned x, unsigned& nloc, unsigned& nx) {
    const unsigned G = gridDim.x * gridDim.y * gridDim.z;
    unsigned sum, cnt, mine, sp = 0u;
    for (;;) {
        sum = 0u; cnt = 0u; mine = 0u;
#pragma unroll
        for (unsigned j = 0; j < 16; ++j) { const unsigned c = xb_ld(&bar[XB_XCNT(j)]); sum += c; cnt += (c > 0u) ? 1u : 0u; mine = (j == x) ? c : mine; }
        if (sum == G) break;
        __builtin_amdgcn_s_sleep(1);
        if ((++sp & 255u) == 0u) { if (xb_ld(&bar[XB_TMO])) break; if (sp > XB_SPIN_CAP) { atomicAdd(&bar[XB_TMO], 1u); break; } }
    }
    nloc = mine > 0u ? mine : 1u; nx = cnt > 0u ? cnt : 1u;
}

__device__ __forceinline__ void xcd_barrier(const XcdBarrier& b) {
    asm volatile("s_waitcnt vmcnt(0)" ::: "memory");
    __syncthreads();
    if (threadIdx.x == 0) {
        unsigned* bar = b.bar;
        __builtin_amdgcn_s_waitcnt(0);
        unsigned nloc = b.st[0], nx = b.st[1];
        if (nloc == 0u) { xcd_barrier_complete(bar, b.x, nloc, nx); b.st[0] = nloc; b.st[1] = nx; }
        const unsigned old = xb_add(&bar[XB_XSUB(b.x)], 1u);
        const unsigned gen = old / nloc;
        if (old + 1u == (gen + 1u) * nloc) {
            __builtin_amdgcn_fence(__ATOMIC_RELEASE, "agent");
            asm volatile("s_waitcnt vmcnt(0)" ::: "memory");
            const unsigned og = xb_add(&bar[XB_TOP], 1u);
            const unsigned tg = og / nx;
            if (og + 1u == (tg + 1u) * nx) xb_add(&bar[XB_TOPGEN], 1u);
            else XB_SPIN(xb_ld(&bar[XB_TOPGEN]) == tg, bar);
            __builtin_amdgcn_fence(__ATOMIC_ACQUIRE, "agent");
            xb_add(&bar[XB_XGEN(b.x)], 1u);
            asm volatile("s_waitcnt vmcnt(0)" ::: "memory");
        } else {
            XB_SPIN(xb_ld(&bar[XB_XGEN(b.x)]) == gen, bar);
            __builtin_amdgcn_fence(__ATOMIC_ACQUIRE, "agent");
            asm volatile("s_waitcnt vmcnt(0)" ::: "memory");
        }
    }
    __syncthreads();
}

#define GRID_BAR() do { XcdBarrier bar_; bar_.bar = (unsigned*)(kargs_ws() + WS_BAR); bar_.x = xb_xcc_id(); bar_.st = (volatile LAS unsigned*)(lds + MISC_OFF); xcd_barrier(bar_); } while (0)
struct Args { const float* in[15]; float* out; unsigned char* ws; };
typedef const __attribute__((address_space(4))) Args CArgs;
__device__ __forceinline__ CArgs* kargs();
__device__ __forceinline__ unsigned char* kargs_ws();
__device__ __forceinline__ CArgs* kargs() { CArgs* p = (CArgs*)__builtin_amdgcn_kernarg_segment_ptr(); asm volatile("" : "+s"(p)); return p; }
__device__ __forceinline__ unsigned char* kargs_ws() { return kargs()->ws; }

__device__ __forceinline__ void prologue(CArgs* a, LAS unsigned char* lds, int wave, int lane) {
    LAS unsigned char* scr = lds + wave * 16384;
    const int gw = blockIdx.x * NWAVES + wave, NGW = gridDim.x * NWAVES;
    constexpr int I_IN = (DM / 64) * (NIN / 64), I_OUT = (DM / 64) * (DM / 64), I_FIN = (DM / 64) * (NFF2 / 64), I_FOUT = (DFF / 64) * (DM / 64);
    constexpr int I_LAYER = I_IN + I_OUT + I_FIN + I_FOUT;
    for (int it = gw; it < DEPTH * I_LAYER; it += NGW) {
        const int l = it / I_LAYER; int r = it % I_LAYER;
        unsigned char* wb = a->ws + WS_W0 + (size_t)l * WS_WSTRIDE;
        if (r < I_IN) { const int nblk = NIN / 64, kb = r / nblk, nb = r % nblk;
            p0_transpose_item(a->in[2] + (size_t)l * DM * NIN, DM, NIN, (bf16*)(wb + WOFF_IN), 64 * kb, 64 * nb, map_in(64 * nb), map_in(64 * nb + 32), a->in[1] + l * DM, scr, lane); continue; } r -= I_IN;
        if (r < I_OUT) { const int nblk = DM / 64, kb = r / nblk, nb = r % nblk;
            p0_transpose_item(a->in[11] + (size_t)l * DM * DM, DM, DM, (bf16*)(wb + WOFF_OUT), 64 * kb, 64 * nb, 64 * nb, 64 * nb + 32, nullptr, scr, lane); continue; } r -= I_OUT;
        if (r < I_FIN) { const int nblk = NFF2 / 64, kb = r / nblk, nb = r % nblk;
            p0_transpose_item(a->in[13] + (size_t)l * DM * NFF2, DM, NFF2, (bf16*)(wb + WOFF_FIN), 64 * kb, 64 * nb, map_fin(64 * nb), map_fin(64 * nb + 32), a->in[12] + l * DM, scr, lane); continue; } r -= I_FIN;
        { const int nblk = DM / 64, kb = r / nblk, nb = r % nblk;
            p0_transpose_item(a->in[14] + (size_t)l * DFF * DM, DFF, DM, (bf16*)(wb + WOFF_FOUT), 64 * kb, 64 * nb, 64 * nb, 64 * nb + 32, nullptr, scr, lane); }
    }
    float* rowss = (float*)(a->ws + WS_ROWSS); bf16* xb = (bf16*)(a->ws + WS_XB);
    for (int m = gw; m < M; m += NGW) {
        const f32x4* xr = (const f32x4*)(a->in[0] + (size_t)m * DM) + lane;
        unsigned long long* o8 = (unsigned long long*)(xb + (size_t)m * DM) + lane;
        float s = 0.f;
#pragma unroll
        for (int j = 0; j < 4; ++j) { const f32x4 v = xr[64 * j]; s += (v.x * v.x + v.y * v.y) + (v.z * v.z + v.w * v.w);
            o8[64 * j] = (unsigned long long)pk2(v.x, v.y) | ((unsigned long long)pk2(v.z, v.w) << 32); }
        s = wave_sum(s);
        if (lane < 16) rowss[(size_t)m * 16 + lane] = lane == 0 ? s : 0.f;
    }
    { const float* wsp = a->in[7]; bf16* o = (bf16*)(a->ws + WS_WSP); const int gt = blockIdx.x * 512 + threadIdx.x, NT = gridDim.x * 512;
      for (int i = gt; i < DEPTH * 8 * 128 * 128; i += NT) { const int s = i & 127, t = (i >> 7) & 127; o[i] = (bf16)(((t >> 6) >= (s >> 6)) ? f2bf(wsp[i]) : 0u); } }
}

__device__ __forceinline__ void mixer_naive(CArgs* a, int l, LAS unsigned char* lds, int wave, int lane) {
    const bf16* P = (const bf16*)(a->ws + WS_PROJ); bf16* MIX = (bf16*)(a->ws + WS_MIX);
    const float* vgss = (const float*)(a->ws + WS_VGSS); const bf16* wsp = (const bf16*)(a->ws + WS_WSP) + (size_t)l * 8 * 128 * 128;
    const float* rel = a->in[5] + (size_t)l * 8 * 257; const float* sgu_g = a->in[6] + l * 512; const float* bsp = a->in[8] + l * 8 * 128;
    const float* ag = a->in[9] + l * 512; const float* gg = a->in[10] + l * 512;
    LAS float* red = (LAS float*)lds;
    for (int tok = blockIdx.x; tok < M; tok += gridDim.x) {
        const int b = tok / SEQ, t = tok % SEQ, c = t >> 6;
        const int h = wave;
        const float q = bf2f(P[(size_t)tok * NIN + h * 64 + lane]);
        float mx = -INFINITY, lsum = 0.f, o = 0.f;
        const int k0 = (c >= 8 ? c - 8 : 0) * 64, k1 = c * 64 + 63;
        for (int kt = k0; kt <= k1; ++kt) {
            const size_t kr = (size_t)(b * SEQ + kt) * NIN;
            float s = wave_sum(q * bf2f(P[kr + 512 + h * 64 + lane]));
            int d = t - kt; d = d < -128 ? -128 : (d > 128 ? 128 : d);
            s += rel[h * 257 + d + 128] * pg8::LOG2E;
            const float mn = fmaxf(mx, s), al = __builtin_amdgcn_exp2f(mx - mn), p = __builtin_amdgcn_exp2f(s - mn);
            lsum = lsum * al + p; o = o * al + p * bf2f(P[kr + 1024 + h * 64 + lane]); mx = mn;
        }
        o = o / lsum;
        const int g = wave, nb = t >> 7, tp = t & 127, ns = tp < 64 ? 64 : 128;
        float mixd = 0.f;
        for (int s = 0; s < ns; ++s) {
            const int srow = b * SEQ + nb * 128 + s;
            const f32x4* pv = (const f32x4*)(vgss + (size_t)srow * 8); const f32x4 p0 = pv[0], p1 = pv[1];
            const float rs = __builtin_amdgcn_rsqf((((p0[0] + p0[1]) + (p0[2] + p0[3])) + ((p1[0] + p1[1]) + (p1[2] + p1[3]))) * (1.0f / 512.0f) + pg8::RMS_EPS);
            mixd += bf2f(wsp[(g * 128 + tp) * 128 + s]) * (bf2f(P[(size_t)srow * NIN + 2048 + g * 64 + lane]) * rs * sgu_g[g * 64 + lane]);
        }
        const float gv = bf2f(P[(size_t)tok * NIN + 1536 + g * 64 + lane]) * (mixd + bsp[g * 128 + tp]);
        const float so = wave_sum(o * o), sg = wave_sum(gv * gv);
        __syncthreads();
        if (lane == 0) { red[wave] = so; red[8 + wave] = sg; }
        __syncthreads();
        float ta = 0.f, tg = 0.f;
#pragma unroll
        for (int w = 0; w < 8; ++w) { ta += red[w]; tg += red[8 + w]; }
        const float ra = __builtin_amdgcn_rsqf(ta * (1.0f / 512.0f) + pg8::RMS_EPS), rg = __builtin_amdgcn_rsqf(tg * (1.0f / 512.0f) + pg8::RMS_EPS);
        MIX[(size_t)tok * DM + h * 64 + lane] = (bf16)f2bf(o * ra * ag[h * 64 + lane]);
        MIX[(size_t)tok * DM + 512 + g * 64 + lane] = (bf16)f2bf(gv * rg * gg[g * 64 + lane]);
    }
    __syncthreads();
}

#ifndef FAST_MIXER
#define FAST_MIXER 1
#endif
#ifndef PHM
#define PHM 31
#endif
#ifndef REPM
#define REPM 0
#endif
#define REPEAT(bit) for (int rep_ = 0; rep_ < (((REPM) >> (bit)) & 1) + 1; ++rep_)
namespace mx {
typedef float f32x16 __attribute__((ext_vector_type(16)));
typedef short bf16x8 __attribute__((ext_vector_type(8)));
typedef short s16x4 __attribute__((ext_vector_type(4)));
typedef unsigned u32x2 __attribute__((ext_vector_type(2)));
constexpr int TBL_OFF = 131072;
constexpr int RS_OFF = TBL_OFF + 8 * 260 * 4 + 4096;
constexpr int RED_OFF = TBL_OFF + 8 * 260 * 4;
__device__ __forceinline__ int crow(int r, int hi) { return (r & 3) + 8 * (r >> 2) + 4 * hi; }
__device__ __forceinline__ int vimg(int row, int chunk) { return row * 128 + ((chunk * 16) ^ (((row >> 1) & 1) << 6)); }
__device__ __forceinline__ s16x4 tr64(LAS unsigned char* p) { return __builtin_bit_cast(s16x4, __builtin_amdgcn_ds_read_tr16_b64_v4i16((LAS s16x4*)p)); }
__device__ __forceinline__ bf16x8 cat8(s16x4 a, s16x4 b) { return (bf16x8){a[0], a[1], a[2], a[3], b[0], b[1], b[2], b[3]}; }
__device__ __forceinline__ unsigned cvtpk(float lo, float hi) { unsigned r; asm("v_cvt_pk_bf16_f32 %0, %1, %2" : "=v"(r) : "v"(lo), "v"(hi)); return r; }
#define MX_FENCE() asm volatile("" ::: "memory")

__device__ __forceinline__ void attn_task(const bf16* P, int b, int c, int h, LAS unsigned char* wl, const LAS float* tbl, int lane, f32x16 (&o)[2][2]) {
    const int r32 = lane & 31, hi = lane >> 5;
    const size_t tok0 = (size_t)b * SEQ + c * 64;
    bf16x8 qf[2][4];
#pragma unroll
    for (int qt = 0; qt < 2; ++qt)
#pragma unroll
        for (int d0 = 0; d0 < 4; ++d0) qf[qt][d0] = *(const bf16x8*)(P + (tok0 + 32 * qt + r32) * NIN + h * 64 + d0 * 16 + hi * 8);
#pragma unroll
    for (int r = 0; r < 16; ++r) { o[0][0][r] = 0.f; o[0][1][r] = 0.f; o[1][0][r] = 0.f; o[1][1][r] = 0.f; }
    float m[2] = {-INFINITY, -INFINITY}, l[2] = {0.f, 0.f};
    const int kc0 = c >= 8 ? c - 8 : 0;
    const int dhalf = (lane >> 4) & 1, qq = (lane & 15) >> 2, p4 = lane & 3;
    int vb[2];
#pragma unroll
    for (int dt = 0; dt < 2; ++dt) vb[dt] = 8192 + (4 * hi + qq) * 128 + ((64 * dt + 32 * dhalf + 8 * p4) ^ ((qq >> 1) << 6));
    const int prow = lane >> 3, pch = lane & 7;
    const unsigned voff = (unsigned)(prow * NIN + (pch ^ (((lane >> 4) & 1) << 2)) * 8) * 2u;
    const unsigned koff0 = (unsigned)(prow * NIN + (pch ^ (lane >> 4)) * 8) * 2u, koff1 = (unsigned)(prow * NIN + (pch ^ (lane >> 4) ^ 4) * 8) * 2u;
    const int swz = (r32 >> 1) & 7;
    int ka[4];
#pragma unroll
    for (int d0 = 0; d0 < 4; ++d0) ka[d0] = r32 * 128 + (((2 * d0 + hi) ^ swz) * 16);
#define MX_DMAK(kc) do { const char* kp_ = (const char*)(P + ((size_t)b * SEQ + (kc) * 64) * NIN + 512 + h * 64); \
        _Pragma("unroll") for (int i = 0; i < 8; ++i) __builtin_amdgcn_global_load_lds((const unsigned*)(kp_ + (size_t)(i * 8 * NIN) * 2 + ((i & 1) ? koff1 : koff0)), (LAS unsigned*)(wl + i * 1024), 16, 0, 0); } while (0)
#define MX_DMAV(kc) do { const char* vp_ = (const char*)(P + ((size_t)b * SEQ + (kc) * 64) * NIN + 1024 + h * 64); \
        _Pragma("unroll") for (int i = 0; i < 8; ++i) __builtin_amdgcn_global_load_lds((const unsigned*)(vp_ + (size_t)(i * 8 * NIN) * 2 + voff), (LAS unsigned*)(wl + 8192 + i * 1024), 16, 0, 0); } while (0)
    MX_DMAK(kc0);
    for (int kc = kc0; kc <= c; ++kc) {
        const int j = kc - c + 8;
        MX_DMAV(kc);
        asm volatile("s_waitcnt vmcnt(8)" ::: "memory");
        bf16x8 kf[2][4];
#pragma unroll
        for (int kt = 0; kt < 2; ++kt)
#pragma unroll
            for (int d0 = 0; d0 < 4; ++d0) kf[kt][d0] = *(const LAS bf16x8*)(wl + kt * 4096 + ka[d0]);
        asm volatile("s_waitcnt lgkmcnt(0)" ::: "memory");
        if (kc < c) MX_DMAK(kc + 1);
#pragma unroll
        for (int qt = 0; qt < 2; ++qt) {
            f32x16 st[2];
            if (j <= 5) { const float bc = tbl[256];
#pragma unroll
                for (int r = 0; r < 16; ++r) { st[0][r] = bc; st[1][r] = bc; } }
            else { int D0 = 64 * (8 - j) + 32 * qt + r32 - 4 * hi; asm volatile("" : "+v"(D0));
#pragma unroll
                for (int kt = 0; kt < 2; ++kt)
#pragma unroll
                    for (int r = 0; r < 16; ++r) { int idx = D0 - (32 * kt + (r & 3) + 8 * (r >> 2)); idx = idx < -128 ? -128 : (idx > 128 ? 128 : idx); st[kt][r] = tbl[idx + 128]; } }
#pragma unroll
            for (int kt = 0; kt < 2; ++kt)
#pragma unroll
                for (int d0 = 0; d0 < 4; ++d0) st[kt] = __builtin_amdgcn_mfma_f32_32x32x16_bf16(kf[kt][d0], qf[qt][d0], st[kt], 0, 0, 0);
            float mxv = fmaxf(st[0][0], st[1][0]);
#pragma unroll
            for (int r = 1; r < 16; ++r) mxv = fmaxf(mxv, fmaxf(st[0][r], st[1][r]));
            mxv = fmaxf(mxv, __shfl_xor(mxv, 32));
            const float mn = fmaxf(m[qt], mxv), al = __builtin_amdgcn_exp2f(m[qt] - mn); m[qt] = mn;
            float rs = 0.f;
#pragma unroll
            for (int kt = 0; kt < 2; ++kt)
#pragma unroll
                for (int r = 0; r < 16; ++r) { const float p = __builtin_amdgcn_exp2f(st[kt][r] - mn); st[kt][r] = p; rs += p; }
            l[qt] = l[qt] * al + rs;
#pragma unroll
            for (int r = 0; r < 16; ++r) { o[qt][0][r] *= al; o[qt][1][r] *= al; }
            bf16x8 pf[4];
#pragma unroll
            for (int s = 0; s < 4; ++s) { v4u w; const int kt = s >> 1, r0 = 8 * (s & 1);
                w.x = cvtpk(st[kt][r0 + 0], st[kt][r0 + 1]); w.y = cvtpk(st[kt][r0 + 2], st[kt][r0 + 3]); w.z = cvtpk(st[kt][r0 + 4], st[kt][r0 + 5]); w.w = cvtpk(st[kt][r0 + 6], st[kt][r0 + 7]);
                pf[s] = __builtin_bit_cast(bf16x8, w); }
            if (qt == 0) { if (kc < c) asm volatile("s_waitcnt vmcnt(8)" ::: "memory"); else asm volatile("s_waitcnt vmcnt(0)" ::: "memory"); }
#pragma unroll
            for (int dt = 0; dt < 2; ++dt) { s16x4 va[4], vc[4]; const unsigned vaddr = (unsigned)(uintptr_t)(wl + vb[dt]);
#pragma unroll
                for (int s = 0; s < 4; ++s) { asm volatile("ds_read_b64_tr_b16 %0, %1 offset:%c2" : "=&v"(va[s]) : "v"(vaddr), "i"(16 * s * 128) : "memory");
                                              asm volatile("ds_read_b64_tr_b16 %0, %1 offset:%c2" : "=&v"(vc[s]) : "v"(vaddr), "i"((16 * s + 8) * 128) : "memory"); }
                asm volatile("s_waitcnt lgkmcnt(0)" : "+v"(va[0]), "+v"(va[1]), "+v"(va[2]), "+v"(va[3]), "+v"(vc[0]), "+v"(vc[1]), "+v"(vc[2]), "+v"(vc[3]) :: "memory");
#pragma unroll
                for (int s = 0; s < 4; ++s) o[qt][dt] = __builtin_amdgcn_mfma_f32_32x32x16_bf16(cat8(va[s], vc[s]), pf[s], o[qt][dt], 0, 0, 0); }
        }
        MX_FENCE();
    }
#undef MX_DMAK
#undef MX_DMAV
#pragma unroll
    for (int qt = 0; qt < 2; ++qt) { float lt = l[qt]; lt += __shfl_xor(lt, 32); const float inv = 1.0f / lt;
#pragma unroll
        for (int r = 0; r < 16; ++r) { o[qt][0][r] *= inv; o[qt][1][r] *= inv; } }
}

__device__ __forceinline__ void sgu_task(const bf16* P, const LAS float* rstab, const bf16* wsp_l, const float* sgu_g, const float* bsp_l, int b, int c, int g, LAS unsigned char* wl, int lane_in, f32x16 (&o)[2][2]) {
    int lane = lane_in; asm volatile("" : "+v"(lane));
    const int r32 = lane & 31, hi = lane >> 5;
    const int nb = c >> 1, cb = c & 1, ns = cb ? 128 : 64;
    const size_t srow0 = (size_t)b * SEQ + nb * 128, tok0 = (size_t)b * SEQ + c * 64;
    const int prow = lane >> 3, pch = lane & 7;
    const f32x4 g0 = *(const f32x4*)(sgu_g + g * 64 + pch * 8), g1 = *(const f32x4*)(sgu_g + g * 64 + pch * 8 + 4);
    MX_FENCE();
#pragma unroll
    for (int hb = 0; hb < 2; ++hb) {
        if (hb * 64 < ns) {
            v4u raw[8];
#pragma unroll
            for (int i = 0; i < 8; ++i) raw[i] = *(const v4u*)(P + (srow0 + hb * 64 + prow + 8 * i) * NIN + 2048 + g * 64 + pch * 8);
#pragma unroll
            for (int i = 0; i < 8; ++i) { const int row = hb * 64 + prow + 8 * i; const float rs = rstab[row];
                v4u w;
                w.x = cvtpk(__builtin_bit_cast(float, raw[i].x << 16) * rs * g0[0], __builtin_bit_cast(float, raw[i].x & 0xffff0000u) * rs * g0[1]);
                w.y = cvtpk(__builtin_bit_cast(float, raw[i].y << 16) * rs * g0[2], __builtin_bit_cast(float, raw[i].y & 0xffff0000u) * rs * g0[3]);
                w.z = cvtpk(__builtin_bit_cast(float, raw[i].z << 16) * rs * g1[0], __builtin_bit_cast(float, raw[i].z & 0xffff0000u) * rs * g1[1]);
                w.w = cvtpk(__builtin_bit_cast(float, raw[i].w << 16) * rs * g1[2], __builtin_bit_cast(float, raw[i].w & 0xffff0000u) * rs * g1[3]);
                *(LAS v4u*)(wl + vimg(row, pch)) = w; }
        }
    }
    MX_FENCE();
#pragma unroll
    for (int r = 0; r < 16; ++r) { o[0][0][r] = 0.f; o[0][1][r] = 0.f; o[1][0][r] = 0.f; o[1][1][r] = 0.f; }
    const int dhalf = (lane >> 4) & 1, qq = (lane & 15) >> 2, p4 = lane & 3;
    int vbs[2];
#pragma unroll
    for (int ct = 0; ct < 2; ++ct) vbs[ct] = (8 * hi + qq) * 128 + ((64 * ct + 32 * dhalf + 8 * p4) ^ ((qq >> 1) << 6));
    const bf16* wrow = wsp_l + ((size_t)g * 128 + cb * 64 + r32) * 128 + hi * 8;
#pragma unroll 2
    for (int step = 0; step < ns / 16; ++step) {
        const bf16x8 wf0 = *(const bf16x8*)(wrow + 16 * step), wf1 = *(const bf16x8*)(wrow + 32 * 128 + 16 * step);
#pragma unroll
        for (int ct = 0; ct < 2; ++ct) { const s16x4 a0 = tr64(wl + vbs[ct] + (16 * step) * 128), a1 = tr64(wl + vbs[ct] + (16 * step + 4) * 128);
            const bf16x8 af = cat8(a0, a1);
            o[0][ct] = __builtin_amdgcn_mfma_f32_32x32x16_bf16(af, wf0, o[0][ct], 0, 0, 0);
            o[1][ct] = __builtin_amdgcn_mfma_f32_32x32x16_bf16(af, wf1, o[1][ct], 0, 0, 0); }
    }
    MX_FENCE();
#pragma unroll
    for (int tt = 0; tt < 2; ++tt) {
        const float bt = bsp_l[g * 128 + cb * 64 + 32 * tt + r32];
        const bf16* up = P + (tok0 + 32 * tt + r32) * NIN + 1536 + g * 64 + 4 * hi;
#pragma unroll
        for (int ct = 0; ct < 2; ++ct)
#pragma unroll
            for (int rg = 0; rg < 4; ++rg) { const u32x2 uu = *(const u32x2*)(up + 32 * ct + 8 * rg);
                o[tt][ct][4 * rg + 0] = __builtin_bit_cast(float, uu.x << 16) * (o[tt][ct][4 * rg + 0] + bt); o[tt][ct][4 * rg + 1] = __builtin_bit_cast(float, uu.x & 0xffff0000u) * (o[tt][ct][4 * rg + 1] + bt);
                o[tt][ct][4 * rg + 2] = __builtin_bit_cast(float, uu.y << 16) * (o[tt][ct][4 * rg + 2] + bt); o[tt][ct][4 * rg + 3] = __builtin_bit_cast(float, uu.y & 0xffff0000u) * (o[tt][ct][4 * rg + 3] + bt); }
    }
}

__device__ __forceinline__ void norm_store(const f32x16 (&o)[2][2], LAS float* red, int wave, int lane_in, const float* gain, bf16* dst) {
    int lane = lane_in; asm volatile("" : "+v"(lane));
    const int r32 = lane & 31, hi = lane >> 5;
#pragma unroll
    for (int tt = 0; tt < 2; ++tt) { float ss = 0.f;
#pragma unroll
        for (int r = 0; r < 16; ++r) ss += o[tt][0][r] * o[tt][0][r] + o[tt][1][r] * o[tt][1][r];
        ss += __shfl_xor(ss, 32);
        if (hi == 0) red[wave * 64 + tt * 32 + r32] = ss; }
    __syncthreads();
#pragma unroll
    for (int tt = 0; tt < 2; ++tt) { float tot = 0.f;
#pragma unroll
        for (int w = 0; w < 8; ++w) tot += red[w * 64 + tt * 32 + r32];
        const float rn = __builtin_amdgcn_rsqf(tot * (1.0f / 512.0f) + pg8::RMS_EPS);
#pragma unroll
        for (int ct = 0; ct < 2; ++ct)
#pragma unroll
            for (int rg = 0; rg < 4; ++rg) { const int ch = 32 * ct + 8 * rg + 4 * hi; const f32x4 gv = *(const f32x4*)(gain + ch);
                u32x2 w; w.x = cvtpk(o[tt][ct][4 * rg + 0] * rn * gv[0], o[tt][ct][4 * rg + 1] * rn * gv[1]); w.y = cvtpk(o[tt][ct][4 * rg + 2] * rn * gv[2], o[tt][ct][4 * rg + 3] * rn * gv[3]);
                *(u32x2*)(dst + (size_t)(32 * tt + r32) * DM + ch) = w; } }
}

__device__ __forceinline__ void mixer_fast(CArgs* a, int l, LAS unsigned char* lds, int wave, int lane) {
    const bf16* P = (const bf16*)(a->ws + WS_PROJ); bf16* MIX = (bf16*)(a->ws + WS_MIX);
    const float* vgss = (const float*)(a->ws + WS_VGSS); const bf16* wsp_l = (const bf16*)(a->ws + WS_WSP) + (size_t)l * 8 * 128 * 128;
    const float* rel = a->in[5] + (size_t)l * 8 * 257; const float* sgu_g = a->in[6] + l * 512; const float* bsp_l = a->in[8] + l * 8 * 128;
    const float* ag = a->in[9] + l * 512; const float* gg = a->in[10] + l * 512;
    LAS float* tbl = (LAS float*)(lds + TBL_OFF); LAS float* red = (LAS float*)(lds + RED_OFF); LAS float* rstab = (LAS float*)(lds + RS_OFF);
    for (int i = threadIdx.x; i < 8 * 257; i += NWAVES * 64) { const int h = i / 257, k = i % 257; tbl[h * 260 + k] = rel[i] * pg8::LOG2E; }
    __syncthreads();
    LAS unsigned char* wl = lds + wave * 16384;
    for (int u = blockIdx.x; u < NB * (SEQ / 64); u += gridDim.x) {
        const int b = u & 7, c = u >> 3;
        const size_t tok0 = (size_t)b * SEQ + c * 64;
        if (threadIdx.x < 128) {
            const size_t srow = (size_t)b * SEQ + (c >> 1) * 128 + threadIdx.x;
            const f32x4 p0 = *(const f32x4*)(vgss + srow * 8), p1 = *(const f32x4*)(vgss + srow * 8 + 4);
            rstab[threadIdx.x] = __builtin_amdgcn_rsqf((((p0[0] + p0[1]) + (p0[2] + p0[3])) + ((p1[0] + p1[1]) + (p1[2] + p1[3]))) * (1.0f / 512.0f) + pg8::RMS_EPS); }
        f32x16 o[2][2];
        REPEAT(7) attn_task(P, b, c, wave, wl, tbl + wave * 260, lane, o);
        norm_store(o, red, wave, lane, ag + wave * 64, MIX + tok0 * DM + wave * 64);
        REPEAT(8) sgu_task(P, rstab, wsp_l, sgu_g, bsp_l, b, c, wave, wl, lane, o);
        norm_store(o, red + 512, wave, lane, gg + wave * 64, MIX + tok0 * DM + 512 + wave * 64);
    }
    __syncthreads();
}
}

__global__ void __launch_bounds__(NWAVES * 64, 2) fwd_megakernel(Args a_unused) {
    extern __shared__ __attribute__((aligned(16))) unsigned char lds_raw[];
    LAS unsigned char* lds = (LAS unsigned char*)lds_raw;
    if (threadIdx.x < 16) ((LAS unsigned*)(lds + MISC_OFF))[threadIdx.x] = 0u;
    __syncthreads();
    (void)xcd_barrier_post((unsigned*)(kargs_ws() + WS_BAR), (volatile LAS unsigned*)(lds + MISC_OFF));
    { const int tid = threadIdx.x, lane = tid & 63, wave = __builtin_amdgcn_readfirstlane(tid >> 6);
      REPEAT(0) prologue(kargs(), lds, wave, lane); }
    GRID_BAR();
#if (REPM >> 6) & 1
    for (int i_ = 0; i_ < 10; ++i_) GRID_BAR();
#endif
#pragma nounroll
    for (int l = 0; l < DEPTH; ++l) {
#if PHM & 1
        REPEAT(1) {
            CArgs* a = kargs(); unsigned char* ws = a->ws; unsigned char* wb = ws + WS_W0 + (size_t)l * WS_WSTRIDE;
            pg8::Gemm g{(const bf16*)(ws + WS_XB), (const bf16*)(wb + WOFF_IN), M, NIN, DM}; pg8::StaticOrder S; S.init(M, NIN, (int)gridDim.x, (int)blockIdx.x);
            pg8::EpiInProj E{(bf16*)(ws + WS_PROJ), (const float*)(ws + WS_ROWSS), (float*)(ws + WS_VGSS), a->in[3] + l * 64, a->in[4] + l * 64};
            pg8::gemm_phase<pg8::EpiInProj, pg8::StaticOrder, true, true>(lds, g, S, E);
        }
#endif
        GRID_BAR();
#if PHM & 2
        REPEAT(2) { int tid = threadIdx.x; asm volatile("" : "+v"(tid)); const int lane = tid & 63, wave = __builtin_amdgcn_readfirstlane(tid >> 6);
#if FAST_MIXER
          mx::mixer_fast(kargs(), l, lds, wave, lane);
#else
          mixer_naive(kargs(), l, lds, wave, lane);
#endif
        }
#endif
        GRID_BAR();
#if PHM & 4
        REPEAT(3) {
            CArgs* a = kargs(); unsigned char* ws = a->ws; unsigned char* wb = ws + WS_W0 + (size_t)l * WS_WSTRIDE; float* xo = a->out;
            float* xw = (((REPM >> 3) & 1) && rep_ == 0) ? (float*)(ws + 84 * MiB) : xo;
            pg8::Gemm g{(const bf16*)(ws + WS_MIX), (const bf16*)(wb + WOFF_OUT), M, DM, DM}; pg8::StaticOrder S; S.init(M, DM, (int)gridDim.x, (int)blockIdx.x);
            pg8::EpiResid E{l == 0 ? a->in[0] : (const float*)xo, xw, (bf16*)(ws + WS_XB), (float*)(ws + WS_ROWSS)};
            pg8::gemm_phase<pg8::EpiResid, pg8::StaticOrder, true, true>(lds, g, S, E);
        }
#endif
        GRID_BAR();
#if PHM & 8
        REPEAT(4) {
            CArgs* a = kargs(); unsigned char* ws = a->ws; unsigned char* wb = ws + WS_W0 + (size_t)l * WS_WSTRIDE;
            pg8::Gemm g{(const bf16*)(ws + WS_XB), (const bf16*)(wb + WOFF_FIN), M, NFF2, DM}; pg8::StaticOrder S; S.init(M, NFF2, (int)gridDim.x, (int)blockIdx.x);
            pg8::EpiSwiGLU E{(bf16*)(ws + WS_HID), (const float*)(ws + WS_ROWSS)};
            pg8::gemm_phase<pg8::EpiSwiGLU, pg8::StaticOrder, true, true>(lds, g, S, E);
        }
#endif
        GRID_BAR();
#if PHM & 16
        REPEAT(5) {
            CArgs* a = kargs(); unsigned char* ws = a->ws; unsigned char* wb = ws + WS_W0 + (size_t)l * WS_WSTRIDE; float* xo = a->out;
            float* xw = (((REPM >> 5) & 1) && rep_ == 0) ? (float*)(ws + 192 * MiB) : xo;
            pg8::Gemm g{(const bf16*)(ws + WS_HID), (const bf16*)(wb + WOFF_FOUT), M, DM, DFF}; pg8::StaticOrder S; S.init(M, DM, (int)gridDim.x, (int)blockIdx.x);
            pg8::EpiResid E{xo, xw, (bf16*)(ws + WS_XB), (float*)(ws + WS_ROWSS)};
            pg8::gemm_phase<pg8::EpiResid, pg8::StaticOrder, true, true>(lds, g, S, E);
        }
#endif
        if (l + 1 < DEPTH) GRID_BAR();
    }
}

extern "C" void kernel_launch(void* const* d_in, const int* in_sizes, int n_in, void* d_out, int out_size, void* d_ws, size_t ws_size, hipStream_t stream) {
    static int grid = 0;
    if (grid == 0) {
        if (n_in != 15 || in_sizes[0] != M * DM || out_size != M * DM || ws_size < WS_END) { fprintf(stderr, "kernel_launch: unexpected shapes (n_in %d, ws %zu)\n", n_in, ws_size); grid = -1; return; }
        int dev = 0, cus = 0, per_cu = 0;
        hipGetDevice(&dev); hipDeviceGetAttribute(&cus, hipDeviceAttributeMultiprocessorCount, dev);
        if (hipFuncSetAttribute((const void*)fwd_megakernel, hipFuncAttributeMaxDynamicSharedMemorySize, LDS_BYTES) != hipSuccess) { fprintf(stderr, "kernel_launch: hipFuncSetAttribute failed\n"); grid = -1; return; }
        if (hipOccupancyMaxActiveBlocksPerMultiprocessor(&per_cu, (const void*)fwd_megakernel, NWAVES * 64, LDS_BYTES) != hipSuccess || per_cu < 1) { fprintf(stderr, "kernel_launch: occupancy query failed (%d)\n", per_cu); (void)hipGetLastError(); per_cu = 1; }
        grid = cus * (per_cu > 1 ? 1 : per_cu);
    }
    if (grid < 0) return;
    if (hipMemsetAsync((char*)d_ws + WS_BAR, 0, BAR_ZERO_BYTES, stream) != hipSuccess) { fprintf(stderr, "kernel_launch: hipMemsetAsync failed\n"); return; }
    Args a{};
    for (int i = 0; i < 15; ++i) a.in[i] = (const float*)d_in[i];
    a.out = (float*)d_out; a.ws = (unsigned char*)d_ws;
    void* args[] = {&a};
    hipError_t e = hipLaunchCooperativeKernel((const void*)fwd_megakernel, dim3(grid), dim3(NWAVES * 64), args, LDS_BYTES, stream);
    if (e != hipSuccess) fprintf(stderr, "cooperative launch failed: %s (grid %d)\n", hipGetErrorString(e), grid);
}
```

```cpp
#include <hip/hip_runtime.h>
#include <hip/hip_cooperative_groups.h>
#include <cstdio>
#include <cstdint>
namespace cg = cooperative_groups;
namespace pg8 {
#define PG8_LAS __attribute__((address_space(3)))
typedef unsigned short bf16_t;
typedef short bf16x8 __attribute__((ext_vector_type(8)));
typedef float f32x4 __attribute__((ext_vector_type(4)));
typedef unsigned u32x4 __attribute__((ext_vector_type(4)));
constexpr int BM = 256, BK = 64, HALF = 128, HTB = HALF * BK * 2  , STAGE_BYTES = 8 * HTB, NXCD = 8, WGM = 8;

__host__ __device__ __forceinline__ int lds_byte(int r, int c) { const int st = (r >> 4) * 2 + (c >> 5), rr = r & 15, cc = c & 31, ob = rr * 64 + cc * 2; return st * 1024 + (ob ^ (((ob >> 9) & 1) << 5)); }
__host__ __device__ __forceinline__ void stage_rc(int b, int& R, int& C) { const int st = b / 1024, sb = b % 1024, swz = sb ^ (((sb >> 9) & 1) << 5); R = (st >> 1) * 16 + swz / 64; C = (st & 1) * 32 + (swz % 64) / 2; }
__host__ __device__ __forceinline__ int perm32(int rho) { const int n = rho >> 4, i = rho & 15; return 8 * (i >> 2) + 4 * n + (i & 3); }

struct Unit { int pm, pn; };
struct Gemm { const bf16_t* A; const bf16_t* Bt; int M, N, K; };

struct StaticOrder {
    int nM, nN, nwg, G, c;
    __host__ __device__ void init(int M, int N, int G_, int c_) { nM = M / BM; nN = N / BM; nwg = nM * nN; G = G_; c = c_; }
    __host__ __device__ bool next(int i, Unit& u) const {
        const long L = (long)i * G + c; if (L >= nwg) return false;
        int wgid = (int)L; { const int q = nwg / NXCD, r = nwg % NXCD, xcd = wgid % NXCD, off = wgid / NXCD; wgid = (xcd < r ? xcd * (q + 1) : r * (q + 1) + (xcd - r) * q) + off; }
        const int nig = WGM * nN, gid = wgid / nig, fm = gid * WGM, gsz = (nM - fm) < WGM ? (nM - fm) : WGM;
        u.pm = fm + ((wgid % nig) % gsz); u.pn = (wgid % nig) / gsz; return true;
    }
    __device__ __forceinline__ void a_ready(const Unit&) const {}
    __device__ __forceinline__ void done(const Unit&) const {}
};

__device__ __forceinline__ unsigned cvt_pk_bf16(float lo, float hi) { unsigned r; asm volatile("v_cvt_pk_bf16_f32 %0, %1, %2" : "=v"(r) : "v"(lo), "v"(hi)); return r; }
typedef float f32x2 __attribute__((ext_vector_type(2)));
constexpr float RMS_EPS = 1e-6f;
constexpr float LOG2E = 1.4426950408889634f;
constexpr float QSCALE = 0.125f * 1.4426950408889634f;
__device__ __forceinline__ float gelu_tanh(float x) {
    const float z2 = x * (1.5957691216057308f + 0.07135481627260025f * x * x);
    const float e = __builtin_amdgcn_exp2f(-LOG2E * z2);
    return x * __builtin_amdgcn_rcpf(1.0f + e);
}
__device__ __forceinline__ float row_rs(const float* rowss, int row) {
    const f32x4 a = *(const f32x4*)(rowss + (size_t)row * 4);
    return __builtin_amdgcn_rsqf(((a[0] + a[1]) + (a[2] + a[3])) * (1.0f / 1024.0f) + RMS_EPS);
}
struct EpiInProj {
    static constexpr bool PERM = true, AFTER_DRAIN = false, INIT = false;
    bf16_t* P; const float* rowss; float* vgss; const float* qg; const float* kg;
    __device__ __forceinline__ void operator()(const f32x4 (&acc)[2][2][4][2], const Unit& u, int wr, int wc, int fr, int fq) const {
        const int region = u.pn >> 1, half = u.pn & 1;
        const int lcol = region * 512 + half * 256 + wc * 64 + fq * 8;
        float gq[2][8];
#pragma unroll
        for (int bj = 0; bj < 2; ++bj)
#pragma unroll
            for (int e = 0; e < 8; ++e) gq[bj][e] = 1.f;
        if (region < 2) { const float* g = region == 0 ? qg : kg; const float sc = region == 0 ? QSCALE : 1.f;
#pragma unroll
            for (int bj = 0; bj < 2; ++bj)
#pragma unroll
                for (int e = 0; e < 8; ++e) gq[bj][e] = g[bj * 32 + fq * 8 + e] * sc; }
#pragma unroll
        for (int ai = 0; ai < 2; ++ai)
#pragma unroll
            for (int m = 0; m < 4; ++m) {
                const int row = u.pm * BM + ai * HALF + wr * 64 + m * 16 + fr;
                const float s = row_rs(rowss, row);
                float v[2][8];
#pragma unroll
                for (int bj = 0; bj < 2; ++bj)
#pragma unroll
                    for (int n = 0; n < 2; ++n)
#pragma unroll
                        for (int i = 0; i < 4; ++i) v[bj][4 * n + i] = acc[ai][bj][m][n][i] * s;
                if (region < 2) {
                    float q = 0.f;
#pragma unroll
                    for (int bj = 0; bj < 2; ++bj)
#pragma unroll
                        for (int e = 0; e < 8; ++e) q += v[bj][e] * v[bj][e];
                    q += __shfl_xor(q, 16); q += __shfl_xor(q, 32);
                    const float r = __builtin_amdgcn_rsqf(q * (1.0f / 64.0f) + RMS_EPS);
#pragma unroll
                    for (int bj = 0; bj < 2; ++bj)
#pragma unroll
                        for (int e = 0; e < 8; ++e) v[bj][e] = v[bj][e] * r * gq[bj][e];
                } else if (region >= 3) {
#pragma unroll
                    for (int bj = 0; bj < 2; ++bj)
#pragma unroll
                        for (int e = 0; e < 8; ++e) v[bj][e] = gelu_tanh(v[bj][e]);
                    if (region == 4) {
                        float q = 0.f;
#pragma unroll
                        for (int bj = 0; bj < 2; ++bj)
#pragma unroll
                            for (int e = 0; e < 8; ++e) q += v[bj][e] * v[bj][e];
                        q += __shfl_xor(q, 16); q += __shfl_xor(q, 32);
                        if (fq == 0) vgss[(size_t)row * 8 + half * 4 + wc] = q;
                    }
                }
                bf16_t* rowp = P + (size_t)row * 2560 + lcol;
#pragma unroll
                for (int bj = 0; bj < 2; ++bj) { u32x4 w; w.x = cvt_pk_bf16(v[bj][0], v[bj][1]); w.y = cvt_pk_bf16(v[bj][2], v[bj][3]); w.z = cvt_pk_bf16(v[bj][4], v[bj][5]); w.w = cvt_pk_bf16(v[bj][6], v[bj][7]);
                    *(u32x4*)(rowp + bj * 32) = w; }
            }
    }
};
struct EpiResid {
    static constexpr bool PERM = true, AFTER_DRAIN = true, INIT = true;
    const float* base; float* out; bf16_t* xb; float* rowss; int write_xb;
    __device__ __forceinline__ void init(f32x4 (&acc)[2][2][4][2], const Unit& u, int wr, int wc, int fr, int fq) const {
        const int col0 = u.pn * BM + wc * 32 + 8 * fq;
#pragma unroll
        for (int ai = 0; ai < 2; ++ai)
#pragma unroll
            for (int m = 0; m < 4; ++m) { const size_t off = (size_t)(u.pm * BM + ai * HALF + wr * 64 + m * 16 + fr) * 1024 + col0;
#pragma unroll
                for (int bj = 0; bj < 2; ++bj) { acc[ai][bj][m][0] = *(const f32x4*)(base + off + bj * HALF); acc[ai][bj][m][1] = *(const f32x4*)(base + off + bj * HALF + 4); } }
    }
    __device__ __forceinline__ void fused(f32x4 (&acc)[2][2][4][2], const Unit& u, int wr, int wc, int fr, int fq, PG8_LAS unsigned char* lds, int wid, int lane) const {
        PG8_LAS float* part = (PG8_LAS float*)lds;
        const int col0 = u.pn * BM + wc * 32 + 8 * fq;
#pragma unroll
        for (int ai = 0; ai < 2; ++ai)
#pragma unroll
            for (int m = 0; m < 4; ++m) {
                const int rl = ai * HALF + wr * 64 + m * 16 + fr;
                const size_t off = (size_t)(u.pm * BM + rl) * 1024 + col0;
                float q = 0.f;
#pragma unroll
                for (int bj = 0; bj < 2; ++bj) {
                    const f32x4 v0 = acc[ai][bj][m][0], v1 = acc[ai][bj][m][1];
                    *(f32x4*)(out + off + bj * HALF) = v0; *(f32x4*)(out + off + bj * HALF + 4) = v1;
                    if (write_xb) { u32x4 w; w.x = cvt_pk_bf16(v0[0], v0[1]); w.y = cvt_pk_bf16(v0[2], v0[3]); w.z = cvt_pk_bf16(v1[0], v1[1]); w.w = cvt_pk_bf16(v1[2], v1[3]);
                        *(u32x4*)(xb + off + bj * HALF) = w; }
                    q += (v0[0] * v0[0] + v0[1] * v0[1]) + (v0[2] * v0[2] + v0[3] * v0[3]) + (v1[0] * v1[0] + v1[1] * v1[1]) + (v1[2] * v1[2] + v1[3] * v1[3]);
                }
                q += __shfl_xor(q, 16); q += __shfl_xor(q, 32);
                if (fq == 0) part[rl * 4 + wc] = q;
            }
        asm volatile("s_waitcnt lgkmcnt(0)" ::: "memory"); __builtin_amdgcn_s_barrier(); asm volatile("" ::: "memory");
        const int t = wid * 64 + lane;
        if (t < 256) { const f32x4 p = *(const PG8_LAS f32x4*)(part + t * 4); rowss[(size_t)(u.pm * BM + t) * 4 + u.pn] = (p[0] + p[1]) + (p[2] + p[3]); }
    }
};
struct EpiSwiGLU {
    static constexpr bool PERM = true, AFTER_DRAIN = false, INIT = false;
    bf16_t* H; const float* rowss;
    __device__ __forceinline__ void operator()(const f32x4 (&acc)[2][2][4][2], const Unit& u, int wr, int wc, int fr, int fq) const {
        const int col0 = u.pn * 128 + wc * 32 + 8 * fq;
#pragma unroll
        for (int ai = 0; ai < 2; ++ai)
#pragma unroll
            for (int m = 0; m < 4; ++m) {
                const int row = u.pm * BM + ai * HALF + wr * 64 + m * 16 + fr;
                const float s = row_rs(rowss, row);
                float h[8];
#pragma unroll
                for (int n = 0; n < 2; ++n)
#pragma unroll
                    for (int i = 0; i < 4; ++i) { const float g = acc[ai][0][m][n][i] * s, up = acc[ai][1][m][n][i] * s;
                        h[4 * n + i] = g * __builtin_amdgcn_rcpf(1.0f + __builtin_amdgcn_exp2f(-LOG2E * g)) * up; }
                u32x4 w; w.x = cvt_pk_bf16(h[0], h[1]); w.y = cvt_pk_bf16(h[2], h[3]); w.z = cvt_pk_bf16(h[4], h[5]); w.w = cvt_pk_bf16(h[6], h[7]);
                *(u32x4*)(H + (size_t)row * 2816 + col0) = w;
            }
    }
};
template <class Epi, class Sched, bool ALIGN_EPI = false, bool SP2 = false>
__device__ __forceinline__ void gemm_phase(PG8_LAS unsigned char* lds, const Gemm g, const Sched& S, const Epi& E) {
    int tid_l = threadIdx.x; asm volatile("" : "+v"(tid_l));
    const int tid = tid_l, wid = __builtin_amdgcn_readfirstlane(tid >> 6), lane = tid & 63, wr = wid >> 2, wc = wid & 3, fr = lane & 15, fq = lane >> 4;
    const int K = g.K, nt = K / BK;
    unsigned voffA[2], voffB[2];
#pragma unroll
    for (int i = 0; i < 2; ++i) { int R, C; stage_rc(tid * 16 + i * 8192, R, C); const int Rb = Epi::PERM ? ((R & ~31) + perm32(R & 31)) : R;
        voffA[i] = (unsigned)(R * K + C) * 2u; voffB[i] = (unsigned)(Rb * K + C) * 2u; }
    const size_t kstep = (size_t)(BK * 2);
    const size_t hstep = (size_t)HALF * K * 2;
    const size_t tstep = 2 * hstep;
    const unsigned ldsw = (unsigned)wid * 1024u;
    const int aoff = lds_byte(wr * 64 + fr, fq * 8), boff = lds_byte(wc * 32 + fr, fq * 8);
#define PG8_SA(b, h) (((b) * 2 + (h)) * HTB)
#define PG8_SB(b, h) ((4 + (b) * 2 + (h)) * HTB)
#define PG8_STAGE(bufoff, gbase, voff) do { _Pragma("unroll") for (int _i = 0; _i < 2; ++_i) \
        __builtin_amdgcn_global_load_lds((const unsigned*)((const char*)(gbase) + (voff)[_i]), (PG8_LAS unsigned*)(lds + (bufoff) + ldsw + _i * 8192), 16, 0, 0); } while (0)
#define PG8_LDA(dst, b, h) do { _Pragma("unroll") for (int m = 0; m < 4; ++m) _Pragma("unroll") for (int k = 0; k < 2; ++k) dst[m][k] = *(const PG8_LAS bf16x8*)(lds + PG8_SA(b, h) + aoff + m * 2048 + k * 1024); } while (0)
#define PG8_LDB(dst, b, h) do { _Pragma("unroll") for (int n = 0; n < 2; ++n) _Pragma("unroll") for (int k = 0; k < 2; ++k) dst[n][k] = *(const PG8_LAS bf16x8*)(lds + PG8_SB(b, h) + boff + n * 2048 + k * 1024); } while (0)
#define PG8_MMA(ai, bj, At, Bt) do { __builtin_amdgcn_s_setprio(1); _Pragma("unroll") for (int m = 0; m < 4; ++m) _Pragma("unroll") for (int n = 0; n < 2; ++n) _Pragma("unroll") for (int k = 0; k < 2; ++k) \
        acc[ai][bj][m][n] = __builtin_amdgcn_mfma_f32_16x16x32_bf16(Bt[n][k], At[m][k], acc[ai][bj][m][n], 0, 0, 0); __builtin_amdgcn_s_setprio(0); } while (0)
#define PG8_WAIT_V(n) asm volatile("s_waitcnt vmcnt(" #n ")" ::: "memory")
#define PG8_WAIT_L(n) asm volatile("s_waitcnt lgkmcnt(" #n ")" ::: "memory")
#define PG8_BAR __builtin_amdgcn_s_barrier()
#define PG8_SCHED __builtin_amdgcn_sched_barrier(0)
    Unit cur, nxt; int ui = 0;
    if (!S.next(0, cur)) return;
    f32x4 acc[2][2][4][2];
    if constexpr (Epi::INIT) E.init(acc, cur, wr, wc, fr, fq);
    else {
#pragma unroll
    for (int a = 0; a < 2; ++a)
#pragma unroll
        for (int b = 0; b < 2; ++b)
#pragma unroll
            for (int m = 0; m < 4; ++m)
#pragma unroll
                for (int n = 0; n < 2; ++n) acc[a][b][m][n] = (f32x4){0.f, 0.f, 0.f, 0.f};
    }
    bf16x8 At[4][2], B0[2][2], B1[2][2];
    const char* cA = (const char*)g.A + (size_t)cur.pm * tstep; const char* cB = (const char*)g.Bt + (size_t)cur.pn * tstep;
    S.a_ready(cur);
    if constexpr (SP2) {
        PG8_STAGE(PG8_SB(0, 0), cB, voffB); PG8_STAGE(PG8_SB(0, 1), cB + hstep, voffB); PG8_STAGE(PG8_SA(0, 0), cA, voffA); PG8_STAGE(PG8_SA(0, 1), cA + hstep, voffA);
        if (wr == 1) PG8_BAR;
        PG8_WAIT_V(2); PG8_BAR;
        PG8_STAGE(PG8_SB(1, 0), cB + kstep, voffB); PG8_STAGE(PG8_SA(1, 0), cA + kstep, voffA); PG8_STAGE(PG8_SB(1, 1), cB + hstep + kstep, voffB);
        PG8_WAIT_V(6); PG8_BAR;
    } else {
        PG8_STAGE(PG8_SB(0, 0), cB, voffB); PG8_STAGE(PG8_SA(0, 0), cA, voffA); PG8_STAGE(PG8_SB(0, 1), cB + hstep, voffB); PG8_STAGE(PG8_SA(0, 1), cA + hstep, voffA);
        if (wr == 1) PG8_BAR;
        PG8_WAIT_V(4); PG8_BAR;
        PG8_STAGE(PG8_SB(1, 0), cB + kstep, voffB); PG8_STAGE(PG8_SA(1, 0), cA + kstep, voffA); PG8_STAGE(PG8_SB(1, 1), cB + hstep + kstep, voffB);
        PG8_WAIT_V(6); PG8_BAR;
    }
    for (;;) {
        const bool has_next = S.next(ui + 1, nxt);
        const char* nA = has_next ? (const char*)g.A + (size_t)nxt.pm * tstep : cA; const char* nB = has_next ? (const char*)g.Bt + (size_t)nxt.pn * tstep : cB;
        for (int t = 0; t < nt; t += 2) {
            const bool last = (t == nt - 2);
            const char* a1 = cA + (size_t)(t + 1) * kstep;
            const char* a2 = last ? nA : cA + (size_t)(t + 2) * kstep; const char* b2 = last ? nB : cB + (size_t)(t + 2) * kstep;
            const char* a3 = a2 + kstep; const char* b3 = b2 + kstep;
            if (last && has_next) S.a_ready(nxt);
            if constexpr (SP2) {
            PG8_LDB(B0, 0, 0); PG8_LDB(B1, 0, 1); PG8_SCHED; PG8_LDA(At, 0, 0); PG8_STAGE(PG8_SA(1, 1), a1 + hstep, voffA);
            PG8_WAIT_V(8); PG8_WAIT_L(0); PG8_BAR; PG8_MMA(0, 0, At, B0); PG8_MMA(0, 1, At, B1); PG8_BAR; PG8_SCHED;
            PG8_LDA(At, 0, 1); PG8_STAGE(PG8_SB(0, 0), b2, voffB); PG8_STAGE(PG8_SB(0, 1), b2 + hstep, voffB); PG8_STAGE(PG8_SA(0, 0), a2, voffA);
            PG8_WAIT_V(8); PG8_WAIT_L(0); PG8_BAR; PG8_MMA(1, 0, At, B0); PG8_MMA(1, 1, At, B1); PG8_BAR; PG8_SCHED;
            PG8_LDB(B0, 1, 0); PG8_LDB(B1, 1, 1); PG8_SCHED; PG8_LDA(At, 1, 0); PG8_STAGE(PG8_SA(0, 1), a2 + hstep, voffA);
            PG8_WAIT_V(8); PG8_WAIT_L(0); PG8_BAR; PG8_MMA(0, 0, At, B0); PG8_MMA(0, 1, At, B1); PG8_BAR; PG8_SCHED;
            PG8_LDA(At, 1, 1); PG8_STAGE(PG8_SB(1, 0), b3, voffB); PG8_STAGE(PG8_SB(1, 1), b3 + hstep, voffB); PG8_STAGE(PG8_SA(1, 0), a3, voffA);
            PG8_WAIT_V(8); PG8_WAIT_L(0); PG8_BAR; PG8_MMA(1, 0, At, B0); PG8_MMA(1, 1, At, B1); PG8_BAR; PG8_SCHED;
            } else {
            PG8_LDB(B0, 0, 0); PG8_SCHED; PG8_LDA(At, 0, 0); PG8_STAGE(PG8_SA(1, 1), a1 + hstep, voffA);
            PG8_WAIT_L(8); PG8_BAR; PG8_WAIT_L(0); PG8_MMA(0, 0, At, B0); PG8_BAR; PG8_SCHED;
            PG8_LDB(B1, 0, 1); PG8_STAGE(PG8_SB(0, 0), b2, voffB);
            PG8_BAR; PG8_WAIT_L(0); PG8_MMA(0, 1, At, B1); PG8_BAR;
            PG8_LDA(At, 0, 1); PG8_STAGE(PG8_SA(0, 0), a2, voffA);
            PG8_BAR; PG8_WAIT_L(0); PG8_MMA(1, 0, At, B0); PG8_BAR; PG8_SCHED;
            PG8_STAGE(PG8_SB(0, 1), b2 + hstep, voffB);
            PG8_WAIT_V(6); PG8_BAR; PG8_MMA(1, 1, At, B1); PG8_BAR;
            PG8_LDB(B0, 1, 0); PG8_SCHED; PG8_LDA(At, 1, 0); PG8_STAGE(PG8_SA(0, 1), a2 + hstep, voffA);
            PG8_WAIT_L(8); PG8_BAR; PG8_WAIT_L(0); PG8_MMA(0, 0, At, B0); PG8_BAR; PG8_SCHED;
            PG8_LDB(B1, 1, 1); PG8_STAGE(PG8_SB(1, 0), b3, voffB);
            PG8_BAR; PG8_WAIT_L(0); PG8_MMA(0, 1, At, B1); PG8_BAR;
            PG8_LDA(At, 1, 1); PG8_STAGE(PG8_SA(1, 0), a3, voffA);
            PG8_BAR; PG8_WAIT_L(0); PG8_MMA(1, 0, At, B0); PG8_BAR; PG8_SCHED;
            PG8_STAGE(PG8_SB(1, 1), b3 + hstep, voffB);
            PG8_WAIT_V(6); PG8_BAR; PG8_MMA(1, 1, At, B1); PG8_BAR;
            }
        }
        if constexpr (ALIGN_EPI) { if (wr == 0) PG8_BAR; }
        if constexpr (!Epi::AFTER_DRAIN) { E(acc, cur, wr, wc, fr, fq); S.done(cur); }
        if (!has_next) break;
        if constexpr (Epi::INIT) E.init(acc, nxt, wr, wc, fr, fq);
        else {
#pragma unroll
        for (int a = 0; a < 2; ++a)
#pragma unroll
            for (int b = 0; b < 2; ++b)
#pragma unroll
                for (int m = 0; m < 4; ++m)
#pragma unroll
                    for (int n = 0; n < 2; ++n) acc[a][b][m][n] = (f32x4){0.f, 0.f, 0.f, 0.f};
        }
        cur = nxt; cA = nA; cB = nB; ++ui;
        if constexpr (ALIGN_EPI) { if (wr == 1) PG8_BAR; }
    }
    PG8_WAIT_V(0);
    if constexpr (!ALIGN_EPI) { if (wr == 0) PG8_BAR; }
    PG8_BAR;
    if constexpr (Epi::AFTER_DRAIN) { E.fused(acc, cur, wr, wc, fr, fq, lds, wid, lane); S.done(cur); }
#undef PG8_SA
#undef PG8_SB
#undef PG8_STAGE
#undef PG8_LDA
#undef PG8_LDB
#undef PG8_MMA
#undef PG8_WAIT_V
#undef PG8_WAIT_L
#undef PG8_BAR
#undef PG8_SCHED
}
}
constexpr int NB = 8, SEQ = 2048, DM = 1024, M = NB * SEQ, NIN = 2560, DFF = 2816, NFF2 = 2 * DFF, DEPTH = 2;
constexpr int NWAVES = 8;
constexpr size_t MiB = 1u << 20;
constexpr size_t WS_ROWSS = 1 * MiB;
constexpr size_t WS_VGSS = 2 * MiB;
constexpr size_t WS_WSP = 3 * MiB;
constexpr size_t WS_W0 = 4 * MiB, WS_WSTRIDE = 24 * MiB;
constexpr size_t WOFF_IN = 0, WOFF_OUT = 5 * MiB, WOFF_FIN = 7 * MiB, WOFF_FOUT = 18 * MiB;
constexpr size_t WS_XB = 52 * MiB;
constexpr size_t WS_PROJ = 84 * MiB;
constexpr size_t WS_MIX = 164 * MiB;
constexpr size_t WS_HID = 84 * MiB;
constexpr size_t WS_END = 196 * MiB;
constexpr int LDS_BYTES = 147456;

#define GAS __attribute__((address_space(1)))
#define LAS __attribute__((address_space(3)))
typedef unsigned short bf16;
typedef unsigned v4u __attribute__((ext_vector_type(4)));
typedef float f32x4 __attribute__((ext_vector_type(4)));
__device__ __forceinline__ unsigned f2bf(float f) { unsigned u = __builtin_bit_cast(unsigned, f); return (u + 0x7fffu + ((u >> 16) & 1u)) >> 16; }
__device__ __forceinline__ unsigned pk2(float lo, float hi) { return f2bf(lo) | (f2bf(hi) << 16); }
__device__ __forceinline__ float bf2f(bf16 v) { return __builtin_bit_cast(float, (unsigned)v << 16); }
__device__ __forceinline__ float wave_sum(float v) {
#pragma unroll
    for (int o = 1; o < 64; o <<= 1) v += __shfl_xor(v, o);
    return v;
}
#define LDS_WAIT() asm volatile("s_waitcnt lgkmcnt(0)" ::: "memory")

typedef short tp_s16x4 __attribute__((ext_vector_type(4)));
__device__ __forceinline__ void p0_transpose_item(const float* W, int K, int N, bf16* WT, int k0, int n0, int prow0, int prow1, const float* gk, LAS unsigned char* scr, int lane) {
    const int lr = lane >> 4, n4 = (lane & 15) * 4;
    f32x4 v[16];
#pragma unroll
    for (int i = 0; i < 16; ++i) v[i] = *(const f32x4*)(W + (size_t)(k0 + 4 * i + lr) * N + n0 + n4);
#pragma unroll
    for (int i = 0; i < 16; ++i) { const int k = 4 * i + lr; const float gg = gk ? gk[k0 + k] : 1.f;
        unsigned long long w = (unsigned long long)pk2(v[i].x * gg, v[i].y * gg) | ((unsigned long long)pk2(v[i].z * gg, v[i].w * gg) << 32);
        *(LAS unsigned long long*)(scr + k * 128 + ((n4 * 2) ^ (((k >> 1) & 1) << 6))) = w; }
    asm volatile("" ::: "memory");
    const int hh = lane >> 5, g2 = (lane >> 4) & 1, i16 = lane & 15, qq = i16 >> 2, p4 = i16 & 3;
#pragma unroll
    for (int j = 0; j < 8; ++j) { const int c = 2 * (j >> 1) + hh, nb = 32 * (j & 1) + 16 * g2;
        const int a0 = (8 * c + qq) * 128 + (((nb + 4 * p4) * 2) ^ ((qq >> 1) << 6));
        const tp_s16x4 lo = __builtin_bit_cast(tp_s16x4, __builtin_amdgcn_ds_read_tr16_b64_v4i16((LAS tp_s16x4*)(scr + a0)));
        const tp_s16x4 hi4 = __builtin_bit_cast(tp_s16x4, __builtin_amdgcn_ds_read_tr16_b64_v4i16((LAS tp_s16x4*)(scr + a0 + 4 * 128)));
        typedef short s16x8_t __attribute__((ext_vector_type(8)));
        const s16x8_t o = (s16x8_t){lo[0], lo[1], lo[2], lo[3], hi4[0], hi4[1], hi4[2], hi4[3]};
        const int prow = ((j & 1) ? prow1 : prow0) + 16 * g2 + i16;
        *(s16x8_t*)(WT + (size_t)prow * K + k0 + 8 * c) = o; }
    LDS_WAIT(); asm volatile("" ::: "memory");
}
__host__ __device__ __forceinline__ int map_in(int n) { const int T = n >> 8, nn = n & 255; return 256 * T + 128 * ((nn >> 5) & 1) + 32 * (nn >> 6) + (nn & 31); }
__host__ __device__ __forceinline__ int map_fin(int n) { return n < DFF ? 256 * (n >> 7) + (n & 127) : 256 * ((n - DFF) >> 7) + 128 + ((n - DFF) & 127); }

typedef GAS unsigned gu32;
#define RLX_AGENT __ATOMIC_RELAXED, __HIP_MEMORY_SCOPE_AGENT
constexpr int MISC_OFF = LDS_BYTES - 64;
constexpr size_t WS_BAR = 0;
constexpr size_t BAR_ZERO_BYTES = 16384;
#define XB_TMO      128
#define XB_XCNT(j)  (256  + 64 * (j))
#define XB_XSUB(j)  (1280 + 64 * (j))
#define XB_XGEN(j)  (2304 + 64 * (j))
#define XB_TOP      3328
#define XB_TOPGEN   3392
#define XCD_BAR_WORDS 3456
#define XB_SPIN_CAP (1u << 18)

__device__ __forceinline__ unsigned xb_ld(unsigned* p)              { return __hip_atomic_load(p, __ATOMIC_RELAXED, __HIP_MEMORY_SCOPE_AGENT); }
__device__ __forceinline__ unsigned xb_add(unsigned* p, unsigned v) { return __hip_atomic_fetch_add(p, v, __ATOMIC_RELAXED, __HIP_MEMORY_SCOPE_AGENT); }
__device__ __forceinline__ unsigned xb_xcc_id() { return (unsigned)__builtin_amdgcn_s_getreg((3 << 11) | 20) & 0xFu; }
#define XB_SPIN(cond, bar) do { unsigned _sp = 0; while (cond) { __builtin_amdgcn_s_sleep(1); \
    if ((++_sp & 255u) == 0u) { if (xb_ld(&(bar)[XB_TMO])) break; if (_sp > XB_SPIN_CAP) { atomicAdd(&(bar)[XB_TMO], 1u); break; } } } } while (0)

struct XcdBarrier {
    unsigned* bar; unsigned x;
    volatile LAS unsigned* st;
};

__device__ __forceinline__ XcdBarrier xcd_barrier_post(unsigned* bar, volatile LAS unsigned* st) {
    XcdBarrier b; b.bar = bar; b.x = xb_xcc_id(); b.st = st;
    if (threadIdx.x == 0) (void)xb_add(&bar[XB_XCNT(b.x)], 1u);
    return b;
}
__device__ __forceinline__ void xcd_barrier_complete(unsigned* bar, unsigned x, unsigned& nloc, unsigned& nx) {
    const unsigned G = gridDim.x * gridDim.y * gridDim.z;
    unsigned sum, cnt, mine, sp = 0u;
    for (;;) {
        sum = 0u; cnt = 0u; mine = 0u;
#pragma unroll
        for (unsigned j = 0; j < 16; ++j) { const unsigned c = xb_ld(&bar[XB_XCNT(j)]); sum += c; cnt += (c > 0u) ? 1u : 0u; mine = (j == x) ? c : mine; }
        if (sum == G) break;
        __builtin_amdgcn_s_sleep(1);
        if ((++sp & 255u) == 0u) { if (xb_ld(&bar[XB_TMO])) break; if (sp > XB_SPIN_CAP) { atomicAdd(&bar[XB_TMO], 1u); break; } }
    }
    nloc = mine > 0u ? mine : 1u; nx = cnt > 0u ? cnt : 1u;
}

__device__ __forceinline__ void xcd_barrier(const XcdBarrier& b) {
    asm volatile("s_waitcnt vmcnt(0)" ::: "memory");
    __syncthreads();
    if (threadIdx.x == 0) {
        unsigned* bar = b.bar;
        __builtin_amdgcn_s_waitcnt(0);
        unsigned nloc = b.st[0], nx = b.st[1];
        if (nloc == 0u) { xcd_barrier_complete(bar, b.x, nloc, nx); b.st[0] = nloc; b.st[1] = nx; }
        const unsigned old = xb_add(&bar[XB_XSUB(b.x)], 1u);
        const unsigned gen = old / nloc;
        if (old + 1u == (gen + 1u) * nloc) {
            __builtin_amdgcn_fence(__ATOMIC_RELEASE, "agent");
            asm volatile("s_waitcnt vmcnt(0)" ::: "memory");
            const unsigned og = xb_add(&bar[XB_TOP], 1u);
            const unsigned tg = og / nx;
            if (og + 1u == (tg + 1u) * nx) xb_add(&bar[XB_TOPGEN], 1u);
            else XB_SPIN(xb_ld(&bar[XB_TOPGEN]) == tg, bar);
            __builtin_amdgcn_fence(__ATOMIC_ACQUIRE, "agent");
            xb_add(&bar[XB_XGEN(b.x)], 1u);
            asm volatile("s_waitcnt vmcnt(0)" ::: "memory");
        } else {
            XB_SPIN(xb_ld(&bar[XB_XGEN(b.x)]) == gen, bar);
            __builtin_amdgcn_fence(__ATOMIC_ACQUIRE, "agent");
            asm volatile("s_waitcnt vmcnt(0)" ::: "memory");
        }
    }
    __syncthreads();
}

#define GRID_BAR() do { XcdBarrier bar_; bar_.bar = (unsigned*)(kargs_ws() + WS_BAR); bar_.x = xb_xcc_id(); bar_.st = (volatile LAS unsigned*)(lds + MISC_OFF); xcd_barrier(bar_); } while (0)
struct Args { const float* in[15]; float* out; unsigned char* ws; };
typedef const __attribute__((address_space(4))) Args CArgs;
__device__ __forceinline__ CArgs* kargs();
__device__ __forceinline__ unsigned char* kargs_ws();
__device__ __forceinline__ CArgs* kargs() { CArgs* p = (CArgs*)__builtin_amdgcn_kernarg_segment_ptr(); asm volatile("" : "+s"(p)); return p; }
__device__ __forceinline__ unsigned char* kargs_ws() { return kargs()->ws; }

__device__ __forceinline__ void prologue(CArgs* a, LAS unsigned char* lds, int wave, int lane) {
    LAS unsigned char* scr = lds + wave * 16384;
    const int gw = blockIdx.x * NWAVES + wave, NGW = gridDim.x * NWAVES;
    constexpr int I_IN = (DM / 64) * (NIN / 64), I_OUT = (DM / 64) * (DM / 64), I_FIN = (DM / 64) * (NFF2 / 64), I_FOUT = (DFF / 64) * (DM / 64);
    constexpr int I_LAYER = I_IN + I_OUT + I_FIN + I_FOUT;
    for (int it = gw; it < DEPTH * I_LAYER; it += NGW) {
        const int l = it / I_LAYER; int r = it % I_LAYER;
        unsigned char* wb = a->ws + WS_W0 + (size_t)l * WS_WSTRIDE;
        if (r < I_IN) { const int nblk = NIN / 64, kb = r / nblk, nb = r % nblk;
            p0_transpose_item(a->in[2] + (size_t)l * DM * NIN, DM, NIN, (bf16*)(wb + WOFF_IN), 64 * kb, 64 * nb, map_in(64 * nb), map_in(64 * nb + 32), a->in[1] + l * DM, scr, lane); continue; } r -= I_IN;
        if (r < I_OUT) { const int nblk = DM / 64, kb = r / nblk, nb = r % nblk;
            p0_transpose_item(a->in[11] + (size_t)l * DM * DM, DM, DM, (bf16*)(wb + WOFF_OUT), 64 * kb, 64 * nb, 64 * nb, 64 * nb + 32, nullptr, scr, lane); continue; } r -= I_OUT;
        if (r < I_FIN) { const int nblk = NFF2 / 64, kb = r / nblk, nb = r % nblk;
            p0_transpose_item(a->in[13] + (size_t)l * DM * NFF2, DM, NFF2, (bf16*)(wb + WOFF_FIN), 64 * kb, 64 * nb, map_fin(64 * nb), map_fin(64 * nb + 32), a->in[12] + l * DM, scr, lane); continue; } r -= I_FIN;
        { const int nblk = DM / 64, kb = r / nblk, nb = r % nblk;
            p0_transpose_item(a->in[14] + (size_t)l * DFF * DM, DFF, DM, (bf16*)(wb + WOFF_FOUT), 64 * kb, 64 * nb, 64 * nb, 64 * nb + 32, nullptr, scr, lane); }
    }
    float* rowss = (float*)(a->ws + WS_ROWSS); bf16* xb = (bf16*)(a->ws + WS_XB);
    for (int m = gw; m < M; m += NGW) {
        const f32x4* xr = (const f32x4*)(a->in[0] + (size_t)m * DM) + lane;
        unsigned long long* o8 = (unsigned long long*)(xb + (size_t)m * DM) + lane;
        float s = 0.f;
#pragma unroll
        for (int j = 0; j < 4; ++j) { const f32x4 v = xr[64 * j]; s += (v.x * v.x + v.y * v.y) + (v.z * v.z + v.w * v.w);
            o8[64 * j] = (unsigned long long)pk2(v.x, v.y) | ((unsigned long long)pk2(v.z, v.w) << 32); }
        s = wave_sum(s);
        if (lane < 4) rowss[(size_t)m * 4 + lane] = lane == 0 ? s : 0.f;
    }
    { const float* wsp = a->in[7]; bf16* o = (bf16*)(a->ws + WS_WSP); const int gt = blockIdx.x * 512 + threadIdx.x, NT = gridDim.x * 512;
      for (int i = gt; i < DEPTH * 8 * 128 * 128; i += NT) { const int s = i & 127, t = (i >> 7) & 127; o[i] = (bf16)(((t >> 6) >= (s >> 6)) ? f2bf(wsp[i]) : 0u); } }
}

__device__ __forceinline__ void mixer_naive(CArgs* a, int l, LAS unsigned char* lds, int wave, int lane) {
    const bf16* P = (const bf16*)(a->ws + WS_PROJ); bf16* MIX = (bf16*)(a->ws + WS_MIX);
    const float* vgss = (const float*)(a->ws + WS_VGSS); const bf16* wsp = (const bf16*)(a->ws + WS_WSP) + (size_t)l * 8 * 128 * 128;
    const float* rel = a->in[5] + (size_t)l * 8 * 257; const float* sgu_g = a->in[6] + l * 512; const float* bsp = a->in[8] + l * 8 * 128;
    const float* ag = a->in[9] + l * 512; const float* gg = a->in[10] + l * 512;
    LAS float* red = (LAS float*)lds;
    for (int tok = blockIdx.x; tok < M; tok += gridDim.x) {
        const int b = tok / SEQ, t = tok % SEQ, c = t >> 6;
        const int h = wave;
        const float q = bf2f(P[(size_t)tok * NIN + h * 64 + lane]);
        float mx = -INFINITY, lsum = 0.f, o = 0.f;
        const int k0 = (c >= 8 ? c - 8 : 0) * 64, k1 = c * 64 + 63;
        for (int kt = k0; kt <= k1; ++kt) {
            const size_t kr = (size_t)(b * SEQ + kt) * NIN;
            float s = wave_sum(q * bf2f(P[kr + 512 + h * 64 + lane]));
            int d = t - kt; d = d < -128 ? -128 : (d > 128 ? 128 : d);
            s += rel[h * 257 + d + 128] * pg8::LOG2E;
            const float mn = fmaxf(mx, s), al = __builtin_amdgcn_exp2f(mx - mn), p = __builtin_amdgcn_exp2f(s - mn);
            lsum = lsum * al + p; o = o * al + p * bf2f(P[kr + 1024 + h * 64 + lane]); mx = mn;
        }
        o = o / lsum;
        const int g = wave, nb = t >> 7, tp = t & 127, ns = tp < 64 ? 64 : 128;
        float mixd = 0.f;
        for (int s = 0; s < ns; ++s) {
            const int srow = b * SEQ + nb * 128 + s;
            const f32x4* pv = (const f32x4*)(vgss + (size_t)srow * 8); const f32x4 p0 = pv[0], p1 = pv[1];
            const float rs = __builtin_amdgcn_rsqf((((p0[0] + p0[1]) + (p0[2] + p0[3])) + ((p1[0] + p1[1]) + (p1[2] + p1[3]))) * (1.0f / 512.0f) + pg8::RMS_EPS);
            mixd += bf2f(wsp[(g * 128 + tp) * 128 + s]) * (bf2f(P[(size_t)srow * NIN + 2048 + g * 64 + lane]) * rs * sgu_g[g * 64 + lane]);
        }
        const float gv = bf2f(P[(size_t)tok * NIN + 1536 + g * 64 + lane]) * (mixd + bsp[g * 128 + tp]);
        const float so = wave_sum(o * o), sg = wave_sum(gv * gv);
        __syncthreads();
        if (lane == 0) { red[wave] = so; red[8 + wave] = sg; }
        __syncthreads();
        float ta = 0.f, tg = 0.f;
#pragma unroll
        for (int w = 0; w < 8; ++w) { ta += red[w]; tg += red[8 + w]; }
        const float ra = __builtin_amdgcn_rsqf(ta * (1.0f / 512.0f) + pg8::RMS_EPS), rg = __builtin_amdgcn_rsqf(tg * (1.0f / 512.0f) + pg8::RMS_EPS);
        MIX[(size_t)tok * DM + h * 64 + lane] = (bf16)f2bf(o * ra * ag[h * 64 + lane]);
        MIX[(size_t)tok * DM + 512 + g * 64 + lane] = (bf16)f2bf(gv * rg * gg[g * 64 + lane]);
    }
    __syncthreads();
}

#ifndef FAST_MIXER
#define FAST_MIXER 1
#endif
#ifndef PHM
#define PHM 31
#endif
#ifndef REPM
#define REPM 0
#endif
#define REPEAT(bit) for (int rep_ = 0; rep_ < (((REPM) >> (bit)) & 1) + 1; ++rep_)
namespace mx {
typedef float f32x16 __attribute__((ext_vector_type(16)));
typedef short bf16x8 __attribute__((ext_vector_type(8)));
typedef short s16x4 __attribute__((ext_vector_type(4)));
typedef unsigned u32x2 __attribute__((ext_vector_type(2)));
constexpr int TBL_OFF = 131072;
constexpr int RS_OFF = TBL_OFF + 8 * 260 * 4 + 4096;
constexpr int RED_OFF = TBL_OFF + 8 * 260 * 4;
__device__ __forceinline__ int crow(int r, int hi) { return (r & 3) + 8 * (r >> 2) + 4 * hi; }
__device__ __forceinline__ int vimg(int row, int chunk) { return row * 128 + ((chunk * 16) ^ (((row >> 1) & 1) << 6)); }
__device__ __forceinline__ s16x4 tr64(LAS unsigned char* p) { return __builtin_bit_cast(s16x4, __builtin_amdgcn_ds_read_tr16_b64_v4i16((LAS s16x4*)p)); }
__device__ __forceinline__ bf16x8 cat8(s16x4 a, s16x4 b) { return (bf16x8){a[0], a[1], a[2], a[3], b[0], b[1], b[2], b[3]}; }
__device__ __forceinline__ unsigned cvtpk(float lo, float hi) { unsigned r; asm("v_cvt_pk_bf16_f32 %0, %1, %2" : "=v"(r) : "v"(lo), "v"(hi)); return r; }
#define MX_FENCE() asm volatile("" ::: "memory")

__device__ __forceinline__ void attn_task(const bf16* P, int b, int c, int h, LAS unsigned char* wl, const LAS float* tbl, int lane, f32x16 (&o)[2][2]) {
    const int r32 = lane & 31, hi = lane >> 5;
    const size_t tok0 = (size_t)b * SEQ + c * 64;
    bf16x8 qf[2][4];
#pragma unroll
    for (int qt = 0; qt < 2; ++qt)
#pragma unroll
        for (int d0 = 0; d0 < 4; ++d0) qf[qt][d0] = *(const bf16x8*)(P + (tok0 + 32 * qt + r32) * NIN + h * 64 + d0 * 16 + hi * 8);
#pragma unroll
    for (int r = 0; r < 16; ++r) { o[0][0][r] = 0.f; o[0][1][r] = 0.f; o[1][0][r] = 0.f; o[1][1][r] = 0.f; }
    float m[2] = {-INFINITY, -INFINITY}, l[2] = {0.f, 0.f};
    const int kc0 = c >= 8 ? c - 8 : 0;
    const int dhalf = (lane >> 4) & 1, qq = (lane & 15) >> 2, p4 = lane & 3;
    int vb[2];
#pragma unroll
    for (int dt = 0; dt < 2; ++dt) vb[dt] = 8192 + (4 * hi + qq) * 128 + ((64 * dt + 32 * dhalf + 8 * p4) ^ ((qq >> 1) << 6));
    const int prow = lane >> 3, pch = lane & 7;
    const unsigned voff = (unsigned)(prow * NIN + (pch ^ (((lane >> 4) & 1) << 2)) * 8) * 2u;
    const unsigned koff0 = (unsigned)(prow * NIN + (pch ^ (lane >> 4)) * 8) * 2u, koff1 = (unsigned)(prow * NIN + (pch ^ (lane >> 4) ^ 4) * 8) * 2u;
    const int swz = (r32 >> 1) & 7;
    int ka[4];
#pragma unroll
    for (int d0 = 0; d0 < 4; ++d0) ka[d0] = r32 * 128 + (((2 * d0 + hi) ^ swz) * 16);
#define MX_DMAK(kc) do { const char* kp_ = (const char*)(P + ((size_t)b * SEQ + (kc) * 64) * NIN + 512 + h * 64); \
        _Pragma("unroll") for (int i = 0; i < 8; ++i) __builtin_amdgcn_global_load_lds((const unsigned*)(kp_ + (size_t)(i * 8 * NIN) * 2 + ((i & 1) ? koff1 : koff0)), (LAS unsigned*)(wl + i * 1024), 16, 0, 0); } while (0)
#define MX_DMAV(kc) do { const char* vp_ = (const char*)(P + ((size_t)b * SEQ + (kc) * 64) * NIN + 1024 + h * 64); \
        _Pragma("unroll") for (int i = 0; i < 8; ++i) __builtin_amdgcn_global_load_lds((const unsigned*)(vp_ + (size_t)(i * 8 * NIN) * 2 + voff), (LAS unsigned*)(wl + 8192 + i * 1024), 16, 0, 0); } while (0)
    MX_DMAK(kc0);
    for (int kc = kc0; kc <= c; ++kc) {
        const int j = kc - c + 8;
        MX_DMAV(kc);
        asm volatile("s_waitcnt vmcnt(8)" ::: "memory");
        bf16x8 kf[2][4];
#pragma unroll
        for (int kt = 0; kt < 2; ++kt)
#pragma unroll
            for (int d0 = 0; d0 < 4; ++d0) kf[kt][d0] = *(const LAS bf16x8*)(wl + kt * 4096 + ka[d0]);
        asm volatile("s_waitcnt lgkmcnt(0)" ::: "memory");
        if (kc < c) MX_DMAK(kc + 1);
#pragma unroll
        for (int qt = 0; qt < 2; ++qt) {
            f32x16 st[2];
            if (j <= 5) { const float bc = tbl[256];
#pragma unroll
                for (int r = 0; r < 16; ++r) { st[0][r] = bc; st[1][r] = bc; } }
            else { int D0 = 64 * (8 - j) + 32 * qt + r32 - 4 * hi; asm volatile("" : "+v"(D0));
#pragma unroll
                for (int kt = 0; kt < 2; ++kt)
#pragma unroll
                    for (int r = 0; r < 16; ++r) { int idx = D0 - (32 * kt + (r & 3) + 8 * (r >> 2)); idx = idx < -128 ? -128 : (idx > 128 ? 128 : idx); st[kt][r] = tbl[idx + 128]; } }
#pragma unroll
            for (int kt = 0; kt < 2; ++kt)
#pragma unroll
                for (int d0 = 0; d0 < 4; ++d0) st[kt] = __builtin_amdgcn_mfma_f32_32x32x16_bf16(kf[kt][d0], qf[qt][d0], st[kt], 0, 0, 0);
            float mxv = fmaxf(st[0][0], st[1][0]);
#pragma unroll
            for (int r = 1; r < 16; ++r) mxv = fmaxf(mxv, fmaxf(st[0][r], st[1][r]));
            mxv = fmaxf(mxv, __shfl_xor(mxv, 32));
            const float mn = fmaxf(m[qt], mxv), al = __builtin_amdgcn_exp2f(m[qt] - mn); m[qt] = mn;
            float rs = 0.f;
#pragma unroll
            for (int kt = 0; kt < 2; ++kt)
#pragma unroll
                for (int r = 0; r < 16; ++r) { const float p = __builtin_amdgcn_exp2f(st[kt][r] - mn); st[kt][r] = p; rs += p; }
            l[qt] = l[qt] * al + rs;
#pragma unroll
            for (int r = 0; r < 16; ++r) { o[qt][0][r] *= al; o[qt][1][r] *= al; }
            bf16x8 pf[4];
#pragma unroll
            for (int s = 0; s < 4; ++s) { v4u w; const int kt = s >> 1, r0 = 8 * (s & 1);
                w.x = cvtpk(st[kt][r0 + 0], st[kt][r0 + 1]); w.y = cvtpk(st[kt][r0 + 2], st[kt][r0 + 3]); w.z = cvtpk(st[kt][r0 + 4], st[kt][r0 + 5]); w.w = cvtpk(st[kt][r0 + 6], st[kt][r0 + 7]);
                pf[s] = __builtin_bit_cast(bf16x8, w); }
            if (qt == 0) { if (kc < c) asm volatile("s_waitcnt vmcnt(8)" ::: "memory"); else asm volatile("s_waitcnt vmcnt(0)" ::: "memory"); }
#pragma unroll
            for (int dt = 0; dt < 2; ++dt) { s16x4 va[4], vc[4]; const unsigned vaddr = (unsigned)(uintptr_t)(wl + vb[dt]);
#pragma unroll
                for (int s = 0; s < 4; ++s) { asm volatile("ds_read_b64_tr_b16 %0, %1 offset:%c2" : "=&v"(va[s]) : "v"(vaddr), "i"(16 * s * 128) : "memory");
                                              asm volatile("ds_read_b64_tr_b16 %0, %1 offset:%c2" : "=&v"(vc[s]) : "v"(vaddr), "i"((16 * s + 8) * 128) : "memory"); }
                asm volatile("s_waitcnt lgkmcnt(0)" : "+v"(va[0]), "+v"(va[1]), "+v"(va[2]), "+v"(va[3]), "+v"(vc[0]), "+v"(vc[1]), "+v"(vc[2]), "+v"(vc[3]) :: "memory");
#pragma unroll
                for (int s = 0; s < 4; ++s) o[qt][dt] = __builtin_amdgcn_mfma_f32_32x32x16_bf16(cat8(va[s], vc[s]), pf[s], o[qt][dt], 0, 0, 0); }
        }
        MX_FENCE();
    }
#undef MX_DMAK
#undef MX_DMAV
#pragma unroll
    for (int qt = 0; qt < 2; ++qt) { float lt = l[qt]; lt += __shfl_xor(lt, 32); const float inv = 1.0f / lt;
#pragma unroll
        for (int r = 0; r < 16; ++r) { o[qt][0][r] *= inv; o[qt][1][r] *= inv; } }
}

__device__ __forceinline__ void sgu_task(const bf16* P, const LAS float* rstab, const bf16* wsp_l, const float* sgu_g, const float* bsp_l, int b, int c, int g, LAS unsigned char* wl, int lane_in, f32x16 (&o)[2][2]) {
    int lane = lane_in; asm volatile("" : "+v"(lane));
    const int r32 = lane & 31, hi = lane >> 5;
    const int nb = c >> 1, cb = c & 1, ns = cb ? 128 : 64;
    const size_t srow0 = (size_t)b * SEQ + nb * 128, tok0 = (size_t)b * SEQ + c * 64;
    const int prow = lane >> 3, pch = lane & 7;
    const f32x4 g0 = *(const f32x4*)(sgu_g + g * 64 + pch * 8), g1 = *(const f32x4*)(sgu_g + g * 64 + pch * 8 + 4);
    MX_FENCE();
#pragma unroll
    for (int hb = 0; hb < 2; ++hb) {
        if (hb * 64 < ns) {
            v4u raw[8];
#pragma unroll
            for (int i = 0; i < 8; ++i) raw[i] = *(const v4u*)(P + (srow0 + hb * 64 + prow + 8 * i) * NIN + 2048 + g * 64 + pch * 8);
#pragma unroll
            for (int i = 0; i < 8; ++i) { const int row = hb * 64 + prow + 8 * i; const float rs = rstab[row];
                v4u w;
                w.x = cvtpk(__builtin_bit_cast(float, raw[i].x << 16) * rs * g0[0], __builtin_bit_cast(float, raw[i].x & 0xffff0000u) * rs * g0[1]);
                w.y = cvtpk(__builtin_bit_cast(float, raw[i].y << 16) * rs * g0[2], __builtin_bit_cast(float, raw[i].y & 0xffff0000u) * rs * g0[3]);
                w.z = cvtpk(__builtin_bit_cast(float, raw[i].z << 16) * rs * g1[0], __builtin_bit_cast(float, raw[i].z & 0xffff0000u) * rs * g1[1]);
                w.w = cvtpk(__builtin_bit_cast(float, raw[i].w << 16) * rs * g1[2], __builtin_bit_cast(float, raw[i].w & 0xffff0000u) * rs * g1[3]);
                *(LAS v4u*)(wl + vimg(row, pch)) = w; }
        }
    }
    MX_FENCE();
#pragma unroll
    for (int r = 0; r < 16; ++r) { o[0][0][r] = 0.f; o[0][1][r] = 0.f; o[1][0][r] = 0.f; o[1][1][r] = 0.f; }
    const int dhalf = (lane >> 4) & 1, qq = (lane & 15) >> 2, p4 = lane & 3;
    int vbs[2];
#pragma unroll
    for (int ct = 0; ct < 2; ++ct) vbs[ct] = (8 * hi + qq) * 128 + ((64 * ct + 32 * dhalf + 8 * p4) ^ ((qq >> 1) << 6));
    const bf16* wrow = wsp_l + ((size_t)g * 128 + cb * 64 + r32) * 128 + hi * 8;
#pragma unroll 2
    for (int step = 0; step < ns / 16; ++step) {
        const bf16x8 wf0 = *(const bf16x8*)(wrow + 16 * step), wf1 = *(const bf16x8*)(wrow + 32 * 128 + 16 * step);
#pragma unroll
        for (int ct = 0; ct < 2; ++ct) { const s16x4 a0 = tr64(wl + vbs[ct] + (16 * step) * 128), a1 = tr64(wl + vbs[ct] + (16 * step + 4) * 128);
            const bf16x8 af = cat8(a0, a1);
            o[0][ct] = __builtin_amdgcn_mfma_f32_32x32x16_bf16(af, wf0, o[0][ct], 0, 0, 0);
            o[1][ct] = __builtin_amdgcn_mfma_f32_32x32x16_bf16(af, wf1, o[1][ct], 0, 0, 0); }
    }
    MX_FENCE();
#pragma unroll
    for (int tt = 0; tt < 2; ++tt) {
        const float bt = bsp_l[g * 128 + cb * 64 + 32 * tt + r32];
        const bf16* up = P + (tok0 + 32 * tt + r32) * NIN + 1536 + g * 64 + 4 * hi;
#pragma unroll
        for (int ct = 0; ct < 2; ++ct)
#pragma unroll
            for (int rg = 0; rg < 4; ++rg) { const u32x2 uu = *(const u32x2*)(up + 32 * ct + 8 * rg);
                o[tt][ct][4 * rg + 0] = __builtin_bit_cast(float, uu.x << 16) * (o[tt][ct][4 * rg + 0] + bt); o[tt][ct][4 * rg + 1] = __builtin_bit_cast(float, uu.x & 0xffff0000u) * (o[tt][ct][4 * rg + 1] + bt);
                o[tt][ct][4 * rg + 2] = __builtin_bit_cast(float, uu.y << 16) * (o[tt][ct][4 * rg + 2] + bt); o[tt][ct][4 * rg + 3] = __builtin_bit_cast(float, uu.y & 0xffff0000u) * (o[tt][ct][4 * rg + 3] + bt); }
    }
}

__device__ __forceinline__ void norm_store(const f32x16 (&o)[2][2], LAS float* red, int wave, int lane_in, const float* gain, bf16* dst) {
    int lane = lane_in; asm volatile("" : "+v"(lane));
    const int r32 = lane & 31, hi = lane >> 5;
#pragma unroll
    for (int tt = 0; tt < 2; ++tt) { float ss = 0.f;
#pragma unroll
        for (int r = 0; r < 16; ++r) ss += o[tt][0][r] * o[tt][0][r] + o[tt][1][r] * o[tt][1][r];
        ss += __shfl_xor(ss, 32);
        if (hi == 0) red[wave * 64 + tt * 32 + r32] = ss; }
    __syncthreads();
#pragma unroll
    for (int tt = 0; tt < 2; ++tt) { float tot = 0.f;
#pragma unroll
        for (int w = 0; w < 8; ++w) tot += red[w * 64 + tt * 32 + r32];
        const float rn = __builtin_amdgcn_rsqf(tot * (1.0f / 512.0f) + pg8::RMS_EPS);
#pragma unroll
        for (int ct = 0; ct < 2; ++ct)
#pragma unroll
            for (int rg = 0; rg < 4; ++rg) { const int ch = 32 * ct + 8 * rg + 4 * hi; const f32x4 gv = *(const f32x4*)(gain + ch);
                u32x2 w; w.x = cvtpk(o[tt][ct][4 * rg + 0] * rn * gv[0], o[tt][ct][4 * rg + 1] * rn * gv[1]); w.y = cvtpk(o[tt][ct][4 * rg + 2] * rn * gv[2], o[tt][ct][4 * rg + 3] * rn * gv[3]);
                *(u32x2*)(dst + (size_t)(32 * tt + r32) * DM + ch) = w; } }
}

__device__ __forceinline__ void mixer_fast(CArgs* a, int l, LAS unsigned char* lds, int wave, int lane) {
    const bf16* P = (const bf16*)(a->ws + WS_PROJ); bf16* MIX = (bf16*)(a->ws + WS_MIX);
    const float* vgss = (const float*)(a->ws + WS_VGSS); const bf16* wsp_l = (const bf16*)(a->ws + WS_WSP) + (size_t)l * 8 * 128 * 128;
    const float* rel = a->in[5] + (size_t)l * 8 * 257; const float* sgu_g = a->in[6] + l * 512; const float* bsp_l = a->in[8] + l * 8 * 128;
    const float* ag = a->in[9] + l * 512; const float* gg = a->in[10] + l * 512;
    LAS float* tbl = (LAS float*)(lds + TBL_OFF); LAS float* red = (LAS float*)(lds + RED_OFF); LAS float* rstab = (LAS float*)(lds + RS_OFF);
    for (int i = threadIdx.x; i < 8 * 257; i += NWAVES * 64) { const int h = i / 257, k = i % 257; tbl[h * 260 + k] = rel[i] * pg8::LOG2E; }
    __syncthreads();
    LAS unsigned char* wl = lds + wave * 16384;
    for (int u = blockIdx.x; u < NB * (SEQ / 64); u += gridDim.x) {
        const int b = u & 7, c = u >> 3;
        const size_t tok0 = (size_t)b * SEQ + c * 64;
        if (threadIdx.x < 128) {
            const size_t srow = (size_t)b * SEQ + (c >> 1) * 128 + threadIdx.x;
            const f32x4 p0 = *(const f32x4*)(vgss + srow * 8), p1 = *(const f32x4*)(vgss + srow * 8 + 4);
            rstab[threadIdx.x] = __builtin_amdgcn_rsqf((((p0[0] + p0[1]) + (p0[2] + p0[3])) + ((p1[0] + p1[1]) + (p1[2] + p1[3]))) * (1.0f / 512.0f) + pg8::RMS_EPS); }
        f32x16 o[2][2];
        REPEAT(7) attn_task(P, b, c, wave, wl, tbl + wave * 260, lane, o);
        norm_store(o, red, wave, lane, ag + wave * 64, MIX + tok0 * DM + wave * 64);
        REPEAT(8) sgu_task(P, rstab, wsp_l, sgu_g, bsp_l, b, c, wave, wl, lane, o);
        norm_store(o, red + 512, wave, lane, gg + wave * 64, MIX + tok0 * DM + 512 + wave * 64);
    }
    __syncthreads();
}
}

__global__ void __launch_bounds__(NWAVES * 64, 2) fwd_megakernel(Args a_unused) {
    extern __shared__ __attribute__((aligned(16))) unsigned char lds_raw[];
    LAS unsigned char* lds = (LAS unsigned char*)lds_raw;
    if (threadIdx.x < 16) ((LAS unsigned*)(lds + MISC_OFF))[threadIdx.x] = 0u;
    __syncthreads();
    (void)xcd_barrier_post((unsigned*)(kargs_ws() + WS_BAR), (volatile LAS unsigned*)(lds + MISC_OFF));
    { const int tid = threadIdx.x, lane = tid & 63, wave = __builtin_amdgcn_readfirstlane(tid >> 6);
      REPEAT(0) prologue(kargs(), lds, wave, lane); }
    GRID_BAR();
#if (REPM >> 6) & 1
    for (int i_ = 0; i_ < 10; ++i_) GRID_BAR();
#endif
#pragma nounroll
    for (int l = 0; l < DEPTH; ++l) {
#if PHM & 1
        REPEAT(1) {
            CArgs* a = kargs(); unsigned char* ws = a->ws; unsigned char* wb = ws + WS_W0 + (size_t)l * WS_WSTRIDE;
            pg8::Gemm g{(const bf16*)(ws + WS_XB), (const bf16*)(wb + WOFF_IN), M, NIN, DM}; pg8::StaticOrder S; S.init(M, NIN, (int)gridDim.x, (int)blockIdx.x);
            pg8::EpiInProj E{(bf16*)(ws + WS_PROJ), (const float*)(ws + WS_ROWSS), (float*)(ws + WS_VGSS), a->in[3] + l * 64, a->in[4] + l * 64};
            pg8::gemm_phase<pg8::EpiInProj, pg8::StaticOrder, true, true>(lds, g, S, E);
        }
#endif
        GRID_BAR();
#if PHM & 2
        REPEAT(2) { int tid = threadIdx.x; asm volatile("" : "+v"(tid)); const int lane = tid & 63, wave = __builtin_amdgcn_readfirstlane(tid >> 6);
#if FAST_MIXER
          mx::mixer_fast(kargs(), l, lds, wave, lane);
#else
          mixer_naive(kargs(), l, lds, wave, lane);
#endif
        }
#endif
        GRID_BAR();
#if PHM & 4
        REPEAT(3) {
            CArgs* a = kargs(); unsigned char* ws = a->ws; unsigned char* wb = ws + WS_W0 + (size_t)l * WS_WSTRIDE; float* xo = a->out;
            float* xw = (((REPM >> 3) & 1) && rep_ == 0) ? (float*)(ws + 84 * MiB) : xo;
            pg8::Gemm g{(const bf16*)(ws + WS_MIX), (const bf16*)(wb + WOFF_OUT), M, DM, DM}; pg8::StaticOrder S; S.init(M, DM, (int)gridDim.x, (int)blockIdx.x);
            pg8::EpiResid E{l == 0 ? a->in[0] : (const float*)xo, xw, (bf16*)(ws + WS_XB), (float*)(ws + WS_ROWSS), 1};
            pg8::gemm_phase<pg8::EpiResid, pg8::StaticOrder, false, true>(lds, g, S, E);
        }
#endif
        GRID_BAR();
#if PHM & 8
        REPEAT(4) {
            CArgs* a = kargs(); unsigned char* ws = a->ws; unsigned char* wb = ws + WS_W0 + (size_t)l * WS_WSTRIDE;
            pg8::Gemm g{(const bf16*)(ws + WS_XB), (const bf16*)(wb + WOFF_FIN), M, NFF2, DM}; pg8::StaticOrder S; S.init(M, NFF2, (int)gridDim.x, (int)blockIdx.x);
            pg8::EpiSwiGLU E{(bf16*)(ws + WS_HID), (const float*)(ws + WS_ROWSS)};
            pg8::gemm_phase<pg8::EpiSwiGLU, pg8::StaticOrder, true, true>(lds, g, S, E);
        }
#endif
        GRID_BAR();
#if PHM & 16
        REPEAT(5) {
            CArgs* a = kargs(); unsigned char* ws = a->ws; unsigned char* wb = ws + WS_W0 + (size_t)l * WS_WSTRIDE; float* xo = a->out;
            float* xw = (((REPM >> 5) & 1) && rep_ == 0) ? (float*)(ws + 192 * MiB) : xo;
            pg8::Gemm g{(const bf16*)(ws + WS_HID), (const bf16*)(wb + WOFF_FOUT), M, DM, DFF}; pg8::StaticOrder S; S.init(M, DM, (int)gridDim.x, (int)blockIdx.x);
            pg8::EpiResid E{xo, xw, (bf16*)(ws + WS_XB), (float*)(ws + WS_ROWSS), l + 1 < DEPTH ? 1 : 0};
            pg8::gemm_phase<pg8::EpiResid, pg8::StaticOrder, false, true>(lds, g, S, E);
        }
#endif
        if (l + 1 < DEPTH) GRID_BAR();
    }
}

extern "C" void kernel_launch(void* const* d_in, const int* in_sizes, int n_in, void* d_out, int out_size, void* d_ws, size_t ws_size, hipStream_t stream) {
    static int grid = 0;
    if (grid == 0) {
        if (n_in != 15 || in_sizes[0] != M * DM || out_size != M * DM || ws_size < WS_END) { fprintf(stderr, "kernel_launch: unexpected shapes (n_in %d, ws %zu)\n", n_in, ws_size); grid = -1; return; }
        int dev = 0, cus = 0, per_cu = 0;
        hipGetDevice(&dev); hipDeviceGetAttribute(&cus, hipDeviceAttributeMultiprocessorCount, dev);
        if (hipFuncSetAttribute((const void*)fwd_megakernel, hipFuncAttributeMaxDynamicSharedMemorySize, LDS_BYTES) != hipSuccess) { fprintf(stderr, "kernel_launch: hipFuncSetAttribute failed\n"); grid = -1; return; }
        if (hipOccupancyMaxActiveBlocksPerMultiprocessor(&per_cu, (const void*)fwd_megakernel, NWAVES * 64, LDS_BYTES) != hipSuccess || per_cu < 1) { fprintf(stderr, "kernel_launch: occupancy query failed (%d)\n", per_cu); (void)hipGetLastError(); per_cu = 1; }
        grid = cus * (per_cu > 1 ? 1 : per_cu);
        if (grid != 256) { fprintf(stderr, "kernel_launch: built for a 256-CU device (one 256x256 unit per workgroup in the N = 1024 phases); got %d\n", grid); grid = -1; return; }
    }
    if (grid < 0) return;
    if (hipMemsetAsync((char*)d_ws + WS_BAR, 0, BAR_ZERO_BYTES, stream) != hipSuccess) { fprintf(stderr, "kernel_launch: hipMemsetAsync failed\n"); return; }
    Args a{};
    for (int i = 0; i < 15; ++i) a.in[i] = (const float*)d_in[i];
    a.out = (float*)d_out; a.ws = (unsigned char*)d_ws;
    void* args[] = {&a};
    hipError_t e = hipLaunchCooperativeKernel((const void*)fwd_megakernel, dim3(grid), dim3(NWAVES * 64), args, LDS_BYTES, stream);
    if (e != hipSuccess) fprintf(stderr, "cooperative launch failed: %s (grid %d)\n", hipGetErrorString(e), grid);
}
```

```cpp
#include <hip/hip_runtime.h>
#include <hip/hip_cooperative_groups.h>
#include <cstdio>
#include <cstdint>
namespace cg = cooperative_groups;
namespace pg8 {
#define PG8_LAS __attribute__((address_space(3)))
typedef unsigned short bf16_t;
typedef short bf16x8 __attribute__((ext_vector_type(8)));
typedef float f32x4 __attribute__((ext_vector_type(4)));
typedef unsigned u32x4 __attribute__((ext_vector_type(4)));
constexpr int BM = 256, BK = 64, HALF = 128, HTB = HALF * BK * 2  , STAGE_BYTES = 8 * HTB, NXCD = 8, WGM = 8;

__host__ __device__ __forceinline__ int lds_byte(int r, int c) { const int st = (r >> 4) * 2 + (c >> 5), rr = r & 15, cc = c & 31, ob = rr * 64 + cc * 2; return st * 1024 + (ob ^ (((ob >> 9) & 1) << 5)); }
__host__ __device__ __forceinline__ void stage_rc(int b, int& R, int& C) { const int st = b / 1024, sb = b % 1024, swz = sb ^ (((sb >> 9) & 1) << 5); R = (st >> 1) * 16 + swz / 64; C = (st & 1) * 32 + (swz % 64) / 2; }
__host__ __device__ __forceinline__ int perm32(int rho) { const int n = rho >> 4, i = rho & 15; return 8 * (i >> 2) + 4 * n + (i & 3); }

struct Unit { int pm, pn; };
struct Gemm { const bf16_t* A; const bf16_t* Bt; int M, N, K; };

struct StaticOrder {
    int nM, nN, nwg, G, c;
    __host__ __device__ void init(int M, int N, int G_, int c_) { nM = M / BM; nN = N / BM; nwg = nM * nN; G = G_; c = c_; }
    __host__ __device__ bool next(int i, Unit& u) const {
        const long L = (long)i * G + c; if (L >= nwg) return false;
        int wgid = (int)L; { const int q = nwg / NXCD, r = nwg % NXCD, xcd = wgid % NXCD, off = wgid / NXCD; wgid = (xcd < r ? xcd * (q + 1) : r * (q + 1) + (xcd - r) * q) + off; }
        const int nig = WGM * nN, gid = wgid / nig, fm = gid * WGM, gsz = (nM - fm) < WGM ? (nM - fm) : WGM;
        u.pm = fm + ((wgid % nig) % gsz); u.pn = (wgid % nig) / gsz; return true;
    }
    __device__ __forceinline__ void a_ready(const Unit&) const {}
    __device__ __forceinline__ void done(const Unit&) const {}
};

__device__ __forceinline__ unsigned cvt_pk_bf16(float lo, float hi) { unsigned r; asm volatile("v_cvt_pk_bf16_f32 %0, %1, %2" : "=v"(r) : "v"(lo), "v"(hi)); return r; }
typedef float f32x2 __attribute__((ext_vector_type(2)));
constexpr float RMS_EPS = 1e-6f;
constexpr float LOG2E = 1.4426950408889634f;
constexpr float QSCALE = 0.125f * 1.4426950408889634f;
__device__ __forceinline__ float gelu_tanh(float x) {
    const float z2 = x * (1.5957691216057308f + 0.07135481627260025f * x * x);
    const float e = __builtin_amdgcn_exp2f(-LOG2E * z2);
    return x * __builtin_amdgcn_rcpf(1.0f + e);
}
__device__ __forceinline__ float row_rs(const float* rowss, int row) {
    const f32x4 a = *(const f32x4*)(rowss + (size_t)row * 4);
    return __builtin_amdgcn_rsqf(((a[0] + a[1]) + (a[2] + a[3])) * (1.0f / 1024.0f) + RMS_EPS);
}
struct EpiInProj {
    static constexpr bool PERM = true, AFTER_DRAIN = false, INIT = false;
    bf16_t* P; const float* rowss; float* vgss; const float* qg; const float* kg;
    __device__ __forceinline__ void operator()(const f32x4 (&acc)[2][2][4][2], const Unit& u, int wr, int wc, int fr, int fq) const {
        const int region = u.pn >> 1, half = u.pn & 1;
        const int lcol = region * 512 + half * 256 + wc * 64 + fq * 8;
        float gq[2][8];
#pragma unroll
        for (int bj = 0; bj < 2; ++bj)
#pragma unroll
            for (int e = 0; e < 8; ++e) gq[bj][e] = 1.f;
        if (region < 2) { const float* g = region == 0 ? qg : kg; const float sc = region == 0 ? QSCALE : 1.f;
#pragma unroll
            for (int bj = 0; bj < 2; ++bj)
#pragma unroll
                for (int e = 0; e < 8; ++e) gq[bj][e] = g[bj * 32 + fq * 8 + e] * sc; }
#pragma unroll
        for (int ai = 0; ai < 2; ++ai)
#pragma unroll
            for (int m = 0; m < 4; ++m) {
                const int row = u.pm * BM + ai * HALF + wr * 64 + m * 16 + fr;
                const float s = row_rs(rowss, row);
                float v[2][8];
#pragma unroll
                for (int bj = 0; bj < 2; ++bj)
#pragma unroll
                    for (int n = 0; n < 2; ++n)
#pragma unroll
                        for (int i = 0; i < 4; ++i) v[bj][4 * n + i] = acc[ai][bj][m][n][i] * s;
                if (region < 2) {
                    float q = 0.f;
#pragma unroll
                    for (int bj = 0; bj < 2; ++bj)
#pragma unroll
                        for (int e = 0; e < 8; ++e) q += v[bj][e] * v[bj][e];
                    q += __shfl_xor(q, 16); q += __shfl_xor(q, 32);
                    const float r = __builtin_amdgcn_rsqf(q * (1.0f / 64.0f) + RMS_EPS);
#pragma unroll
                    for (int bj = 0; bj < 2; ++bj)
#pragma unroll
                        for (int e = 0; e < 8; ++e) v[bj][e] = v[bj][e] * r * gq[bj][e];
                } else if (region >= 3) {
#pragma unroll
                    for (int bj = 0; bj < 2; ++bj)
#pragma unroll
                        for (int e = 0; e < 8; ++e) v[bj][e] = gelu_tanh(v[bj][e]);
                    if (region == 4) {
                        float q = 0.f;
#pragma unroll
                        for (int bj = 0; bj < 2; ++bj)
#pragma unroll
                            for (int e = 0; e < 8; ++e) q += v[bj][e] * v[bj][e];
                        q += __shfl_xor(q, 16); q += __shfl_xor(q, 32);
                        if (fq == 0) vgss[(size_t)row * 8 + half * 4 + wc] = q;
                    }
                }
                bf16_t* rowp = P + (size_t)row * 2560 + lcol;
#pragma unroll
                for (int bj = 0; bj < 2; ++bj) { u32x4 w; w.x = cvt_pk_bf16(v[bj][0], v[bj][1]); w.y = cvt_pk_bf16(v[bj][2], v[bj][3]); w.z = cvt_pk_bf16(v[bj][4], v[bj][5]); w.w = cvt_pk_bf16(v[bj][6], v[bj][7]);
                    *(u32x4*)(rowp + bj * 32) = w; }
            }
    }
};
struct EpiResid {
    static constexpr bool PERM = true, AFTER_DRAIN = true, INIT = true;
    const float* base; float* out; bf16_t* xb; float* rowss; int write_xb;
    __device__ __forceinline__ void init(f32x4 (&acc)[2][2][4][2], const Unit& u, int wr, int wc, int fr, int fq) const {
        const int col0 = u.pn * BM + wc * 32 + 8 * fq;
#pragma unroll
        for (int ai = 0; ai < 2; ++ai)
#pragma unroll
            for (int m = 0; m < 4; ++m) { const size_t off = (size_t)(u.pm * BM + ai * HALF + wr * 64 + m * 16 + fr) * 1024 + col0;
#pragma unroll
                for (int bj = 0; bj < 2; ++bj) { acc[ai][bj][m][0] = *(const f32x4*)(base + off + bj * HALF); acc[ai][bj][m][1] = *(const f32x4*)(base + off + bj * HALF + 4); } }
    }
    __device__ __forceinline__ void fused(f32x4 (&acc)[2][2][4][2], const Unit& u, int wr, int wc, int fr, int fq, PG8_LAS unsigned char* lds, int wid, int lane) const {
        PG8_LAS float* part = (PG8_LAS float*)lds;
        const int col0 = u.pn * BM + wc * 32 + 8 * fq;
#pragma unroll
        for (int ai = 0; ai < 2; ++ai)
#pragma unroll
            for (int m = 0; m < 4; ++m) {
                const int rl = ai * HALF + wr * 64 + m * 16 + fr;
                const size_t off = (size_t)(u.pm * BM + rl) * 1024 + col0;
                float q = 0.f;
#pragma unroll
                for (int bj = 0; bj < 2; ++bj) {
                    const f32x4 v0 = acc[ai][bj][m][0], v1 = acc[ai][bj][m][1];
                    *(f32x4*)(out + off + bj * HALF) = v0; *(f32x4*)(out + off + bj * HALF + 4) = v1;
                    if (write_xb) { u32x4 w; w.x = cvt_pk_bf16(v0[0], v0[1]); w.y = cvt_pk_bf16(v0[2], v0[3]); w.z = cvt_pk_bf16(v1[0], v1[1]); w.w = cvt_pk_bf16(v1[2], v1[3]);
                        *(u32x4*)(xb + off + bj * HALF) = w; }
                    q += (v0[0] * v0[0] + v0[1] * v0[1]) + (v0[2] * v0[2] + v0[3] * v0[3]) + (v1[0] * v1[0] + v1[1] * v1[1]) + (v1[2] * v1[2] + v1[3] * v1[3]);
                }
                q += __shfl_xor(q, 16); q += __shfl_xor(q, 32);
                if (fq == 0) part[rl * 4 + wc] = q;
            }
        asm volatile("s_waitcnt lgkmcnt(0)" ::: "memory"); __builtin_amdgcn_s_barrier(); asm volatile("" ::: "memory");
        const int t = wid * 64 + lane;
        if (t < 256) { const f32x4 p = *(const PG8_LAS f32x4*)(part + t * 4); rowss[(size_t)(u.pm * BM + t) * 4 + u.pn] = (p[0] + p[1]) + (p[2] + p[3]); }
    }
};
struct EpiSwiGLU {
    static constexpr bool PERM = true, AFTER_DRAIN = false, INIT = false;
    bf16_t* H; const float* rowss;
    __device__ __forceinline__ void operator()(const f32x4 (&acc)[2][2][4][2], const Unit& u, int wr, int wc, int fr, int fq) const {
        const int col0 = u.pn * 128 + wc * 32 + 8 * fq;
#pragma unroll
        for (int ai = 0; ai < 2; ++ai)
#pragma unroll
            for (int m = 0; m < 4; ++m) {
                const int row = u.pm * BM + ai * HALF + wr * 64 + m * 16 + fr;
                const float s = row_rs(rowss, row);
                float h[8];
#pragma unroll
                for (int n = 0; n < 2; ++n)
#pragma unroll
                    for (int i = 0; i < 4; ++i) { const float g = acc[ai][0][m][n][i] * s, up = acc[ai][1][m][n][i] * s;
                        h[4 * n + i] = g * __builtin_amdgcn_rcpf(1.0f + __builtin_amdgcn_exp2f(-LOG2E * g)) * up; }
                u32x4 w; w.x = cvt_pk_bf16(h[0], h[1]); w.y = cvt_pk_bf16(h[2], h[3]); w.z = cvt_pk_bf16(h[4], h[5]); w.w = cvt_pk_bf16(h[6], h[7]);
                *(u32x4*)(H + (size_t)row * 2816 + col0) = w;
            }
    }
};
template <class Epi, class Sched, bool ALIGN_EPI = false, bool SP2 = false>
__device__ __forceinline__ void gemm_phase(PG8_LAS unsigned char* lds, const Gemm g, const Sched& S, const Epi& E) {
    int tid_l = threadIdx.x; asm volatile("" : "+v"(tid_l));
    const int tid = tid_l, wid = __builtin_amdgcn_readfirstlane(tid >> 6), lane = tid & 63, wr = wid >> 2, wc = wid & 3, fr = lane & 15, fq = lane >> 4;
    const int K = g.K, nt = K / BK;
    unsigned voffA[2], voffB[2];
#pragma unroll
    for (int i = 0; i < 2; ++i) { int R, C; stage_rc(tid * 16 + i * 8192, R, C); const int Rb = Epi::PERM ? ((R & ~31) + perm32(R & 31)) : R;
        voffA[i] = (unsigned)(R * K + C) * 2u; voffB[i] = (unsigned)(Rb * K + C) * 2u; }
    const size_t kstep = (size_t)(BK * 2);
    const size_t hstep = (size_t)HALF * K * 2;
    const size_t tstep = 2 * hstep;
    const unsigned ldsw = (unsigned)wid * 1024u;
    const int aoff = lds_byte(wr * 64 + fr, fq * 8), boff = lds_byte(wc * 32 + fr, fq * 8);
#define PG8_SA(b, h) (((b) * 2 + (h)) * HTB)
#define PG8_SB(b, h) ((4 + (b) * 2 + (h)) * HTB)
#define PG8_STAGE(bufoff, gbase, voff) do { _Pragma("unroll") for (int _i = 0; _i < 2; ++_i) \
        __builtin_amdgcn_global_load_lds((const unsigned*)((const char*)(gbase) + (voff)[_i]), (PG8_LAS unsigned*)(lds + (bufoff) + ldsw + _i * 8192), 16, 0, 0); } while (0)
#define PG8_LDA(dst, b, h) do { _Pragma("unroll") for (int m = 0; m < 4; ++m) _Pragma("unroll") for (int k = 0; k < 2; ++k) dst[m][k] = *(const PG8_LAS bf16x8*)(lds + PG8_SA(b, h) + aoff + m * 2048 + k * 1024); } while (0)
#define PG8_LDB(dst, b, h) do { _Pragma("unroll") for (int n = 0; n < 2; ++n) _Pragma("unroll") for (int k = 0; k < 2; ++k) dst[n][k] = *(const PG8_LAS bf16x8*)(lds + PG8_SB(b, h) + boff + n * 2048 + k * 1024); } while (0)
#define PG8_MMA(ai, bj, At, Bt) do { __builtin_amdgcn_s_setprio(1); _Pragma("unroll") for (int m = 0; m < 4; ++m) _Pragma("unroll") for (int n = 0; n < 2; ++n) _Pragma("unroll") for (int k = 0; k < 2; ++k) \
        acc[ai][bj][m][n] = __builtin_amdgcn_mfma_f32_16x16x32_bf16(Bt[n][k], At[m][k], acc[ai][bj][m][n], 0, 0, 0); __builtin_amdgcn_s_setprio(0); } while (0)
#define PG8_WAIT_V(n) asm volatile("s_waitcnt vmcnt(" #n ")" ::: "memory")
#define PG8_WAIT_L(n) asm volatile("s_waitcnt lgkmcnt(" #n ")" ::: "memory")
#define PG8_BAR __builtin_amdgcn_s_barrier()
#define PG8_SCHED __builtin_amdgcn_sched_barrier(0)
    Unit cur, nxt; int ui = 0;
    if (!S.next(0, cur)) return;
    f32x4 acc[2][2][4][2];
    if constexpr (Epi::INIT) E.init(acc, cur, wr, wc, fr, fq);
    else {
#pragma unroll
    for (int a = 0; a < 2; ++a)
#pragma unroll
        for (int b = 0; b < 2; ++b)
#pragma unroll
            for (int m = 0; m < 4; ++m)
#pragma unroll
                for (int n = 0; n < 2; ++n) acc[a][b][m][n] = (f32x4){0.f, 0.f, 0.f, 0.f};
    }
    bf16x8 At[4][2], B0[2][2], B1[2][2];
    const char* cA = (const char*)g.A + (size_t)cur.pm * tstep; const char* cB = (const char*)g.Bt + (size_t)cur.pn * tstep;
    S.a_ready(cur);
    if constexpr (SP2) {
        PG8_STAGE(PG8_SB(0, 0), cB, voffB); PG8_STAGE(PG8_SB(0, 1), cB + hstep, voffB); PG8_STAGE(PG8_SA(0, 0), cA, voffA); PG8_STAGE(PG8_SA(0, 1), cA + hstep, voffA);
        if (wr == 1) PG8_BAR;
        PG8_WAIT_V(2); PG8_BAR;
        PG8_STAGE(PG8_SB(1, 0), cB + kstep, voffB); PG8_STAGE(PG8_SA(1, 0), cA + kstep, voffA); PG8_STAGE(PG8_SB(1, 1), cB + hstep + kstep, voffB);
        PG8_WAIT_V(6); PG8_BAR;
    } else {
        PG8_STAGE(PG8_SB(0, 0), cB, voffB); PG8_STAGE(PG8_SA(0, 0), cA, voffA); PG8_STAGE(PG8_SB(0, 1), cB + hstep, voffB); PG8_STAGE(PG8_SA(0, 1), cA + hstep, voffA);
        if (wr == 1) PG8_BAR;
        PG8_WAIT_V(4); PG8_BAR;
        PG8_STAGE(PG8_SB(1, 0), cB + kstep, voffB); PG8_STAGE(PG8_SA(1, 0), cA + kstep, voffA); PG8_STAGE(PG8_SB(1, 1), cB + hstep + kstep, voffB);
        PG8_WAIT_V(6); PG8_BAR;
    }
    for (;;) {
        const bool has_next = S.next(ui + 1, nxt);
        const char* nA = has_next ? (const char*)g.A + (size_t)nxt.pm * tstep : cA; const char* nB = has_next ? (const char*)g.Bt + (size_t)nxt.pn * tstep : cB;
        for (int t = 0; t < nt; t += 2) {
            const bool last = (t == nt - 2);
            const char* a1 = cA + (size_t)(t + 1) * kstep;
            const char* a2 = last ? nA : cA + (size_t)(t + 2) * kstep; const char* b2 = last ? nB : cB + (size_t)(t + 2) * kstep;
            const char* a3 = a2 + kstep; const char* b3 = b2 + kstep;
            if (last && has_next) S.a_ready(nxt);
            if constexpr (SP2) {
            PG8_LDB(B0, 0, 0); PG8_LDB(B1, 0, 1); PG8_SCHED; PG8_LDA(At, 0, 0); PG8_STAGE(PG8_SA(1, 1), a1 + hstep, voffA);
            PG8_WAIT_V(8); PG8_WAIT_L(0); PG8_BAR; PG8_MMA(0, 0, At, B0); PG8_MMA(0, 1, At, B1); PG8_BAR; PG8_SCHED;
            PG8_LDA(At, 0, 1); PG8_STAGE(PG8_SB(0, 0), b2, voffB); PG8_STAGE(PG8_SB(0, 1), b2 + hstep, voffB); PG8_STAGE(PG8_SA(0, 0), a2, voffA);
            PG8_WAIT_V(8); PG8_WAIT_L(0); PG8_BAR; PG8_MMA(1, 0, At, B0); PG8_MMA(1, 1, At, B1); PG8_BAR; PG8_SCHED;
            PG8_LDB(B0, 1, 0); PG8_LDB(B1, 1, 1); PG8_SCHED; PG8_LDA(At, 1, 0); PG8_STAGE(PG8_SA(0, 1), a2 + hstep, voffA);
            PG8_WAIT_V(8); PG8_WAIT_L(0); PG8_BAR; PG8_MMA(0, 0, At, B0); PG8_MMA(0, 1, At, B1); PG8_BAR; PG8_SCHED;
            PG8_LDA(At, 1, 1); PG8_STAGE(PG8_SB(1, 0), b3, voffB); PG8_STAGE(PG8_SB(1, 1), b3 + hstep, voffB); PG8_STAGE(PG8_SA(1, 0), a3, voffA);
            PG8_WAIT_V(8); PG8_WAIT_L(0); PG8_BAR; PG8_MMA(1, 0, At, B0); PG8_MMA(1, 1, At, B1); PG8_BAR; PG8_SCHED;
            } else {
            PG8_LDB(B0, 0, 0); PG8_SCHED; PG8_LDA(At, 0, 0); PG8_STAGE(PG8_SA(1, 1), a1 + hstep, voffA);
            PG8_WAIT_L(8); PG8_BAR; PG8_WAIT_L(0); PG8_MMA(0, 0, At, B0); PG8_BAR; PG8_SCHED;
            PG8_LDB(B1, 0, 1); PG8_STAGE(PG8_SB(0, 0), b2, voffB);
            PG8_BAR; PG8_WAIT_L(0); PG8_MMA(0, 1, At, B1); PG8_BAR;
            PG8_LDA(At, 0, 1); PG8_STAGE(PG8_SA(0, 0), a2, voffA);
            PG8_BAR; PG8_WAIT_L(0); PG8_MMA(1, 0, At, B0); PG8_BAR; PG8_SCHED;
            PG8_STAGE(PG8_SB(0, 1), b2 + hstep, voffB);
            PG8_WAIT_V(6); PG8_BAR; PG8_MMA(1, 1, At, B1); PG8_BAR;
            PG8_LDB(B0, 1, 0); PG8_SCHED; PG8_LDA(At, 1, 0); PG8_STAGE(PG8_SA(0, 1), a2 + hstep, voffA);
            PG8_WAIT_L(8); PG8_BAR; PG8_WAIT_L(0); PG8_MMA(0, 0, At, B0); PG8_BAR; PG8_SCHED;
            PG8_LDB(B1, 1, 1); PG8_STAGE(PG8_SB(1, 0), b3, voffB);
            PG8_BAR; PG8_WAIT_L(0); PG8_MMA(0, 1, At, B1); PG8_BAR;
            PG8_LDA(At, 1, 1); PG8_STAGE(PG8_SA(1, 0), a3, voffA);
            PG8_BAR; PG8_WAIT_L(0); PG8_MMA(1, 0, At, B0); PG8_BAR; PG8_SCHED;
            PG8_STAGE(PG8_SB(1, 1), b3 + hstep, voffB);
            PG8_WAIT_V(6); PG8_BAR; PG8_MMA(1, 1, At, B1); PG8_BAR;
            }
        }
        if constexpr (ALIGN_EPI) { if (wr == 0) PG8_BAR; }
        if constexpr (!Epi::AFTER_DRAIN) { E(acc, cur, wr, wc, fr, fq); S.done(cur); }
        if (!has_next) break;
        if constexpr (Epi::INIT) E.init(acc, nxt, wr, wc, fr, fq);
        else {
#pragma unroll
        for (int a = 0; a < 2; ++a)
#pragma unroll
            for (int b = 0; b < 2; ++b)
#pragma unroll
                for (int m = 0; m < 4; ++m)
#pragma unroll
                    for (int n = 0; n < 2; ++n) acc[a][b][m][n] = (f32x4){0.f, 0.f, 0.f, 0.f};
        }
        cur = nxt; cA = nA; cB = nB; ++ui;
        if constexpr (ALIGN_EPI) { if (wr == 1) PG8_BAR; }
    }
    PG8_WAIT_V(0);
    if constexpr (!ALIGN_EPI) { if (wr == 0) PG8_BAR; }
    PG8_BAR;
    if constexpr (Epi::AFTER_DRAIN) { E.fused(acc, cur, wr, wc, fr, fq, lds, wid, lane); S.done(cur); }
#undef PG8_SA
#undef PG8_SB
#undef PG8_STAGE
#undef PG8_LDA
#undef PG8_LDB
#undef PG8_MMA
#undef PG8_WAIT_V
#undef PG8_WAIT_L
#undef PG8_BAR
#undef PG8_SCHED
}
}
constexpr int NB = 8, SEQ = 2048, DM = 1024, M = NB * SEQ, NIN = 2560, DFF = 2816, NFF2 = 2 * DFF, DEPTH = 2;
constexpr int NWAVES = 8;
constexpr size_t MiB = 1u << 20;
constexpr size_t WS_ROWSS = 1 * MiB;
constexpr size_t WS_VGSS = 2 * MiB;
constexpr size_t WS_WSP = 3 * MiB;
constexpr size_t WS_W0 = 4 * MiB, WS_WSTRIDE = 24 * MiB;
constexpr size_t WOFF_IN = 0, WOFF_OUT = 5 * MiB, WOFF_FIN = 7 * MiB, WOFF_FOUT = 18 * MiB;
constexpr size_t WS_XB = 52 * MiB;
constexpr size_t WS_PROJ = 84 * MiB;
constexpr size_t WS_MIX = 164 * MiB;
constexpr size_t WS_HID = 84 * MiB;
constexpr size_t WS_END = 196 * MiB;
constexpr int LDS_BYTES = 147456;

#define GAS __attribute__((address_space(1)))
#define LAS __attribute__((address_space(3)))
typedef unsigned short bf16;
typedef unsigned v4u __attribute__((ext_vector_type(4)));
typedef float f32x4 __attribute__((ext_vector_type(4)));
__device__ __forceinline__ unsigned f2bf(float f) { unsigned u = __builtin_bit_cast(unsigned, f); return (u + 0x7fffu + ((u >> 16) & 1u)) >> 16; }
__device__ __forceinline__ unsigned pk2(float lo, float hi) { return f2bf(lo) | (f2bf(hi) << 16); }
__device__ __forceinline__ float bf2f(bf16 v) { return __builtin_bit_cast(float, (unsigned)v << 16); }
__device__ __forceinline__ float wave_sum(float v) {
#pragma unroll
    for (int o = 1; o < 64; o <<= 1) v += __shfl_xor(v, o);
    return v;
}
#define LDS_WAIT() asm volatile("s_waitcnt lgkmcnt(0)" ::: "memory")

typedef short tp_s16x4 __attribute__((ext_vector_type(4)));
__device__ __forceinline__ void p0_transpose_item(const float* W, int K, int N, bf16* WT, int k0, int n0, int prow0, int prow1, const float* gk, LAS unsigned char* scr, int lane) {
    const int lr = lane >> 4, n4 = (lane & 15) * 4;
    f32x4 v[16];
#pragma unroll
    for (int i = 0; i < 16; ++i) v[i] = *(const f32x4*)(W + (size_t)(k0 + 4 * i + lr) * N + n0 + n4);
#pragma unroll
    for (int i = 0; i < 16; ++i) { const int k = 4 * i + lr; const float gg = gk ? gk[k0 + k] : 1.f;
        unsigned long long w = (unsigned long long)pk2(v[i].x * gg, v[i].y * gg) | ((unsigned long long)pk2(v[i].z * gg, v[i].w * gg) << 32);
        *(LAS unsigned long long*)(scr + k * 128 + ((n4 * 2) ^ (((k >> 1) & 1) << 6))) = w; }
    asm volatile("" ::: "memory");
    const int hh = lane >> 5, g2 = (lane >> 4) & 1, i16 = lane & 15, qq = i16 >> 2, p4 = i16 & 3;
#pragma unroll
    for (int j = 0; j < 8; ++j) { const int c = 2 * (j >> 1) + hh, nb = 32 * (j & 1) + 16 * g2;
        const int a0 = (8 * c + qq) * 128 + (((nb + 4 * p4) * 2) ^ ((qq >> 1) << 6));
        const tp_s16x4 lo = __builtin_bit_cast(tp_s16x4, __builtin_amdgcn_ds_read_tr16_b64_v4i16((LAS tp_s16x4*)(scr + a0)));
        const tp_s16x4 hi4 = __builtin_bit_cast(tp_s16x4, __builtin_amdgcn_ds_read_tr16_b64_v4i16((LAS tp_s16x4*)(scr + a0 + 4 * 128)));
        typedef short s16x8_t __attribute__((ext_vector_type(8)));
        const s16x8_t o = (s16x8_t){lo[0], lo[1], lo[2], lo[3], hi4[0], hi4[1], hi4[2], hi4[3]};
        const int prow = ((j & 1) ? prow1 : prow0) + 16 * g2 + i16;
        *(s16x8_t*)(WT + (size_t)prow * K + k0 + 8 * c) = o; }
    LDS_WAIT(); asm volatile("" ::: "memory");
}
__host__ __device__ __forceinline__ int map_in(int n) { const int T = n >> 8, nn = n & 255; return 256 * T + 128 * ((nn >> 5) & 1) + 32 * (nn >> 6) + (nn & 31); }
__host__ __device__ __forceinline__ int map_fin(int n) { return n < DFF ? 256 * (n >> 7) + (n & 127) : 256 * ((n - DFF) >> 7) + 128 + ((n - DFF) & 127); }

typedef GAS unsigned gu32;
#define RLX_AGENT __ATOMIC_RELAXED, __HIP_MEMORY_SCOPE_AGENT
constexpr int MISC_OFF = LDS_BYTES - 64;
constexpr size_t WS_BAR = 0;
constexpr size_t BAR_ZERO_BYTES = 32768;
#define XB_TMO      128
#define XB_XCNT(j)  (256  + 64 * (j))
#define XB_XSUB(j)  (1280 + 64 * (j))
#define XB_XGEN(j)  (2304 + 64 * (j))
#define XB_TOP      3328
#define XB_TOPGEN   3392
#define XCD_BAR_WORDS 3456
#define XB_SPIN_CAP (1u << 18)

__device__ __forceinline__ unsigned xb_ld(unsigned* p)              { return __hip_atomic_load(p, __ATOMIC_RELAXED, __HIP_MEMORY_SCOPE_AGENT); }
__device__ __forceinline__ unsigned xb_add(unsigned* p, unsigned v) { return __hip_atomic_fetch_add(p, v, __ATOMIC_RELAXED, __HIP_MEMORY_SCOPE_AGENT); }
__device__ __forceinline__ unsigned xb_xcc_id() { return (unsigned)__builtin_amdgcn_s_getreg((3 << 11) | 20) & 0xFu; }
#define XB_SPIN(cond, bar) do { unsigned _sp = 0; while (cond) { __builtin_amdgcn_s_sleep(1); \
    if ((++_sp & 255u) == 0u) { if (xb_ld(&(bar)[XB_TMO])) break; if (_sp > XB_SPIN_CAP) { atomicAdd(&(bar)[XB_TMO], 1u); break; } } } } while (0)

struct XcdBarrier {
    unsigned* bar; unsigned x;
    volatile LAS unsigned* st;
};

__device__ __forceinline__ XcdBarrier xcd_barrier_post(unsigned* bar, volatile LAS unsigned* st) {
    XcdBarrier b; b.bar = bar; b.x = xb_xcc_id(); b.st = st;
    if (threadIdx.x == 0) (void)xb_add(&bar[XB_XCNT(b.x)], 1u);
    return b;
}
__device__ __forceinline__ void xcd_barrier_complete(unsigned* bar, unsigned x, unsigned& nloc, unsigned& nx) {
    const unsigned G = gridDim.x * gridDim.y * gridDim.z;
    unsigned sum, cnt, mine, sp = 0u;
    for (;;) {
        sum = 0u; cnt = 0u; mine = 0u;
#pragma unroll
        for (unsigned j = 0; j < 16; ++j) { const unsigned c = xb_ld(&bar[XB_XCNT(j)]); sum += c; cnt += (c > 0u) ? 1u : 0u; mine = (j == x) ? c : mine; }
        if (sum == G) break;
        __builtin_amdgcn_s_sleep(1);
        if ((++sp & 255u) == 0u) { if (xb_ld(&bar[XB_TMO])) break; if (sp > XB_SPIN_CAP) { atomicAdd(&bar[XB_TMO], 1u); break; } }
    }
    nloc = mine > 0u ? mine : 1u; nx = cnt > 0u ? cnt : 1u;
}

__device__ __forceinline__ void xcd_barrier(const XcdBarrier& b) {
    asm volatile("s_waitcnt vmcnt(0)" ::: "memory");
    __syncthreads();
    if (threadIdx.x == 0) {
        unsigned* bar = b.bar;
        __builtin_amdgcn_s_waitcnt(0);
        unsigned nloc = b.st[0], nx = b.st[1];
        if (nloc == 0u) { xcd_barrier_complete(bar, b.x, nloc, nx); b.st[0] = nloc; b.st[1] = nx; }
        const unsigned old = xb_add(&bar[XB_XSUB(b.x)], 1u);
        const unsigned gen = old / nloc;
        if (old + 1u == (gen + 1u) * nloc) {
            __builtin_amdgcn_fence(__ATOMIC_RELEASE, "agent");
            asm volatile("s_waitcnt vmcnt(0)" ::: "memory");
            const unsigned og = xb_add(&bar[XB_TOP], 1u);
            const unsigned tg = og / nx;
            if (og + 1u == (tg + 1u) * nx) xb_add(&bar[XB_TOPGEN], 1u);
            else XB_SPIN(xb_ld(&bar[XB_TOPGEN]) == tg, bar);
            __builtin_amdgcn_fence(__ATOMIC_ACQUIRE, "agent");
            xb_add(&bar[XB_XGEN(b.x)], 1u);
            asm volatile("s_waitcnt vmcnt(0)" ::: "memory");
        } else {
            XB_SPIN(xb_ld(&bar[XB_XGEN(b.x)]) == gen, bar);
            __builtin_amdgcn_fence(__ATOMIC_ACQUIRE, "agent");
            asm volatile("s_waitcnt vmcnt(0)" ::: "memory");
        }
    }
    __syncthreads();
}

constexpr size_t WS_GCNT = 16384, WS_GMASK = 16384 + 8 * 256;
__device__ __forceinline__ void group_barrier(unsigned char* ws, volatile LAS unsigned* misc) {
    asm volatile("s_waitcnt vmcnt(0)" ::: "memory");
    __syncthreads();
    if (threadIdx.x == 0) {
        unsigned bx = blockIdx.x; asm volatile("" : "+s"(bx));
        unsigned* cnt = (unsigned*)(ws + WS_GCNT) + 64 * (bx & 7u);
        const unsigned pure = misc[4], ep = misc[5] + 1u; misc[5] = ep;
        if (!pure) { __builtin_amdgcn_fence(__ATOMIC_RELEASE, "agent"); asm volatile("s_waitcnt vmcnt(0)" ::: "memory"); }
        (void)xb_add(cnt, 1u);
        const unsigned target = ep * (gridDim.x >> 3);
        unsigned sp = 0u;
        while (xb_ld(cnt) < target) { __builtin_amdgcn_s_sleep(1); if (++sp > (1u << 22)) break; }
        __builtin_amdgcn_fence(__ATOMIC_ACQUIRE, "agent");
        asm volatile("s_waitcnt vmcnt(0)" ::: "memory");
    }
    __syncthreads();
}
#define GROUP_BAR() group_barrier(kargs_ws(), (volatile LAS unsigned*)(lds + MISC_OFF))
#define GRID_BAR() do { XcdBarrier bar_; bar_.bar = (unsigned*)(kargs_ws() + WS_BAR); bar_.x = xb_xcc_id(); bar_.st = (volatile LAS unsigned*)(lds + MISC_OFF); xcd_barrier(bar_); } while (0)
struct Args { const float* in[15]; float* out; unsigned char* ws; };
typedef const __attribute__((address_space(4))) Args CArgs;
__device__ __forceinline__ CArgs* kargs();
__device__ __forceinline__ unsigned char* kargs_ws();
__device__ __forceinline__ CArgs* kargs() { CArgs* p = (CArgs*)__builtin_amdgcn_kernarg_segment_ptr(); asm volatile("" : "+s"(p)); return p; }
__device__ __forceinline__ unsigned char* kargs_ws() { return kargs()->ws; }

__device__ __forceinline__ void convert_weights(CArgs* a, LAS unsigned char* lds, int wave, int lane, int l0, int l1, int gw, int NGW) {
    LAS unsigned char* scr = lds + wave * 16384;
    constexpr int I_IN = (DM / 64) * (NIN / 64), I_OUT = (DM / 64) * (DM / 64), I_FIN = (DM / 64) * (NFF2 / 64), I_FOUT = (DFF / 64) * (DM / 64);
    constexpr int I_LAYER = I_IN + I_OUT + I_FIN + I_FOUT;
#pragma nounroll
    for (int it = l0 * I_LAYER + gw; it < l1 * I_LAYER; it += NGW) {
        const int l = it / I_LAYER; int r = it % I_LAYER;
        unsigned char* wb = a->ws + WS_W0 + (size_t)l * WS_WSTRIDE;
        if (r < I_IN) { const int nblk = NIN / 64, kb = r / nblk, nb = r % nblk;
            p0_transpose_item(a->in[2] + (size_t)l * DM * NIN, DM, NIN, (bf16*)(wb + WOFF_IN), 64 * kb, 64 * nb, map_in(64 * nb), map_in(64 * nb + 32), a->in[1] + l * DM, scr, lane); continue; } r -= I_IN;
        if (r < I_OUT) { const int nblk = DM / 64, kb = r / nblk, nb = r % nblk;
            p0_transpose_item(a->in[11] + (size_t)l * DM * DM, DM, DM, (bf16*)(wb + WOFF_OUT), 64 * kb, 64 * nb, 64 * nb, 64 * nb + 32, nullptr, scr, lane); continue; } r -= I_OUT;
        if (r < I_FIN) { const int nblk = NFF2 / 64, kb = r / nblk, nb = r % nblk;
            p0_transpose_item(a->in[13] + (size_t)l * DM * NFF2, DM, NFF2, (bf16*)(wb + WOFF_FIN), 64 * kb, 64 * nb, map_fin(64 * nb), map_fin(64 * nb + 32), a->in[12] + l * DM, scr, lane); continue; } r -= I_FIN;
        { const int nblk = DM / 64, kb = r / nblk, nb = r % nblk;
            p0_transpose_item(a->in[14] + (size_t)l * DFF * DM, DFF, DM, (bf16*)(wb + WOFF_FOUT), 64 * kb, 64 * nb, 64 * nb, 64 * nb + 32, nullptr, scr, lane); }
    }
}
__device__ __forceinline__ void prologue(CArgs* a, LAS unsigned char* lds, int wave, int lane) {
    const int gw = blockIdx.x * NWAVES + wave, NGW = gridDim.x * NWAVES;
    convert_weights(a, lds, wave, lane, 0, 1, gw, NGW);
    float* rowss = (float*)(a->ws + WS_ROWSS); bf16* xb = (bf16*)(a->ws + WS_XB);
    for (int m = gw; m < M; m += NGW) {
        const f32x4* xr = (const f32x4*)(a->in[0] + (size_t)m * DM) + lane;
        unsigned long long* o8 = (unsigned long long*)(xb + (size_t)m * DM) + lane;
        float s = 0.f;
#pragma unroll
        for (int j = 0; j < 4; ++j) { const f32x4 v = xr[64 * j]; s += (v.x * v.x + v.y * v.y) + (v.z * v.z + v.w * v.w);
            o8[64 * j] = (unsigned long long)pk2(v.x, v.y) | ((unsigned long long)pk2(v.z, v.w) << 32); }
        s = wave_sum(s);
        if (lane < 4) rowss[(size_t)m * 4 + lane] = lane == 0 ? s : 0.f;
    }
    { const float* wsp = a->in[7]; bf16* o = (bf16*)(a->ws + WS_WSP); const int gt = blockIdx.x * 512 + threadIdx.x, NT = gridDim.x * 512;
      for (int i = gt; i < DEPTH * 8 * 128 * 128; i += NT) { const int s = i & 127, t = (i >> 7) & 127; o[i] = (bf16)(((t >> 6) >= (s >> 6)) ? f2bf(wsp[i]) : 0u); } }
}

__device__ __forceinline__ void mixer_naive(CArgs* a, int l, LAS unsigned char* lds, int wave, int lane) {
    const bf16* P = (const bf16*)(a->ws + WS_PROJ); bf16* MIX = (bf16*)(a->ws + WS_MIX);
    const float* vgss = (const float*)(a->ws + WS_VGSS); const bf16* wsp = (const bf16*)(a->ws + WS_WSP) + (size_t)l * 8 * 128 * 128;
    const float* rel = a->in[5] + (size_t)l * 8 * 257; const float* sgu_g = a->in[6] + l * 512; const float* bsp = a->in[8] + l * 8 * 128;
    const float* ag = a->in[9] + l * 512; const float* gg = a->in[10] + l * 512;
    LAS float* red = (LAS float*)lds;
    for (int tok = blockIdx.x; tok < M; tok += gridDim.x) {
        const int b = tok / SEQ, t = tok % SEQ, c = t >> 6;
        const int h = wave;
        const float q = bf2f(P[(size_t)tok * NIN + h * 64 + lane]);
        float mx = -INFINITY, lsum = 0.f, o = 0.f;
        const int k0 = (c >= 8 ? c - 8 : 0) * 64, k1 = c * 64 + 63;
        for (int kt = k0; kt <= k1; ++kt) {
            const size_t kr = (size_t)(b * SEQ + kt) * NIN;
            float s = wave_sum(q * bf2f(P[kr + 512 + h * 64 + lane]));
            int d = t - kt; d = d < -128 ? -128 : (d > 128 ? 128 : d);
            s += rel[h * 257 + d + 128] * pg8::LOG2E;
            const float mn = fmaxf(mx, s), al = __builtin_amdgcn_exp2f(mx - mn), p = __builtin_amdgcn_exp2f(s - mn);
            lsum = lsum * al + p; o = o * al + p * bf2f(P[kr + 1024 + h * 64 + lane]); mx = mn;
        }
        o = o / lsum;
        const int g = wave, nb = t >> 7, tp = t & 127, ns = tp < 64 ? 64 : 128;
        float mixd = 0.f;
        for (int s = 0; s < ns; ++s) {
            const int srow = b * SEQ + nb * 128 + s;
            const f32x4* pv = (const f32x4*)(vgss + (size_t)srow * 8); const f32x4 p0 = pv[0], p1 = pv[1];
            const float rs = __builtin_amdgcn_rsqf((((p0[0] + p0[1]) + (p0[2] + p0[3])) + ((p1[0] + p1[1]) + (p1[2] + p1[3]))) * (1.0f / 512.0f) + pg8::RMS_EPS);
            mixd += bf2f(wsp[(g * 128 + tp) * 128 + s]) * (bf2f(P[(size_t)srow * NIN + 2048 + g * 64 + lane]) * rs * sgu_g[g * 64 + lane]);
        }
        const float gv = bf2f(P[(size_t)tok * NIN + 1536 + g * 64 + lane]) * (mixd + bsp[g * 128 + tp]);
        const float so = wave_sum(o * o), sg = wave_sum(gv * gv);
        __syncthreads();
        if (lane == 0) { red[wave] = so; red[8 + wave] = sg; }
        __syncthreads();
        float ta = 0.f, tg = 0.f;
#pragma unroll
        for (int w = 0; w < 8; ++w) { ta += red[w]; tg += red[8 + w]; }
        const float ra = __builtin_amdgcn_rsqf(ta * (1.0f / 512.0f) + pg8::RMS_EPS), rg = __builtin_amdgcn_rsqf(tg * (1.0f / 512.0f) + pg8::RMS_EPS);
        MIX[(size_t)tok * DM + h * 64 + lane] = (bf16)f2bf(o * ra * ag[h * 64 + lane]);
        MIX[(size_t)tok * DM + 512 + g * 64 + lane] = (bf16)f2bf(gv * rg * gg[g * 64 + lane]);
    }
    __syncthreads();
}

#ifndef FAST_MIXER
#define FAST_MIXER 1
#endif
#ifndef PHM
#define PHM 31
#endif
#ifndef REPM
#define REPM 0
#endif
#define REPEAT(bit) for (int rep_ = 0; rep_ < (((REPM) >> (bit)) & 1) + 1; ++rep_)
namespace mx {
typedef float f32x16 __attribute__((ext_vector_type(16)));
typedef short bf16x8 __attribute__((ext_vector_type(8)));
typedef short s16x4 __attribute__((ext_vector_type(4)));
typedef unsigned u32x2 __attribute__((ext_vector_type(2)));
constexpr int TBL_OFF = 131072;
constexpr int TBL_LD = 320;
constexpr int RS_OFF = TBL_OFF + 8 * TBL_LD * 4 + 4096;
constexpr int RED_OFF = TBL_OFF + 8 * TBL_LD * 4;
__device__ __forceinline__ int crow(int r, int hi) { return (r & 3) + 8 * (r >> 2) + 4 * hi; }
__device__ __forceinline__ int vimg(int row, int chunk) { return row * 128 + ((chunk * 16) ^ (((row >> 1) & 1) << 6)); }
__device__ __forceinline__ s16x4 tr64(LAS unsigned char* p) { return __builtin_bit_cast(s16x4, __builtin_amdgcn_ds_read_tr16_b64_v4i16((LAS s16x4*)p)); }
__device__ __forceinline__ bf16x8 cat8(s16x4 a, s16x4 b) { return (bf16x8){a[0], a[1], a[2], a[3], b[0], b[1], b[2], b[3]}; }
__device__ __forceinline__ unsigned cvtpk(float lo, float hi) { unsigned r; asm("v_cvt_pk_bf16_f32 %0, %1, %2" : "=v"(r) : "v"(lo), "v"(hi)); return r; }
#define MX_FENCE() asm volatile("" ::: "memory")
__device__ __forceinline__ float max3f(float a, float b, float c) { float r; asm("v_max3_f32 %0, %1, %2, %3" : "=v"(r) : "v"(a), "v"(b), "v"(c)); return r; }

__device__ __forceinline__ void attn_task(const bf16* P, int b, int c, int h, LAS unsigned char* wl, const LAS float* tbl, int lane, f32x16 (&o)[2][2]) {
    const int r32 = lane & 31, hi = lane >> 5;
    const size_t tok0 = (size_t)b * SEQ + c * 64;
    bf16x8 qf[2][4];
#pragma unroll
    for (int qt = 0; qt < 2; ++qt)
#pragma unroll
        for (int d0 = 0; d0 < 4; ++d0) qf[qt][d0] = *(const bf16x8*)(P + (tok0 + 32 * qt + r32) * NIN + h * 64 + d0 * 16 + hi * 8);
#pragma unroll
    for (int r = 0; r < 16; ++r) { o[0][0][r] = 0.f; o[0][1][r] = 0.f; o[1][0][r] = 0.f; o[1][1][r] = 0.f; }
    float m[2] = {-INFINITY, -INFINITY}, l[2] = {0.f, 0.f};
    const int kc0 = c >= 8 ? c - 8 : 0;
    const int dhalf = (lane >> 4) & 1, qq = (lane & 15) >> 2, p4 = lane & 3;
    int vb[2];
#pragma unroll
    for (int dt = 0; dt < 2; ++dt) vb[dt] = 8192 + (4 * hi + qq) * 128 + ((64 * dt + 32 * dhalf + 8 * p4) ^ ((qq >> 1) << 6));
    const int prow = lane >> 3, pch = lane & 7;
    const unsigned voff = (unsigned)(prow * NIN + (pch ^ (((lane >> 4) & 1) << 2)) * 8) * 2u;
    const unsigned koff0 = (unsigned)(prow * NIN + (pch ^ (lane >> 4)) * 8) * 2u, koff1 = (unsigned)(prow * NIN + (pch ^ (lane >> 4) ^ 4) * 8) * 2u;
    const int swz = (r32 >> 1) & 7;
    int ka[4];
#pragma unroll
    for (int d0 = 0; d0 < 4; ++d0) ka[d0] = r32 * 128 + (((2 * d0 + hi) ^ swz) * 16);
#define MX_DMAK(kc) do { const char* kp_ = (const char*)(P + ((size_t)b * SEQ + (kc) * 64) * NIN + 512 + h * 64); \
        _Pragma("unroll") for (int i = 0; i < 8; ++i) __builtin_amdgcn_global_load_lds((const unsigned*)(kp_ + (size_t)(i * 8 * NIN) * 2 + ((i & 1) ? koff1 : koff0)), (LAS unsigned*)(wl + i * 1024), 16, 0, 0); } while (0)
#define MX_DMAV(kc) do { const char* vp_ = (const char*)(P + ((size_t)b * SEQ + (kc) * 64) * NIN + 1024 + h * 64); \
        _Pragma("unroll") for (int i = 0; i < 8; ++i) __builtin_amdgcn_global_load_lds((const unsigned*)(vp_ + (size_t)(i * 8 * NIN) * 2 + voff), (LAS unsigned*)(wl + 8192 + i * 1024), 16, 0, 0); } while (0)
    MX_DMAK(kc0);
    for (int kc = kc0; kc <= c; ++kc) {
        const int j = kc - c + 8;
        MX_DMAV(kc);
        asm volatile("s_waitcnt vmcnt(8)" ::: "memory");
        bf16x8 kf[2][4];
#pragma unroll
        for (int kt = 0; kt < 2; ++kt)
#pragma unroll
            for (int d0 = 0; d0 < 4; ++d0) kf[kt][d0] = *(const LAS bf16x8*)(wl + kt * 4096 + ka[d0]);
        asm volatile("s_waitcnt lgkmcnt(0)" ::: "memory");
        if (kc < c) MX_DMAK(kc + 1);
#pragma unroll
        for (int qt = 0; qt < 2; ++qt) {
            f32x16 st[2];
            float badd = 0.f;
            if (j <= 5) { badd = tbl[256];
#pragma unroll
                for (int r = 0; r < 16; ++r) { st[0][r] = 0.f; st[1][r] = 0.f; } }
            else { const LAS float* tb = tbl + (64 * (8 - j) + 32 * qt + r32 - 4 * hi + 128 - 63);
#pragma unroll
                for (int kt = 0; kt < 2; ++kt)
#pragma unroll
                    for (int r = 0; r < 16; ++r) st[kt][r] = tb[63 - (32 * kt + (r & 3) + 8 * (r >> 2))]; }
#pragma unroll
            for (int kt = 0; kt < 2; ++kt)
#pragma unroll
                for (int d0 = 0; d0 < 4; ++d0) st[kt] = __builtin_amdgcn_mfma_f32_32x32x16_bf16(kf[kt][d0], qf[qt][d0], st[kt], 0, 0, 0);
            asm volatile("s_nop 15\n\ts_nop 7" : "+v"(st[0]), "+v"(st[1]));
            float mxa = max3f(st[0][0], st[0][1], st[0][2]), mxb = max3f(st[1][0], st[1][1], st[1][2]);
#pragma unroll
            for (int r = 3; r < 15; r += 2) { mxa = max3f(mxa, st[0][r], st[0][r + 1]); mxb = max3f(mxb, st[1][r], st[1][r + 1]); }
            float mxv = max3f(mxa, mxb, st[0][15]); mxv = max3f(mxv, st[1][15], mxv);
            mxv = max3f(mxv, __shfl_xor(mxv, 32), mxv) + badd;
            const float mn = max3f(m[qt], mxv, mxv), al = __builtin_amdgcn_exp2f(m[qt] - mn), sub = mn - badd; m[qt] = mn;
            float rs = 0.f;
#pragma unroll
            for (int kt = 0; kt < 2; ++kt)
#pragma unroll
                for (int r = 0; r < 16; ++r) { const float p = __builtin_amdgcn_exp2f(st[kt][r] - sub); st[kt][r] = p; rs += p; }
            l[qt] = l[qt] * al + rs;
#pragma unroll
            for (int r = 0; r < 16; ++r) { o[qt][0][r] *= al; o[qt][1][r] *= al; }
            bf16x8 pf[4];
#pragma unroll
            for (int s = 0; s < 4; ++s) { v4u w; const int kt = s >> 1, r0 = 8 * (s & 1);
                w.x = cvtpk(st[kt][r0 + 0], st[kt][r0 + 1]); w.y = cvtpk(st[kt][r0 + 2], st[kt][r0 + 3]); w.z = cvtpk(st[kt][r0 + 4], st[kt][r0 + 5]); w.w = cvtpk(st[kt][r0 + 6], st[kt][r0 + 7]);
                pf[s] = __builtin_bit_cast(bf16x8, w); }
            if (qt == 0) { if (kc < c) asm volatile("s_waitcnt vmcnt(8)" ::: "memory"); else asm volatile("s_waitcnt vmcnt(0)" ::: "memory"); }
#pragma unroll
            for (int dt = 0; dt < 2; ++dt) { s16x4 va[4], vc[4]; const unsigned vaddr = (unsigned)(uintptr_t)(wl + vb[dt]);
#pragma unroll
                for (int s = 0; s < 4; ++s) { asm volatile("ds_read_b64_tr_b16 %0, %1 offset:%c2" : "=&v"(va[s]) : "v"(vaddr), "i"(16 * s * 128) : "memory");
                                              asm volatile("ds_read_b64_tr_b16 %0, %1 offset:%c2" : "=&v"(vc[s]) : "v"(vaddr), "i"((16 * s + 8) * 128) : "memory"); }
                asm volatile("s_waitcnt lgkmcnt(0)" : "+v"(va[0]), "+v"(va[1]), "+v"(va[2]), "+v"(va[3]), "+v"(vc[0]), "+v"(vc[1]), "+v"(vc[2]), "+v"(vc[3]) :: "memory");
#pragma unroll
                for (int s = 0; s < 4; ++s) o[qt][dt] = __builtin_amdgcn_mfma_f32_32x32x16_bf16(cat8(va[s], vc[s]), pf[s], o[qt][dt], 0, 0, 0); }
        }
        MX_FENCE();
    }
#undef MX_DMAK
#undef MX_DMAV
#pragma unroll
    for (int qt = 0; qt < 2; ++qt) { float lt = l[qt]; lt += __shfl_xor(lt, 32); const float inv = 1.0f / lt;
#pragma unroll
        for (int r = 0; r < 16; ++r) { o[qt][0][r] *= inv; o[qt][1][r] *= inv; } }
}

__device__ __forceinline__ void sgu_task(const bf16* P, const LAS float* rstab, const bf16* wsp_l, const float* sgu_g, const float* bsp_l, int b, int c, int g, LAS unsigned char* wl, int lane_in, f32x16 (&o)[2][2]) {
    int lane = lane_in; asm volatile("" : "+v"(lane));
    const int r32 = lane & 31, hi = lane >> 5;
    const int nb = c >> 1, cb = c & 1, ns = cb ? 128 : 64;
    const size_t srow0 = (size_t)b * SEQ + nb * 128, tok0 = (size_t)b * SEQ + c * 64;
    const int prow = lane >> 3, pch = lane & 7;
    const f32x4 g0 = *(const f32x4*)(sgu_g + g * 64 + pch * 8), g1 = *(const f32x4*)(sgu_g + g * 64 + pch * 8 + 4);
    MX_FENCE();
#pragma unroll
    for (int hb = 0; hb < 2; ++hb) {
        if (hb * 64 < ns) {
            v4u raw[8];
#pragma unroll
            for (int i = 0; i < 8; ++i) raw[i] = *(const v4u*)(P + (srow0 + hb * 64 + prow + 8 * i) * NIN + 2048 + g * 64 + pch * 8);
#pragma unroll
            for (int i = 0; i < 8; ++i) { const int row = hb * 64 + prow + 8 * i; const float rs = rstab[row];
                v4u w;
                w.x = cvtpk(__builtin_bit_cast(float, raw[i].x << 16) * rs * g0[0], __builtin_bit_cast(float, raw[i].x & 0xffff0000u) * rs * g0[1]);
                w.y = cvtpk(__builtin_bit_cast(float, raw[i].y << 16) * rs * g0[2], __builtin_bit_cast(float, raw[i].y & 0xffff0000u) * rs * g0[3]);
                w.z = cvtpk(__builtin_bit_cast(float, raw[i].z << 16) * rs * g1[0], __builtin_bit_cast(float, raw[i].z & 0xffff0000u) * rs * g1[1]);
                w.w = cvtpk(__builtin_bit_cast(float, raw[i].w << 16) * rs * g1[2], __builtin_bit_cast(float, raw[i].w & 0xffff0000u) * rs * g1[3]);
                *(LAS v4u*)(wl + vimg(row, pch)) = w; }
        }
    }
    MX_FENCE();
#pragma unroll
    for (int r = 0; r < 16; ++r) { o[0][0][r] = 0.f; o[0][1][r] = 0.f; o[1][0][r] = 0.f; o[1][1][r] = 0.f; }
    const int dhalf = (lane >> 4) & 1, qq = (lane & 15) >> 2, p4 = lane & 3;
    int vbs[2];
#pragma unroll
    for (int ct = 0; ct < 2; ++ct) vbs[ct] = (8 * hi + qq) * 128 + ((64 * ct + 32 * dhalf + 8 * p4) ^ ((qq >> 1) << 6));
    const bf16* wrow = wsp_l + ((size_t)g * 128 + cb * 64 + r32) * 128 + hi * 8;
#pragma unroll 2
    for (int step = 0; step < ns / 16; ++step) {
        const bf16x8 wf0 = *(const bf16x8*)(wrow + 16 * step), wf1 = *(const bf16x8*)(wrow + 32 * 128 + 16 * step);
#pragma unroll
        for (int ct = 0; ct < 2; ++ct) { const s16x4 a0 = tr64(wl + vbs[ct] + (16 * step) * 128), a1 = tr64(wl + vbs[ct] + (16 * step + 4) * 128);
            const bf16x8 af = cat8(a0, a1);
            o[0][ct] = __builtin_amdgcn_mfma_f32_32x32x16_bf16(af, wf0, o[0][ct], 0, 0, 0);
            o[1][ct] = __builtin_amdgcn_mfma_f32_32x32x16_bf16(af, wf1, o[1][ct], 0, 0, 0); }
    }
    MX_FENCE();
#pragma unroll
    for (int tt = 0; tt < 2; ++tt) {
        const float bt = bsp_l[g * 128 + cb * 64 + 32 * tt + r32];
        const bf16* up = P + (tok0 + 32 * tt + r32) * NIN + 1536 + g * 64 + 4 * hi;
#pragma unroll
        for (int ct = 0; ct < 2; ++ct)
#pragma unroll
            for (int rg = 0; rg < 4; ++rg) { const u32x2 uu = *(const u32x2*)(up + 32 * ct + 8 * rg);
                o[tt][ct][4 * rg + 0] = __builtin_bit_cast(float, uu.x << 16) * (o[tt][ct][4 * rg + 0] + bt); o[tt][ct][4 * rg + 1] = __builtin_bit_cast(float, uu.x & 0xffff0000u) * (o[tt][ct][4 * rg + 1] + bt);
                o[tt][ct][4 * rg + 2] = __builtin_bit_cast(float, uu.y << 16) * (o[tt][ct][4 * rg + 2] + bt); o[tt][ct][4 * rg + 3] = __builtin_bit_cast(float, uu.y & 0xffff0000u) * (o[tt][ct][4 * rg + 3] + bt); }
    }
}

__device__ __forceinline__ void norm_store(const f32x16 (&o)[2][2], LAS float* red, int wave, int lane_in, const float* gain, bf16* dst) {
    int lane = lane_in; asm volatile("" : "+v"(lane));
    const int r32 = lane & 31, hi = lane >> 5;
#pragma unroll
    for (int tt = 0; tt < 2; ++tt) { float ss = 0.f;
#pragma unroll
        for (int r = 0; r < 16; ++r) ss += o[tt][0][r] * o[tt][0][r] + o[tt][1][r] * o[tt][1][r];
        ss += __shfl_xor(ss, 32);
        if (hi == 0) red[wave * 64 + tt * 32 + r32] = ss; }
    __syncthreads();
#pragma unroll
    for (int tt = 0; tt < 2; ++tt) { float tot = 0.f;
#pragma unroll
        for (int w = 0; w < 8; ++w) tot += red[w * 64 + tt * 32 + r32];
        const float rn = __builtin_amdgcn_rsqf(tot * (1.0f / 512.0f) + pg8::RMS_EPS);
#pragma unroll
        for (int ct = 0; ct < 2; ++ct)
#pragma unroll
            for (int rg = 0; rg < 4; ++rg) { const int ch = 32 * ct + 8 * rg + 4 * hi; const f32x4 gv = *(const f32x4*)(gain + ch);
                u32x2 w; w.x = cvtpk(o[tt][ct][4 * rg + 0] * rn * gv[0], o[tt][ct][4 * rg + 1] * rn * gv[1]); w.y = cvtpk(o[tt][ct][4 * rg + 2] * rn * gv[2], o[tt][ct][4 * rg + 3] * rn * gv[3]);
                *(u32x2*)(dst + (size_t)(32 * tt + r32) * DM + ch) = w; } }
}

__device__ __forceinline__ void mixer_fast(CArgs* a, int l, LAS unsigned char* lds, int wave, int lane) {
    const bf16* P = (const bf16*)(a->ws + WS_PROJ); bf16* MIX = (bf16*)(a->ws + WS_MIX);
    const float* vgss = (const float*)(a->ws + WS_VGSS); const bf16* wsp_l = (const bf16*)(a->ws + WS_WSP) + (size_t)l * 8 * 128 * 128;
    const float* rel = a->in[5] + (size_t)l * 8 * 257; const float* sgu_g = a->in[6] + l * 512; const float* bsp_l = a->in[8] + l * 8 * 128;
    const float* ag = a->in[9] + l * 512; const float* gg = a->in[10] + l * 512;
    LAS float* tbl = (LAS float*)(lds + TBL_OFF); LAS float* red = (LAS float*)(lds + RED_OFF); LAS float* rstab = (LAS float*)(lds + RS_OFF);
    for (int i = threadIdx.x; i < 8 * TBL_LD; i += NWAVES * 64) { const int h = i / TBL_LD, k = i % TBL_LD; tbl[i] = rel[h * 257 + (k < 256 ? k : 256)] * pg8::LOG2E; }
    __syncthreads();
    LAS unsigned char* wl = lds + wave * 16384;
    for (int u = blockIdx.x; u < NB * (SEQ / 64); u += gridDim.x) {
        const int b = u & 7, c = u >> 3;
        const size_t tok0 = (size_t)b * SEQ + c * 64;
        if (threadIdx.x < 128) {
            const size_t srow = (size_t)b * SEQ + (c >> 1) * 128 + threadIdx.x;
            const f32x4 p0 = *(const f32x4*)(vgss + srow * 8), p1 = *(const f32x4*)(vgss + srow * 8 + 4);
            rstab[threadIdx.x] = __builtin_amdgcn_rsqf((((p0[0] + p0[1]) + (p0[2] + p0[3])) + ((p1[0] + p1[1]) + (p1[2] + p1[3]))) * (1.0f / 512.0f) + pg8::RMS_EPS); }
        f32x16 o[2][2];
        REPEAT(7) attn_task(P, b, c, wave, wl, tbl + wave * TBL_LD, lane, o);
        norm_store(o, red, wave, lane, ag + wave * 64, MIX + tok0 * DM + wave * 64);
        REPEAT(8) sgu_task(P, rstab, wsp_l, sgu_g, bsp_l, b, c, wave, wl, lane, o);
        norm_store(o, red + 512, wave, lane, gg + wave * 64, MIX + tok0 * DM + 512 + wave * 64);
    }
    __syncthreads();
}
}

__global__ void __launch_bounds__(NWAVES * 64, 2) fwd_megakernel(Args a_unused) {
    extern __shared__ __attribute__((aligned(16))) unsigned char lds_raw[];
    LAS unsigned char* lds = (LAS unsigned char*)lds_raw;
    if (threadIdx.x < 16) ((LAS unsigned*)(lds + MISC_OFF))[threadIdx.x] = 0u;
    __syncthreads();
    (void)xcd_barrier_post((unsigned*)(kargs_ws() + WS_BAR), (volatile LAS unsigned*)(lds + MISC_OFF));
    { const int tid = threadIdx.x, lane = tid & 63, wave = __builtin_amdgcn_readfirstlane(tid >> 6);
      REPEAT(0) prologue(kargs(), lds, wave, lane);
      if (tid == 0) __hip_atomic_fetch_or((unsigned*)(kargs_ws() + WS_GMASK) + 64 * (blockIdx.x & 7), 1u << xb_xcc_id(), __ATOMIC_RELAXED, __HIP_MEMORY_SCOPE_AGENT); }
    GRID_BAR();
    if (threadIdx.x == 0) { const unsigned mk = xb_ld((unsigned*)(kargs_ws() + WS_GMASK) + 64 * (blockIdx.x & 7)); ((volatile LAS unsigned*)(lds + MISC_OFF))[4] = (__builtin_popcount(mk) == 1) ? 1u : 0u; }
#if (REPM >> 6) & 1
    for (int i_ = 0; i_ < 10; ++i_) GRID_BAR();
#endif
#pragma nounroll
    for (int l = 0; l < DEPTH; ++l) {
#if PHM & 1
        REPEAT(1) {
            CArgs* a = kargs(); unsigned char* ws = a->ws; unsigned char* wb = ws + WS_W0 + (size_t)l * WS_WSTRIDE;
            pg8::Gemm g{(const bf16*)(ws + WS_XB), (const bf16*)(wb + WOFF_IN), M, NIN, DM}; pg8::StaticOrder S; S.init(M, NIN, (int)gridDim.x, (int)blockIdx.x);
            pg8::EpiInProj E{(bf16*)(ws + WS_PROJ), (const float*)(ws + WS_ROWSS), (float*)(ws + WS_VGSS), a->in[3] + l * 64, a->in[4] + l * 64};
            pg8::gemm_phase<pg8::EpiInProj, pg8::StaticOrder, true, true>(lds, g, S, E);
        }
#endif
        if (l == 0 && 2 * blockIdx.x >= gridDim.x) {
            int tid = threadIdx.x; asm volatile("" : "+v"(tid)); const int lane = tid & 63, wave = __builtin_amdgcn_readfirstlane(tid >> 6);
            const int half = gridDim.x - gridDim.x / 2;
            convert_weights(kargs(), lds, wave, lane, 1, 2, (blockIdx.x - gridDim.x / 2) * NWAVES + wave, half * NWAVES);
        }
        GROUP_BAR();
#if PHM & 2
        REPEAT(2) { int tid = threadIdx.x; asm volatile("" : "+v"(tid)); const int lane = tid & 63, wave = __builtin_amdgcn_readfirstlane(tid >> 6);
#if FAST_MIXER
          mx::mixer_fast(kargs(), l, lds, wave, lane);
#else
          mixer_naive(kargs(), l, lds, wave, lane);
#endif
        }
#endif
        GROUP_BAR();
#if PHM & 4
        REPEAT(3) {
            CArgs* a = kargs(); unsigned char* ws = a->ws; unsigned char* wb = ws + WS_W0 + (size_t)l * WS_WSTRIDE; float* xo = a->out;
            float* xw = (((REPM >> 3) & 1) && rep_ == 0) ? (float*)(ws + 84 * MiB) : xo;
            pg8::Gemm g{(const bf16*)(ws + WS_MIX), (const bf16*)(wb + WOFF_OUT), M, DM, DM}; pg8::StaticOrder S; S.init(M, DM, (int)gridDim.x, (int)blockIdx.x);
            pg8::EpiResid E{l == 0 ? a->in[0] : (const float*)xo, xw, (bf16*)(ws + WS_XB), (float*)(ws + WS_ROWSS), 1};
            pg8::gemm_phase<pg8::EpiResid, pg8::StaticOrder, false, true>(lds, g, S, E);
        }
#endif
        GROUP_BAR();
#if PHM & 8
        REPEAT(4) {
            CArgs* a = kargs(); unsigned char* ws = a->ws; unsigned char* wb = ws + WS_W0 + (size_t)l * WS_WSTRIDE;
            pg8::Gemm g{(const bf16*)(ws + WS_XB), (const bf16*)(wb + WOFF_FIN), M, NFF2, DM}; pg8::StaticOrder S; S.init(M, NFF2, (int)gridDim.x, (int)blockIdx.x);
            pg8::EpiSwiGLU E{(bf16*)(ws + WS_HID), (const float*)(ws + WS_ROWSS)};
            pg8::gemm_phase<pg8::EpiSwiGLU, pg8::StaticOrder, true, true>(lds, g, S, E);
        }
#endif
        GROUP_BAR();
#if PHM & 16
        REPEAT(5) {
            CArgs* a = kargs(); unsigned char* ws = a->ws; unsigned char* wb = ws + WS_W0 + (size_t)l * WS_WSTRIDE; float* xo = a->out;
            float* xw = (((REPM >> 5) & 1) && rep_ == 0) ? (float*)(ws + 192 * MiB) : xo;
            pg8::Gemm g{(const bf16*)(ws + WS_HID), (const bf16*)(wb + WOFF_FOUT), M, DM, DFF}; pg8::StaticOrder S; S.init(M, DM, (int)gridDim.x, (int)blockIdx.x);
            pg8::EpiResid E{xo, xw, (bf16*)(ws + WS_XB), (float*)(ws + WS_ROWSS), l + 1 < DEPTH ? 1 : 0};
            pg8::gemm_phase<pg8::EpiResid, pg8::StaticOrder, false, true>(lds, g, S, E);
        }
#endif
        if (l + 1 < DEPTH) GRID_BAR();
    }
}

extern "C" void kernel_launch(void* const* d_in, const int* in_sizes, int n_in, void* d_out, int out_size, void* d_ws, size_t ws_size, hipStream_t stream) {
    static int grid = 0;
    if (grid == 0) {
        if (n_in != 15 || in_sizes[0] != M * DM || out_size != M * DM || ws_size < WS_END) { fprintf(stderr, "kernel_launch: unexpected shapes (n_in %d, ws %zu)\n", n_in, ws_size); grid = -1; return; }
        int dev = 0, cus = 0, per_cu = 0;
        hipGetDevice(&dev); hipDeviceGetAttribute(&cus, hipDeviceAttributeMultiprocessorCount, dev);
        if (hipFuncSetAttribute((const void*)fwd_megakernel, hipFuncAttributeMaxDynamicSharedMemorySize, LDS_BYTES) != hipSuccess) { fprintf(stderr, "kernel_launch: hipFuncSetAttribute failed\n"); grid = -1; return; }
        if (hipOccupancyMaxActiveBlocksPerMultiprocessor(&per_cu, (const void*)fwd_megakernel, NWAVES * 64, LDS_BYTES) != hipSuccess || per_cu < 1) { fprintf(stderr, "kernel_launch: occupancy query failed (%d)\n", per_cu); (void)hipGetLastError(); per_cu = 1; }
        grid = cus * (per_cu > 1 ? 1 : per_cu);
        if (grid != 256) { fprintf(stderr, "kernel_launch: built for a 256-CU device (one 256x256 unit per workgroup in the N = 1024 phases); got %d\n", grid); grid = -1; return; }
    }
    if (grid < 0) return;
    if (hipMemsetAsync((char*)d_ws + WS_BAR, 0, BAR_ZERO_BYTES, stream) != hipSuccess) { fprintf(stderr, "kernel_launch: hipMemsetAsync failed\n"); return; }
    Args a{};
    for (int i = 0; i < 15; ++i) a.in[i] = (const float*)d_in[i];
    a.out = (float*)d_out; a.ws = (unsigned char*)d_ws;
    void* args[] = {&a};
    hipError_t e = hipLaunchCooperativeKernel((const void*)fwd_megakernel, dim3(grid), dim3(NWAVES * 64), args, LDS_BYTES, stream);
    if (e != hipSuccess) fprintf(stderr, "cooperative launch failed: %s (grid %d)\n", hipGetErrorString(e), grid);
}
```

```cpp
#include <hip/hip_runtime.h>
#include <hip/hip_cooperative_groups.h>
#include <cstdio>
#include <cstdint>
namespace cg = cooperative_groups;
namespace pg8 {
#define PG8_LAS __attribute__((address_space(3)))
typedef unsigned short bf16_t;
typedef short bf16x8 __attribute__((ext_vector_type(8)));
typedef float f32x4 __attribute__((ext_vector_type(4)));
typedef unsigned u32x4 __attribute__((ext_vector_type(4)));
constexpr int BM = 256, BK = 64, HALF = 128, HTB = HALF * BK * 2  , STAGE_BYTES = 8 * HTB, NXCD = 8, WGM = 8;

__host__ __device__ __forceinline__ int lds_byte(int r, int c) { const int st = (r >> 4) * 2 + (c >> 5), rr = r & 15, cc = c & 31, ob = rr * 64 + cc * 2; return st * 1024 + (ob ^ (((ob >> 9) & 1) << 5)); }
__host__ __device__ __forceinline__ void stage_rc(int b, int& R, int& C) { const int st = b / 1024, sb = b % 1024, swz = sb ^ (((sb >> 9) & 1) << 5); R = (st >> 1) * 16 + swz / 64; C = (st & 1) * 32 + (swz % 64) / 2; }
__host__ __device__ __forceinline__ int perm32(int rho) { const int n = rho >> 4, i = rho & 15; return 8 * (i >> 2) + 4 * n + (i & 3); }

struct Unit { int pm, pn; };
struct Gemm { const bf16_t* A; const bf16_t* Bt; int M, N, K; };

struct StaticOrder {
    int nM, nN, nwg, G, c;
    __host__ __device__ void init(int M, int N, int G_, int c_) { nM = M / BM; nN = N / BM; nwg = nM * nN; G = G_; c = c_; }
    __host__ __device__ bool next(int i, Unit& u) const {
        const long L = (long)i * G + c; if (L >= nwg) return false;
        int wgid = (int)L; { const int q = nwg / NXCD, r = nwg % NXCD, xcd = wgid % NXCD, off = wgid / NXCD; wgid = (xcd < r ? xcd * (q + 1) : r * (q + 1) + (xcd - r) * q) + off; }
        const int nig = WGM * nN, gid = wgid / nig, fm = gid * WGM, gsz = (nM - fm) < WGM ? (nM - fm) : WGM;
        u.pm = fm + ((wgid % nig) % gsz); u.pn = (wgid % nig) / gsz; return true;
    }
    __device__ __forceinline__ void a_ready(const Unit&) const {}
    __device__ __forceinline__ void done(const Unit&) const {}
};

__device__ __forceinline__ unsigned cvt_pk_bf16(float lo, float hi) { unsigned r; asm volatile("v_cvt_pk_bf16_f32 %0, %1, %2" : "=v"(r) : "v"(lo), "v"(hi)); return r; }
typedef float f32x2 __attribute__((ext_vector_type(2)));
constexpr float RMS_EPS = 1e-6f;
constexpr float LOG2E = 1.4426950408889634f;
constexpr float QSCALE = 0.125f * 1.4426950408889634f;
__device__ __forceinline__ float gelu_tanh(float x) {
    const float z2 = x * (1.5957691216057308f + 0.07135481627260025f * x * x);
    const float e = __builtin_amdgcn_exp2f(-LOG2E * z2);
    return x * __builtin_amdgcn_rcpf(1.0f + e);
}
__device__ __forceinline__ float row_rs(const float* rowss, int row) {
    const f32x4 a = *(const f32x4*)(rowss + (size_t)row * 4);
    return __builtin_amdgcn_rsqf(((a[0] + a[1]) + (a[2] + a[3])) * (1.0f / 1024.0f) + RMS_EPS);
}
struct EpiInProj {
    static constexpr bool PERM = true, AFTER_DRAIN = false, INIT = false;
    bf16_t* P; const float* rowss; float* vgss; const float* qg; const float* kg; const PG8_LAS float* rs_lds; int pm_cached;
    __device__ __forceinline__ void operator()(const f32x4 (&acc)[2][2][4][2], const Unit& u, int wr, int wc, int fr, int fq) const {
        const int region = u.pn >> 1, half = u.pn & 1;
        const int lcol = region * 512 + half * 256 + wc * 64 + fq * 8;
        float gq[2][8];
#pragma unroll
        for (int bj = 0; bj < 2; ++bj)
#pragma unroll
            for (int e = 0; e < 8; ++e) gq[bj][e] = 1.f;
        if (region < 2) { const PG8_LAS float* g = rs_lds + 256 + region * 64;
#pragma unroll
            for (int bj = 0; bj < 2; ++bj)
#pragma unroll
                for (int e = 0; e < 8; ++e) gq[bj][e] = g[bj * 32 + fq * 8 + e]; }
#pragma unroll
        for (int ai = 0; ai < 2; ++ai)
#pragma unroll
            for (int m = 0; m < 4; ++m) {
                const int row = u.pm * BM + ai * HALF + wr * 64 + m * 16 + fr;
                const float s = (u.pm == pm_cached) ? rs_lds[ai * HALF + wr * 64 + m * 16 + fr] : row_rs(rowss, row);
                float v[2][8];
#pragma unroll
                for (int bj = 0; bj < 2; ++bj)
#pragma unroll
                    for (int n = 0; n < 2; ++n)
#pragma unroll
                        for (int i = 0; i < 4; ++i) v[bj][4 * n + i] = acc[ai][bj][m][n][i] * s;
                if (region < 2) {
                    float q = 0.f;
#pragma unroll
                    for (int bj = 0; bj < 2; ++bj)
#pragma unroll
                        for (int e = 0; e < 8; ++e) q += v[bj][e] * v[bj][e];
                    q += __shfl_xor(q, 16); q += __shfl_xor(q, 32);
                    const float r = __builtin_amdgcn_rsqf(q * (1.0f / 64.0f) + RMS_EPS);
#pragma unroll
                    for (int bj = 0; bj < 2; ++bj)
#pragma unroll
                        for (int e = 0; e < 8; ++e) v[bj][e] = v[bj][e] * r * gq[bj][e];
                } else if (region >= 3) {
#pragma unroll
                    for (int bj = 0; bj < 2; ++bj)
#pragma unroll
                        for (int e = 0; e < 8; ++e) v[bj][e] = gelu_tanh(v[bj][e]);
                    if (region == 4) {
                        float q = 0.f;
#pragma unroll
                        for (int bj = 0; bj < 2; ++bj)
#pragma unroll
                            for (int e = 0; e < 8; ++e) q += v[bj][e] * v[bj][e];
                        q += __shfl_xor(q, 16); q += __shfl_xor(q, 32);
                        if (fq == 0) vgss[(size_t)row * 8 + half * 4 + wc] = q;
                    }
                }
                bf16_t* rowp = P + (size_t)row * 2560 + lcol;
#pragma unroll
                for (int bj = 0; bj < 2; ++bj) { u32x4 w; w.x = cvt_pk_bf16(v[bj][0], v[bj][1]); w.y = cvt_pk_bf16(v[bj][2], v[bj][3]); w.z = cvt_pk_bf16(v[bj][4], v[bj][5]); w.w = cvt_pk_bf16(v[bj][6], v[bj][7]);
                    *(u32x4*)(rowp + bj * 32) = w; }
            }
    }
};
struct EpiResid {
    static constexpr bool PERM = true, AFTER_DRAIN = true, INIT = true;
    const float* base32; float* out32; bf16_t* xb; float* rowss;
    __device__ __forceinline__ void init(f32x4 (&acc)[2][2][4][2], const Unit& u, int wr, int wc, int fr, int fq) const {
        const int col0 = u.pn * BM + wc * 32 + 8 * fq;
        if (base32) {
#pragma unroll
            for (int ai = 0; ai < 2; ++ai)
#pragma unroll
                for (int m = 0; m < 4; ++m) { const size_t off = (size_t)(u.pm * BM + ai * HALF + wr * 64 + m * 16 + fr) * 1024 + col0;
#pragma unroll
                    for (int bj = 0; bj < 2; ++bj) { acc[ai][bj][m][0] = *(const f32x4*)(base32 + off + bj * HALF); acc[ai][bj][m][1] = *(const f32x4*)(base32 + off + bj * HALF + 4); } }
        } else {
#pragma unroll
            for (int ai = 0; ai < 2; ++ai)
#pragma unroll
                for (int m = 0; m < 4; ++m) { const size_t off = (size_t)(u.pm * BM + ai * HALF + wr * 64 + m * 16 + fr) * 1024 + col0;
#pragma unroll
                    for (int bj = 0; bj < 2; ++bj) { const u32x4 w = *(const u32x4*)(xb + off + bj * HALF);
                        acc[ai][bj][m][0] = (f32x4){__builtin_bit_cast(float, w.x << 16), __builtin_bit_cast(float, w.x & 0xffff0000u), __builtin_bit_cast(float, w.y << 16), __builtin_bit_cast(float, w.y & 0xffff0000u)};
                        acc[ai][bj][m][1] = (f32x4){__builtin_bit_cast(float, w.z << 16), __builtin_bit_cast(float, w.z & 0xffff0000u), __builtin_bit_cast(float, w.w << 16), __builtin_bit_cast(float, w.w & 0xffff0000u)}; } }
        }
    }
    __device__ __forceinline__ void fused(f32x4 (&acc)[2][2][4][2], const Unit& u, int wr, int wc, int fr, int fq, PG8_LAS unsigned char* lds, int wid, int lane) const {
        PG8_LAS float* part = (PG8_LAS float*)lds;
        const int col0 = u.pn * BM + wc * 32 + 8 * fq;
#pragma unroll
        for (int ai = 0; ai < 2; ++ai)
#pragma unroll
            for (int m = 0; m < 4; ++m) {
                const int rl = ai * HALF + wr * 64 + m * 16 + fr;
                const size_t off = (size_t)(u.pm * BM + rl) * 1024 + col0;
                float q = 0.f;
#pragma unroll
                for (int bj = 0; bj < 2; ++bj) {
                    const f32x4 v0 = acc[ai][bj][m][0], v1 = acc[ai][bj][m][1];
                    if (out32) { *(f32x4*)(out32 + off + bj * HALF) = v0; *(f32x4*)(out32 + off + bj * HALF + 4) = v1; }
                    else { u32x4 w; w.x = cvt_pk_bf16(v0[0], v0[1]); w.y = cvt_pk_bf16(v0[2], v0[3]); w.z = cvt_pk_bf16(v1[0], v1[1]); w.w = cvt_pk_bf16(v1[2], v1[3]);
                        *(u32x4*)(xb + off + bj * HALF) = w; }
                    q += (v0[0] * v0[0] + v0[1] * v0[1]) + (v0[2] * v0[2] + v0[3] * v0[3]) + (v1[0] * v1[0] + v1[1] * v1[1]) + (v1[2] * v1[2] + v1[3] * v1[3]);
                }
                q += __shfl_xor(q, 16); q += __shfl_xor(q, 32);
                if (fq == 0) part[rl * 4 + wc] = q;
            }
        asm volatile("s_waitcnt lgkmcnt(0)" ::: "memory"); __builtin_amdgcn_s_barrier(); asm volatile("" ::: "memory");
        const int t = wid * 64 + lane;
        if (t < 256) { const f32x4 p = *(const PG8_LAS f32x4*)(part + t * 4); rowss[(size_t)(u.pm * BM + t) * 4 + u.pn] = (p[0] + p[1]) + (p[2] + p[3]); }
    }
};
struct EpiSwiGLU {
    static constexpr bool PERM = true, AFTER_DRAIN = false, INIT = false;
    bf16_t* H; const float* rowss; const PG8_LAS float* rs_lds; int pm_cached;
    __device__ __forceinline__ void operator()(const f32x4 (&acc)[2][2][4][2], const Unit& u, int wr, int wc, int fr, int fq) const {
        const int col0 = u.pn * 128 + wc * 32 + 8 * fq;
#pragma unroll
        for (int ai = 0; ai < 2; ++ai)
#pragma unroll
            for (int m = 0; m < 4; ++m) {
                const int row = u.pm * BM + ai * HALF + wr * 64 + m * 16 + fr;
                const float s = (u.pm == pm_cached) ? rs_lds[ai * HALF + wr * 64 + m * 16 + fr] : row_rs(rowss, row);
                float h[8];
#pragma unroll
                for (int n = 0; n < 2; ++n)
#pragma unroll
                    for (int i = 0; i < 4; ++i) { const float g = acc[ai][0][m][n][i] * s, up = acc[ai][1][m][n][i] * s;
                        h[4 * n + i] = g * __builtin_amdgcn_rcpf(1.0f + __builtin_amdgcn_exp2f(-LOG2E * g)) * up; }
                u32x4 w; w.x = cvt_pk_bf16(h[0], h[1]); w.y = cvt_pk_bf16(h[2], h[3]); w.z = cvt_pk_bf16(h[4], h[5]); w.w = cvt_pk_bf16(h[6], h[7]);
                *(u32x4*)(H + ((size_t)(col0 >> 6) * 16384 + row) * 64 + (col0 & 63)) = w;
            }
    }
};
struct NoPre { __device__ __forceinline__ void drain() const {} __device__ __forceinline__ void sync() const {} };
template <class Epi, class Sched, bool ALIGN_EPI = false, bool SP2 = false, bool TILED = false, class Pre = NoPre>
__device__ __forceinline__ void gemm_phase(PG8_LAS unsigned char* lds, const Gemm g, const Sched& S, const Epi& E, const Pre& pre = Pre()) {
    int tid_l = threadIdx.x; asm volatile("" : "+v"(tid_l));
    const int tid = tid_l, wid = __builtin_amdgcn_readfirstlane(tid >> 6), lane = tid & 63, wr = wid >> 2, wc = wid & 3, fr = lane & 15, fq = lane >> 4;
    const int K = g.K, nt = K / BK;
    unsigned voffA[2], voffB[2];
#pragma unroll
    for (int i = 0; i < 2; ++i) { int R, C; stage_rc(tid * 16 + i * 8192, R, C); const int Rb = Epi::PERM ? ((R & ~31) + perm32(R & 31)) : R;
        const int lda = TILED ? 64 : K; voffA[i] = (unsigned)(R * lda + C) * 2u; voffB[i] = (unsigned)(Rb * lda + C) * 2u; }
    const size_t kstepA = TILED ? (size_t)g.M * BK * 2 : (size_t)(BK * 2), kstepB = TILED ? (size_t)g.N * BK * 2 : (size_t)(BK * 2);
    const size_t hstep = (size_t)HALF * (TILED ? 64 : K) * 2;
    const size_t tstep = 2 * hstep;
    const unsigned ldsw = (unsigned)wid * 1024u;
    const int aoff = lds_byte(wr * 64 + fr, fq * 8), boff = lds_byte(wc * 32 + fr, fq * 8);
#define PG8_SA(b, h) (((b) * 2 + (h)) * HTB)
#define PG8_SB(b, h) ((4 + (b) * 2 + (h)) * HTB)
#define PG8_STAGE(bufoff, gbase, voff) do { _Pragma("unroll") for (int _i = 0; _i < 2; ++_i) \
        __builtin_amdgcn_global_load_lds((const unsigned*)((const char*)(gbase) + (voff)[_i]), (PG8_LAS unsigned*)(lds + (bufoff) + ldsw + _i * 8192), 16, 0, 0); } while (0)
#define PG8_LDA(dst, b, h) do { _Pragma("unroll") for (int m = 0; m < 4; ++m) _Pragma("unroll") for (int k = 0; k < 2; ++k) dst[m][k] = *(const PG8_LAS bf16x8*)(lds + PG8_SA(b, h) + aoff + m * 2048 + k * 1024); } while (0)
#define PG8_LDB(dst, b, h) do { _Pragma("unroll") for (int n = 0; n < 2; ++n) _Pragma("unroll") for (int k = 0; k < 2; ++k) dst[n][k] = *(const PG8_LAS bf16x8*)(lds + PG8_SB(b, h) + boff + n * 2048 + k * 1024); } while (0)
#define PG8_MMA(ai, bj, At, Bt) do { __builtin_amdgcn_s_setprio(1); _Pragma("unroll") for (int m = 0; m < 4; ++m) _Pragma("unroll") for (int n = 0; n < 2; ++n) _Pragma("unroll") for (int k = 0; k < 2; ++k) \
        acc[ai][bj][m][n] = __builtin_amdgcn_mfma_f32_16x16x32_bf16(Bt[n][k], At[m][k], acc[ai][bj][m][n], 0, 0, 0); __builtin_amdgcn_s_setprio(0); } while (0)
#define PG8_WAIT_V(n) asm volatile("s_waitcnt vmcnt(" #n ")" ::: "memory")
#define PG8_WAIT_L(n) asm volatile("s_waitcnt lgkmcnt(" #n ")" ::: "memory")
#define PG8_BAR __builtin_amdgcn_s_barrier()
#define PG8_SCHED __builtin_amdgcn_sched_barrier(0)
    Unit cur, nxt; int ui = 0;
    if (!S.next(0, cur)) return;
    f32x4 acc[2][2][4][2];
    pre.drain();
    if constexpr (Epi::INIT) E.init(acc, cur, wr, wc, fr, fq);
    else {
#pragma unroll
    for (int a = 0; a < 2; ++a)
#pragma unroll
        for (int b = 0; b < 2; ++b)
#pragma unroll
            for (int m = 0; m < 4; ++m)
#pragma unroll
                for (int n = 0; n < 2; ++n) acc[a][b][m][n] = (f32x4){0.f, 0.f, 0.f, 0.f};
    }
    pre.sync();
    bf16x8 At[4][2], B0[2][2], B1[2][2];
    const char* cA = (const char*)g.A + (size_t)cur.pm * tstep; const char* cB = (const char*)g.Bt + (size_t)cur.pn * tstep;
    S.a_ready(cur);
    if constexpr (SP2) {
        PG8_STAGE(PG8_SB(0, 0), cB, voffB); PG8_STAGE(PG8_SB(0, 1), cB + hstep, voffB); PG8_STAGE(PG8_SA(0, 0), cA, voffA); PG8_STAGE(PG8_SA(0, 1), cA + hstep, voffA);
        if (wr == 1) PG8_BAR;
        PG8_WAIT_V(2); PG8_BAR;
        PG8_STAGE(PG8_SB(1, 0), cB + kstepB, voffB); PG8_STAGE(PG8_SA(1, 0), cA + kstepA, voffA); PG8_STAGE(PG8_SB(1, 1), cB + hstep + kstepB, voffB);
        PG8_WAIT_V(6); PG8_BAR;
    } else {
        PG8_STAGE(PG8_SB(0, 0), cB, voffB); PG8_STAGE(PG8_SA(0, 0), cA, voffA); PG8_STAGE(PG8_SB(0, 1), cB + hstep, voffB); PG8_STAGE(PG8_SA(0, 1), cA + hstep, voffA);
        if (wr == 1) PG8_BAR;
        PG8_WAIT_V(4); PG8_BAR;
        PG8_STAGE(PG8_SB(1, 0), cB + kstepB, voffB); PG8_STAGE(PG8_SA(1, 0), cA + kstepA, voffA); PG8_STAGE(PG8_SB(1, 1), cB + hstep + kstepB, voffB);
        PG8_WAIT_V(6); PG8_BAR;
    }
    for (;;) {
        const bool has_next = S.next(ui + 1, nxt);
        const char* nA = has_next ? (const char*)g.A + (size_t)nxt.pm * tstep : cA; const char* nB = has_next ? (const char*)g.Bt + (size_t)nxt.pn * tstep : cB;
        for (int t = 0; t < nt; t += 2) {
            const bool last = (t == nt - 2);
            const char* a1 = cA + (size_t)(t + 1) * kstepA;
            const char* a2 = last ? nA : cA + (size_t)(t + 2) * kstepA; const char* b2 = last ? nB : cB + (size_t)(t + 2) * kstepB;
            const char* a3 = a2 + kstepA; const char* b3 = b2 + kstepB;
            if (last && has_next) S.a_ready(nxt);
            if constexpr (SP2) {
            PG8_LDB(B0, 0, 0); PG8_LDB(B1, 0, 1); PG8_SCHED; PG8_LDA(At, 0, 0); PG8_STAGE(PG8_SA(1, 1), a1 + hstep, voffA);
            PG8_WAIT_V(8); PG8_WAIT_L(0); PG8_BAR; PG8_MMA(0, 0, At, B0); PG8_MMA(0, 1, At, B1); PG8_BAR; PG8_SCHED;
            PG8_LDA(At, 0, 1); PG8_STAGE(PG8_SB(0, 0), b2, voffB); PG8_STAGE(PG8_SB(0, 1), b2 + hstep, voffB); PG8_STAGE(PG8_SA(0, 0), a2, voffA);
            PG8_WAIT_V(8); PG8_WAIT_L(0); PG8_BAR; PG8_MMA(1, 0, At, B0); PG8_MMA(1, 1, At, B1); PG8_BAR; PG8_SCHED;
            PG8_LDB(B0, 1, 0); PG8_LDB(B1, 1, 1); PG8_SCHED; PG8_LDA(At, 1, 0); PG8_STAGE(PG8_SA(0, 1), a2 + hstep, voffA);
            PG8_WAIT_V(8); PG8_WAIT_L(0); PG8_BAR; PG8_MMA(0, 0, At, B0); PG8_MMA(0, 1, At, B1); PG8_BAR; PG8_SCHED;
            PG8_LDA(At, 1, 1); PG8_STAGE(PG8_SB(1, 0), b3, voffB); PG8_STAGE(PG8_SB(1, 1), b3 + hstep, voffB); PG8_STAGE(PG8_SA(1, 0), a3, voffA);
            PG8_WAIT_V(8); PG8_WAIT_L(0); PG8_BAR; PG8_MMA(1, 0, At, B0); PG8_MMA(1, 1, At, B1); PG8_BAR; PG8_SCHED;
            } else {
            PG8_LDB(B0, 0, 0); PG8_SCHED; PG8_LDA(At, 0, 0); PG8_STAGE(PG8_SA(1, 1), a1 + hstep, voffA);
            PG8_WAIT_L(8); PG8_BAR; PG8_WAIT_L(0); PG8_MMA(0, 0, At, B0); PG8_BAR; PG8_SCHED;
            PG8_LDB(B1, 0, 1); PG8_STAGE(PG8_SB(0, 0), b2, voffB);
            PG8_BAR; PG8_WAIT_L(0); PG8_MMA(0, 1, At, B1); PG8_BAR;
            PG8_LDA(At, 0, 1); PG8_STAGE(PG8_SA(0, 0), a2, voffA);
            PG8_BAR; PG8_WAIT_L(0); PG8_MMA(1, 0, At, B0); PG8_BAR; PG8_SCHED;
            PG8_STAGE(PG8_SB(0, 1), b2 + hstep, voffB);
            PG8_WAIT_V(6); PG8_BAR; PG8_MMA(1, 1, At, B1); PG8_BAR;
            PG8_LDB(B0, 1, 0); PG8_SCHED; PG8_LDA(At, 1, 0); PG8_STAGE(PG8_SA(0, 1), a2 + hstep, voffA);
            PG8_WAIT_L(8); PG8_BAR; PG8_WAIT_L(0); PG8_MMA(0, 0, At, B0); PG8_BAR; PG8_SCHED;
            PG8_LDB(B1, 1, 1); PG8_STAGE(PG8_SB(1, 0), b3, voffB);
            PG8_BAR; PG8_WAIT_L(0); PG8_MMA(0, 1, At, B1); PG8_BAR;
            PG8_LDA(At, 1, 1); PG8_STAGE(PG8_SA(1, 0), a3, voffA);
            PG8_BAR; PG8_WAIT_L(0); PG8_MMA(1, 0, At, B0); PG8_BAR; PG8_SCHED;
            PG8_STAGE(PG8_SB(1, 1), b3 + hstep, voffB);
            PG8_WAIT_V(6); PG8_BAR; PG8_MMA(1, 1, At, B1); PG8_BAR;
            }
        }
        if constexpr (ALIGN_EPI) { if (wr == 0) PG8_BAR; }
        if constexpr (!Epi::AFTER_DRAIN) { E(acc, cur, wr, wc, fr, fq); S.done(cur); }
        if (!has_next) break;
        if constexpr (Epi::INIT) E.init(acc, nxt, wr, wc, fr, fq);
        else {
#pragma unroll
        for (int a = 0; a < 2; ++a)
#pragma unroll
            for (int b = 0; b < 2; ++b)
#pragma unroll
                for (int m = 0; m < 4; ++m)
#pragma unroll
                    for (int n = 0; n < 2; ++n) acc[a][b][m][n] = (f32x4){0.f, 0.f, 0.f, 0.f};
        }
        cur = nxt; cA = nA; cB = nB; ++ui;
        if constexpr (ALIGN_EPI) { if (wr == 1) PG8_BAR; }
    }
    PG8_WAIT_V(0);
    if constexpr (!ALIGN_EPI) { if (wr == 0) PG8_BAR; }
    PG8_BAR;
    if constexpr (Epi::AFTER_DRAIN) { E.fused(acc, cur, wr, wc, fr, fq, lds, wid, lane); S.done(cur); }
#undef PG8_SA
#undef PG8_SB
#undef PG8_STAGE
#undef PG8_LDA
#undef PG8_LDB
#undef PG8_MMA
#undef PG8_WAIT_V
#undef PG8_WAIT_L
#undef PG8_BAR
#undef PG8_SCHED
}
}
constexpr int NB = 8, SEQ = 2048, DM = 1024, M = NB * SEQ, NIN = 2560, DFF = 2816, NFF2 = 2 * DFF, DEPTH = 2;
constexpr int NWAVES = 8;
constexpr size_t MiB = 1u << 20;
constexpr size_t WS_ROWSS = 1 * MiB;
constexpr size_t WS_VGSS = 2 * MiB;
constexpr size_t WS_WSP = 3 * MiB;
constexpr size_t WS_W0 = 4 * MiB, WS_WSTRIDE = 24 * MiB;
constexpr size_t WOFF_IN = 0, WOFF_OUT = 5 * MiB, WOFF_FIN = 7 * MiB, WOFF_FOUT = 18 * MiB;
constexpr size_t WS_XB = 52 * MiB;
constexpr size_t WS_PROJ = 84 * MiB;
constexpr size_t WS_MIX = 164 * MiB;
constexpr size_t WS_HID = 84 * MiB;
constexpr size_t WS_END = 196 * MiB;
constexpr int LDS_BYTES = 155648;

#define GAS __attribute__((address_space(1)))
#define LAS __attribute__((address_space(3)))
typedef unsigned short bf16;
typedef unsigned v4u __attribute__((ext_vector_type(4)));
typedef float f32x4 __attribute__((ext_vector_type(4)));
__device__ __forceinline__ unsigned f2bf(float f) { unsigned u = __builtin_bit_cast(unsigned, f); return (u + 0x7fffu + ((u >> 16) & 1u)) >> 16; }
__device__ __forceinline__ unsigned pk2(float lo, float hi) { return f2bf(lo) | (f2bf(hi) << 16); }
__device__ __forceinline__ float bf2f(bf16 v) { return __builtin_bit_cast(float, (unsigned)v << 16); }
__device__ __forceinline__ float wave_sum(float v) {
#pragma unroll
    for (int o = 1; o < 64; o <<= 1) v += __shfl_xor(v, o);
    return v;
}
#define LDS_WAIT() asm volatile("s_waitcnt lgkmcnt(0)" ::: "memory")

typedef short tp_s16x4 __attribute__((ext_vector_type(4)));
__device__ __forceinline__ void p0_transpose_item(const float* W, int K, int N, bf16* WT, int k0, int n0, int prow0, int prow1, const float* gk, LAS unsigned char* scr, int lane, int tiled_n = 0) {
    const int lr = lane >> 4, n4 = (lane & 15) * 4;
    f32x4 v[16];
#pragma unroll
    for (int i = 0; i < 16; ++i) v[i] = *(const f32x4*)(W + (size_t)(k0 + 4 * i + lr) * N + n0 + n4);
#pragma unroll
    for (int i = 0; i < 16; ++i) { const int k = 4 * i + lr; const float gg = gk ? gk[k0 + k] : 1.f;
        unsigned long long w = (unsigned long long)pk2(v[i].x * gg, v[i].y * gg) | ((unsigned long long)pk2(v[i].z * gg, v[i].w * gg) << 32);
        *(LAS unsigned long long*)(scr + k * 128 + ((n4 * 2) ^ (((k >> 1) & 1) << 6))) = w; }
    asm volatile("" ::: "memory");
    const int hh = lane >> 5, g2 = (lane >> 4) & 1, i16 = lane & 15, qq = i16 >> 2, p4 = i16 & 3;
#pragma unroll
    for (int j = 0; j < 8; ++j) { const int c = 2 * (j >> 1) + hh, nb = 32 * (j & 1) + 16 * g2;
        const int a0 = (8 * c + qq) * 128 + (((nb + 4 * p4) * 2) ^ ((qq >> 1) << 6));
        const tp_s16x4 lo = __builtin_bit_cast(tp_s16x4, __builtin_amdgcn_ds_read_tr16_b64_v4i16((LAS tp_s16x4*)(scr + a0)));
        const tp_s16x4 hi4 = __builtin_bit_cast(tp_s16x4, __builtin_amdgcn_ds_read_tr16_b64_v4i16((LAS tp_s16x4*)(scr + a0 + 4 * 128)));
        typedef short s16x8_t __attribute__((ext_vector_type(8)));
        const s16x8_t o = (s16x8_t){lo[0], lo[1], lo[2], lo[3], hi4[0], hi4[1], hi4[2], hi4[3]};
        const int prow = ((j & 1) ? prow1 : prow0) + 16 * g2 + i16;
        *(s16x8_t*)(WT + (tiled_n ? ((size_t)(k0 >> 6) * tiled_n + prow) * 64 + 8 * c : (size_t)prow * K + k0 + 8 * c)) = o; }
    LDS_WAIT(); asm volatile("" ::: "memory");
}
__host__ __device__ __forceinline__ int map_in(int n) { const int T = n >> 8, nn = n & 255; return 256 * T + 128 * ((nn >> 5) & 1) + 32 * (nn >> 6) + (nn & 31); }
__host__ __device__ __forceinline__ int map_fin(int n) { return n < DFF ? 256 * (n >> 7) + (n & 127) : 256 * ((n - DFF) >> 7) + 128 + ((n - DFF) & 127); }

typedef GAS unsigned gu32;
#define RLX_AGENT __ATOMIC_RELAXED, __HIP_MEMORY_SCOPE_AGENT
constexpr int MISC_OFF = LDS_BYTES - 64;
constexpr size_t WS_BAR = 0;
constexpr size_t BAR_ZERO_BYTES = 32768;
#define XB_TMO      128
#define XB_XCNT(j)  (256  + 64 * (j))
#define XB_XSUB(j)  (1280 + 64 * (j))
#define XB_XGEN(j)  (2304 + 64 * (j))
#define XB_TOP      3328
#define XB_TOPGEN   3392
#define XCD_BAR_WORDS 3456
#define XB_SPIN_CAP (1u << 18)

__device__ __forceinline__ unsigned xb_ld(unsigned* p)              { return __hip_atomic_load(p, __ATOMIC_RELAXED, __HIP_MEMORY_SCOPE_AGENT); }
__device__ __forceinline__ unsigned xb_add(unsigned* p, unsigned v) { return __hip_atomic_fetch_add(p, v, __ATOMIC_RELAXED, __HIP_MEMORY_SCOPE_AGENT); }
__device__ __forceinline__ unsigned xb_xcc_id() { return (unsigned)__builtin_amdgcn_s_getreg((3 << 11) | 20) & 0xFu; }
#define XB_SPIN(cond, bar) do { unsigned _sp = 0; while (cond) { __builtin_amdgcn_s_sleep(1); \
    if ((++_sp & 255u) == 0u) { if (xb_ld(&(bar)[XB_TMO])) break; if (_sp > XB_SPIN_CAP) { atomicAdd(&(bar)[XB_TMO], 1u); break; } } } } while (0)

struct XcdBarrier {
    unsigned* bar; unsigned x;
    volatile LAS unsigned* st;
};

__device__ __forceinline__ XcdBarrier xcd_barrier_post(unsigned* bar, volatile LAS unsigned* st) {
    XcdBarrier b; b.bar = bar; b.x = xb_xcc_id(); b.st = st;
    if (threadIdx.x == 0) (void)xb_add(&bar[XB_XCNT(b.x)], 1u);
    return b;
}
__device__ __forceinline__ void xcd_barrier_complete(unsigned* bar, unsigned x, unsigned& nloc, unsigned& nx) {
    const unsigned G = gridDim.x * gridDim.y * gridDim.z;
    unsigned sum, cnt, mine, sp = 0u;
    for (;;) {
        sum = 0u; cnt = 0u; mine = 0u;
#pragma unroll
        for (unsigned j = 0; j < 16; ++j) { const unsigned c = xb_ld(&bar[XB_XCNT(j)]); sum += c; cnt += (c > 0u) ? 1u : 0u; mine = (j == x) ? c : mine; }
        if (sum == G) break;
        __builtin_amdgcn_s_sleep(1);
        if ((++sp & 255u) == 0u) { if (xb_ld(&bar[XB_TMO])) break; if (sp > XB_SPIN_CAP) { atomicAdd(&bar[XB_TMO], 1u); break; } }
    }
    nloc = mine > 0u ? mine : 1u; nx = cnt > 0u ? cnt : 1u;
}

__device__ __forceinline__ void xcd_barrier(const XcdBarrier& b) {
    asm volatile("s_waitcnt vmcnt(0)" ::: "memory");
    __syncthreads();
    if (threadIdx.x == 0) {
        unsigned* bar = b.bar;
        __builtin_amdgcn_s_waitcnt(0);
        unsigned nloc = b.st[0], nx = b.st[1];
        if (nloc == 0u) { xcd_barrier_complete(bar, b.x, nloc, nx); b.st[0] = nloc; b.st[1] = nx; }
        const unsigned old = xb_add(&bar[XB_XSUB(b.x)], 1u);
        const unsigned gen = old / nloc;
        if (old + 1u == (gen + 1u) * nloc) {
            __builtin_amdgcn_fence(__ATOMIC_RELEASE, "agent");
            asm volatile("s_waitcnt vmcnt(0)" ::: "memory");
            const unsigned og = xb_add(&bar[XB_TOP], 1u);
            const unsigned tg = og / nx;
            if (og + 1u == (tg + 1u) * nx) xb_add(&bar[XB_TOPGEN], 1u);
            else XB_SPIN(xb_ld(&bar[XB_TOPGEN]) == tg, bar);
            __builtin_amdgcn_fence(__ATOMIC_ACQUIRE, "agent");
            xb_add(&bar[XB_XGEN(b.x)], 1u);
            asm volatile("s_waitcnt vmcnt(0)" ::: "memory");
        } else {
            XB_SPIN(xb_ld(&bar[XB_XGEN(b.x)]) == gen, bar);
            __builtin_amdgcn_fence(__ATOMIC_ACQUIRE, "agent");
            asm volatile("s_waitcnt vmcnt(0)" ::: "memory");
        }
    }
    __syncthreads();
}

constexpr size_t WS_GCNT = 16384, WS_GMASK = 16384 + 8 * 256, WS_XIDX = 16384 + 16 * 256;
__device__ __forceinline__ void group_barrier(unsigned char* ws, volatile LAS unsigned* misc) {
    asm volatile("s_waitcnt vmcnt(0)" ::: "memory");
    __syncthreads();
    if (threadIdx.x == 0) {
        unsigned bx = misc[6];
        unsigned* cnt = (unsigned*)(ws + WS_GCNT) + 64 * (bx & 7u);
        const unsigned pure = misc[4], ep = misc[5] + 1u; misc[5] = ep;
        if (!pure) { __builtin_amdgcn_fence(__ATOMIC_RELEASE, "agent"); asm volatile("s_waitcnt vmcnt(0)" ::: "memory"); }
        const unsigned old_ = xb_add(cnt, 1u);
        if (pure) { __builtin_amdgcn_fence(__ATOMIC_ACQUIRE, "agent"); asm volatile("s_waitcnt vmcnt(0)" ::: "memory"); }
        const unsigned target = ep * (gridDim.x >> 3);
        unsigned sp = 0u;
        if (old_ + 1u < target) while (xb_ld(cnt) < target) { __builtin_amdgcn_s_sleep(1); if (++sp > (1u << 22)) break; }
        if (!pure) __builtin_amdgcn_fence(__ATOMIC_ACQUIRE, "agent");
        asm volatile("s_waitcnt vmcnt(0)" ::: "memory");
    }
    __syncthreads();
}
struct PreGroupBar {
    unsigned char* ws; volatile LAS unsigned* misc;
    __device__ __forceinline__ void drain() const { asm volatile("s_waitcnt vmcnt(0)" ::: "memory"); }
    __device__ __forceinline__ void sync() const {
        asm volatile("s_waitcnt lgkmcnt(0)" ::: "memory"); __builtin_amdgcn_s_barrier(); asm volatile("" ::: "memory");
        if (threadIdx.x == 0) {
            unsigned bx = misc[6];
            unsigned* cnt = (unsigned*)(ws + WS_GCNT) + 64 * (bx & 7u);
            const unsigned pure = misc[4], ep = misc[5] + 1u; misc[5] = ep;
            if (!pure) { __builtin_amdgcn_fence(__ATOMIC_RELEASE, "agent"); asm volatile("s_waitcnt vmcnt(0)" ::: "memory"); }
            const unsigned old_ = xb_add(cnt, 1u);
            if (pure) { __builtin_amdgcn_fence(__ATOMIC_ACQUIRE, "agent"); asm volatile("s_waitcnt vmcnt(0)" ::: "memory"); }
            const unsigned target = ep * (gridDim.x >> 3);
            unsigned sp = 0u;
            if (old_ + 1u < target) while (xb_ld(cnt) < target) { __builtin_amdgcn_s_sleep(1); if (++sp > (1u << 22)) break; }
            if (!pure) __builtin_amdgcn_fence(__ATOMIC_ACQUIRE, "agent");
            asm volatile("s_waitcnt vmcnt(0)" ::: "memory");
        }
        asm volatile("s_waitcnt lgkmcnt(0)" ::: "memory"); __builtin_amdgcn_s_barrier(); asm volatile("" ::: "memory");
    }
};
#define GROUP_BAR() group_barrier(kargs_ws(), (volatile LAS unsigned*)(lds + MISC_OFF))
#define VBID() ((int)__builtin_amdgcn_readfirstlane(((volatile LAS unsigned*)(lds + MISC_OFF))[6]))
#define GRID_BAR() do { XcdBarrier bar_; bar_.bar = (unsigned*)(kargs_ws() + WS_BAR); bar_.x = xb_xcc_id(); bar_.st = (volatile LAS unsigned*)(lds + MISC_OFF); xcd_barrier(bar_); } while (0)
struct Args { const float* in[15]; float* out; unsigned char* ws; };
typedef const __attribute__((address_space(4))) Args CArgs;
__device__ __forceinline__ CArgs* kargs();
__device__ __forceinline__ unsigned char* kargs_ws();
__device__ __forceinline__ CArgs* kargs() { CArgs* p = (CArgs*)__builtin_amdgcn_kernarg_segment_ptr(); asm volatile("" : "+s"(p)); return p; }
__device__ __forceinline__ unsigned char* kargs_ws() { return kargs()->ws; }

constexpr int CW_I_IN = (DM / 64) * (NIN / 64), CW_I_LAYER = CW_I_IN + (DM / 64) * (DM / 64) + (DM / 64) * (NFF2 / 64) + (DFF / 64) * (DM / 64);
__device__ __forceinline__ void convert_weights(CArgs* a, LAS unsigned char* lds, int wave, int lane, int it0, int it1, int gw, int NGW) {
    LAS unsigned char* scr = lds + wave * 16384;
    constexpr int I_IN = (DM / 64) * (NIN / 64), I_OUT = (DM / 64) * (DM / 64), I_FIN = (DM / 64) * (NFF2 / 64), I_FOUT = (DFF / 64) * (DM / 64);
    constexpr int I_LAYER = I_IN + I_OUT + I_FIN + I_FOUT;
    static_assert(I_IN == CW_I_IN && I_LAYER == CW_I_LAYER, "item counts");
#pragma nounroll
    for (int it = it0 + gw; it < it1; it += NGW) {
        const int l = it / I_LAYER; int r = it % I_LAYER;
        unsigned char* wb = a->ws + WS_W0 + (size_t)l * WS_WSTRIDE;
        if (r < I_IN) { const int nblk = NIN / 64, kb = r / nblk, nb = r % nblk;
            p0_transpose_item(a->in[2] + (size_t)l * DM * NIN, DM, NIN, (bf16*)(wb + WOFF_IN), 64 * kb, 64 * nb, map_in(64 * nb), map_in(64 * nb + 32), a->in[1] + l * DM, scr, lane); continue; } r -= I_IN;
        if (r < I_OUT) { const int nblk = DM / 64, kb = r / nblk, nb = r % nblk;
            p0_transpose_item(a->in[11] + (size_t)l * DM * DM, DM, DM, (bf16*)(wb + WOFF_OUT), 64 * kb, 64 * nb, 64 * nb, 64 * nb + 32, nullptr, scr, lane); continue; } r -= I_OUT;
        if (r < I_FIN) { const int nblk = NFF2 / 64, kb = r / nblk, nb = r % nblk;
            p0_transpose_item(a->in[13] + (size_t)l * DM * NFF2, DM, NFF2, (bf16*)(wb + WOFF_FIN), 64 * kb, 64 * nb, map_fin(64 * nb), map_fin(64 * nb + 32), a->in[12] + l * DM, scr, lane); continue; } r -= I_FIN;
        { const int nblk = DM / 64, kb = r / nblk, nb = r % nblk;
            p0_transpose_item(a->in[14] + (size_t)l * DFF * DM, DFF, DM, (bf16*)(wb + WOFF_FOUT), 64 * kb, 64 * nb, 64 * nb, 64 * nb + 32, nullptr, scr, lane, DM); }
    }
}
__device__ __forceinline__ void prologue(CArgs* a, LAS unsigned char* lds, int wave, int lane) {
    const int gw = blockIdx.x * NWAVES + wave, NGW = gridDim.x * NWAVES;
    convert_weights(a, lds, wave, lane, 0, CW_I_IN, gw, NGW);
    float* rowss = (float*)(a->ws + WS_ROWSS); bf16* xb = (bf16*)(a->ws + WS_XB);
#pragma nounroll
    for (int m0 = gw * 4; m0 < M; m0 += NGW * 4) {
        f32x4 v[4][4];
#pragma unroll
        for (int r = 0; r < 4; ++r) { const f32x4* xr = (const f32x4*)(a->in[0] + (size_t)(m0 + r) * DM) + lane;
#pragma unroll
            for (int j = 0; j < 4; ++j) v[r][j] = xr[64 * j]; }
#pragma unroll
        for (int r = 0; r < 4; ++r) { unsigned long long* o8 = (unsigned long long*)(xb + (size_t)(m0 + r) * DM) + lane; float sq = 0.f;
#pragma unroll
            for (int j = 0; j < 4; ++j) { const f32x4 w = v[r][j]; sq += (w.x * w.x + w.y * w.y) + (w.z * w.z + w.w * w.w);
                o8[64 * j] = (unsigned long long)pk2(w.x, w.y) | ((unsigned long long)pk2(w.z, w.w) << 32); }
            sq = wave_sum(sq);
            if (lane < 4) rowss[(size_t)(m0 + r) * 4 + lane] = lane == 0 ? sq : 0.f; }
    }
    { const float* wsp = a->in[7]; bf16* o = (bf16*)(a->ws + WS_WSP); const int gt = blockIdx.x * 512 + threadIdx.x, NT = gridDim.x * 512;
      for (int i = gt; i < DEPTH * 8 * 128 * 128; i += NT) { const int s = i & 127, t = (i >> 7) & 127; o[i] = (bf16)(((t >> 6) >= (s >> 6)) ? f2bf(wsp[i]) : 0u); } }
}

__device__ __forceinline__ void mixer_naive(CArgs* a, int l, LAS unsigned char* lds, int wave, int lane) {
    const bf16* P = (const bf16*)(a->ws + WS_PROJ); bf16* MIX = (bf16*)(a->ws + WS_MIX);
    const float* vgss = (const float*)(a->ws + WS_VGSS); const bf16* wsp = (const bf16*)(a->ws + WS_WSP) + (size_t)l * 8 * 128 * 128;
    const float* rel = a->in[5] + (size_t)l * 8 * 257; const float* sgu_g = a->in[6] + l * 512; const float* bsp = a->in[8] + l * 8 * 128;
    const float* ag = a->in[9] + l * 512; const float* gg = a->in[10] + l * 512;
    LAS float* red = (LAS float*)lds;
    for (int tok = blockIdx.x; tok < M; tok += gridDim.x) {
        const int b = tok / SEQ, t = tok % SEQ, c = t >> 6;
        const int h = wave;
        const float q = bf2f(P[(size_t)tok * NIN + h * 64 + lane]);
        float mx = -INFINITY, lsum = 0.f, o = 0.f;
        const int k0 = (c >= 8 ? c - 8 : 0) * 64, k1 = c * 64 + 63;
        for (int kt = k0; kt <= k1; ++kt) {
            const size_t kr = (size_t)(b * SEQ + kt) * NIN;
            float s = wave_sum(q * bf2f(P[kr + 512 + h * 64 + lane]));
            int d = t - kt; d = d < -128 ? -128 : (d > 128 ? 128 : d);
            s += rel[h * 257 + d + 128] * pg8::LOG2E;
            const float mn = fmaxf(mx, s), al = __builtin_amdgcn_exp2f(mx - mn), p = __builtin_amdgcn_exp2f(s - mn);
            lsum = lsum * al + p; o = o * al + p * bf2f(P[kr + 1024 + h * 64 + lane]); mx = mn;
        }
        o = o / lsum;
        const int g = wave, nb = t >> 7, tp = t & 127, ns = tp < 64 ? 64 : 128;
        float mixd = 0.f;
        for (int s = 0; s < ns; ++s) {
            const int srow = b * SEQ + nb * 128 + s;
            const f32x4* pv = (const f32x4*)(vgss + (size_t)srow * 8); const f32x4 p0 = pv[0], p1 = pv[1];
            const float rs = __builtin_amdgcn_rsqf((((p0[0] + p0[1]) + (p0[2] + p0[3])) + ((p1[0] + p1[1]) + (p1[2] + p1[3]))) * (1.0f / 512.0f) + pg8::RMS_EPS);
            mixd += bf2f(wsp[(g * 128 + tp) * 128 + s]) * (bf2f(P[(size_t)srow * NIN + 2048 + g * 64 + lane]) * rs * sgu_g[g * 64 + lane]);
        }
        const float gv = bf2f(P[(size_t)tok * NIN + 1536 + g * 64 + lane]) * (mixd + bsp[g * 128 + tp]);
        const float so = wave_sum(o * o), sg = wave_sum(gv * gv);
        __syncthreads();
        if (lane == 0) { red[wave] = so; red[8 + wave] = sg; }
        __syncthreads();
        float ta = 0.f, tg = 0.f;
#pragma unroll
        for (int w = 0; w < 8; ++w) { ta += red[w]; tg += red[8 + w]; }
        const float ra = __builtin_amdgcn_rsqf(ta * (1.0f / 512.0f) + pg8::RMS_EPS), rg = __builtin_amdgcn_rsqf(tg * (1.0f / 512.0f) + pg8::RMS_EPS);
        MIX[(size_t)tok * DM + h * 64 + lane] = (bf16)f2bf(o * ra * ag[h * 64 + lane]);
        MIX[(size_t)tok * DM + 512 + g * 64 + lane] = (bf16)f2bf(gv * rg * gg[g * 64 + lane]);
    }
    __syncthreads();
}

#ifndef FAST_MIXER
#define FAST_MIXER 1
#endif
#ifndef PHM
#define PHM 31
#endif
#ifndef REPM
#define REPM 0
#endif
#define REPEAT(bit) for (int rep_ = 0; rep_ < (((REPM) >> (bit)) & 1) + 1; ++rep_)
namespace mx {
typedef float f32x16 __attribute__((ext_vector_type(16)));
typedef short bf16x8 __attribute__((ext_vector_type(8)));
typedef short s16x4 __attribute__((ext_vector_type(4)));
typedef unsigned u32x2 __attribute__((ext_vector_type(2)));
constexpr int TBL_OFF = 131072;
constexpr int TBL_LD = 320;
constexpr int RS_OFF = TBL_OFF + 8 * TBL_LD * 4 + 4096;
constexpr int RED_OFF = TBL_OFF + 8 * TBL_LD * 4;
__device__ __forceinline__ int crow(int r, int hi) { return (r & 3) + 8 * (r >> 2) + 4 * hi; }
__device__ __forceinline__ int vimg(int row, int chunk) { return row * 128 + ((chunk * 16) ^ (((row >> 1) & 1) << 6)); }
__device__ __forceinline__ s16x4 tr64(LAS unsigned char* p) { return __builtin_bit_cast(s16x4, __builtin_amdgcn_ds_read_tr16_b64_v4i16((LAS s16x4*)p)); }
__device__ __forceinline__ bf16x8 cat8(s16x4 a, s16x4 b) { return (bf16x8){a[0], a[1], a[2], a[3], b[0], b[1], b[2], b[3]}; }
__device__ __forceinline__ unsigned cvtpk(float lo, float hi) { unsigned r; asm("v_cvt_pk_bf16_f32 %0, %1, %2" : "=v"(r) : "v"(lo), "v"(hi)); return r; }
#ifndef ATTREP
#define ATTREP 1
#endif
#ifndef DMAREP
#define DMAREP 1
#endif
#if DMAREP == 1
#define MX_VM8 "s_waitcnt vmcnt(8)"
#else
#define MX_VM8 "s_waitcnt vmcnt(16)"
#endif
#define MX_FENCE() asm volatile("" ::: "memory")
__device__ __forceinline__ float max3f(float a, float b, float c) { float r; asm("v_max3_f32 %0, %1, %2, %3" : "=v"(r) : "v"(a), "v"(b), "v"(c)); return r; }

__device__ __forceinline__ void attn_task(const bf16* P, int b, int c, int h, LAS unsigned char* wl, const LAS float* tbl, int lane, f32x16 (&o)[2][2]) {
    const int r32 = lane & 31, hi = lane >> 5;
    const size_t tok0 = (size_t)b * SEQ + c * 64;
    bf16x8 qf[2][4];
#pragma unroll
    for (int qt = 0; qt < 2; ++qt)
#pragma unroll
        for (int d0 = 0; d0 < 4; ++d0) qf[qt][d0] = *(const bf16x8*)(P + (tok0 + 32 * qt + r32) * NIN + h * 64 + d0 * 16 + hi * 8);
#pragma unroll
    for (int r = 0; r < 16; ++r) { o[0][0][r] = 0.f; o[0][1][r] = 0.f; o[1][0][r] = 0.f; o[1][1][r] = 0.f; }
    float m[2] = {-INFINITY, -INFINITY}, l[2] = {0.f, 0.f};
    const int kc0 = c >= 8 ? c - 8 : 0;
    const int dhalf = (lane >> 4) & 1, qq = (lane & 15) >> 2, p4 = lane & 3;
    int vb[2];
#pragma unroll
    for (int dt = 0; dt < 2; ++dt) vb[dt] = 8192 + (4 * hi + qq) * 128 + ((64 * dt + 32 * dhalf + 8 * p4) ^ ((qq >> 1) << 6));
    const int prow = lane >> 3, pch = lane & 7;
    const unsigned voff = (unsigned)(prow * NIN + (pch ^ (((lane >> 4) & 1) << 2)) * 8) * 2u;
    const unsigned koff0 = (unsigned)(prow * NIN + (pch ^ (lane >> 4)) * 8) * 2u, koff1 = (unsigned)(prow * NIN + (pch ^ (lane >> 4) ^ 4) * 8) * 2u;
    const int swz = (r32 >> 1) & 7;
    int ka[4];
#pragma unroll
    for (int d0 = 0; d0 < 4; ++d0) ka[d0] = r32 * 128 + (((2 * d0 + hi) ^ swz) * 16);
#define MX_DMAK(kc) do { const char* kp_ = (const char*)(P + ((size_t)b * SEQ + (kc) * 64) * NIN + 512 + h * 64); \
        _Pragma("unroll") for (int i = 0; i < 8 * DMAREP; ++i) __builtin_amdgcn_global_load_lds((const unsigned*)(kp_ + (size_t)((i & 7) * 8 * NIN) * 2 + ((i & 1) ? koff1 : koff0)), (LAS unsigned*)(wl + (i & 7) * 1024), 16, 0, 0); } while (0)
#define MX_DMAV(kc) do { const char* vp_ = (const char*)(P + ((size_t)b * SEQ + (kc) * 64) * NIN + 1024 + h * 64); \
        _Pragma("unroll") for (int i = 0; i < 8 * DMAREP; ++i) __builtin_amdgcn_global_load_lds((const unsigned*)(vp_ + (size_t)((i & 7) * 8 * NIN) * 2 + voff), (LAS unsigned*)(wl + 8192 + (i & 7) * 1024), 16, 0, 0); } while (0)
    MX_DMAK(kc0);
    const int nk = c - kc0 + 1, total = nk * ATTREP; (void)total;
#if ATTREP == 1
    for (int kc = kc0; kc <= c; ++kc) {
        const int kcn = kc + 1; const bool more = kc < c;
#else
    for (int it = 0; it < total; ++it) {
        const int kc = kc0 + it % nk, kcn = kc0 + (it + 1) % nk; const bool more = it + 1 < total;
#endif
        const int j = kc - c + 8;
        MX_DMAV(kc);
        asm volatile(MX_VM8 ::: "memory");
        bf16x8 kf[2][4];
#pragma unroll
        for (int kt = 0; kt < 2; ++kt)
#pragma unroll
            for (int d0 = 0; d0 < 4; ++d0) kf[kt][d0] = *(const LAS bf16x8*)(wl + kt * 4096 + ka[d0]);
        asm volatile("s_waitcnt lgkmcnt(0)" ::: "memory");
        if (more) MX_DMAK(kcn);
#pragma unroll
        for (int qt = 0; qt < 2; ++qt) {
            f32x16 st[2];
            float badd = 0.f;
            if (j <= 5) { badd = tbl[256];
#pragma unroll
                for (int r = 0; r < 16; ++r) { st[0][r] = 0.f; st[1][r] = 0.f; } }
            else { const LAS float* tb = tbl + (64 * (8 - j) + 32 * qt + r32 - 4 * hi + 128 - 63);
#pragma unroll
                for (int kt = 0; kt < 2; ++kt)
#pragma unroll
                    for (int r = 0; r < 16; ++r) st[kt][r] = tb[63 - (32 * kt + (r & 3) + 8 * (r >> 2))]; }
#pragma unroll
            for (int kt = 0; kt < 2; ++kt)
#pragma unroll
                for (int d0 = 0; d0 < 4; ++d0) st[kt] = __builtin_amdgcn_mfma_f32_32x32x16_bf16(kf[kt][d0], qf[qt][d0], st[kt], 0, 0, 0);
            asm volatile("s_nop 15\n\ts_nop 7" : "+v"(st[0]), "+v"(st[1]));
            float mxa = max3f(st[0][0], st[0][1], st[0][2]), mxb = max3f(st[1][0], st[1][1], st[1][2]);
#pragma unroll
            for (int r = 3; r < 15; r += 2) { mxa = max3f(mxa, st[0][r], st[0][r + 1]); mxb = max3f(mxb, st[1][r], st[1][r + 1]); }
            float mxv = max3f(mxa, mxb, st[0][15]); mxv = max3f(mxv, st[1][15], mxv);
            mxv = max3f(mxv, __shfl_xor(mxv, 32), mxv) + badd;
            const bool need = mxv > m[qt] + 8.0f;
            if (__builtin_amdgcn_ballot_w64(need) != 0ull) {
                const float mn = need ? mxv : m[qt], al = __builtin_amdgcn_exp2f(m[qt] - mn); m[qt] = mn; l[qt] *= al;
#pragma unroll
                for (int r = 0; r < 16; ++r) { o[qt][0][r] *= al; o[qt][1][r] *= al; }
            }
            const float sub = m[qt] - badd;
            float rs = 0.f;
#pragma unroll
            for (int kt = 0; kt < 2; ++kt)
#pragma unroll
                for (int r = 0; r < 16; ++r) { const float p = __builtin_amdgcn_exp2f(st[kt][r] - sub); st[kt][r] = p; rs += p; }
            l[qt] += rs;
            bf16x8 pf[4];
#pragma unroll
            for (int s = 0; s < 4; ++s) { v4u w; const int kt = s >> 1, r0 = 8 * (s & 1);
                w.x = cvtpk(st[kt][r0 + 0], st[kt][r0 + 1]); w.y = cvtpk(st[kt][r0 + 2], st[kt][r0 + 3]); w.z = cvtpk(st[kt][r0 + 4], st[kt][r0 + 5]); w.w = cvtpk(st[kt][r0 + 6], st[kt][r0 + 7]);
                pf[s] = __builtin_bit_cast(bf16x8, w); }
            if (qt == 0) { if (more) asm volatile(MX_VM8 ::: "memory"); else asm volatile("s_waitcnt vmcnt(0)" ::: "memory"); }
#pragma unroll
            for (int dt = 0; dt < 2; ++dt) { s16x4 va[4], vc[4]; const unsigned vaddr = (unsigned)(uintptr_t)(wl + vb[dt]);
#pragma unroll
                for (int s = 0; s < 4; ++s) { asm volatile("ds_read_b64_tr_b16 %0, %1 offset:%c2" : "=&v"(va[s]) : "v"(vaddr), "i"(16 * s * 128) : "memory");
                                              asm volatile("ds_read_b64_tr_b16 %0, %1 offset:%c2" : "=&v"(vc[s]) : "v"(vaddr), "i"((16 * s + 8) * 128) : "memory"); }
                asm volatile("s_waitcnt lgkmcnt(0)" : "+v"(va[0]), "+v"(va[1]), "+v"(va[2]), "+v"(va[3]), "+v"(vc[0]), "+v"(vc[1]), "+v"(vc[2]), "+v"(vc[3]) :: "memory");
#pragma unroll
                for (int s = 0; s < 4; ++s) o[qt][dt] = __builtin_amdgcn_mfma_f32_32x32x16_bf16(cat8(va[s], vc[s]), pf[s], o[qt][dt], 0, 0, 0); }
        }
        MX_FENCE();
    }
#undef MX_DMAK
#undef MX_DMAV
#pragma unroll
    for (int qt = 0; qt < 2; ++qt) { float lt = l[qt]; lt += __shfl_xor(lt, 32); const float inv = 1.0f / lt;
#pragma unroll
        for (int r = 0; r < 16; ++r) { o[qt][0][r] *= inv; o[qt][1][r] *= inv; } }
}

__device__ __forceinline__ void sgu_task(const bf16* P, const LAS float* rstab, const bf16* wsp_l, const float* sgu_g, const float* bsp_l, int b, int c, int g, LAS unsigned char* wl, int lane_in, f32x16 (&o)[2][2]) {
    int lane = lane_in; asm volatile("" : "+v"(lane));
    const int r32 = lane & 31, hi = lane >> 5;
    const int nb = c >> 1, cb = c & 1, ns = cb ? 128 : 64;
    const size_t srow0 = (size_t)b * SEQ + nb * 128, tok0 = (size_t)b * SEQ + c * 64;
    const int prow = lane >> 3, pch = lane & 7;
    const f32x4 g0 = *(const f32x4*)(sgu_g + g * 64 + pch * 8), g1 = *(const f32x4*)(sgu_g + g * 64 + pch * 8 + 4);
    v4u ureg[8];
#pragma unroll
    for (int i = 0; i < 8; ++i) ureg[i] = *(const v4u*)(P + (tok0 + prow + 8 * i) * NIN + 1536 + g * 64 + pch * 8);
    const bf16* wrow = wsp_l + ((size_t)g * 128 + cb * 64 + r32) * 128 + hi * 8;
    bf16x8 wfa[8], wfb[8];
#pragma unroll
    for (int step = 0; step < 8; ++step) if (step * 16 < ns) { wfa[step] = *(const bf16x8*)(wrow + 16 * step); wfb[step] = *(const bf16x8*)(wrow + 32 * 128 + 16 * step); }
    MX_FENCE();
#pragma unroll
    for (int hb = 0; hb < 2; ++hb) {
        if (hb * 64 < ns) {
            v4u raw[8];
#pragma unroll
            for (int i = 0; i < 8; ++i) raw[i] = *(const v4u*)(P + (srow0 + hb * 64 + prow + 8 * i) * NIN + 2048 + g * 64 + pch * 8);
#pragma unroll
            for (int i = 0; i < 8; ++i) { const int row = hb * 64 + prow + 8 * i; const f32x4 q0 = *(const LAS f32x4*)(rstab + row * 8), q1 = *(const LAS f32x4*)(rstab + row * 8 + 4);
                const float rs = __builtin_amdgcn_rsqf((((q0[0] + q0[1]) + (q0[2] + q0[3])) + ((q1[0] + q1[1]) + (q1[2] + q1[3]))) * (1.0f / 512.0f) + pg8::RMS_EPS);
                v4u w;
                w.x = cvtpk(__builtin_bit_cast(float, raw[i].x << 16) * rs * g0[0], __builtin_bit_cast(float, raw[i].x & 0xffff0000u) * rs * g0[1]);
                w.y = cvtpk(__builtin_bit_cast(float, raw[i].y << 16) * rs * g0[2], __builtin_bit_cast(float, raw[i].y & 0xffff0000u) * rs * g0[3]);
                w.z = cvtpk(__builtin_bit_cast(float, raw[i].z << 16) * rs * g1[0], __builtin_bit_cast(float, raw[i].z & 0xffff0000u) * rs * g1[1]);
                w.w = cvtpk(__builtin_bit_cast(float, raw[i].w << 16) * rs * g1[2], __builtin_bit_cast(float, raw[i].w & 0xffff0000u) * rs * g1[3]);
                *(LAS v4u*)(wl + vimg(row, pch)) = w; }
        }
    }
    MX_FENCE();
#pragma unroll
    for (int r = 0; r < 16; ++r) { o[0][0][r] = 0.f; o[0][1][r] = 0.f; o[1][0][r] = 0.f; o[1][1][r] = 0.f; }
    const int dhalf = (lane >> 4) & 1, qq = (lane & 15) >> 2, p4 = lane & 3;
    int vbs[2];
#pragma unroll
    for (int ct = 0; ct < 2; ++ct) vbs[ct] = (8 * hi + qq) * 128 + ((64 * ct + 32 * dhalf + 8 * p4) ^ ((qq >> 1) << 6));
#pragma unroll
    for (int step = 0; step < 8; ++step) { if (step * 16 < ns) {
        const bf16x8 wf0 = wfa[step], wf1 = wfb[step];
#pragma unroll
        for (int ct = 0; ct < 2; ++ct) { const s16x4 a0 = tr64(wl + vbs[ct] + (16 * step) * 128), a1 = tr64(wl + vbs[ct] + (16 * step + 4) * 128);
            const bf16x8 af = cat8(a0, a1);
            o[0][ct] = __builtin_amdgcn_mfma_f32_32x32x16_bf16(af, wf0, o[0][ct], 0, 0, 0);
            o[1][ct] = __builtin_amdgcn_mfma_f32_32x32x16_bf16(af, wf1, o[1][ct], 0, 0, 0); }
    } }
    MX_FENCE();
#pragma unroll
    for (int i = 0; i < 8; ++i) { const int row = 8 * i + prow; *(LAS v4u*)(wl + row * 128 + ((pch ^ (row & 7)) * 16)) = ureg[i]; }
    MX_FENCE();
#pragma unroll
    for (int tt = 0; tt < 2; ++tt) {
        const int tok = 32 * tt + r32;
        const float bt = bsp_l[g * 128 + cb * 64 + tok];
#pragma unroll
        for (int ct = 0; ct < 2; ++ct)
#pragma unroll
            for (int rg = 0; rg < 4; ++rg) { const u32x2 uu = *(const LAS u32x2*)(wl + tok * 128 + (((4 * ct + rg) ^ (tok & 7)) * 16) + hi * 8);
                o[tt][ct][4 * rg + 0] = __builtin_bit_cast(float, uu.x << 16) * (o[tt][ct][4 * rg + 0] + bt); o[tt][ct][4 * rg + 1] = __builtin_bit_cast(float, uu.x & 0xffff0000u) * (o[tt][ct][4 * rg + 1] + bt);
                o[tt][ct][4 * rg + 2] = __builtin_bit_cast(float, uu.y << 16) * (o[tt][ct][4 * rg + 2] + bt); o[tt][ct][4 * rg + 3] = __builtin_bit_cast(float, uu.y & 0xffff0000u) * (o[tt][ct][4 * rg + 3] + bt); }
    }
    MX_FENCE();
}

__device__ __forceinline__ void norm_store(const f32x16 (&o)[2][2], LAS float* red, LAS unsigned char* wl, int wave, int lane_in, const float* gain, bf16* dst) {
    int lane = lane_in; asm volatile("" : "+v"(lane));
    const int r32 = lane & 31, hi = lane >> 5;
    f32x4 gvv[2][4];
#pragma unroll
    for (int ct = 0; ct < 2; ++ct)
#pragma unroll
        for (int rg = 0; rg < 4; ++rg) gvv[ct][rg] = *(const f32x4*)(gain + 32 * ct + 8 * rg + 4 * hi);
#pragma unroll
    for (int tt = 0; tt < 2; ++tt) { float ss = 0.f;
#pragma unroll
        for (int r = 0; r < 16; ++r) ss += o[tt][0][r] * o[tt][0][r] + o[tt][1][r] * o[tt][1][r];
        ss += __shfl_xor(ss, 32);
        if (hi == 0) red[wave * 64 + tt * 32 + r32] = ss; }
    __syncthreads();
#pragma unroll
    for (int tt = 0; tt < 2; ++tt) { float tot = 0.f; const int tok = 32 * tt + r32;
#pragma unroll
        for (int w = 0; w < 8; ++w) tot += red[w * 64 + tok];
        const float rn = __builtin_amdgcn_rsqf(tot * (1.0f / 512.0f) + pg8::RMS_EPS);
#pragma unroll
        for (int ct = 0; ct < 2; ++ct)
#pragma unroll
            for (int rg = 0; rg < 4; ++rg) { const f32x4 gv = gvv[ct][rg];
                u32x2 w; w.x = cvtpk(o[tt][ct][4 * rg + 0] * rn * gv[0], o[tt][ct][4 * rg + 1] * rn * gv[1]); w.y = cvtpk(o[tt][ct][4 * rg + 2] * rn * gv[2], o[tt][ct][4 * rg + 3] * rn * gv[3]);
                *(LAS u32x2*)(wl + tok * 128 + (((4 * ct + rg) ^ (tok & 7)) * 16) + hi * 8) = w; } }
    MX_FENCE();
    const int prow = lane >> 3, pch = lane & 7;
#pragma unroll
    for (int i = 0; i < 8; ++i) { const int row = 8 * i + prow; const v4u v = *(const LAS v4u*)(wl + row * 128 + ((pch ^ (row & 7)) * 16));
        *(v4u*)(dst + (size_t)row * DM + pch * 8) = v; }
    MX_FENCE();
}

__device__ __forceinline__ void fill_bias_table(CArgs* a, int l, LAS unsigned char* lds) {
    const float* rel = a->in[5] + (size_t)l * 8 * 257; LAS float* tbl = (LAS float*)(lds + TBL_OFF);
    for (int i = threadIdx.x; i < 8 * TBL_LD; i += NWAVES * 64) { const int h = i / TBL_LD, k = i % TBL_LD; tbl[i] = rel[h * 257 + (k < 256 ? k : 256)] * pg8::LOG2E; }
}
__device__ __forceinline__ void mixer_fast(CArgs* a, int l, LAS unsigned char* lds, int wave, int lane, int vb) {
    const bf16* P = (const bf16*)(a->ws + WS_PROJ); bf16* MIX = (bf16*)(a->ws + WS_MIX);
    const float* vgss = (const float*)(a->ws + WS_VGSS); const bf16* wsp_l = (const bf16*)(a->ws + WS_WSP) + (size_t)l * 8 * 128 * 128;
    const float* rel = a->in[5] + (size_t)l * 8 * 257; const float* sgu_g = a->in[6] + l * 512; const float* bsp_l = a->in[8] + l * 8 * 128;
    const float* ag = a->in[9] + l * 512; const float* gg = a->in[10] + l * 512;
    LAS float* tbl = (LAS float*)(lds + TBL_OFF); LAS float* red = (LAS float*)(lds + RED_OFF); LAS float* rstab = (LAS float*)(lds + RS_OFF);
    LAS unsigned char* wl = lds + wave * 16384;
    for (int u = vb; u < NB * (SEQ / 64); u += gridDim.x) {
        const int b = u & 7, c = u >> 3;
        const size_t tok0 = (size_t)b * SEQ + c * 64;
        if (wave == 0) {
            const char* src = (const char*)(vgss + ((size_t)b * SEQ + (c >> 1) * 128) * 8) + lane * 16;
#pragma unroll
            for (int i = 0; i < 4; ++i) __builtin_amdgcn_global_load_lds((const unsigned*)(src + i * 1024), (LAS unsigned*)(lds + RS_OFF + i * 1024), 16, 0, 0);
        }
        f32x16 o[2][2];
        REPEAT(7) attn_task(P, b, c, wave, wl, tbl + wave * TBL_LD, lane, o);
        norm_store(o, red, wl, wave, lane, ag + wave * 64, MIX + tok0 * DM + wave * 64);
        REPEAT(8) sgu_task(P, rstab, wsp_l, sgu_g, bsp_l, b, c, wave, wl, lane, o);
        norm_store(o, red + 512, wl, wave, lane, gg + wave * 64, MIX + tok0 * DM + 512 + wave * 64);
    }
    __syncthreads();
}
}

__global__ void __launch_bounds__(NWAVES * 64, 2) fwd_megakernel(Args a_unused) {
    extern __shared__ __attribute__((aligned(16))) unsigned char lds_raw[];
    LAS unsigned char* lds = (LAS unsigned char*)lds_raw;
    if (threadIdx.x < 16) ((LAS unsigned*)(lds + MISC_OFF))[threadIdx.x] = 0u;
    __syncthreads();
    (void)xcd_barrier_post((unsigned*)(kargs_ws() + WS_BAR), (volatile LAS unsigned*)(lds + MISC_OFF));
    if (threadIdx.x == 64) { const unsigned x_ = xb_xcc_id(); ((volatile LAS unsigned*)(lds + MISC_OFF))[7] = xb_add((unsigned*)(kargs_ws() + WS_XIDX) + 64 * x_, 1u); }
    { const int tid = threadIdx.x, lane = tid & 63, wave = __builtin_amdgcn_readfirstlane(tid >> 6);
      REPEAT(0) prologue(kargs(), lds, wave, lane); }
    GRID_BAR();
    if (threadIdx.x == 64) { volatile LAS unsigned* mi = (volatile LAS unsigned*)(lds + MISC_OFF); unsigned* xi = (unsigned*)(kargs_ws() + WS_XIDX); bool ok = (gridDim.x & 7u) == 0u;
        for (int j = 0; j < 16; ++j) { const unsigned cj = xb_ld(xi + 64 * j); ok = ok && (j < 8 ? cj == (gridDim.x >> 3) : cj == 0u); }
        mi[6] = ok ? mi[7] * 8u + xb_xcc_id() : blockIdx.x; mi[4] = ok ? 1u : 0u; }
    __syncthreads();
#if (REPM >> 6) & 1
    for (int i_ = 0; i_ < 10; ++i_) GRID_BAR();
#endif
#pragma nounroll
    for (int l = 0; l < DEPTH; ++l) {
#if PHM & 1
        REPEAT(1) {
            CArgs* a = kargs(); unsigned char* ws = a->ws; unsigned char* wb = ws + WS_W0 + (size_t)l * WS_WSTRIDE;
            pg8::Gemm g{(const bf16*)(ws + WS_XB), (const bf16*)(wb + WOFF_IN), M, NIN, DM}; pg8::StaticOrder S; S.init(M, NIN, (int)gridDim.x, VBID());
            pg8::Unit u0; u0.pm = -1; u0.pn = 0; (void)S.next(0, u0);
            { LAS float* rsl = (LAS float*)(lds + 131072); const int t_ = threadIdx.x;
              if (u0.pm >= 0 && t_ < 256) rsl[t_] = pg8::row_rs((const float*)(ws + WS_ROWSS), u0.pm * 256 + t_);
              else if (t_ >= 256 && t_ < 384) rsl[t_] = t_ < 320 ? a->in[3][l * 64 + t_ - 256] * pg8::QSCALE : a->in[4][l * 64 + t_ - 320];
              __syncthreads(); }
            pg8::EpiInProj E{(bf16*)(ws + WS_PROJ), (const float*)(ws + WS_ROWSS), (float*)(ws + WS_VGSS), a->in[3] + l * 64, a->in[4] + l * 64, (const LAS float*)(lds + 131072), u0.pm};
            pg8::gemm_phase<pg8::EpiInProj, pg8::StaticOrder, true, true>(lds, g, S, E);
        }
#endif
        if (l == 0 && 2 * VBID() >= (int)gridDim.x) {
            int tid = threadIdx.x; asm volatile("" : "+v"(tid)); const int lane = tid & 63, wave = __builtin_amdgcn_readfirstlane(tid >> 6);
            const int half = gridDim.x - gridDim.x / 2;
            convert_weights(kargs(), lds, wave, lane, CW_I_IN, CW_I_LAYER, (VBID() - (int)gridDim.x / 2) * NWAVES + wave, half * NWAVES);
        }
#if FAST_MIXER
        mx::fill_bias_table(kargs(), l, lds);
#endif
        if (l == 0) GRID_BAR(); else GROUP_BAR();
#if PHM & 2
        REPEAT(2) { int tid = threadIdx.x; asm volatile("" : "+v"(tid)); const int lane = tid & 63, wave = __builtin_amdgcn_readfirstlane(tid >> 6);
#if FAST_MIXER
          mx::mixer_fast(kargs(), l, lds, wave, lane, VBID());
#else
          mixer_naive(kargs(), l, lds, wave, lane);
#endif
        }
#endif
#if PHM & 4
        REPEAT(3) {
            CArgs* a = kargs(); unsigned char* ws = a->ws; unsigned char* wb = ws + WS_W0 + (size_t)l * WS_WSTRIDE; float* xo = a->out;
            pg8::Gemm g{(const bf16*)(ws + WS_MIX), (const bf16*)(wb + WOFF_OUT), M, DM, DM}; pg8::StaticOrder S; S.init(M, DM, (int)gridDim.x, VBID());
            pg8::EpiResid E{l == 0 ? a->in[0] : (const float*)nullptr, (float*)nullptr, (bf16*)(ws + WS_XB), (float*)(ws + WS_ROWSS)};
            PreGroupBar pre{ws, (volatile LAS unsigned*)(lds + MISC_OFF)};
            pg8::gemm_phase<pg8::EpiResid, pg8::StaticOrder, false, true, false, PreGroupBar>(lds, g, S, E, pre);
        }
#endif
        GROUP_BAR();
#if PHM & 8
        REPEAT(4) {
            CArgs* a = kargs(); unsigned char* ws = a->ws; unsigned char* wb = ws + WS_W0 + (size_t)l * WS_WSTRIDE;
            pg8::Gemm g{(const bf16*)(ws + WS_XB), (const bf16*)(wb + WOFF_FIN), M, NFF2, DM}; pg8::StaticOrder S; S.init(M, NFF2, (int)gridDim.x, VBID());
            pg8::Unit u0; u0.pm = -1; u0.pn = 0; (void)S.next(0, u0);
            { LAS float* rsl = (LAS float*)(lds + 131072); if (u0.pm >= 0 && threadIdx.x < 256) rsl[threadIdx.x] = pg8::row_rs((const float*)(ws + WS_ROWSS), u0.pm * 256 + (int)threadIdx.x); __syncthreads(); }
            pg8::EpiSwiGLU E{(bf16*)(ws + WS_HID), (const float*)(ws + WS_ROWSS), (const LAS float*)(lds + 131072), u0.pm};
            pg8::gemm_phase<pg8::EpiSwiGLU, pg8::StaticOrder, true, true>(lds, g, S, E);
        }
#endif
        if (l == 0 && 2 * VBID() >= (int)gridDim.x) {
            int tid = threadIdx.x; asm volatile("" : "+v"(tid)); const int lane = tid & 63, wave = __builtin_amdgcn_readfirstlane(tid >> 6);
            const int half = gridDim.x - gridDim.x / 2;
            convert_weights(kargs(), lds, wave, lane, CW_I_LAYER, 2 * CW_I_LAYER, (VBID() - (int)gridDim.x / 2) * NWAVES + wave, half * NWAVES);
        }
#if PHM & 16
        REPEAT(5) {
            CArgs* a = kargs(); unsigned char* ws = a->ws; unsigned char* wb = ws + WS_W0 + (size_t)l * WS_WSTRIDE; float* xo = a->out;
            pg8::Gemm g{(const bf16*)(ws + WS_HID), (const bf16*)(wb + WOFF_FOUT), M, DM, DFF}; pg8::StaticOrder S; S.init(M, DM, (int)gridDim.x, VBID());
            pg8::EpiResid E{(const float*)nullptr, l + 1 < DEPTH ? (float*)nullptr : xo, (bf16*)(ws + WS_XB), (float*)(ws + WS_ROWSS)};
            PreGroupBar pre{ws, (volatile LAS unsigned*)(lds + MISC_OFF)};
            pg8::gemm_phase<pg8::EpiResid, pg8::StaticOrder, false, true, true, PreGroupBar>(lds, g, S, E, pre);
        }
#endif
        if (l + 1 < DEPTH) GRID_BAR();
    }
}

extern "C" void kernel_launch(void* const* d_in, const int* in_sizes, int n_in, void* d_out, int out_size, void* d_ws, size_t ws_size, hipStream_t stream) {
    static int grid = 0;
    if (grid == 0) {
        if (n_in != 15 || in_sizes[0] != M * DM || out_size != M * DM || ws_size < WS_END) { fprintf(stderr, "kernel_launch: unexpected shapes (n_in %d, ws %zu)\n", n_in, ws_size); grid = -1; return; }
        int dev = 0, cus = 0, per_cu = 0;
        hipGetDevice(&dev); hipDeviceGetAttribute(&cus, hipDeviceAttributeMultiprocessorCount, dev);
        if (hipFuncSetAttribute((const void*)fwd_megakernel, hipFuncAttributeMaxDynamicSharedMemorySize, LDS_BYTES) != hipSuccess) { fprintf(stderr, "kernel_launch: hipFuncSetAttribute failed\n"); grid = -1; return; }
        if (hipOccupancyMaxActiveBlocksPerMultiprocessor(&per_cu, (const void*)fwd_megakernel, NWAVES * 64, LDS_BYTES) != hipSuccess || per_cu < 1) { fprintf(stderr, "kernel_launch: occupancy query failed (%d)\n", per_cu); (void)hipGetLastError(); per_cu = 1; }
        grid = cus * (per_cu > 1 ? 1 : per_cu);
        if (grid != 256) { fprintf(stderr, "kernel_launch: built for a 256-CU device (one 256x256 unit per workgroup in the N = 1024 phases); got %d\n", grid); grid = -1; return; }
    }
    if (grid < 0) return;
    if (hipMemsetAsync((char*)d_ws + WS_BAR, 0, BAR_ZERO_BYTES, stream) != hipSuccess) { fprintf(stderr, "kernel_launch: hipMemsetAsync failed\n"); return; }
    Args a{};
    for (int i = 0; i < 15; ++i) a.in[i] = (const float*)d_in[i];
    a.out = (float*)d_out; a.ws = (unsigned char*)d_ws;
    void* args[] = {&a};
    hipError_t e = hipLaunchCooperativeKernel((const void*)fwd_megakernel, dim3(grid), dim3(NWAVES * 64), args, LDS_BYTES, stream);
    if (e != hipSuccess) fprintf(stderr, "cooperative launch failed: %s (grid %d)\n", hipGetErrorString(e), grid);
}
```

```cpp
#include <hip/hip_runtime.h>
#include <hip/hip_cooperative_groups.h>
#include <cstdio>
#include <cstdint>
namespace cg = cooperative_groups;
namespace pg8 {
#define PG8_LAS __attribute__((address_space(3)))
typedef unsigned short bf16_t;
typedef short bf16x8 __attribute__((ext_vector_type(8)));
typedef float f32x4 __attribute__((ext_vector_type(4)));
typedef unsigned u32x4 __attribute__((ext_vector_type(4)));
constexpr int BM = 256, BK = 64, HALF = 128, HTB = HALF * BK * 2  , STAGE_BYTES = 8 * HTB, NXCD = 8, WGM = 8;

__host__ __device__ __forceinline__ int lds_byte(int r, int c) { const int st = (r >> 4) * 2 + (c >> 5), rr = r & 15, cc = c & 31, ob = rr * 64 + cc * 2; return st * 1024 + (ob ^ (((ob >> 9) & 1) << 5)); }
__host__ __device__ __forceinline__ void stage_rc(int b, int& R, int& C) { const int st = b / 1024, sb = b % 1024, swz = sb ^ (((sb >> 9) & 1) << 5); R = (st >> 1) * 16 + swz / 64; C = (st & 1) * 32 + (swz % 64) / 2; }
__host__ __device__ __forceinline__ int perm32(int rho) { const int n = rho >> 4, i = rho & 15; return 8 * (i >> 2) + 4 * n + (i & 3); }

struct Unit { int pm, pn; };
struct Gemm { const bf16_t* A; const bf16_t* Bt; int M, N, K; };

struct StaticOrder {
    int nM, nN, nwg, G, c;
    __host__ __device__ void init(int M, int N, int G_, int c_) { nM = M / BM; nN = N / BM; nwg = nM * nN; G = G_; c = c_; }
    __host__ __device__ bool next(int i, Unit& u) const {
        const long L = (long)i * G + c; if (L >= nwg) return false;
        int wgid = (int)L; { const int q = nwg / NXCD, r = nwg % NXCD, xcd = wgid % NXCD, off = wgid / NXCD; wgid = (xcd < r ? xcd * (q + 1) : r * (q + 1) + (xcd - r) * q) + off; }
        const int nig = WGM * nN, gid = wgid / nig, fm = gid * WGM, gsz = (nM - fm) < WGM ? (nM - fm) : WGM;
        u.pm = fm + ((wgid % nig) % gsz); u.pn = (wgid % nig) / gsz; return true;
    }
    __device__ __forceinline__ void a_ready(const Unit&) const {}
    __device__ __forceinline__ void done(const Unit&) const {}
};

__device__ __forceinline__ unsigned cvt_pk_bf16(float lo, float hi) { unsigned r; asm volatile("v_cvt_pk_bf16_f32 %0, %1, %2" : "=v"(r) : "v"(lo), "v"(hi)); return r; }
typedef float f32x2 __attribute__((ext_vector_type(2)));
constexpr float RMS_EPS = 1e-6f;
constexpr float LOG2E = 1.4426950408889634f;
constexpr float QSCALE = 0.125f * 1.4426950408889634f;
__device__ __forceinline__ float gelu_tanh(float x) {
    const float z2 = x * (1.5957691216057308f + 0.07135481627260025f * x * x);
    const float e = __builtin_amdgcn_exp2f(-LOG2E * z2);
    return x * __builtin_amdgcn_rcpf(1.0f + e);
}
__device__ __forceinline__ float row_rs(const float* rowss, int row) {
    const f32x4 a = *(const f32x4*)(rowss + (size_t)row * 4);
    return __builtin_amdgcn_rsqf(((a[0] + a[1]) + (a[2] + a[3])) * (1.0f / 1024.0f) + RMS_EPS);
}
struct EpiInProj {
    static constexpr bool PERM = true, AFTER_DRAIN = false, INIT = false;
    bf16_t* P; const float* rowss; float* vgss; const float* qg; const float* kg; const PG8_LAS float* rs_lds; int pm_cached;
    __device__ __forceinline__ void operator()(const f32x4 (&acc)[2][2][4][2], const Unit& u, int wr, int wc, int fr, int fq) const {
        const int region = u.pn >> 1, half = u.pn & 1;
        const int lcol = region * 512 + half * 256 + wc * 64 + fq * 8;
        float gq[2][8];
#pragma unroll
        for (int bj = 0; bj < 2; ++bj)
#pragma unroll
            for (int e = 0; e < 8; ++e) gq[bj][e] = 1.f;
        if (region < 2) { const PG8_LAS float* g = rs_lds + 256 + region * 64;
#pragma unroll
            for (int bj = 0; bj < 2; ++bj)
#pragma unroll
                for (int e = 0; e < 8; ++e) gq[bj][e] = g[bj * 32 + fq * 8 + e]; }
#pragma unroll
        for (int ai = 0; ai < 2; ++ai)
#pragma unroll
            for (int m = 0; m < 4; ++m) {
                const int row = u.pm * BM + ai * HALF + wr * 64 + m * 16 + fr;
                const float s = (u.pm == pm_cached) ? rs_lds[ai * HALF + wr * 64 + m * 16 + fr] : row_rs(rowss, row);
                float v[2][8];
#pragma unroll
                for (int bj = 0; bj < 2; ++bj)
#pragma unroll
                    for (int n = 0; n < 2; ++n)
#pragma unroll
                        for (int i = 0; i < 4; ++i) v[bj][4 * n + i] = acc[ai][bj][m][n][i] * s;
                if (region < 2) {
                    float q = 0.f;
#pragma unroll
                    for (int bj = 0; bj < 2; ++bj)
#pragma unroll
                        for (int e = 0; e < 8; ++e) q += v[bj][e] * v[bj][e];
                    q += __shfl_xor(q, 16); q += __shfl_xor(q, 32);
                    const float r = __builtin_amdgcn_rsqf(q * (1.0f / 64.0f) + RMS_EPS);
#pragma unroll
                    for (int bj = 0; bj < 2; ++bj)
#pragma unroll
                        for (int e = 0; e < 8; ++e) v[bj][e] = v[bj][e] * r * gq[bj][e];
                } else if (region >= 3) {
#pragma unroll
                    for (int bj = 0; bj < 2; ++bj)
#pragma unroll
                        for (int e = 0; e < 8; ++e) v[bj][e] = gelu_tanh(v[bj][e]);
                    if (region == 4) {
                        float q = 0.f;
#pragma unroll
                        for (int bj = 0; bj < 2; ++bj)
#pragma unroll
                            for (int e = 0; e < 8; ++e) q += v[bj][e] * v[bj][e];
                        q += __shfl_xor(q, 16); q += __shfl_xor(q, 32);
                        if (fq == 0) vgss[(size_t)row * 8 + half * 4 + wc] = q;
                    }
                }
                bf16_t* rowp = P + (size_t)row * 2560 + lcol;
#pragma unroll
                for (int bj = 0; bj < 2; ++bj) { u32x4 w; w.x = cvt_pk_bf16(v[bj][0], v[bj][1]); w.y = cvt_pk_bf16(v[bj][2], v[bj][3]); w.z = cvt_pk_bf16(v[bj][4], v[bj][5]); w.w = cvt_pk_bf16(v[bj][6], v[bj][7]);
                    *(u32x4*)(rowp + bj * 32) = w; }
            }
    }
};
struct EpiResid {
    static constexpr bool PERM = true, AFTER_DRAIN = true, INIT = true;
    const float* base32; float* out32; bf16_t* xb; float* rowss;
    __device__ __forceinline__ void init(f32x4 (&acc)[2][2][4][2], const Unit& u, int wr, int wc, int fr, int fq) const {
        const int col0 = u.pn * BM + wc * 32 + 8 * fq;
        if (base32) {
#pragma unroll
            for (int ai = 0; ai < 2; ++ai)
#pragma unroll
                for (int m = 0; m < 4; ++m) { const size_t off = (size_t)(u.pm * BM + ai * HALF + wr * 64 + m * 16 + fr) * 1024 + col0;
#pragma unroll
                    for (int bj = 0; bj < 2; ++bj) { acc[ai][bj][m][0] = __builtin_nontemporal_load((const f32x4*)(base32 + off + bj * HALF)); acc[ai][bj][m][1] = __builtin_nontemporal_load((const f32x4*)(base32 + off + bj * HALF + 4)); } }
        } else {
#pragma unroll
            for (int ai = 0; ai < 2; ++ai)
#pragma unroll
                for (int m = 0; m < 4; ++m) { const size_t off = (size_t)(u.pm * BM + ai * HALF + wr * 64 + m * 16 + fr) * 1024 + col0;
#pragma unroll
                    for (int bj = 0; bj < 2; ++bj) { const u32x4 w = *(const u32x4*)(xb + off + bj * HALF);
                        acc[ai][bj][m][0] = (f32x4){__builtin_bit_cast(float, w.x << 16), __builtin_bit_cast(float, w.x & 0xffff0000u), __builtin_bit_cast(float, w.y << 16), __builtin_bit_cast(float, w.y & 0xffff0000u)};
                        acc[ai][bj][m][1] = (f32x4){__builtin_bit_cast(float, w.z << 16), __builtin_bit_cast(float, w.z & 0xffff0000u), __builtin_bit_cast(float, w.w << 16), __builtin_bit_cast(float, w.w & 0xffff0000u)}; } }
        }
    }
    __device__ __forceinline__ void fused(f32x4 (&acc)[2][2][4][2], const Unit& u, int wr, int wc, int fr, int fq, PG8_LAS unsigned char* lds, int wid, int lane) const {
        PG8_LAS float* part = (PG8_LAS float*)lds;
        const int col0 = u.pn * BM + wc * 32 + 8 * fq;
#pragma unroll
        for (int ai = 0; ai < 2; ++ai)
#pragma unroll
            for (int m = 0; m < 4; ++m) {
                const int rl = ai * HALF + wr * 64 + m * 16 + fr;
                const size_t off = (size_t)(u.pm * BM + rl) * 1024 + col0;
                float q = 0.f;
#pragma unroll
                for (int bj = 0; bj < 2; ++bj) {
                    const f32x4 v0 = acc[ai][bj][m][0], v1 = acc[ai][bj][m][1];
                    if (out32) { *(f32x4*)(out32 + off + bj * HALF) = v0; *(f32x4*)(out32 + off + bj * HALF + 4) = v1; }
                    else { u32x4 w; w.x = cvt_pk_bf16(v0[0], v0[1]); w.y = cvt_pk_bf16(v0[2], v0[3]); w.z = cvt_pk_bf16(v1[0], v1[1]); w.w = cvt_pk_bf16(v1[2], v1[3]);
                        *(u32x4*)(xb + off + bj * HALF) = w; }
                    q += (v0[0] * v0[0] + v0[1] * v0[1]) + (v0[2] * v0[2] + v0[3] * v0[3]) + (v1[0] * v1[0] + v1[1] * v1[1]) + (v1[2] * v1[2] + v1[3] * v1[3]);
                }
                q += __shfl_xor(q, 16); q += __shfl_xor(q, 32);
                if (fq == 0) part[rl * 4 + wc] = q;
            }
        asm volatile("s_waitcnt lgkmcnt(0)" ::: "memory"); __builtin_amdgcn_s_barrier(); asm volatile("" ::: "memory");
        const int t = wid * 64 + lane;
        if (t < 256) { const f32x4 p = *(const PG8_LAS f32x4*)(part + t * 4); rowss[(size_t)(u.pm * BM + t) * 4 + u.pn] = (p[0] + p[1]) + (p[2] + p[3]); }
    }
};
struct EpiSwiGLU {
    static constexpr bool PERM = true, AFTER_DRAIN = false, INIT = false;
    bf16_t* H; const float* rowss; const PG8_LAS float* rs_lds; int pm_cached;
    __device__ __forceinline__ void operator()(const f32x4 (&acc)[2][2][4][2], const Unit& u, int wr, int wc, int fr, int fq) const {
        const int col0 = u.pn * 128 + wc * 32 + 8 * fq;
#pragma unroll
        for (int ai = 0; ai < 2; ++ai)
#pragma unroll
            for (int m = 0; m < 4; ++m) {
                const int row = u.pm * BM + ai * HALF + wr * 64 + m * 16 + fr;
                const float s = (u.pm == pm_cached) ? rs_lds[ai * HALF + wr * 64 + m * 16 + fr] : row_rs(rowss, row);
                float h[8];
#pragma unroll
                for (int n = 0; n < 2; ++n)
#pragma unroll
                    for (int i = 0; i < 4; ++i) { const float g = acc[ai][0][m][n][i] * s, up = acc[ai][1][m][n][i] * s;
                        h[4 * n + i] = g * __builtin_amdgcn_rcpf(1.0f + __builtin_amdgcn_exp2f(-LOG2E * g)) * up; }
                u32x4 w; w.x = cvt_pk_bf16(h[0], h[1]); w.y = cvt_pk_bf16(h[2], h[3]); w.z = cvt_pk_bf16(h[4], h[5]); w.w = cvt_pk_bf16(h[6], h[7]);
                *(u32x4*)(H + ((size_t)(col0 >> 6) * 16384 + row) * 64 + (col0 & 63)) = w;
            }
    }
};
struct NoPre { __device__ __forceinline__ void drain() const {} __device__ __forceinline__ void sync() const {} };
template <class Epi, class Sched, bool ALIGN_EPI = false, bool SP2 = false, bool TILED = false, class Pre = NoPre>
__device__ __forceinline__ void gemm_phase(PG8_LAS unsigned char* lds, const Gemm g, const Sched& S, const Epi& E, const Pre& pre = Pre()) {
    int tid_l = threadIdx.x; asm volatile("" : "+v"(tid_l));
    const int tid = tid_l, wid = __builtin_amdgcn_readfirstlane(tid >> 6), lane = tid & 63, wr = wid >> 2, wc = wid & 3, fr = lane & 15, fq = lane >> 4;
    const int K = g.K, nt = K / BK;
    unsigned voffA[2], voffB[2];
#pragma unroll
    for (int i = 0; i < 2; ++i) { int R, C; stage_rc(tid * 16 + i * 8192, R, C); const int Rb = Epi::PERM ? ((R & ~31) + perm32(R & 31)) : R;
        const int lda = TILED ? 64 : K; voffA[i] = (unsigned)(R * lda + C) * 2u; voffB[i] = (unsigned)(Rb * lda + C) * 2u; }
    const size_t kstepA = TILED ? (size_t)g.M * BK * 2 : (size_t)(BK * 2), kstepB = TILED ? (size_t)g.N * BK * 2 : (size_t)(BK * 2);
    const size_t hstep = (size_t)HALF * (TILED ? 64 : K) * 2;
    const size_t tstep = 2 * hstep;
    const unsigned ldsw = (unsigned)wid * 1024u;
    const int aoff = lds_byte(wr * 64 + fr, fq * 8), boff = lds_byte(wc * 32 + fr, fq * 8);
#define PG8_SA(b, h) (((b) * 2 + (h)) * HTB)
#define PG8_SB(b, h) ((4 + (b) * 2 + (h)) * HTB)
#define PG8_STAGE(bufoff, gbase, voff) do { _Pragma("unroll") for (int _i = 0; _i < 2; ++_i) \
        __builtin_amdgcn_global_load_lds((const unsigned*)((const char*)(gbase) + (voff)[_i]), (PG8_LAS unsigned*)(lds + (bufoff) + ldsw + _i * 8192), 16, 0, 0); } while (0)
#define PG8_LDA(dst, b, h) do { _Pragma("unroll") for (int m = 0; m < 4; ++m) _Pragma("unroll") for (int k = 0; k < 2; ++k) dst[m][k] = *(const PG8_LAS bf16x8*)(lds + PG8_SA(b, h) + aoff + m * 2048 + k * 1024); } while (0)
#define PG8_LDB(dst, b, h) do { _Pragma("unroll") for (int n = 0; n < 2; ++n) _Pragma("unroll") for (int k = 0; k < 2; ++k) dst[n][k] = *(const PG8_LAS bf16x8*)(lds + PG8_SB(b, h) + boff + n * 2048 + k * 1024); } while (0)
#define PG8_MMA(ai, bj, At, Bt) do { __builtin_amdgcn_s_setprio(1); _Pragma("unroll") for (int m = 0; m < 4; ++m) _Pragma("unroll") for (int n = 0; n < 2; ++n) _Pragma("unroll") for (int k = 0; k < 2; ++k) \
        acc[ai][bj][m][n] = __builtin_amdgcn_mfma_f32_16x16x32_bf16(Bt[n][k], At[m][k], acc[ai][bj][m][n], 0, 0, 0); __builtin_amdgcn_s_setprio(0); } while (0)
#define PG8_WAIT_V(n) asm volatile("s_waitcnt vmcnt(" #n ")" ::: "memory")
#define PG8_WAIT_L(n) asm volatile("s_waitcnt lgkmcnt(" #n ")" ::: "memory")
#define PG8_BAR __builtin_amdgcn_s_barrier()
#define PG8_SCHED __builtin_amdgcn_sched_barrier(0)
    Unit cur, nxt; int ui = 0;
    if (!S.next(0, cur)) return;
    f32x4 acc[2][2][4][2];
    pre.drain();
    if constexpr (Epi::INIT) E.init(acc, cur, wr, wc, fr, fq);
    else {
#pragma unroll
    for (int a = 0; a < 2; ++a)
#pragma unroll
        for (int b = 0; b < 2; ++b)
#pragma unroll
            for (int m = 0; m < 4; ++m)
#pragma unroll
                for (int n = 0; n < 2; ++n) acc[a][b][m][n] = (f32x4){0.f, 0.f, 0.f, 0.f};
    }
    pre.sync();
    bf16x8 At[4][2], B0[2][2], B1[2][2];
    const char* cA = (const char*)g.A + (size_t)cur.pm * tstep; const char* cB = (const char*)g.Bt + (size_t)cur.pn * tstep;
    S.a_ready(cur);
    if constexpr (SP2) {
        PG8_STAGE(PG8_SB(0, 0), cB, voffB); PG8_STAGE(PG8_SB(0, 1), cB + hstep, voffB); PG8_STAGE(PG8_SA(0, 0), cA, voffA); PG8_STAGE(PG8_SA(0, 1), cA + hstep, voffA);
        if (wr == 1) PG8_BAR;
        PG8_WAIT_V(2); PG8_BAR;
        PG8_STAGE(PG8_SB(1, 0), cB + kstepB, voffB); PG8_STAGE(PG8_SA(1, 0), cA + kstepA, voffA); PG8_STAGE(PG8_SB(1, 1), cB + hstep + kstepB, voffB);
        PG8_WAIT_V(6); PG8_BAR;
    } else {
        PG8_STAGE(PG8_SB(0, 0), cB, voffB); PG8_STAGE(PG8_SA(0, 0), cA, voffA); PG8_STAGE(PG8_SB(0, 1), cB + hstep, voffB); PG8_STAGE(PG8_SA(0, 1), cA + hstep, voffA);
        if (wr == 1) PG8_BAR;
        PG8_WAIT_V(4); PG8_BAR;
        PG8_STAGE(PG8_SB(1, 0), cB + kstepB, voffB); PG8_STAGE(PG8_SA(1, 0), cA + kstepA, voffA); PG8_STAGE(PG8_SB(1, 1), cB + hstep + kstepB, voffB);
        PG8_WAIT_V(6); PG8_BAR;
    }
    for (;;) {
        const bool has_next = S.next(ui + 1, nxt);
        const char* nA = has_next ? (const char*)g.A + (size_t)nxt.pm * tstep : cA; const char* nB = has_next ? (const char*)g.Bt + (size_t)nxt.pn * tstep : cB;
        for (int t = 0; t < nt; t += 2) {
            const bool last = (t == nt - 2);
            const char* a1 = cA + (size_t)(t + 1) * kstepA;
            const char* a2 = last ? nA : cA + (size_t)(t + 2) * kstepA; const char* b2 = last ? nB : cB + (size_t)(t + 2) * kstepB;
            const char* a3 = a2 + kstepA; const char* b3 = b2 + kstepB;
            if (last && has_next) S.a_ready(nxt);
            if constexpr (SP2) {
            PG8_LDB(B0, 0, 0); PG8_LDB(B1, 0, 1); PG8_SCHED; PG8_LDA(At, 0, 0); PG8_STAGE(PG8_SA(1, 1), a1 + hstep, voffA);
            PG8_WAIT_V(8); PG8_WAIT_L(0); PG8_BAR; PG8_MMA(0, 0, At, B0); PG8_MMA(0, 1, At, B1); PG8_BAR; PG8_SCHED;
            PG8_LDA(At, 0, 1); PG8_STAGE(PG8_SB(0, 0), b2, voffB); PG8_STAGE(PG8_SB(0, 1), b2 + hstep, voffB); PG8_STAGE(PG8_SA(0, 0), a2, voffA);
            PG8_WAIT_V(8); PG8_WAIT_L(0); PG8_BAR; PG8_MMA(1, 0, At, B0); PG8_MMA(1, 1, At, B1); PG8_BAR; PG8_SCHED;
            PG8_LDB(B0, 1, 0); PG8_LDB(B1, 1, 1); PG8_SCHED; PG8_LDA(At, 1, 0); PG8_STAGE(PG8_SA(0, 1), a2 + hstep, voffA);
            PG8_WAIT_V(8); PG8_WAIT_L(0); PG8_BAR; PG8_MMA(0, 0, At, B0); PG8_MMA(0, 1, At, B1); PG8_BAR; PG8_SCHED;
            PG8_LDA(At, 1, 1); PG8_STAGE(PG8_SB(1, 0), b3, voffB); PG8_STAGE(PG8_SB(1, 1), b3 + hstep, voffB); PG8_STAGE(PG8_SA(1, 0), a3, voffA);
            PG8_WAIT_V(8); PG8_WAIT_L(0); PG8_BAR; PG8_MMA(1, 0, At, B0); PG8_MMA(1, 1, At, B1); PG8_BAR; PG8_SCHED;
            } else {
            PG8_LDB(B0, 0, 0); PG8_SCHED; PG8_LDA(At, 0, 0); PG8_STAGE(PG8_SA(1, 1), a1 + hstep, voffA);
            PG8_WAIT_L(8); PG8_BAR; PG8_WAIT_L(0); PG8_MMA(0, 0, At, B0); PG8_BAR; PG8_SCHED;
            PG8_LDB(B1, 0, 1); PG8_STAGE(PG8_SB(0, 0), b2, voffB);
            PG8_BAR; PG8_WAIT_L(0); PG8_MMA(0, 1, At, B1); PG8_BAR;
            PG8_LDA(At, 0, 1); PG8_STAGE(PG8_SA(0, 0), a2, voffA);
            PG8_BAR; PG8_WAIT_L(0); PG8_MMA(1, 0, At, B0); PG8_BAR; PG8_SCHED;
            PG8_STAGE(PG8_SB(0, 1), b2 + hstep, voffB);
            PG8_WAIT_V(6); PG8_BAR; PG8_MMA(1, 1, At, B1); PG8_BAR;
            PG8_LDB(B0, 1, 0); PG8_SCHED; PG8_LDA(At, 1, 0); PG8_STAGE(PG8_SA(0, 1), a2 + hstep, voffA);
            PG8_WAIT_L(8); PG8_BAR; PG8_WAIT_L(0); PG8_MMA(0, 0, At, B0); PG8_BAR; PG8_SCHED;
            PG8_LDB(B1, 1, 1); PG8_STAGE(PG8_SB(1, 0), b3, voffB);
            PG8_BAR; PG8_WAIT_L(0); PG8_MMA(0, 1, At, B1); PG8_BAR;
            PG8_LDA(At, 1, 1); PG8_STAGE(PG8_SA(1, 0), a3, voffA);
            PG8_BAR; PG8_WAIT_L(0); PG8_MMA(1, 0, At, B0); PG8_BAR; PG8_SCHED;
            PG8_STAGE(PG8_SB(1, 1), b3 + hstep, voffB);
            PG8_WAIT_V(6); PG8_BAR; PG8_MMA(1, 1, At, B1); PG8_BAR;
            }
        }
        if constexpr (ALIGN_EPI) { if (wr == 0) PG8_BAR; }
        if constexpr (!Epi::AFTER_DRAIN) { E(acc, cur, wr, wc, fr, fq); S.done(cur); }
        if (!has_next) break;
        if constexpr (Epi::INIT) E.init(acc, nxt, wr, wc, fr, fq);
        else {
#pragma unroll
        for (int a = 0; a < 2; ++a)
#pragma unroll
            for (int b = 0; b < 2; ++b)
#pragma unroll
                for (int m = 0; m < 4; ++m)
#pragma unroll
                    for (int n = 0; n < 2; ++n) acc[a][b][m][n] = (f32x4){0.f, 0.f, 0.f, 0.f};
        }
        cur = nxt; cA = nA; cB = nB; ++ui;
        if constexpr (ALIGN_EPI) { if (wr == 1) PG8_BAR; }
    }
    PG8_WAIT_V(0);
    if constexpr (!ALIGN_EPI) { if (wr == 0) PG8_BAR; }
    PG8_BAR;
    if constexpr (Epi::AFTER_DRAIN) { E.fused(acc, cur, wr, wc, fr, fq, lds, wid, lane); S.done(cur); }
#undef PG8_SA
#undef PG8_SB
#undef PG8_STAGE
#undef PG8_LDA
#undef PG8_LDB
#undef PG8_MMA
#undef PG8_WAIT_V
#undef PG8_WAIT_L
#undef PG8_BAR
#undef PG8_SCHED
}
}
constexpr int NB = 8, SEQ = 2048, DM = 1024, M = NB * SEQ, NIN = 2560, DFF = 2816, NFF2 = 2 * DFF, DEPTH = 2;
constexpr int NWAVES = 8;
constexpr size_t MiB = 1u << 20;
constexpr size_t WS_ROWSS = 1 * MiB;
constexpr size_t WS_VGSS = 2 * MiB;
constexpr size_t WS_WSP = 3 * MiB;
constexpr size_t WS_W0 = 4 * MiB, WS_WSTRIDE = 24 * MiB;
constexpr size_t WOFF_IN = 0, WOFF_OUT = 5 * MiB, WOFF_FIN = 7 * MiB, WOFF_FOUT = 18 * MiB;
constexpr size_t WS_XB = 52 * MiB;
constexpr size_t WS_PROJ = 84 * MiB;
constexpr size_t WS_MIX = 164 * MiB;
constexpr size_t WS_HID = 84 * MiB;
constexpr size_t WS_END = 196 * MiB;
constexpr int LDS_BYTES = 155648;

#define GAS __attribute__((address_space(1)))
#define LAS __attribute__((address_space(3)))
typedef unsigned short bf16;
typedef unsigned v4u __attribute__((ext_vector_type(4)));
typedef float f32x4 __attribute__((ext_vector_type(4)));
__device__ __forceinline__ unsigned f2bf(float f) { unsigned u = __builtin_bit_cast(unsigned, f); return (u + 0x7fffu + ((u >> 16) & 1u)) >> 16; }
__device__ __forceinline__ unsigned pk2(float lo, float hi) { return f2bf(lo) | (f2bf(hi) << 16); }
__device__ __forceinline__ float bf2f(bf16 v) { return __builtin_bit_cast(float, (unsigned)v << 16); }
__device__ __forceinline__ float wave_sum(float v) {
#pragma unroll
    for (int o = 1; o < 64; o <<= 1) v += __shfl_xor(v, o);
    return v;
}
#define LDS_WAIT() asm volatile("s_waitcnt lgkmcnt(0)" ::: "memory")

typedef short tp_s16x4 __attribute__((ext_vector_type(4)));
__device__ __forceinline__ void p0_transpose_item(const float* W, int K, int N, bf16* WT, int k0, int n0, int prow0, int prow1, const float* gk, LAS unsigned char* scr, int lane, int tiled_n = 0) {
    const int lr = lane >> 4, n4 = (lane & 15) * 4;
    f32x4 v[16];
#pragma unroll
    for (int i = 0; i < 16; ++i) v[i] = __builtin_nontemporal_load((const f32x4*)(W + (size_t)(k0 + 4 * i + lr) * N + n0 + n4));
#pragma unroll
    for (int i = 0; i < 16; ++i) { const int k = 4 * i + lr; const float gg = gk ? gk[k0 + k] : 1.f;
        unsigned long long w = (unsigned long long)pk2(v[i].x * gg, v[i].y * gg) | ((unsigned long long)pk2(v[i].z * gg, v[i].w * gg) << 32);
        *(LAS unsigned long long*)(scr + k * 128 + ((n4 * 2) ^ (((k >> 1) & 1) << 6))) = w; }
    asm volatile("" ::: "memory");
    const int hh = lane >> 5, g2 = (lane >> 4) & 1, i16 = lane & 15, qq = i16 >> 2, p4 = i16 & 3;
#pragma unroll
    for (int j = 0; j < 8; ++j) { const int c = 2 * (j >> 1) + hh, nb = 32 * (j & 1) + 16 * g2;
        const int a0 = (8 * c + qq) * 128 + (((nb + 4 * p4) * 2) ^ ((qq >> 1) << 6));
        const tp_s16x4 lo = __builtin_bit_cast(tp_s16x4, __builtin_amdgcn_ds_read_tr16_b64_v4i16((LAS tp_s16x4*)(scr + a0)));
        const tp_s16x4 hi4 = __builtin_bit_cast(tp_s16x4, __builtin_amdgcn_ds_read_tr16_b64_v4i16((LAS tp_s16x4*)(scr + a0 + 4 * 128)));
        typedef short s16x8_t __attribute__((ext_vector_type(8)));
        const s16x8_t o = (s16x8_t){lo[0], lo[1], lo[2], lo[3], hi4[0], hi4[1], hi4[2], hi4[3]};
        const int prow = ((j & 1) ? prow1 : prow0) + 16 * g2 + i16;
        *(s16x8_t*)(WT + (tiled_n ? ((size_t)(k0 >> 6) * tiled_n + prow) * 64 + 8 * c : (size_t)prow * K + k0 + 8 * c)) = o; }
    LDS_WAIT(); asm volatile("" ::: "memory");
}
__host__ __device__ __forceinline__ int map_in(int n) { const int T = n >> 8, nn = n & 255; return 256 * T + 128 * ((nn >> 5) & 1) + 32 * (nn >> 6) + (nn & 31); }
__host__ __device__ __forceinline__ int map_fin(int n) { return n < DFF ? 256 * (n >> 7) + (n & 127) : 256 * ((n - DFF) >> 7) + 128 + ((n - DFF) & 127); }

typedef GAS unsigned gu32;
#define RLX_AGENT __ATOMIC_RELAXED, __HIP_MEMORY_SCOPE_AGENT
constexpr int MISC_OFF = LDS_BYTES - 64;
constexpr size_t WS_BAR = 0;
constexpr size_t BAR_ZERO_BYTES = 32768;
#define XB_TMO      128
#define XB_XCNT(j)  (256  + 64 * (j))
#define XB_XSUB(j)  (1280 + 64 * (j))
#define XB_XGEN(j)  (2304 + 64 * (j))
#define XB_TOP      3328
#define XB_TOPGEN   3392
#define XCD_BAR_WORDS 3456
#define XB_SPIN_CAP (1u << 18)

__device__ __forceinline__ unsigned xb_ld(unsigned* p)              { return __hip_atomic_load(p, __ATOMIC_RELAXED, __HIP_MEMORY_SCOPE_AGENT); }
__device__ __forceinline__ unsigned xb_add(unsigned* p, unsigned v) { return __hip_atomic_fetch_add(p, v, __ATOMIC_RELAXED, __HIP_MEMORY_SCOPE_AGENT); }
__device__ __forceinline__ unsigned xb_xcc_id() { return (unsigned)__builtin_amdgcn_s_getreg((3 << 11) | 20) & 0xFu; }
#define XB_SPIN(cond, bar) do { unsigned _sp = 0; while (cond) { __builtin_amdgcn_s_sleep(1); \
    if ((++_sp & 255u) == 0u) { if (xb_ld(&(bar)[XB_TMO])) break; if (_sp > XB_SPIN_CAP) { atomicAdd(&(bar)[XB_TMO], 1u); break; } } } } while (0)

struct XcdBarrier {
    unsigned* bar; unsigned x;
    volatile LAS unsigned* st;
};

__device__ __forceinline__ XcdBarrier xcd_barrier_post(unsigned* bar, volatile LAS unsigned* st) {
    XcdBarrier b; b.bar = bar; b.x = xb_xcc_id(); b.st = st;
    if (threadIdx.x == 0) (void)xb_add(&bar[XB_XCNT(b.x)], 1u);
    return b;
}
__device__ __forceinline__ void xcd_barrier_complete(unsigned* bar, unsigned x, unsigned& nloc, unsigned& nx) {
    const unsigned G = gridDim.x * gridDim.y * gridDim.z;
    unsigned sum, cnt, mine, sp = 0u;
    for (;;) {
        sum = 0u; cnt = 0u; mine = 0u;
#pragma unroll
        for (unsigned j = 0; j < 16; ++j) { const unsigned c = xb_ld(&bar[XB_XCNT(j)]); sum += c; cnt += (c > 0u) ? 1u : 0u; mine = (j == x) ? c : mine; }
        if (sum == G) break;
        __builtin_amdgcn_s_sleep(1);
        if ((++sp & 255u) == 0u) { if (xb_ld(&bar[XB_TMO])) break; if (sp > XB_SPIN_CAP) { atomicAdd(&bar[XB_TMO], 1u); break; } }
    }
    nloc = mine > 0u ? mine : 1u; nx = cnt > 0u ? cnt : 1u;
}

__device__ __forceinline__ void xcd_barrier(const XcdBarrier& b) {
    asm volatile("s_waitcnt vmcnt(0)" ::: "memory");
    __syncthreads();
    if (threadIdx.x == 0) {
        unsigned* bar = b.bar;
        __builtin_amdgcn_s_waitcnt(0);
        unsigned nloc = b.st[0], nx = b.st[1];
        if (nloc == 0u) { xcd_barrier_complete(bar, b.x, nloc, nx); b.st[0] = nloc; b.st[1] = nx; }
        const unsigned old = xb_add(&bar[XB_XSUB(b.x)], 1u);
        const unsigned gen = old / nloc;
        if (old + 1u == (gen + 1u) * nloc) {
            __builtin_amdgcn_fence(__ATOMIC_RELEASE, "agent");
            asm volatile("s_waitcnt vmcnt(0)" ::: "memory");
            const unsigned og = xb_add(&bar[XB_TOP], 1u);
            const unsigned tg = og / nx;
            if (og + 1u == (tg + 1u) * nx) xb_add(&bar[XB_TOPGEN], 1u);
            else XB_SPIN(xb_ld(&bar[XB_TOPGEN]) == tg, bar);
            __builtin_amdgcn_fence(__ATOMIC_ACQUIRE, "agent");
            xb_add(&bar[XB_XGEN(b.x)], 1u);
            asm volatile("s_waitcnt vmcnt(0)" ::: "memory");
        } else {
            XB_SPIN(xb_ld(&bar[XB_XGEN(b.x)]) == gen, bar);
            __builtin_amdgcn_fence(__ATOMIC_ACQUIRE, "agent");
            asm volatile("s_waitcnt vmcnt(0)" ::: "memory");
        }
    }
    __syncthreads();
}

constexpr size_t WS_GCNT = 16384, WS_GMASK = 16384 + 8 * 256, WS_XIDX = 16384 + 16 * 256;
__device__ __forceinline__ void group_barrier(unsigned char* ws, volatile LAS unsigned* misc) {
    asm volatile("s_waitcnt vmcnt(0)" ::: "memory");
    __syncthreads();
    if (threadIdx.x == 0) {
        unsigned bx = misc[6];
        unsigned* cnt = (unsigned*)(ws + WS_GCNT) + 64 * (bx & 7u);
        const unsigned pure = misc[4], ep = misc[5] + 1u; misc[5] = ep;
        if (!pure) { __builtin_amdgcn_fence(__ATOMIC_RELEASE, "agent"); asm volatile("s_waitcnt vmcnt(0)" ::: "memory"); }
        const unsigned old_ = xb_add(cnt, 1u);
        if (pure) { __builtin_amdgcn_fence(__ATOMIC_ACQUIRE, "agent"); asm volatile("s_waitcnt vmcnt(0)" ::: "memory"); }
        const unsigned target = ep * (gridDim.x >> 3);
        unsigned sp = 0u;
        if (old_ + 1u < target) while (xb_ld(cnt) < target) { __builtin_amdgcn_s_sleep(1); if (++sp > (1u << 22)) break; }
        if (!pure) __builtin_amdgcn_fence(__ATOMIC_ACQUIRE, "agent");
        asm volatile("s_waitcnt vmcnt(0)" ::: "memory");
    }
    __syncthreads();
}
struct PreGroupBar {
    unsigned char* ws; volatile LAS unsigned* misc;
    __device__ __forceinline__ void drain() const { asm volatile("s_waitcnt vmcnt(0)" ::: "memory"); }
    __device__ __forceinline__ void sync() const {
        asm volatile("s_waitcnt lgkmcnt(0)" ::: "memory"); __builtin_amdgcn_s_barrier(); asm volatile("" ::: "memory");
        if (threadIdx.x == 0) {
            unsigned bx = misc[6];
            unsigned* cnt = (unsigned*)(ws + WS_GCNT) + 64 * (bx & 7u);
            const unsigned pure = misc[4], ep = misc[5] + 1u; misc[5] = ep;
            if (!pure) { __builtin_amdgcn_fence(__ATOMIC_RELEASE, "agent"); asm volatile("s_waitcnt vmcnt(0)" ::: "memory"); }
            const unsigned old_ = xb_add(cnt, 1u);
            if (pure) { __builtin_amdgcn_fence(__ATOMIC_ACQUIRE, "agent"); asm volatile("s_waitcnt vmcnt(0)" ::: "memory"); }
            const unsigned target = ep * (gridDim.x >> 3);
            unsigned sp = 0u;
            if (old_ + 1u < target) while (xb_ld(cnt) < target) { __builtin_amdgcn_s_sleep(1); if (++sp > (1u << 22)) break; }
            if (!pure) __builtin_amdgcn_fence(__ATOMIC_ACQUIRE, "agent");
            asm volatile("s_waitcnt vmcnt(0)" ::: "memory");
        }
        asm volatile("s_waitcnt lgkmcnt(0)" ::: "memory"); __builtin_amdgcn_s_barrier(); asm volatile("" ::: "memory");
    }
};
#define GROUP_BAR() group_barrier(kargs_ws(), (volatile LAS unsigned*)(lds + MISC_OFF))
#define VBID() ((int)__builtin_amdgcn_readfirstlane(((volatile LAS unsigned*)(lds + MISC_OFF))[6]))
#define GRID_BAR() do { XcdBarrier bar_; bar_.bar = (unsigned*)(kargs_ws() + WS_BAR); bar_.x = xb_xcc_id(); bar_.st = (volatile LAS unsigned*)(lds + MISC_OFF); xcd_barrier(bar_); } while (0)
struct Args { const float* in[15]; float* out; unsigned char* ws; };
typedef const __attribute__((address_space(4))) Args CArgs;
__device__ __forceinline__ CArgs* kargs();
__device__ __forceinline__ unsigned char* kargs_ws();
__device__ __forceinline__ CArgs* kargs() { CArgs* p = (CArgs*)__builtin_amdgcn_kernarg_segment_ptr(); asm volatile("" : "+s"(p)); return p; }
__device__ __forceinline__ unsigned char* kargs_ws() { return kargs()->ws; }

constexpr int CW_I_IN = (DM / 64) * (NIN / 64), CW_I_LAYER = CW_I_IN + (DM / 64) * (DM / 64) + (DM / 64) * (NFF2 / 64) + (DFF / 64) * (DM / 64);
__device__ __forceinline__ void convert_weights(CArgs* a, LAS unsigned char* lds, int wave, int lane, int it0, int it1, int gw, int NGW) {
    LAS unsigned char* scr = lds + wave * 16384;
    constexpr int I_IN = (DM / 64) * (NIN / 64), I_OUT = (DM / 64) * (DM / 64), I_FIN = (DM / 64) * (NFF2 / 64), I_FOUT = (DFF / 64) * (DM / 64);
    constexpr int I_LAYER = I_IN + I_OUT + I_FIN + I_FOUT;
    static_assert(I_IN == CW_I_IN && I_LAYER == CW_I_LAYER, "item counts");
#pragma nounroll
    for (int it = it0 + gw; it < it1; it += NGW) {
        const int l = it / I_LAYER; int r = it % I_LAYER;
        unsigned char* wb = a->ws + WS_W0 + (size_t)l * WS_WSTRIDE;
        if (r < I_IN) { const int nblk = NIN / 64, kb = r / nblk, nb = r % nblk;
            p0_transpose_item(a->in[2] + (size_t)l * DM * NIN, DM, NIN, (bf16*)(wb + WOFF_IN), 64 * kb, 64 * nb, map_in(64 * nb), map_in(64 * nb + 32), a->in[1] + l * DM, scr, lane); continue; } r -= I_IN;
        if (r < I_OUT) { const int nblk = DM / 64, kb = r / nblk, nb = r % nblk;
            p0_transpose_item(a->in[11] + (size_t)l * DM * DM, DM, DM, (bf16*)(wb + WOFF_OUT), 64 * kb, 64 * nb, 64 * nb, 64 * nb + 32, nullptr, scr, lane); continue; } r -= I_OUT;
        if (r < I_FIN) { const int nblk = NFF2 / 64, kb = r / nblk, nb = r % nblk;
            p0_transpose_item(a->in[13] + (size_t)l * DM * NFF2, DM, NFF2, (bf16*)(wb + WOFF_FIN), 64 * kb, 64 * nb, map_fin(64 * nb), map_fin(64 * nb + 32), a->in[12] + l * DM, scr, lane); continue; } r -= I_FIN;
        { const int nblk = DM / 64, kb = r / nblk, nb = r % nblk;
            p0_transpose_item(a->in[14] + (size_t)l * DFF * DM, DFF, DM, (bf16*)(wb + WOFF_FOUT), 64 * kb, 64 * nb, 64 * nb, 64 * nb + 32, nullptr, scr, lane, DM); }
    }
}
__device__ __forceinline__ void prologue(CArgs* a, LAS unsigned char* lds, int wave, int lane) {
    const int gw = blockIdx.x * NWAVES + wave, NGW = gridDim.x * NWAVES;
    convert_weights(a, lds, wave, lane, 0, CW_I_IN, gw, NGW);
    float* rowss = (float*)(a->ws + WS_ROWSS); bf16* xb = (bf16*)(a->ws + WS_XB);
#pragma nounroll
    for (int m0 = gw * 4; m0 < M; m0 += NGW * 4) {
        f32x4 v[4][4];
#pragma unroll
        for (int r = 0; r < 4; ++r) { const f32x4* xr = (const f32x4*)(a->in[0] + (size_t)(m0 + r) * DM) + lane;
#pragma unroll
            for (int j = 0; j < 4; ++j) v[r][j] = xr[64 * j]; }
#pragma unroll
        for (int r = 0; r < 4; ++r) { unsigned long long* o8 = (unsigned long long*)(xb + (size_t)(m0 + r) * DM) + lane; float sq = 0.f;
#pragma unroll
            for (int j = 0; j < 4; ++j) { const f32x4 w = v[r][j]; sq += (w.x * w.x + w.y * w.y) + (w.z * w.z + w.w * w.w);
                o8[64 * j] = (unsigned long long)pk2(w.x, w.y) | ((unsigned long long)pk2(w.z, w.w) << 32); }
            sq = wave_sum(sq);
            if (lane < 4) rowss[(size_t)(m0 + r) * 4 + lane] = lane == 0 ? sq : 0.f; }
    }
    { const float* wsp = a->in[7]; bf16* o = (bf16*)(a->ws + WS_WSP); const int gt = blockIdx.x * 512 + threadIdx.x, NT = gridDim.x * 512;
      for (int i = gt; i < DEPTH * 8 * 128 * 128; i += NT) { const int s = i & 127, t = (i >> 7) & 127; o[i] = (bf16)(((t >> 6) >= (s >> 6)) ? f2bf(wsp[i]) : 0u); } }
}

__device__ __forceinline__ void mixer_naive(CArgs* a, int l, LAS unsigned char* lds, int wave, int lane) {
    const bf16* P = (const bf16*)(a->ws + WS_PROJ); bf16* MIX = (bf16*)(a->ws + WS_MIX);
    const float* vgss = (const float*)(a->ws + WS_VGSS); const bf16* wsp = (const bf16*)(a->ws + WS_WSP) + (size_t)l * 8 * 128 * 128;
    const float* rel = a->in[5] + (size_t)l * 8 * 257; const float* sgu_g = a->in[6] + l * 512; const float* bsp = a->in[8] + l * 8 * 128;
    const float* ag = a->in[9] + l * 512; const float* gg = a->in[10] + l * 512;
    LAS float* red = (LAS float*)lds;
    for (int tok = blockIdx.x; tok < M; tok += gridDim.x) {
        const int b = tok / SEQ, t = tok % SEQ, c = t >> 6;
        const int h = wave;
        const float q = bf2f(P[(size_t)tok * NIN + h * 64 + lane]);
        float mx = -INFINITY, lsum = 0.f, o = 0.f;
        const int k0 = (c >= 8 ? c - 8 : 0) * 64, k1 = c * 64 + 63;
        for (int kt = k0; kt <= k1; ++kt) {
            const size_t kr = (size_t)(b * SEQ + kt) * NIN;
            float s = wave_sum(q * bf2f(P[kr + 512 + h * 64 + lane]));
            int d = t - kt; d = d < -128 ? -128 : (d > 128 ? 128 : d);
            s += rel[h * 257 + d + 128] * pg8::LOG2E;
            const float mn = fmaxf(mx, s), al = __builtin_amdgcn_exp2f(mx - mn), p = __builtin_amdgcn_exp2f(s - mn);
            lsum = lsum * al + p; o = o * al + p * bf2f(P[kr + 1024 + h * 64 + lane]); mx = mn;
        }
        o = o / lsum;
        const int g = wave, nb = t >> 7, tp = t & 127, ns = tp < 64 ? 64 : 128;
        float mixd = 0.f;
        for (int s = 0; s < ns; ++s) {
            const int srow = b * SEQ + nb * 128 + s;
            const f32x4* pv = (const f32x4*)(vgss + (size_t)srow * 8); const f32x4 p0 = pv[0], p1 = pv[1];
            const float rs = __builtin_amdgcn_rsqf((((p0[0] + p0[1]) + (p0[2] + p0[3])) + ((p1[0] + p1[1]) + (p1[2] + p1[3]))) * (1.0f / 512.0f) + pg8::RMS_EPS);
            mixd += bf2f(wsp[(g * 128 + tp) * 128 + s]) * (bf2f(P[(size_t)srow * NIN + 2048 + g * 64 + lane]) * rs * sgu_g[g * 64 + lane]);
        }
        const float gv = bf2f(P[(size_t)tok * NIN + 1536 + g * 64 + lane]) * (mixd + bsp[g * 128 + tp]);
        const float so = wave_sum(o * o), sg = wave_sum(gv * gv);
        __syncthreads();
        if (lane == 0) { red[wave] = so; red[8 + wave] = sg; }
        __syncthreads();
        float ta = 0.f, tg = 0.f;
#pragma unroll
        for (int w = 0; w < 8; ++w) { ta += red[w]; tg += red[8 + w]; }
        const float ra = __builtin_amdgcn_rsqf(ta * (1.0f / 512.0f) + pg8::RMS_EPS), rg = __builtin_amdgcn_rsqf(tg * (1.0f / 512.0f) + pg8::RMS_EPS);
        MIX[(size_t)tok * DM + h * 64 + lane] = (bf16)f2bf(o * ra * ag[h * 64 + lane]);
        MIX[(size_t)tok * DM + 512 + g * 64 + lane] = (bf16)f2bf(gv * rg * gg[g * 64 + lane]);
    }
    __syncthreads();
}

#ifndef FAST_MIXER
#define FAST_MIXER 1
#endif
#ifndef PHM
#define PHM 31
#endif
#ifndef REPM
#define REPM 0
#endif
#define REPEAT(bit) for (int rep_ = 0; rep_ < (((REPM) >> (bit)) & 1) + 1; ++rep_)
namespace mx {
typedef float f32x16 __attribute__((ext_vector_type(16)));
typedef short bf16x8 __attribute__((ext_vector_type(8)));
typedef short s16x4 __attribute__((ext_vector_type(4)));
typedef unsigned u32x2 __attribute__((ext_vector_type(2)));
constexpr int TBL_OFF = 131072;
constexpr int TBL_LD = 320;
constexpr int RS_OFF = TBL_OFF + 8 * TBL_LD * 4 + 4096;
constexpr int RED_OFF = TBL_OFF + 8 * TBL_LD * 4;
__device__ __forceinline__ int crow(int r, int hi) { return (r & 3) + 8 * (r >> 2) + 4 * hi; }
__device__ __forceinline__ int vimg(int row, int chunk) { return row * 128 + ((chunk * 16) ^ (((row >> 1) & 1) << 6)); }
__device__ __forceinline__ s16x4 tr64(LAS unsigned char* p) { return __builtin_bit_cast(s16x4, __builtin_amdgcn_ds_read_tr16_b64_v4i16((LAS s16x4*)p)); }
__device__ __forceinline__ bf16x8 cat8(s16x4 a, s16x4 b) { return (bf16x8){a[0], a[1], a[2], a[3], b[0], b[1], b[2], b[3]}; }
__device__ __forceinline__ unsigned cvtpk(float lo, float hi) { unsigned r; asm("v_cvt_pk_bf16_f32 %0, %1, %2" : "=v"(r) : "v"(lo), "v"(hi)); return r; }
#ifndef ATTREP
#define ATTREP 1
#endif
#ifndef DMAREP
#define DMAREP 1
#endif
#if DMAREP == 1
#define MX_VM8 "s_waitcnt vmcnt(8)"
#else
#define MX_VM8 "s_waitcnt vmcnt(16)"
#endif
#define MX_FENCE() asm volatile("" ::: "memory")
__device__ __forceinline__ float max3f(float a, float b, float c) { float r; asm("v_max3_f32 %0, %1, %2, %3" : "=v"(r) : "v"(a), "v"(b), "v"(c)); return r; }

__device__ __forceinline__ void attn_task(const bf16* P, int b, int c, int h, LAS unsigned char* wl, const LAS float* tbl, int lane, f32x16 (&o)[2][2]) {
    const int r32 = lane & 31, hi = lane >> 5;
    const size_t tok0 = (size_t)b * SEQ + c * 64;
    bf16x8 qf[2][4];
#pragma unroll
    for (int qt = 0; qt < 2; ++qt)
#pragma unroll
        for (int d0 = 0; d0 < 4; ++d0) qf[qt][d0] = *(const bf16x8*)(P + (tok0 + 32 * qt + r32) * NIN + h * 64 + d0 * 16 + hi * 8);
#pragma unroll
    for (int r = 0; r < 16; ++r) { o[0][0][r] = 0.f; o[0][1][r] = 0.f; o[1][0][r] = 0.f; o[1][1][r] = 0.f; }
    float m[2] = {-INFINITY, -INFINITY}, l[2] = {0.f, 0.f};
    const int kc0 = c >= 8 ? c - 8 : 0;
    const int dhalf = (lane >> 4) & 1, qq = (lane & 15) >> 2, p4 = lane & 3;
    int vb[2];
#pragma unroll
    for (int dt = 0; dt < 2; ++dt) vb[dt] = 8192 + (4 * hi + qq) * 128 + ((64 * dt + 32 * dhalf + 8 * p4) ^ ((qq >> 1) << 6));
    const int prow = lane >> 3, pch = lane & 7;
    const unsigned voff = (unsigned)(prow * NIN + (pch ^ (((lane >> 4) & 1) << 2)) * 8) * 2u;
    const unsigned koff0 = (unsigned)(prow * NIN + (pch ^ (lane >> 4)) * 8) * 2u, koff1 = (unsigned)(prow * NIN + (pch ^ (lane >> 4) ^ 4) * 8) * 2u;
    const int swz = (r32 >> 1) & 7;
    int ka[4];
#pragma unroll
    for (int d0 = 0; d0 < 4; ++d0) ka[d0] = r32 * 128 + (((2 * d0 + hi) ^ swz) * 16);
#define MX_DMAK(kc) do { const char* kp_ = (const char*)(P + ((size_t)b * SEQ + (kc) * 64) * NIN + 512 + h * 64); \
        _Pragma("unroll") for (int i = 0; i < 8 * DMAREP; ++i) __builtin_amdgcn_global_load_lds((const unsigned*)(kp_ + (size_t)((i & 7) * 8 * NIN) * 2 + ((i & 1) ? koff1 : koff0)), (LAS unsigned*)(wl + (i & 7) * 1024), 16, 0, 0); } while (0)
#define MX_DMAV(kc) do { const char* vp_ = (const char*)(P + ((size_t)b * SEQ + (kc) * 64) * NIN + 1024 + h * 64); \
        _Pragma("unroll") for (int i = 0; i < 8 * DMAREP; ++i) __builtin_amdgcn_global_load_lds((const unsigned*)(vp_ + (size_t)((i & 7) * 8 * NIN) * 2 + voff), (LAS unsigned*)(wl + 8192 + (i & 7) * 1024), 16, 0, 0); } while (0)
    MX_DMAK(kc0);
    const int nk = c - kc0 + 1, total = nk * ATTREP; (void)total;
#if ATTREP == 1
    for (int kc = kc0; kc <= c; ++kc) {
        const int kcn = kc + 1; const bool more = kc < c;
#else
    for (int it = 0; it < total; ++it) {
        const int kc = kc0 + it % nk, kcn = kc0 + (it + 1) % nk; const bool more = it + 1 < total;
#endif
        const int j = kc - c + 8;
        MX_DMAV(kc);
        asm volatile(MX_VM8 ::: "memory");
        bf16x8 kf[2][4];
#pragma unroll
        for (int kt = 0; kt < 2; ++kt)
#pragma unroll
            for (int d0 = 0; d0 < 4; ++d0) kf[kt][d0] = *(const LAS bf16x8*)(wl + kt * 4096 + ka[d0]);
        asm volatile("s_waitcnt lgkmcnt(0)" ::: "memory");
        if (more) MX_DMAK(kcn);
#pragma unroll
        for (int qt = 0; qt < 2; ++qt) {
            f32x16 st[2];
            float badd = 0.f;
            if (j <= 5) { badd = tbl[256];
#pragma unroll
                for (int r = 0; r < 16; ++r) { st[0][r] = 0.f; st[1][r] = 0.f; } }
            else { const LAS float* tb = tbl + (64 * (8 - j) + 32 * qt + r32 - 4 * hi + 128 - 63);
#pragma unroll
                for (int kt = 0; kt < 2; ++kt)
#pragma unroll
                    for (int r = 0; r < 16; ++r) st[kt][r] = tb[63 - (32 * kt + (r & 3) + 8 * (r >> 2))]; }
#pragma unroll
            for (int kt = 0; kt < 2; ++kt)
#pragma unroll
                for (int d0 = 0; d0 < 4; ++d0) st[kt] = __builtin_amdgcn_mfma_f32_32x32x16_bf16(kf[kt][d0], qf[qt][d0], st[kt], 0, 0, 0);
            asm volatile("s_nop 15\n\ts_nop 7" : "+v"(st[0]), "+v"(st[1]));
            float mxa = max3f(st[0][0], st[0][1], st[0][2]), mxb = max3f(st[1][0], st[1][1], st[1][2]);
#pragma unroll
            for (int r = 3; r < 15; r += 2) { mxa = max3f(mxa, st[0][r], st[0][r + 1]); mxb = max3f(mxb, st[1][r], st[1][r + 1]); }
            float mxv = max3f(mxa, mxb, st[0][15]); mxv = max3f(mxv, st[1][15], mxv);
            mxv = max3f(mxv, __shfl_xor(mxv, 32), mxv) + badd;
            const bool need = mxv > m[qt] + 8.0f;
            if (__builtin_amdgcn_ballot_w64(need) != 0ull) {
                const float mn = need ? mxv : m[qt], al = __builtin_amdgcn_exp2f(m[qt] - mn); m[qt] = mn; l[qt] *= al;
#pragma unroll
                for (int r = 0; r < 16; ++r) { o[qt][0][r] *= al; o[qt][1][r] *= al; }
            }
            const float sub = m[qt] - badd;
            float rs = 0.f;
#pragma unroll
            for (int kt = 0; kt < 2; ++kt)
#pragma unroll
                for (int r = 0; r < 16; ++r) { const float p = __builtin_amdgcn_exp2f(st[kt][r] - sub); st[kt][r] = p; rs += p; }
            l[qt] += rs;
            bf16x8 pf[4];
#pragma unroll
            for (int s = 0; s < 4; ++s) { v4u w; const int kt = s >> 1, r0 = 8 * (s & 1);
                w.x = cvtpk(st[kt][r0 + 0], st[kt][r0 + 1]); w.y = cvtpk(st[kt][r0 + 2], st[kt][r0 + 3]); w.z = cvtpk(st[kt][r0 + 4], st[kt][r0 + 5]); w.w = cvtpk(st[kt][r0 + 6], st[kt][r0 + 7]);
                pf[s] = __builtin_bit_cast(bf16x8, w); }
            if (qt == 0) { if (more) asm volatile(MX_VM8 ::: "memory"); else asm volatile("s_waitcnt vmcnt(0)" ::: "memory"); }
#pragma unroll
            for (int dt = 0; dt < 2; ++dt) { s16x4 va[4], vc[4]; const unsigned vaddr = (unsigned)(uintptr_t)(wl + vb[dt]);
#pragma unroll
                for (int s = 0; s < 4; ++s) { asm volatile("ds_read_b64_tr_b16 %0, %1 offset:%c2" : "=&v"(va[s]) : "v"(vaddr), "i"(16 * s * 128) : "memory");
                                              asm volatile("ds_read_b64_tr_b16 %0, %1 offset:%c2" : "=&v"(vc[s]) : "v"(vaddr), "i"((16 * s + 8) * 128) : "memory"); }
                asm volatile("s_waitcnt lgkmcnt(0)" : "+v"(va[0]), "+v"(va[1]), "+v"(va[2]), "+v"(va[3]), "+v"(vc[0]), "+v"(vc[1]), "+v"(vc[2]), "+v"(vc[3]) :: "memory");
#pragma unroll
                for (int s = 0; s < 4; ++s) o[qt][dt] = __builtin_amdgcn_mfma_f32_32x32x16_bf16(cat8(va[s], vc[s]), pf[s], o[qt][dt], 0, 0, 0); }
        }
        MX_FENCE();
    }
#undef MX_DMAK
#undef MX_DMAV
#pragma unroll
    for (int qt = 0; qt < 2; ++qt) { float lt = l[qt]; lt += __shfl_xor(lt, 32); const float inv = 1.0f / lt;
#pragma unroll
        for (int r = 0; r < 16; ++r) { o[qt][0][r] *= inv; o[qt][1][r] *= inv; } }
}

__device__ __forceinline__ void sgu_task(const bf16* P, const LAS float* rstab, const bf16* wsp_l, const float* sgu_g, const float* bsp_l, int b, int c, int g, LAS unsigned char* wl, int lane_in, f32x16 (&o)[2][2]) {
    int lane = lane_in; asm volatile("" : "+v"(lane));
    const int r32 = lane & 31, hi = lane >> 5;
    const int nb = c >> 1, cb = c & 1, ns = cb ? 128 : 64;
    const size_t srow0 = (size_t)b * SEQ + nb * 128, tok0 = (size_t)b * SEQ + c * 64;
    const int prow = lane >> 3, pch = lane & 7;
    const f32x4 g0 = *(const f32x4*)(sgu_g + g * 64 + pch * 8), g1 = *(const f32x4*)(sgu_g + g * 64 + pch * 8 + 4);
    v4u ureg[8];
#pragma unroll
    for (int i = 0; i < 8; ++i) ureg[i] = *(const v4u*)(P + (tok0 + prow + 8 * i) * NIN + 1536 + g * 64 + pch * 8);
    const bf16* wrow = wsp_l + ((size_t)g * 128 + cb * 64 + r32) * 128 + hi * 8;
    bf16x8 wfa[8], wfb[8];
#pragma unroll
    for (int step = 0; step < 8; ++step) if (step * 16 < ns) { wfa[step] = *(const bf16x8*)(wrow + 16 * step); wfb[step] = *(const bf16x8*)(wrow + 32 * 128 + 16 * step); }
    MX_FENCE();
#pragma unroll
    for (int hb = 0; hb < 2; ++hb) {
        if (hb * 64 < ns) {
            v4u raw[8];
#pragma unroll
            for (int i = 0; i < 8; ++i) raw[i] = *(const v4u*)(P + (srow0 + hb * 64 + prow + 8 * i) * NIN + 2048 + g * 64 + pch * 8);
#pragma unroll
            for (int i = 0; i < 8; ++i) { const int row = hb * 64 + prow + 8 * i; const f32x4 q0 = *(const LAS f32x4*)(rstab + row * 8), q1 = *(const LAS f32x4*)(rstab + row * 8 + 4);
                const float rs = __builtin_amdgcn_rsqf((((q0[0] + q0[1]) + (q0[2] + q0[3])) + ((q1[0] + q1[1]) + (q1[2] + q1[3]))) * (1.0f / 512.0f) + pg8::RMS_EPS);
                v4u w;
                w.x = cvtpk(__builtin_bit_cast(float, raw[i].x << 16) * rs * g0[0], __builtin_bit_cast(float, raw[i].x & 0xffff0000u) * rs * g0[1]);
                w.y = cvtpk(__builtin_bit_cast(float, raw[i].y << 16) * rs * g0[2], __builtin_bit_cast(float, raw[i].y & 0xffff0000u) * rs * g0[3]);
                w.z = cvtpk(__builtin_bit_cast(float, raw[i].z << 16) * rs * g1[0], __builtin_bit_cast(float, raw[i].z & 0xffff0000u) * rs * g1[1]);
                w.w = cvtpk(__builtin_bit_cast(float, raw[i].w << 16) * rs * g1[2], __builtin_bit_cast(float, raw[i].w & 0xffff0000u) * rs * g1[3]);
                *(LAS v4u*)(wl + vimg(row, pch)) = w; }
        }
    }
    MX_FENCE();
#pragma unroll
    for (int r = 0; r < 16; ++r) { o[0][0][r] = 0.f; o[0][1][r] = 0.f; o[1][0][r] = 0.f; o[1][1][r] = 0.f; }
    const int dhalf = (lane >> 4) & 1, qq = (lane & 15) >> 2, p4 = lane & 3;
    int vbs[2];
#pragma unroll
    for (int ct = 0; ct < 2; ++ct) vbs[ct] = (8 * hi + qq) * 128 + ((64 * ct + 32 * dhalf + 8 * p4) ^ ((qq >> 1) << 6));
#pragma unroll
    for (int step = 0; step < 8; ++step) { if (step * 16 < ns) {
        const bf16x8 wf0 = wfa[step], wf1 = wfb[step];
#pragma unroll
        for (int ct = 0; ct < 2; ++ct) { const s16x4 a0 = tr64(wl + vbs[ct] + (16 * step) * 128), a1 = tr64(wl + vbs[ct] + (16 * step + 4) * 128);
            const bf16x8 af = cat8(a0, a1);
            o[0][ct] = __builtin_amdgcn_mfma_f32_32x32x16_bf16(af, wf0, o[0][ct], 0, 0, 0);
            o[1][ct] = __builtin_amdgcn_mfma_f32_32x32x16_bf16(af, wf1, o[1][ct], 0, 0, 0); }
    } }
    MX_FENCE();
#pragma unroll
    for (int i = 0; i < 8; ++i) { const int row = 8 * i + prow; *(LAS v4u*)(wl + row * 128 + ((pch ^ (row & 7)) * 16)) = ureg[i]; }
    MX_FENCE();
#pragma unroll
    for (int tt = 0; tt < 2; ++tt) {
        const int tok = 32 * tt + r32;
        const float bt = bsp_l[g * 128 + cb * 64 + tok];
#pragma unroll
        for (int ct = 0; ct < 2; ++ct)
#pragma unroll
            for (int rg = 0; rg < 4; ++rg) { const u32x2 uu = *(const LAS u32x2*)(wl + tok * 128 + (((4 * ct + rg) ^ (tok & 7)) * 16) + hi * 8);
                o[tt][ct][4 * rg + 0] = __builtin_bit_cast(float, uu.x << 16) * (o[tt][ct][4 * rg + 0] + bt); o[tt][ct][4 * rg + 1] = __builtin_bit_cast(float, uu.x & 0xffff0000u) * (o[tt][ct][4 * rg + 1] + bt);
                o[tt][ct][4 * rg + 2] = __builtin_bit_cast(float, uu.y << 16) * (o[tt][ct][4 * rg + 2] + bt); o[tt][ct][4 * rg + 3] = __builtin_bit_cast(float, uu.y & 0xffff0000u) * (o[tt][ct][4 * rg + 3] + bt); }
    }
    MX_FENCE();
}

__device__ __forceinline__ void norm_store(const f32x16 (&o)[2][2], LAS float* red, LAS unsigned char* wl, int wave, int lane_in, const float* gain, bf16* dst) {
    int lane = lane_in; asm volatile("" : "+v"(lane));
    const int r32 = lane & 31, hi = lane >> 5;
    f32x4 gvv[2][4];
#pragma unroll
    for (int ct = 0; ct < 2; ++ct)
#pragma unroll
        for (int rg = 0; rg < 4; ++rg) gvv[ct][rg] = *(const f32x4*)(gain + 32 * ct + 8 * rg + 4 * hi);
#pragma unroll
    for (int tt = 0; tt < 2; ++tt) { float ss = 0.f;
#pragma unroll
        for (int r = 0; r < 16; ++r) ss += o[tt][0][r] * o[tt][0][r] + o[tt][1][r] * o[tt][1][r];
        ss += __shfl_xor(ss, 32);
        if (hi == 0) red[wave * 64 + tt * 32 + r32] = ss; }
    __syncthreads();
#pragma unroll
    for (int tt = 0; tt < 2; ++tt) { float tot = 0.f; const int tok = 32 * tt + r32;
#pragma unroll
        for (int w = 0; w < 8; ++w) tot += red[w * 64 + tok];
        const float rn = __builtin_amdgcn_rsqf(tot * (1.0f / 512.0f) + pg8::RMS_EPS);
#pragma unroll
        for (int ct = 0; ct < 2; ++ct)
#pragma unroll
            for (int rg = 0; rg < 4; ++rg) { const f32x4 gv = gvv[ct][rg];
                u32x2 w; w.x = cvtpk(o[tt][ct][4 * rg + 0] * rn * gv[0], o[tt][ct][4 * rg + 1] * rn * gv[1]); w.y = cvtpk(o[tt][ct][4 * rg + 2] * rn * gv[2], o[tt][ct][4 * rg + 3] * rn * gv[3]);
                *(LAS u32x2*)(wl + tok * 128 + (((4 * ct + rg) ^ (tok & 7)) * 16) + hi * 8) = w; } }
    MX_FENCE();
    const int prow = lane >> 3, pch = lane & 7;
#pragma unroll
    for (int i = 0; i < 8; ++i) { const int row = 8 * i + prow; const v4u v = *(const LAS v4u*)(wl + row * 128 + ((pch ^ (row & 7)) * 16));
        *(v4u*)(dst + (size_t)row * DM + pch * 8) = v; }
    MX_FENCE();
}

__device__ __forceinline__ void fill_bias_table(CArgs* a, int l, LAS unsigned char* lds) {
    const float* rel = a->in[5] + (size_t)l * 8 * 257; LAS float* tbl = (LAS float*)(lds + TBL_OFF);
    for (int i = threadIdx.x; i < 8 * TBL_LD; i += NWAVES * 64) { const int h = i / TBL_LD, k = i % TBL_LD; tbl[i] = rel[h * 257 + (k < 256 ? k : 256)] * pg8::LOG2E; }
}
__device__ __forceinline__ void mixer_fast(CArgs* a, int l, LAS unsigned char* lds, int wave, int lane, int vb) {
    const bf16* P = (const bf16*)(a->ws + WS_PROJ); bf16* MIX = (bf16*)(a->ws + WS_MIX);
    const float* vgss = (const float*)(a->ws + WS_VGSS); const bf16* wsp_l = (const bf16*)(a->ws + WS_WSP) + (size_t)l * 8 * 128 * 128;
    const float* rel = a->in[5] + (size_t)l * 8 * 257; const float* sgu_g = a->in[6] + l * 512; const float* bsp_l = a->in[8] + l * 8 * 128;
    const float* ag = a->in[9] + l * 512; const float* gg = a->in[10] + l * 512;
    LAS float* tbl = (LAS float*)(lds + TBL_OFF); LAS float* red = (LAS float*)(lds + RED_OFF); LAS float* rstab = (LAS float*)(lds + RS_OFF);
    LAS unsigned char* wl = lds + wave * 16384;
    for (int u = vb; u < NB * (SEQ / 64); u += gridDim.x) {
        const int b = u & 7, c = u >> 3;
        const size_t tok0 = (size_t)b * SEQ + c * 64;
        if (wave == 0) {
            const char* src = (const char*)(vgss + ((size_t)b * SEQ + (c >> 1) * 128) * 8) + lane * 16;
#pragma unroll
            for (int i = 0; i < 4; ++i) __builtin_amdgcn_global_load_lds((const unsigned*)(src + i * 1024), (LAS unsigned*)(lds + RS_OFF + i * 1024), 16, 0, 0);
        }
        f32x16 o[2][2];
        REPEAT(7) attn_task(P, b, c, wave, wl, tbl + wave * TBL_LD, lane, o);
        norm_store(o, red, wl, wave, lane, ag + wave * 64, MIX + tok0 * DM + wave * 64);
        REPEAT(8) sgu_task(P, rstab, wsp_l, sgu_g, bsp_l, b, c, wave, wl, lane, o);
        norm_store(o, red + 512, wl, wave, lane, gg + wave * 64, MIX + tok0 * DM + 512 + wave * 64);
    }
    __syncthreads();
}
}

__global__ void __launch_bounds__(NWAVES * 64, 2) fwd_megakernel(Args a_unused) {
    extern __shared__ __attribute__((aligned(16))) unsigned char lds_raw[];
    LAS unsigned char* lds = (LAS unsigned char*)lds_raw;
    if (threadIdx.x < 16) ((LAS unsigned*)(lds + MISC_OFF))[threadIdx.x] = 0u;
    __syncthreads();
    (void)xcd_barrier_post((unsigned*)(kargs_ws() + WS_BAR), (volatile LAS unsigned*)(lds + MISC_OFF));
    if (threadIdx.x == 64) { const unsigned x_ = xb_xcc_id(); ((volatile LAS unsigned*)(lds + MISC_OFF))[7] = xb_add((unsigned*)(kargs_ws() + WS_XIDX) + 64 * x_, 1u); }
    { const int tid = threadIdx.x, lane = tid & 63, wave = __builtin_amdgcn_readfirstlane(tid >> 6);
      REPEAT(0) prologue(kargs(), lds, wave, lane); }
    GRID_BAR();
    if (threadIdx.x == 64) { volatile LAS unsigned* mi = (volatile LAS unsigned*)(lds + MISC_OFF); unsigned* xi = (unsigned*)(kargs_ws() + WS_XIDX); bool ok = (gridDim.x & 7u) == 0u;
        for (int j = 0; j < 16; ++j) { const unsigned cj = xb_ld(xi + 64 * j); ok = ok && (j < 8 ? cj == (gridDim.x >> 3) : cj == 0u); }
        mi[6] = ok ? mi[7] * 8u + xb_xcc_id() : blockIdx.x; mi[4] = ok ? 1u : 0u; }
    __syncthreads();
#if (REPM >> 6) & 1
    for (int i_ = 0; i_ < 10; ++i_) GRID_BAR();
#endif
#pragma nounroll
    for (int l = 0; l < DEPTH; ++l) {
#if PHM & 1
        REPEAT(1) {
            CArgs* a = kargs(); unsigned char* ws = a->ws; unsigned char* wb = ws + WS_W0 + (size_t)l * WS_WSTRIDE;
            pg8::Gemm g{(const bf16*)(ws + WS_XB), (const bf16*)(wb + WOFF_IN), M, NIN, DM}; pg8::StaticOrder S; S.init(M, NIN, (int)gridDim.x, VBID());
            pg8::Unit u0; u0.pm = -1; u0.pn = 0; (void)S.next(0, u0);
            { LAS float* rsl = (LAS float*)(lds + 131072); const int t_ = threadIdx.x;
              if (u0.pm >= 0 && t_ < 256) rsl[t_] = pg8::row_rs((const float*)(ws + WS_ROWSS), u0.pm * 256 + t_);
              else if (t_ >= 256 && t_ < 384) rsl[t_] = t_ < 320 ? a->in[3][l * 64 + t_ - 256] * pg8::QSCALE : a->in[4][l * 64 + t_ - 320];
              __syncthreads(); }
            pg8::EpiInProj E{(bf16*)(ws + WS_PROJ), (const float*)(ws + WS_ROWSS), (float*)(ws + WS_VGSS), a->in[3] + l * 64, a->in[4] + l * 64, (const LAS float*)(lds + 131072), u0.pm};
            pg8::gemm_phase<pg8::EpiInProj, pg8::StaticOrder, true, true>(lds, g, S, E);
        }
#endif
        if (l == 0 && 2 * VBID() >= (int)gridDim.x) {
            int tid = threadIdx.x; asm volatile("" : "+v"(tid)); const int lane = tid & 63, wave = __builtin_amdgcn_readfirstlane(tid >> 6);
            const int half = gridDim.x - gridDim.x / 2;
            convert_weights(kargs(), lds, wave, lane, CW_I_IN, CW_I_LAYER, (VBID() - (int)gridDim.x / 2) * NWAVES + wave, half * NWAVES);
        }
#if FAST_MIXER
        mx::fill_bias_table(kargs(), l, lds);
#endif
        if (l == 0) GRID_BAR(); else GROUP_BAR();
#if PHM & 2
        REPEAT(2) { int tid = threadIdx.x; asm volatile("" : "+v"(tid)); const int lane = tid & 63, wave = __builtin_amdgcn_readfirstlane(tid >> 6);
#if FAST_MIXER
          mx::mixer_fast(kargs(), l, lds, wave, lane, VBID());
#else
          mixer_naive(kargs(), l, lds, wave, lane);
#endif
        }
#endif
#if PHM & 4
        REPEAT(3) {
            CArgs* a = kargs(); unsigned char* ws = a->ws; unsigned char* wb = ws + WS_W0 + (size_t)l * WS_WSTRIDE; float* xo = a->out;
            pg8::Gemm g{(const bf16*)(ws + WS_MIX), (const bf16*)(wb + WOFF_OUT), M, DM, DM}; pg8::StaticOrder S; S.init(M, DM, (int)gridDim.x, VBID());
            pg8::EpiResid E{l == 0 ? a->in[0] : (const float*)nullptr, (float*)nullptr, (bf16*)(ws + WS_XB), (float*)(ws + WS_ROWSS)};
            PreGroupBar pre{ws, (volatile LAS unsigned*)(lds + MISC_OFF)};
            pg8::gemm_phase<pg8::EpiResid, pg8::StaticOrder, false, true, false, PreGroupBar>(lds, g, S, E, pre);
        }
#endif
        GROUP_BAR();
#if PHM & 8
        REPEAT(4) {
            CArgs* a = kargs(); unsigned char* ws = a->ws; unsigned char* wb = ws + WS_W0 + (size_t)l * WS_WSTRIDE;
            pg8::Gemm g{(const bf16*)(ws + WS_XB), (const bf16*)(wb + WOFF_FIN), M, NFF2, DM}; pg8::StaticOrder S; S.init(M, NFF2, (int)gridDim.x, VBID());
            pg8::Unit u0; u0.pm = -1; u0.pn = 0; (void)S.next(0, u0);
            { LAS float* rsl = (LAS float*)(lds + 131072); if (u0.pm >= 0 && threadIdx.x < 256) rsl[threadIdx.x] = pg8::row_rs((const float*)(ws + WS_ROWSS), u0.pm * 256 + (int)threadIdx.x); __syncthreads(); }
            pg8::EpiSwiGLU E{(bf16*)(ws + WS_HID), (const float*)(ws + WS_ROWSS), (const LAS float*)(lds + 131072), u0.pm};
            pg8::gemm_phase<pg8::EpiSwiGLU, pg8::StaticOrder, true, true>(lds, g, S, E);
        }
#endif
        if (l == 0 && 2 * VBID() >= (int)gridDim.x) {
            int tid = threadIdx.x; asm volatile("" : "+v"(tid)); const int lane = tid & 63, wave = __builtin_amdgcn_readfirstlane(tid >> 6);
            const int half = gridDim.x - gridDim.x / 2;
            convert_weights(kargs(), lds, wave, lane, CW_I_LAYER, 2 * CW_I_LAYER, (VBID() - (int)gridDim.x / 2) * NWAVES + wave, half * NWAVES);
        }
#if PHM & 16
        REPEAT(5) {
            CArgs* a = kargs(); unsigned char* ws = a->ws; unsigned char* wb = ws + WS_W0 + (size_t)l * WS_WSTRIDE; float* xo = a->out;
            pg8::Gemm g{(const bf16*)(ws + WS_HID), (const bf16*)(wb + WOFF_FOUT), M, DM, DFF}; pg8::StaticOrder S; S.init(M, DM, (int)gridDim.x, VBID());
            pg8::EpiResid E{(const float*)nullptr, l + 1 < DEPTH ? (float*)nullptr : xo, (bf16*)(ws + WS_XB), (float*)(ws + WS_ROWSS)};
            PreGroupBar pre{ws, (volatile LAS unsigned*)(lds + MISC_OFF)};
            pg8::gemm_phase<pg8::EpiResid, pg8::StaticOrder, false, true, true, PreGroupBar>(lds, g, S, E, pre);
        }
#endif
        if (l + 1 < DEPTH) GRID_BAR();
    }
}

extern "C" void kernel_launch(void* const* d_in, const int* in_sizes, int n_in, void* d_out, int out_size, void* d_ws, size_t ws_size, hipStream_t stream) {
    static int grid = 0;
    if (grid == 0) {
        if (n_in != 15 || in_sizes[0] != M * DM || out_size != M * DM || ws_size < WS_END) { fprintf(stderr, "kernel_launch: unexpected shapes (n_in %d, ws %zu)\n", n_in, ws_size); grid = -1; return; }
        int dev = 0, cus = 0, per_cu = 0;
        hipGetDevice(&dev); hipDeviceGetAttribute(&cus, hipDeviceAttributeMultiprocessorCount, dev);
        if (hipFuncSetAttribute((const void*)fwd_megakernel, hipFuncAttributeMaxDynamicSharedMemorySize, LDS_BYTES) != hipSuccess) { fprintf(stderr, "kernel_launch: hipFuncSetAttribute failed\n"); grid = -1; return; }
        if (hipOccupancyMaxActiveBlocksPerMultiprocessor(&per_cu, (const void*)fwd_megakernel, NWAVES * 64, LDS_BYTES) != hipSuccess || per_cu < 1) { fprintf(stderr, "kernel_launch: occupancy query failed (%d)\n", per_cu); (void)hipGetLastError(); per_cu = 1; }
        grid = cus * (per_cu > 1 ? 1 : per_cu);
        if (grid != 256) { fprintf(stderr, "kernel_launch: built for a 256-CU device (one 256x256 unit per workgroup in the N = 1024 phases); got %d\n", grid); grid = -1; return; }
    }
    if (grid < 0) return;
    if (hipMemsetAsync((char*)d_ws + WS_BAR, 0, BAR_ZERO_BYTES, stream) != hipSuccess) { fprintf(stderr, "kernel_launch: hipMemsetAsync failed\n"); return; }
    Args a{};
    for (int i = 0; i < 15; ++i) a.in[i] = (const float*)d_in[i];
    a.out = (float*)d_out; a.ws = (unsigned char*)d_ws;
    void* args[] = {&a};
    hipError_t e = hipLaunchCooperativeKernel((const void*)fwd_megakernel, dim3(grid), dim3(NWAVES * 64), args, LDS_BYTES, stream);
    if (e != hipSuccess) fprintf(stderr, "cooperative launch failed: %s (grid %d)\n", hipGetErrorString(e), grid);
}
```

```cpp
#include <hip/hip_runtime.h>
#include <hip/hip_cooperative_groups.h>
#include <cstdio>
#include <cstdint>
namespace cg = cooperative_groups;
namespace pg8 {
#define PG8_LAS __attribute__((address_space(3)))
typedef unsigned short bf16_t;
typedef short bf16x8 __attribute__((ext_vector_type(8)));
typedef float f32x4 __attribute__((ext_vector_type(4)));
typedef unsigned u32x4 __attribute__((ext_vector_type(4)));
constexpr int BM = 256, BK = 64, HALF = 128, HTB = HALF * BK * 2  , STAGE_BYTES = 8 * HTB, NXCD = 8, WGM = 8;

__host__ __device__ __forceinline__ int lds_byte(int r, int c) { const int st = (r >> 4) * 2 + (c >> 5), rr = r & 15, cc = c & 31, ob = rr * 64 + cc * 2; return st * 1024 + (ob ^ (((ob >> 9) & 1) << 5)); }
__host__ __device__ __forceinline__ void stage_rc(int b, int& R, int& C) { const int st = b / 1024, sb = b % 1024, swz = sb ^ (((sb >> 9) & 1) << 5); R = (st >> 1) * 16 + swz / 64; C = (st & 1) * 32 + (swz % 64) / 2; }
__host__ __device__ __forceinline__ int perm32(int rho) { const int n = rho >> 4, i = rho & 15; return 8 * (i >> 2) + 4 * n + (i & 3); }

struct Unit { int pm, pn; };
struct Gemm { const bf16_t* A; const bf16_t* Bt; int M, N, K; };

struct StaticOrder {
    int nM, nN, nwg, G, c;
    __host__ __device__ void init(int M, int N, int G_, int c_) { nM = M / BM; nN = N / BM; nwg = nM * nN; G = G_; c = c_; }
    __host__ __device__ bool next(int i, Unit& u) const {
        const long L = (long)i * G + c; if (L >= nwg) return false;
        int wgid = (int)L; { const int q = nwg / NXCD, r = nwg % NXCD, xcd = wgid % NXCD, off = wgid / NXCD; wgid = (xcd < r ? xcd * (q + 1) : r * (q + 1) + (xcd - r) * q) + off; }
        const int nig = WGM * nN, gid = wgid / nig, fm = gid * WGM, gsz = (nM - fm) < WGM ? (nM - fm) : WGM;
        u.pm = fm + ((wgid % nig) % gsz); u.pn = (wgid % nig) / gsz; return true;
    }
    __device__ __forceinline__ void a_ready(const Unit&) const {}
    __device__ __forceinline__ void done(const Unit&) const {}
};

__device__ __forceinline__ unsigned cvt_pk_bf16(float lo, float hi) { unsigned r; asm volatile("v_cvt_pk_bf16_f32 %0, %1, %2" : "=v"(r) : "v"(lo), "v"(hi)); return r; }
typedef float f32x2 __attribute__((ext_vector_type(2)));
constexpr float RMS_EPS = 1e-6f;
constexpr float LOG2E = 1.4426950408889634f;
constexpr float QSCALE = 0.125f * 1.4426950408889634f;
__device__ __forceinline__ float gelu_tanh(float x) {
    const float z2 = x * (1.5957691216057308f + 0.07135481627260025f * x * x);
    const float e = __builtin_amdgcn_exp2f(-LOG2E * z2);
    return x * __builtin_amdgcn_rcpf(1.0f + e);
}
__device__ __forceinline__ float row_rs(const float* rowss, int row) {
    const f32x4 a = *(const f32x4*)(rowss + (size_t)row * 4);
    return __builtin_amdgcn_rsqf(((a[0] + a[1]) + (a[2] + a[3])) * (1.0f / 1024.0f) + RMS_EPS);
}
struct EpiInProj {
    static constexpr bool PERM = true, AFTER_DRAIN = false, INIT = false;
    bf16_t* P; const float* rowss; float* vgss; const float* qg; const float* kg; const PG8_LAS float* rs_lds; int pm_cached;
    __device__ __forceinline__ void operator()(const f32x4 (&acc)[2][2][4][2], const Unit& u, int wr, int wc, int fr, int fq) const {
        const int region = u.pn >> 1, half = u.pn & 1;
        const int lcol = region * 512 + half * 256 + wc * 64 + fq * 8;
        float gq[2][8];
#pragma unroll
        for (int bj = 0; bj < 2; ++bj)
#pragma unroll
            for (int e = 0; e < 8; ++e) gq[bj][e] = 1.f;
        if (region < 2) { const PG8_LAS float* g = rs_lds + 256 + region * 64;
#pragma unroll
            for (int bj = 0; bj < 2; ++bj)
#pragma unroll
                for (int e = 0; e < 8; ++e) gq[bj][e] = g[bj * 32 + fq * 8 + e]; }
#pragma unroll
        for (int ai = 0; ai < 2; ++ai)
#pragma unroll
            for (int m = 0; m < 4; ++m) {
                const int row = u.pm * BM + ai * HALF + wr * 64 + m * 16 + fr;
                const float s = (u.pm == pm_cached) ? rs_lds[ai * HALF + wr * 64 + m * 16 + fr] : row_rs(rowss, row);
                float v[2][8];
#pragma unroll
                for (int bj = 0; bj < 2; ++bj)
#pragma unroll
                    for (int n = 0; n < 2; ++n)
#pragma unroll
                        for (int i = 0; i < 4; ++i) v[bj][4 * n + i] = acc[ai][bj][m][n][i] * s;
                if (region < 2) {
                    float q = 0.f;
#pragma unroll
                    for (int bj = 0; bj < 2; ++bj)
#pragma unroll
                        for (int e = 0; e < 8; ++e) q += v[bj][e] * v[bj][e];
                    q += __shfl_xor(q, 16); q += __shfl_xor(q, 32);
                    const float r = __builtin_amdgcn_rsqf(q * (1.0f / 64.0f) + RMS_EPS);
#pragma unroll
                    for (int bj = 0; bj < 2; ++bj)
#pragma unroll
                        for (int e = 0; e < 8; ++e) v[bj][e] = v[bj][e] * r * gq[bj][e];
                } else if (region >= 3) {
#pragma unroll
                    for (int bj = 0; bj < 2; ++bj)
#pragma unroll
                        for (int e = 0; e < 8; ++e) v[bj][e] = gelu_tanh(v[bj][e]);
                    if (region == 4) {
                        float q = 0.f;
#pragma unroll
                        for (int bj = 0; bj < 2; ++bj)
#pragma unroll
                            for (int e = 0; e < 8; ++e) q += v[bj][e] * v[bj][e];
                        q += __shfl_xor(q, 16); q += __shfl_xor(q, 32);
                        if (fq == 0) vgss[(size_t)row * 8 + half * 4 + wc] = q;
                    }
                }
                bf16_t* rowp = P + (size_t)row * 2560 + lcol;
#pragma unroll
                for (int bj = 0; bj < 2; ++bj) { u32x4 w; w.x = cvt_pk_bf16(v[bj][0], v[bj][1]); w.y = cvt_pk_bf16(v[bj][2], v[bj][3]); w.z = cvt_pk_bf16(v[bj][4], v[bj][5]); w.w = cvt_pk_bf16(v[bj][6], v[bj][7]);
                    *(u32x4*)(rowp + bj * 32) = w; }
            }
    }
};
struct EpiResid {
    static constexpr bool PERM = true, AFTER_DRAIN = true, INIT = true;
    const float* base32; float* out32; bf16_t* xb; float* rowss;
    __device__ __forceinline__ void init(f32x4 (&acc)[2][2][4][2], const Unit& u, int wr, int wc, int fr, int fq) const {
        const int col0 = u.pn * BM + wc * 32 + 8 * fq;
        if (base32) {
#pragma unroll
            for (int ai = 0; ai < 2; ++ai)
#pragma unroll
                for (int m = 0; m < 4; ++m) { const size_t off = (size_t)(u.pm * BM + ai * HALF + wr * 64 + m * 16 + fr) * 1024 + col0;
#pragma unroll
                    for (int bj = 0; bj < 2; ++bj) { acc[ai][bj][m][0] = __builtin_nontemporal_load((const f32x4*)(base32 + off + bj * HALF)); acc[ai][bj][m][1] = __builtin_nontemporal_load((const f32x4*)(base32 + off + bj * HALF + 4)); } }
        } else {
#pragma unroll
            for (int ai = 0; ai < 2; ++ai)
#pragma unroll
                for (int m = 0; m < 4; ++m) { const size_t off = (size_t)(u.pm * BM + ai * HALF + wr * 64 + m * 16 + fr) * 1024 + col0;
#pragma unroll
                    for (int bj = 0; bj < 2; ++bj) { const u32x4 w = *(const u32x4*)(xb + off + bj * HALF);
                        acc[ai][bj][m][0] = (f32x4){__builtin_bit_cast(float, w.x << 16), __builtin_bit_cast(float, w.x & 0xffff0000u), __builtin_bit_cast(float, w.y << 16), __builtin_bit_cast(float, w.y & 0xffff0000u)};
                        acc[ai][bj][m][1] = (f32x4){__builtin_bit_cast(float, w.z << 16), __builtin_bit_cast(float, w.z & 0xffff0000u), __builtin_bit_cast(float, w.w << 16), __builtin_bit_cast(float, w.w & 0xffff0000u)}; } }
        }
    }
    __device__ __forceinline__ void fused(f32x4 (&acc)[2][2][4][2], const Unit& u, int wr, int wc, int fr, int fq, PG8_LAS unsigned char* lds, int wid, int lane) const {
        PG8_LAS float* part = (PG8_LAS float*)lds;
        const int col0 = u.pn * BM + wc * 32 + 8 * fq;
#pragma unroll
        for (int ai = 0; ai < 2; ++ai)
#pragma unroll
            for (int m = 0; m < 4; ++m) {
                const int rl = ai * HALF + wr * 64 + m * 16 + fr;
                const size_t off = (size_t)(u.pm * BM + rl) * 1024 + col0;
                float q = 0.f;
#pragma unroll
                for (int bj = 0; bj < 2; ++bj) {
                    const f32x4 v0 = acc[ai][bj][m][0], v1 = acc[ai][bj][m][1];
                    if (out32) { *(f32x4*)(out32 + off + bj * HALF) = v0; *(f32x4*)(out32 + off + bj * HALF + 4) = v1; }
                    else { u32x4 w; w.x = cvt_pk_bf16(v0[0], v0[1]); w.y = cvt_pk_bf16(v0[2], v0[3]); w.z = cvt_pk_bf16(v1[0], v1[1]); w.w = cvt_pk_bf16(v1[2], v1[3]);
                        *(u32x4*)(xb + off + bj * HALF) = w; }
                    q += (v0[0] * v0[0] + v0[1] * v0[1]) + (v0[2] * v0[2] + v0[3] * v0[3]) + (v1[0] * v1[0] + v1[1] * v1[1]) + (v1[2] * v1[2] + v1[3] * v1[3]);
                }
                q += __shfl_xor(q, 16); q += __shfl_xor(q, 32);
                if (fq == 0) part[rl * 4 + wc] = q;
            }
        asm volatile("s_waitcnt lgkmcnt(0)" ::: "memory"); __builtin_amdgcn_s_barrier(); asm volatile("" ::: "memory");
        const int t = wid * 64 + lane;
        if (t < 256) { const f32x4 p = *(const PG8_LAS f32x4*)(part + t * 4); rowss[(size_t)(u.pm * BM + t) * 4 + u.pn] = (p[0] + p[1]) + (p[2] + p[3]); }
    }
};
struct EpiSwiGLU {
    static constexpr bool PERM = true, AFTER_DRAIN = false, INIT = false;
    bf16_t* H; const float* rowss; const PG8_LAS float* rs_lds; int pm_cached;
    __device__ __forceinline__ void operator()(const f32x4 (&acc)[2][2][4][2], const Unit& u, int wr, int wc, int fr, int fq) const {
        const int col0 = u.pn * 128 + wc * 32 + 8 * fq;
#pragma unroll
        for (int ai = 0; ai < 2; ++ai)
#pragma unroll
            for (int m = 0; m < 4; ++m) {
                const int row = u.pm * BM + ai * HALF + wr * 64 + m * 16 + fr;
                const float s = (u.pm == pm_cached) ? rs_lds[ai * HALF + wr * 64 + m * 16 + fr] : row_rs(rowss, row);
                float h[8];
#pragma unroll
                for (int n = 0; n < 2; ++n)
#pragma unroll
                    for (int i = 0; i < 4; ++i) { const float g = acc[ai][0][m][n][i] * s, up = acc[ai][1][m][n][i] * s;
                        h[4 * n + i] = g * __builtin_amdgcn_rcpf(1.0f + __builtin_amdgcn_exp2f(-LOG2E * g)) * up; }
                u32x4 w; w.x = cvt_pk_bf16(h[0], h[1]); w.y = cvt_pk_bf16(h[2], h[3]); w.z = cvt_pk_bf16(h[4], h[5]); w.w = cvt_pk_bf16(h[6], h[7]);
                *(u32x4*)(H + ((size_t)(col0 >> 6) * 16384 + row) * 64 + (col0 & 63)) = w;
            }
    }
};
struct NoPre { __device__ __forceinline__ void drain() const {} __device__ __forceinline__ void sync() const {} };
template <class Epi, class Sched, bool ALIGN_EPI = false, bool SP2 = false, bool TILED = false, class Pre = NoPre>
__device__ __forceinline__ void gemm_phase(PG8_LAS unsigned char* lds, const Gemm g, const Sched& S, const Epi& E, const Pre& pre = Pre()) {
    int tid_l = threadIdx.x; asm volatile("" : "+v"(tid_l));
    const int tid = tid_l, wid = __builtin_amdgcn_readfirstlane(tid >> 6), lane = tid & 63, wr = wid >> 2, wc = wid & 3, fr = lane & 15, fq = lane >> 4;
    const int K = g.K, nt = K / BK;
    unsigned voffA[2], voffB[2];
#pragma unroll
    for (int i = 0; i < 2; ++i) { int R, C; stage_rc(tid * 16 + i * 8192, R, C); const int Rb = Epi::PERM ? ((R & ~31) + perm32(R & 31)) : R;
        const int lda = TILED ? 64 : K; voffA[i] = (unsigned)(R * lda + C) * 2u; voffB[i] = (unsigned)(Rb * lda + C) * 2u; }
    const size_t kstepA = TILED ? (size_t)g.M * BK * 2 : (size_t)(BK * 2), kstepB = TILED ? (size_t)g.N * BK * 2 : (size_t)(BK * 2);
    const size_t hstep = (size_t)HALF * (TILED ? 64 : K) * 2;
    const size_t tstep = 2 * hstep;
    const unsigned ldsw = (unsigned)wid * 1024u;
    const int aoff = lds_byte(wr * 64 + fr, fq * 8), boff = lds_byte(wc * 32 + fr, fq * 8);
#define PG8_SA(b, h) (((b) * 2 + (h)) * HTB)
#define PG8_SB(b, h) ((4 + (b) * 2 + (h)) * HTB)
#define PG8_STAGE(bufoff, gbase, voff) do { _Pragma("unroll") for (int _i = 0; _i < 2; ++_i) \
        __builtin_amdgcn_global_load_lds((const unsigned*)((const char*)(gbase) + (voff)[_i]), (PG8_LAS unsigned*)(lds + (bufoff) + ldsw + _i * 8192), 16, 0, 0); } while (0)
#define PG8_LDA(dst, b, h) do { _Pragma("unroll") for (int m = 0; m < 4; ++m) _Pragma("unroll") for (int k = 0; k < 2; ++k) dst[m][k] = *(const PG8_LAS bf16x8*)(lds + PG8_SA(b, h) + aoff + m * 2048 + k * 1024); } while (0)
#define PG8_LDB(dst, b, h) do { _Pragma("unroll") for (int n = 0; n < 2; ++n) _Pragma("unroll") for (int k = 0; k < 2; ++k) dst[n][k] = *(const PG8_LAS bf16x8*)(lds + PG8_SB(b, h) + boff + n * 2048 + k * 1024); } while (0)
#define PG8_MMA(ai, bj, At, Bt) do { __builtin_amdgcn_s_setprio(1); _Pragma("unroll") for (int m = 0; m < 4; ++m) _Pragma("unroll") for (int n = 0; n < 2; ++n) _Pragma("unroll") for (int k = 0; k < 2; ++k) \
        acc[ai][bj][m][n] = __builtin_amdgcn_mfma_f32_16x16x32_bf16(Bt[n][k], At[m][k], acc[ai][bj][m][n], 0, 0, 0); __builtin_amdgcn_s_setprio(0); } while (0)
#define PG8_WAIT_V(n) asm volatile("s_waitcnt vmcnt(" #n ")" ::: "memory")
#define PG8_WAIT_L(n) asm volatile("s_waitcnt lgkmcnt(" #n ")" ::: "memory")
#define PG8_BAR __builtin_amdgcn_s_barrier()
#define PG8_SCHED __builtin_amdgcn_sched_barrier(0)
    Unit cur, nxt; int ui = 0;
    if (!S.next(0, cur)) return;
    f32x4 acc[2][2][4][2];
    pre.drain();
    if constexpr (Epi::INIT) E.init(acc, cur, wr, wc, fr, fq);
    else {
#pragma unroll
    for (int a = 0; a < 2; ++a)
#pragma unroll
        for (int b = 0; b < 2; ++b)
#pragma unroll
            for (int m = 0; m < 4; ++m)
#pragma unroll
                for (int n = 0; n < 2; ++n) acc[a][b][m][n] = (f32x4){0.f, 0.f, 0.f, 0.f};
    }
    pre.sync();
    bf16x8 At[4][2], B0[2][2], B1[2][2];
    const char* cA = (const char*)g.A + (size_t)cur.pm * tstep; const char* cB = (const char*)g.Bt + (size_t)cur.pn * tstep;
    S.a_ready(cur);
    if constexpr (SP2) {
        PG8_STAGE(PG8_SB(0, 0), cB, voffB); PG8_STAGE(PG8_SB(0, 1), cB + hstep, voffB); PG8_STAGE(PG8_SA(0, 0), cA, voffA); PG8_STAGE(PG8_SA(0, 1), cA + hstep, voffA);
        if (wr == 1) PG8_BAR;
        PG8_WAIT_V(2); PG8_BAR;
        PG8_STAGE(PG8_SB(1, 0), cB + kstepB, voffB); PG8_STAGE(PG8_SA(1, 0), cA + kstepA, voffA); PG8_STAGE(PG8_SB(1, 1), cB + hstep + kstepB, voffB);
        PG8_WAIT_V(6); PG8_BAR;
    } else {
        PG8_STAGE(PG8_SB(0, 0), cB, voffB); PG8_STAGE(PG8_SA(0, 0), cA, voffA); PG8_STAGE(PG8_SB(0, 1), cB + hstep, voffB); PG8_STAGE(PG8_SA(0, 1), cA + hstep, voffA);
        if (wr == 1) PG8_BAR;
        PG8_WAIT_V(4); PG8_BAR;
        PG8_STAGE(PG8_SB(1, 0), cB + kstepB, voffB); PG8_STAGE(PG8_SA(1, 0), cA + kstepA, voffA); PG8_STAGE(PG8_SB(1, 1), cB + hstep + kstepB, voffB);
        PG8_WAIT_V(6); PG8_BAR;
    }
    for (;;) {
        const bool has_next = S.next(ui + 1, nxt);
        const char* nA = has_next ? (const char*)g.A + (size_t)nxt.pm * tstep : cA; const char* nB = has_next ? (const char*)g.Bt + (size_t)nxt.pn * tstep : cB;
        for (int t = 0; t < nt; t += 2) {
            const bool last = (t == nt - 2);
            const char* a1 = cA + (size_t)(t + 1) * kstepA;
            const char* a2 = last ? nA : cA + (size_t)(t + 2) * kstepA; const char* b2 = last ? nB : cB + (size_t)(t + 2) * kstepB;
            const char* a3 = a2 + kstepA; const char* b3 = b2 + kstepB;
            if (last && has_next) S.a_ready(nxt);
            if constexpr (SP2) {
            PG8_LDB(B0, 0, 0); PG8_LDB(B1, 0, 1); PG8_SCHED; PG8_LDA(At, 0, 0); PG8_STAGE(PG8_SA(1, 1), a1 + hstep, voffA);
            PG8_WAIT_V(8); PG8_WAIT_L(0); PG8_BAR; PG8_MMA(0, 0, At, B0); PG8_MMA(0, 1, At, B1); PG8_BAR; PG8_SCHED;
            PG8_LDA(At, 0, 1); PG8_STAGE(PG8_SB(0, 0), b2, voffB); PG8_STAGE(PG8_SB(0, 1), b2 + hstep, voffB); PG8_STAGE(PG8_SA(0, 0), a2, voffA);
            PG8_WAIT_V(8); PG8_WAIT_L(0); PG8_BAR; PG8_MMA(1, 0, At, B0); PG8_MMA(1, 1, At, B1); PG8_BAR; PG8_SCHED;
            PG8_LDB(B0, 1, 0); PG8_LDB(B1, 1, 1); PG8_SCHED; PG8_LDA(At, 1, 0); PG8_STAGE(PG8_SA(0, 1), a2 + hstep, voffA);
            PG8_WAIT_V(8); PG8_WAIT_L(0); PG8_BAR; PG8_MMA(0, 0, At, B0); PG8_MMA(0, 1, At, B1); PG8_BAR; PG8_SCHED;
            PG8_LDA(At, 1, 1); PG8_STAGE(PG8_SB(1, 0), b3, voffB); PG8_STAGE(PG8_SB(1, 1), b3 + hstep, voffB); PG8_STAGE(PG8_SA(1, 0), a3, voffA);
            PG8_WAIT_V(8); PG8_WAIT_L(0); PG8_BAR; PG8_MMA(1, 0, At, B0); PG8_MMA(1, 1, At, B1); PG8_BAR; PG8_SCHED;
            } else {
            PG8_LDB(B0, 0, 0); PG8_SCHED; PG8_LDA(At, 0, 0); PG8_STAGE(PG8_SA(1, 1), a1 + hstep, voffA);
            PG8_WAIT_L(8); PG8_BAR; PG8_WAIT_L(0); PG8_MMA(0, 0, At, B0); PG8_BAR; PG8_SCHED;
            PG8_LDB(B1, 0, 1); PG8_STAGE(PG8_SB(0, 0), b2, voffB);
            PG8_BAR; PG8_WAIT_L(0); PG8_MMA(0, 1, At, B1); PG8_BAR;
            PG8_LDA(At, 0, 1); PG8_STAGE(PG8_SA(0, 0), a2, voffA);
            PG8_BAR; PG8_WAIT_L(0); PG8_MMA(1, 0, At, B0); PG8_BAR; PG8_SCHED;
            PG8_STAGE(PG8_SB(0, 1), b2 + hstep, voffB);
            PG8_WAIT_V(6); PG8_BAR; PG8_MMA(1, 1, At, B1); PG8_BAR;
            PG8_LDB(B0, 1, 0); PG8_SCHED; PG8_LDA(At, 1, 0); PG8_STAGE(PG8_SA(0, 1), a2 + hstep, voffA);
            PG8_WAIT_L(8); PG8_BAR; PG8_WAIT_L(0); PG8_MMA(0, 0, At, B0); PG8_BAR; PG8_SCHED;
            PG8_LDB(B1, 1, 1); PG8_STAGE(PG8_SB(1, 0), b3, voffB);
            PG8_BAR; PG8_WAIT_L(0); PG8_MMA(0, 1, At, B1); PG8_BAR;
            PG8_LDA(At, 1, 1); PG8_STAGE(PG8_SA(1, 0), a3, voffA);
            PG8_BAR; PG8_WAIT_L(0); PG8_MMA(1, 0, At, B0); PG8_BAR; PG8_SCHED;
            PG8_STAGE(PG8_SB(1, 1), b3 + hstep, voffB);
            PG8_WAIT_V(6); PG8_BAR; PG8_MMA(1, 1, At, B1); PG8_BAR;
            }
        }
        if constexpr (ALIGN_EPI) { if (wr == 0) PG8_BAR; }
        if constexpr (!Epi::AFTER_DRAIN) { E(acc, cur, wr, wc, fr, fq); S.done(cur); }
        if (!has_next) break;
        if constexpr (Epi::INIT) E.init(acc, nxt, wr, wc, fr, fq);
        else {
#pragma unroll
        for (int a = 0; a < 2; ++a)
#pragma unroll
            for (int b = 0; b < 2; ++b)
#pragma unroll
                for (int m = 0; m < 4; ++m)
#pragma unroll
                    for (int n = 0; n < 2; ++n) acc[a][b][m][n] = (f32x4){0.f, 0.f, 0.f, 0.f};
        }
        cur = nxt; cA = nA; cB = nB; ++ui;
        if constexpr (ALIGN_EPI) { if (wr == 1) PG8_BAR; }
    }
    PG8_WAIT_V(0);
    if constexpr (!ALIGN_EPI) { if (wr == 0) PG8_BAR; }
    PG8_BAR;
    if constexpr (Epi::AFTER_DRAIN) { E.fused(acc, cur, wr, wc, fr, fq, lds, wid, lane); S.done(cur); }
#undef PG8_SA
#undef PG8_SB
#undef PG8_STAGE
#undef PG8_LDA
#undef PG8_LDB
#undef PG8_MMA
#undef PG8_WAIT_V
#undef PG8_WAIT_L
#undef PG8_BAR
#undef PG8_SCHED
}
}
constexpr int NB = 8, SEQ = 2048, DM = 1024, M = NB * SEQ, NIN = 2560, DFF = 2816, NFF2 = 2 * DFF, DEPTH = 2;
constexpr int NWAVES = 8;
constexpr size_t MiB = 1u << 20;
constexpr size_t WS_ROWSS = 1 * MiB;
constexpr size_t WS_VGSS = 2 * MiB;
constexpr size_t WS_WSP = 3 * MiB;
constexpr size_t WS_W0 = 4 * MiB, WS_WSTRIDE = 24 * MiB;
constexpr size_t WOFF_IN = 0, WOFF_OUT = 5 * MiB, WOFF_FIN = 7 * MiB, WOFF_FOUT = 18 * MiB;
constexpr size_t WS_XB = 52 * MiB;
constexpr size_t WS_PROJ = 84 * MiB;
constexpr size_t WS_MIX = 164 * MiB;
constexpr size_t WS_HID = 84 * MiB;
constexpr size_t WS_END = 196 * MiB;
constexpr int LDS_BYTES = 155648;

#define GAS __attribute__((address_space(1)))
#define LAS __attribute__((address_space(3)))
typedef unsigned short bf16;
typedef unsigned v4u __attribute__((ext_vector_type(4)));
typedef float f32x4 __attribute__((ext_vector_type(4)));
__device__ __forceinline__ unsigned f2bf(float f) { unsigned u = __builtin_bit_cast(unsigned, f); return (u + 0x7fffu + ((u >> 16) & 1u)) >> 16; }
__device__ __forceinline__ unsigned pk2(float lo, float hi) { return f2bf(lo) | (f2bf(hi) << 16); }
__device__ __forceinline__ float bf2f(bf16 v) { return __builtin_bit_cast(float, (unsigned)v << 16); }
__device__ __forceinline__ float wave_sum(float v) {
#pragma unroll
    for (int o = 1; o < 64; o <<= 1) v += __shfl_xor(v, o);
    return v;
}
#define LDS_WAIT() asm volatile("s_waitcnt lgkmcnt(0)" ::: "memory")

typedef short tp_s16x4 __attribute__((ext_vector_type(4)));
__device__ __forceinline__ void p0_transpose_item(const float* W, int K, int N, bf16* WT, int k0, int n0, int prow0, int prow1, const float* gk, LAS unsigned char* scr, int lane, int tiled_n = 0) {
    const int lr = lane >> 4, n4 = (lane & 15) * 4;
    f32x4 v[16];
#pragma unroll
    for (int i = 0; i < 16; ++i) v[i] = __builtin_nontemporal_load((const f32x4*)(W + (size_t)(k0 + 4 * i + lr) * N + n0 + n4));
#pragma unroll
    for (int i = 0; i < 16; ++i) { const int k = 4 * i + lr; const float gg = gk ? gk[k0 + k] : 1.f;
        unsigned long long w = (unsigned long long)pk2(v[i].x * gg, v[i].y * gg) | ((unsigned long long)pk2(v[i].z * gg, v[i].w * gg) << 32);
        *(LAS unsigned long long*)(scr + k * 128 + ((n4 * 2) ^ (((k >> 1) & 1) << 6))) = w; }
    asm volatile("" ::: "memory");
    const int hh = lane >> 5, g2 = (lane >> 4) & 1, i16 = lane & 15, qq = i16 >> 2, p4 = i16 & 3;
#pragma unroll
    for (int j = 0; j < 8; ++j) { const int c = 2 * (j >> 1) + hh, nb = 32 * (j & 1) + 16 * g2;
        const int a0 = (8 * c + qq) * 128 + (((nb + 4 * p4) * 2) ^ ((qq >> 1) << 6));
        const tp_s16x4 lo = __builtin_bit_cast(tp_s16x4, __builtin_amdgcn_ds_read_tr16_b64_v4i16((LAS tp_s16x4*)(scr + a0)));
        const tp_s16x4 hi4 = __builtin_bit_cast(tp_s16x4, __builtin_amdgcn_ds_read_tr16_b64_v4i16((LAS tp_s16x4*)(scr + a0 + 4 * 128)));
        typedef short s16x8_t __attribute__((ext_vector_type(8)));
        const s16x8_t o = (s16x8_t){lo[0], lo[1], lo[2], lo[3], hi4[0], hi4[1], hi4[2], hi4[3]};
        const int prow = ((j & 1) ? prow1 : prow0) + 16 * g2 + i16;
        *(s16x8_t*)(WT + (tiled_n ? ((size_t)(k0 >> 6) * tiled_n + prow) * 64 + 8 * c : (size_t)prow * K + k0 + 8 * c)) = o; }
    LDS_WAIT(); asm volatile("" ::: "memory");
}
__host__ __device__ __forceinline__ int map_in(int n) { const int T = n >> 8, nn = n & 255; return 256 * T + 128 * ((nn >> 5) & 1) + 32 * (nn >> 6) + (nn & 31); }
__host__ __device__ __forceinline__ int map_fin(int n) { return n < DFF ? 256 * (n >> 7) + (n & 127) : 256 * ((n - DFF) >> 7) + 128 + ((n - DFF) & 127); }

typedef GAS unsigned gu32;
#define RLX_AGENT __ATOMIC_RELAXED, __HIP_MEMORY_SCOPE_AGENT
constexpr int MISC_OFF = LDS_BYTES - 64;
constexpr size_t WS_BAR = 0;
constexpr size_t BAR_ZERO_BYTES = 32768;
#define XB_TMO      128
#define XB_XCNT(j)  (256  + 64 * (j))
#define XB_XSUB(j)  (1280 + 64 * (j))
#define XB_XGEN(j)  (2304 + 64 * (j))
#define XB_TOP      3328
#define XB_TOPGEN   3392
#define XCD_BAR_WORDS 3456
#define XB_SPIN_CAP (1u << 18)

__device__ __forceinline__ unsigned xb_ld(unsigned* p)              { return __hip_atomic_load(p, __ATOMIC_RELAXED, __HIP_MEMORY_SCOPE_AGENT); }
__device__ __forceinline__ unsigned xb_add(unsigned* p, unsigned v) { return __hip_atomic_fetch_add(p, v, __ATOMIC_RELAXED, __HIP_MEMORY_SCOPE_AGENT); }
__device__ __forceinline__ unsigned xb_xcc_id() { return (unsigned)__builtin_amdgcn_s_getreg((3 << 11) | 20) & 0xFu; }
#define XB_SPIN(cond, bar) do { unsigned _sp = 0; while (cond) { __builtin_amdgcn_s_sleep(1); \
    if ((++_sp & 255u) == 0u) { if (xb_ld(&(bar)[XB_TMO])) break; if (_sp > XB_SPIN_CAP) { atomicAdd(&(bar)[XB_TMO], 1u); break; } } } } while (0)

struct XcdBarrier {
    unsigned* bar; unsigned x;
    volatile LAS unsigned* st;
};

__device__ __forceinline__ XcdBarrier xcd_barrier_post(unsigned* bar, volatile LAS unsigned* st) {
    XcdBarrier b; b.bar = bar; b.x = xb_xcc_id(); b.st = st;
    if (threadIdx.x == 0) (void)xb_add(&bar[XB_XCNT(b.x)], 1u);
    return b;
}
__device__ __forceinline__ void xcd_barrier_complete(unsigned* bar, unsigned x, unsigned& nloc, unsigned& nx) {
    const unsigned G = gridDim.x * gridDim.y * gridDim.z;
    unsigned sum, cnt, mine, sp = 0u;
    for (;;) {
        sum = 0u; cnt = 0u; mine = 0u;
#pragma unroll
        for (unsigned j = 0; j < 16; ++j) { const unsigned c = xb_ld(&bar[XB_XCNT(j)]); sum += c; cnt += (c > 0u) ? 1u : 0u; mine = (j == x) ? c : mine; }
        if (sum == G) break;
        __builtin_amdgcn_s_sleep(1);
        if ((++sp & 255u) == 0u) { if (xb_ld(&bar[XB_TMO])) break; if (sp > XB_SPIN_CAP) { atomicAdd(&bar[XB_TMO], 1u); break; } }
    }
    nloc = mine > 0u ? mine : 1u; nx = cnt > 0u ? cnt : 1u;
}

__device__ __forceinline__ void xcd_barrier(const XcdBarrier& b) {
    asm volatile("s_waitcnt vmcnt(0)" ::: "memory");
    __syncthreads();
    if (threadIdx.x == 0) {
        unsigned* bar = b.bar;
        __builtin_amdgcn_s_waitcnt(0);
        unsigned nloc = b.st[0], nx = b.st[1];
        if (nloc == 0u) { xcd_barrier_complete(bar, b.x, nloc, nx); b.st[0] = nloc; b.st[1] = nx; }
        const unsigned old = xb_add(&bar[XB_XSUB(b.x)], 1u);
        const unsigned gen = old / nloc;
        if (old + 1u == (gen + 1u) * nloc) {
            __builtin_amdgcn_fence(__ATOMIC_RELEASE, "agent");
            asm volatile("s_waitcnt vmcnt(0)" ::: "memory");
            const unsigned og = xb_add(&bar[XB_TOP], 1u);
            const unsigned tg = og / nx;
            if (og + 1u == (tg + 1u) * nx) xb_add(&bar[XB_TOPGEN], 1u);
            else XB_SPIN(xb_ld(&bar[XB_TOPGEN]) == tg, bar);
            __builtin_amdgcn_fence(__ATOMIC_ACQUIRE, "agent");
            xb_add(&bar[XB_XGEN(b.x)], 1u);
            asm volatile("s_waitcnt vmcnt(0)" ::: "memory");
        } else {
            XB_SPIN(xb_ld(&bar[XB_XGEN(b.x)]) == gen, bar);
            __builtin_amdgcn_fence(__ATOMIC_ACQUIRE, "agent");
            asm volatile("s_waitcnt vmcnt(0)" ::: "memory");
        }
    }
    __syncthreads();
}

constexpr size_t WS_GCNT = 16384, WS_GMASK = 16384 + 8 * 256, WS_XIDX = 16384 + 16 * 256;
__device__ __forceinline__ void group_barrier(unsigned char* ws, volatile LAS unsigned* misc) {
    asm volatile("s_waitcnt vmcnt(0)" ::: "memory");
    __syncthreads();
    if (threadIdx.x == 0) {
        unsigned bx = misc[6];
        unsigned* cnt = (unsigned*)(ws + WS_GCNT) + 64 * (bx & 7u);
        const unsigned pure = misc[4], ep = misc[5] + 1u; misc[5] = ep;
        if (!pure) { __builtin_amdgcn_fence(__ATOMIC_RELEASE, "agent"); asm volatile("s_waitcnt vmcnt(0)" ::: "memory"); }
        const unsigned old_ = xb_add(cnt, 1u);
        if (pure) { __builtin_amdgcn_fence(__ATOMIC_ACQUIRE, "agent"); asm volatile("s_waitcnt vmcnt(0)" ::: "memory"); }
        const unsigned target = ep * (gridDim.x >> 3);
        unsigned sp = 0u;
        if (old_ + 1u < target) while (xb_ld(cnt) < target) { __builtin_amdgcn_s_sleep(1); if (++sp > (1u << 22)) break; }
        if (!pure) __builtin_amdgcn_fence(__ATOMIC_ACQUIRE, "agent");
        asm volatile("s_waitcnt vmcnt(0)" ::: "memory");
    }
    __syncthreads();
}
struct PreGroupBar {
    unsigned char* ws; volatile LAS unsigned* misc;
    __device__ __forceinline__ void drain() const { asm volatile("s_waitcnt vmcnt(0)" ::: "memory"); }
    __device__ __forceinline__ void sync() const {
        asm volatile("s_waitcnt lgkmcnt(0)" ::: "memory"); __builtin_amdgcn_s_barrier(); asm volatile("" ::: "memory");
        if (threadIdx.x == 0) {
            unsigned bx = misc[6];
            unsigned* cnt = (unsigned*)(ws + WS_GCNT) + 64 * (bx & 7u);
            const unsigned pure = misc[4], ep = misc[5] + 1u; misc[5] = ep;
            if (!pure) { __builtin_amdgcn_fence(__ATOMIC_RELEASE, "agent"); asm volatile("s_waitcnt vmcnt(0)" ::: "memory"); }
            const unsigned old_ = xb_add(cnt, 1u);
            if (pure) { __builtin_amdgcn_fence(__ATOMIC_ACQUIRE, "agent"); asm volatile("s_waitcnt vmcnt(0)" ::: "memory"); }
            const unsigned target = ep * (gridDim.x >> 3);
            unsigned sp = 0u;
            if (old_ + 1u < target) while (xb_ld(cnt) < target) { __builtin_amdgcn_s_sleep(1); if (++sp > (1u << 22)) break; }
            if (!pure) __builtin_amdgcn_fence(__ATOMIC_ACQUIRE, "agent");
            asm volatile("s_waitcnt vmcnt(0)" ::: "memory");
        }
        asm volatile("s_waitcnt lgkmcnt(0)" ::: "memory"); __builtin_amdgcn_s_barrier(); asm volatile("" ::: "memory");
    }
};
#define GROUP_BAR() group_barrier(kargs_ws(), (volatile LAS unsigned*)(lds + MISC_OFF))
#define VBID() ((int)__builtin_amdgcn_readfirstlane(((volatile LAS unsigned*)(lds + MISC_OFF))[6]))
#define GRID_BAR() do { XcdBarrier bar_; bar_.bar = (unsigned*)(kargs_ws() + WS_BAR); bar_.x = xb_xcc_id(); bar_.st = (volatile LAS unsigned*)(lds + MISC_OFF); xcd_barrier(bar_); } while (0)
struct Args { const float* in[15]; float* out; unsigned char* ws; };
typedef const __attribute__((address_space(4))) Args CArgs;
__device__ __forceinline__ CArgs* kargs();
__device__ __forceinline__ unsigned char* kargs_ws();
__device__ __forceinline__ CArgs* kargs() { CArgs* p = (CArgs*)__builtin_amdgcn_kernarg_segment_ptr(); asm volatile("" : "+s"(p)); return p; }
__device__ __forceinline__ unsigned char* kargs_ws() { return kargs()->ws; }

constexpr int CW_I_IN = (DM / 64) * (NIN / 64), CW_I_LAYER = CW_I_IN + (DM / 64) * (DM / 64) + (DM / 64) * (NFF2 / 64) + (DFF / 64) * (DM / 64);
__device__ __forceinline__ void convert_weights(CArgs* a, LAS unsigned char* lds, int wave, int lane, int it0, int it1, int gw, int NGW) {
    LAS unsigned char* scr = lds + wave * 16384;
    constexpr int I_IN = (DM / 64) * (NIN / 64), I_OUT = (DM / 64) * (DM / 64), I_FIN = (DM / 64) * (NFF2 / 64), I_FOUT = (DFF / 64) * (DM / 64);
    constexpr int I_LAYER = I_IN + I_OUT + I_FIN + I_FOUT;
    static_assert(I_IN == CW_I_IN && I_LAYER == CW_I_LAYER, "item counts");
#pragma nounroll
    for (int it = it0 + gw; it < it1; it += NGW) {
        const int l = it / I_LAYER; int r = it % I_LAYER;
        unsigned char* wb = a->ws + WS_W0 + (size_t)l * WS_WSTRIDE;
        if (r < I_IN) { const int nblk = NIN / 64, kb = r / nblk, nb = r % nblk;
            p0_transpose_item(a->in[2] + (size_t)l * DM * NIN, DM, NIN, (bf16*)(wb + WOFF_IN), 64 * kb, 64 * nb, map_in(64 * nb), map_in(64 * nb + 32), a->in[1] + l * DM, scr, lane); continue; } r -= I_IN;
        if (r < I_OUT) { const int nblk = DM / 64, kb = r / nblk, nb = r % nblk;
            p0_transpose_item(a->in[11] + (size_t)l * DM * DM, DM, DM, (bf16*)(wb + WOFF_OUT), 64 * kb, 64 * nb, 64 * nb, 64 * nb + 32, nullptr, scr, lane); continue; } r -= I_OUT;
        if (r < I_FIN) { const int nblk = NFF2 / 64, kb = r / nblk, nb = r % nblk;
            p0_transpose_item(a->in[13] + (size_t)l * DM * NFF2, DM, NFF2, (bf16*)(wb + WOFF_FIN), 64 * kb, 64 * nb, map_fin(64 * nb), map_fin(64 * nb + 32), a->in[12] + l * DM, scr, lane); continue; } r -= I_FIN;
        { const int nblk = DM / 64, kb = r / nblk, nb = r % nblk;
            p0_transpose_item(a->in[14] + (size_t)l * DFF * DM, DFF, DM, (bf16*)(wb + WOFF_FOUT), 64 * kb, 64 * nb, 64 * nb, 64 * nb + 32, nullptr, scr, lane, DM); }
    }
}
__device__ __forceinline__ void prologue(CArgs* a, LAS unsigned char* lds, int wave, int lane) {
    const int gw = blockIdx.x * NWAVES + wave, NGW = gridDim.x * NWAVES;
    convert_weights(a, lds, wave, lane, 0, CW_I_IN, gw, NGW);
    float* rowss = (float*)(a->ws + WS_ROWSS); bf16* xb = (bf16*)(a->ws + WS_XB);
#pragma nounroll
    for (int m0 = gw * 4; m0 < M; m0 += NGW * 4) {
        f32x4 v[4][4];
#pragma unroll
        for (int r = 0; r < 4; ++r) { const f32x4* xr = (const f32x4*)(a->in[0] + (size_t)(m0 + r) * DM) + lane;
#pragma unroll
            for (int j = 0; j < 4; ++j) v[r][j] = __builtin_nontemporal_load(xr + 64 * j); }
#pragma unroll
        for (int r = 0; r < 4; ++r) { unsigned long long* o8 = (unsigned long long*)(xb + (size_t)(m0 + r) * DM) + lane; float sq = 0.f;
#pragma unroll
            for (int j = 0; j < 4; ++j) { const f32x4 w = v[r][j]; sq += (w.x * w.x + w.y * w.y) + (w.z * w.z + w.w * w.w);
                o8[64 * j] = (unsigned long long)pk2(w.x, w.y) | ((unsigned long long)pk2(w.z, w.w) << 32); }
            sq = wave_sum(sq);
            if (lane < 4) rowss[(size_t)(m0 + r) * 4 + lane] = lane == 0 ? sq : 0.f; }
    }
    { const float* wsp = a->in[7]; bf16* o = (bf16*)(a->ws + WS_WSP); const int gt = blockIdx.x * 512 + threadIdx.x, NT = gridDim.x * 512;
      for (int i = gt; i < DEPTH * 8 * 128 * 128; i += NT) { const int s = i & 127, t = (i >> 7) & 127; o[i] = (bf16)(((t >> 6) >= (s >> 6)) ? f2bf(wsp[i]) : 0u); } }
}

__device__ __forceinline__ void mixer_naive(CArgs* a, int l, LAS unsigned char* lds, int wave, int lane) {
    const bf16* P = (const bf16*)(a->ws + WS_PROJ); bf16* MIX = (bf16*)(a->ws + WS_MIX);
    const float* vgss = (const float*)(a->ws + WS_VGSS); const bf16* wsp = (const bf16*)(a->ws + WS_WSP) + (size_t)l * 8 * 128 * 128;
    const float* rel = a->in[5] + (size_t)l * 8 * 257; const float* sgu_g = a->in[6] + l * 512; const float* bsp = a->in[8] + l * 8 * 128;
    const float* ag = a->in[9] + l * 512; const float* gg = a->in[10] + l * 512;
    LAS float* red = (LAS float*)lds;
    for (int tok = blockIdx.x; tok < M; tok += gridDim.x) {
        const int b = tok / SEQ, t = tok % SEQ, c = t >> 6;
        const int h = wave;
        const float q = bf2f(P[(size_t)tok * NIN + h * 64 + lane]);
        float mx = -INFINITY, lsum = 0.f, o = 0.f;
        const int k0 = (c >= 8 ? c - 8 : 0) * 64, k1 = c * 64 + 63;
        for (int kt = k0; kt <= k1; ++kt) {
            const size_t kr = (size_t)(b * SEQ + kt) * NIN;
            float s = wave_sum(q * bf2f(P[kr + 512 + h * 64 + lane]));
            int d = t - kt; d = d < -128 ? -128 : (d > 128 ? 128 : d);
            s += rel[h * 257 + d + 128] * pg8::LOG2E;
            const float mn = fmaxf(mx, s), al = __builtin_amdgcn_exp2f(mx - mn), p = __builtin_amdgcn_exp2f(s - mn);
            lsum = lsum * al + p; o = o * al + p * bf2f(P[kr + 1024 + h * 64 + lane]); mx = mn;
        }
        o = o / lsum;
        const int g = wave, nb = t >> 7, tp = t & 127, ns = tp < 64 ? 64 : 128;
        float mixd = 0.f;
        for (int s = 0; s < ns; ++s) {
            const int srow = b * SEQ + nb * 128 + s;
            const f32x4* pv = (const f32x4*)(vgss + (size_t)srow * 8); const f32x4 p0 = pv[0], p1 = pv[1];
            const float rs = __builtin_amdgcn_rsqf((((p0[0] + p0[1]) + (p0[2] + p0[3])) + ((p1[0] + p1[1]) + (p1[2] + p1[3]))) * (1.0f / 512.0f) + pg8::RMS_EPS);
            mixd += bf2f(wsp[(g * 128 + tp) * 128 + s]) * (bf2f(P[(size_t)srow * NIN + 2048 + g * 64 + lane]) * rs * sgu_g[g * 64 + lane]);
        }
        const float gv = bf2f(P[(size_t)tok * NIN + 1536 + g * 64 + lane]) * (mixd + bsp[g * 128 + tp]);
        const float so = wave_sum(o * o), sg = wave_sum(gv * gv);
        __syncthreads();
        if (lane == 0) { red[wave] = so; red[8 + wave] = sg; }
        __syncthreads();
        float ta = 0.f, tg = 0.f;
#pragma unroll
        for (int w = 0; w < 8; ++w) { ta += red[w]; tg += red[8 + w]; }
        const float ra = __builtin_amdgcn_rsqf(ta * (1.0f / 512.0f) + pg8::RMS_EPS), rg = __builtin_amdgcn_rsqf(tg * (1.0f / 512.0f) + pg8::RMS_EPS);
        MIX[(size_t)tok * DM + h * 64 + lane] = (bf16)f2bf(o * ra * ag[h * 64 + lane]);
        MIX[(size_t)tok * DM + 512 + g * 64 + lane] = (bf16)f2bf(gv * rg * gg[g * 64 + lane]);
    }
    __syncthreads();
}

#ifndef FAST_MIXER
#define FAST_MIXER 1
#endif
#ifndef PHM
#define PHM 31
#endif
#ifndef REPM
#define REPM 0
#endif
#define REPEAT(bit) for (int rep_ = 0; rep_ < (((REPM) >> (bit)) & 1) + 1; ++rep_)
namespace mx {
typedef float f32x16 __attribute__((ext_vector_type(16)));
typedef short bf16x8 __attribute__((ext_vector_type(8)));
typedef short s16x4 __attribute__((ext_vector_type(4)));
typedef unsigned u32x2 __attribute__((ext_vector_type(2)));
constexpr int TBL_OFF = 131072;
constexpr int TBL_LD = 320;
constexpr int RS_OFF = TBL_OFF + 8 * TBL_LD * 4 + 4096;
constexpr int RED_OFF = TBL_OFF + 8 * TBL_LD * 4;
__device__ __forceinline__ int crow(int r, int hi) { return (r & 3) + 8 * (r >> 2) + 4 * hi; }
__device__ __forceinline__ int vimg(int row, int chunk) { return row * 128 + ((chunk * 16) ^ (((row >> 1) & 1) << 6)); }
__device__ __forceinline__ s16x4 tr64(LAS unsigned char* p) { return __builtin_bit_cast(s16x4, __builtin_amdgcn_ds_read_tr16_b64_v4i16((LAS s16x4*)p)); }
__device__ __forceinline__ bf16x8 cat8(s16x4 a, s16x4 b) { return (bf16x8){a[0], a[1], a[2], a[3], b[0], b[1], b[2], b[3]}; }
__device__ __forceinline__ unsigned cvtpk(float lo, float hi) { unsigned r; asm("v_cvt_pk_bf16_f32 %0, %1, %2" : "=v"(r) : "v"(lo), "v"(hi)); return r; }
#ifndef ATTREP
#define ATTREP 1
#endif
#ifndef DMAREP
#define DMAREP 1
#endif
#if DMAREP == 1
#define MX_VM8 "s_waitcnt vmcnt(8)"
#else
#define MX_VM8 "s_waitcnt vmcnt(16)"
#endif
#define MX_FENCE() asm volatile("" ::: "memory")
__device__ __forceinline__ float max3f(float a, float b, float c) { float r; asm("v_max3_f32 %0, %1, %2, %3" : "=v"(r) : "v"(a), "v"(b), "v"(c)); return r; }

__device__ __forceinline__ void attn_task(const bf16* P, int b, int c, int h, LAS unsigned char* wl, const LAS float* tbl, int lane, f32x16 (&o)[2][2]) {
    const int r32 = lane & 31, hi = lane >> 5;
    const size_t tok0 = (size_t)b * SEQ + c * 64;
    bf16x8 qf[2][4];
#pragma unroll
    for (int qt = 0; qt < 2; ++qt)
#pragma unroll
        for (int d0 = 0; d0 < 4; ++d0) qf[qt][d0] = *(const bf16x8*)(P + (tok0 + 32 * qt + r32) * NIN + h * 64 + d0 * 16 + hi * 8);
#pragma unroll
    for (int r = 0; r < 16; ++r) { o[0][0][r] = 0.f; o[0][1][r] = 0.f; o[1][0][r] = 0.f; o[1][1][r] = 0.f; }
    float m[2] = {-INFINITY, -INFINITY}, l[2] = {0.f, 0.f};
    const int kc0 = c >= 8 ? c - 8 : 0;
    const int dhalf = (lane >> 4) & 1, qq = (lane & 15) >> 2, p4 = lane & 3;
    int vb[2];
#pragma unroll
    for (int dt = 0; dt < 2; ++dt) vb[dt] = 8192 + (4 * hi + qq) * 128 + ((64 * dt + 32 * dhalf + 8 * p4) ^ ((qq >> 1) << 6));
    const int prow = lane >> 3, pch = lane & 7;
    const unsigned voff = (unsigned)(prow * NIN + (pch ^ (((lane >> 4) & 1) << 2)) * 8) * 2u;
    const unsigned koff0 = (unsigned)(prow * NIN + (pch ^ (lane >> 4)) * 8) * 2u, koff1 = (unsigned)(prow * NIN + (pch ^ (lane >> 4) ^ 4) * 8) * 2u;
    const int swz = (r32 >> 1) & 7;
    int ka[4];
#pragma unroll
    for (int d0 = 0; d0 < 4; ++d0) ka[d0] = r32 * 128 + (((2 * d0 + hi) ^ swz) * 16);
#define MX_DMAK(kc) do { const char* kp_ = (const char*)(P + ((size_t)b * SEQ + (kc) * 64) * NIN + 512 + h * 64); \
        _Pragma("unroll") for (int i = 0; i < 8 * DMAREP; ++i) __builtin_amdgcn_global_load_lds((const unsigned*)(kp_ + (size_t)((i & 7) * 8 * NIN) * 2 + ((i & 1) ? koff1 : koff0)), (LAS unsigned*)(wl + (i & 7) * 1024), 16, 0, 0); } while (0)
#define MX_DMAV(kc) do { const char* vp_ = (const char*)(P + ((size_t)b * SEQ + (kc) * 64) * NIN + 1024 + h * 64); \
        _Pragma("unroll") for (int i = 0; i < 8 * DMAREP; ++i) __builtin_amdgcn_global_load_lds((const unsigned*)(vp_ + (size_t)((i & 7) * 8 * NIN) * 2 + voff), (LAS unsigned*)(wl + 8192 + (i & 7) * 1024), 16, 0, 0); } while (0)
    MX_DMAK(kc0);
    const int nk = c - kc0 + 1, total = nk * ATTREP; (void)total;
#if ATTREP == 1
    for (int kc = kc0; kc <= c; ++kc) {
        const int kcn = kc + 1; const bool more = kc < c;
#else
    for (int it = 0; it < total; ++it) {
        const int kc = kc0 + it % nk, kcn = kc0 + (it + 1) % nk; const bool more = it + 1 < total;
#endif
        const int j = kc - c + 8;
        MX_DMAV(kc);
        asm volatile(MX_VM8 ::: "memory");
        bf16x8 kf[2][4];
#pragma unroll
        for (int kt = 0; kt < 2; ++kt)
#pragma unroll
            for (int d0 = 0; d0 < 4; ++d0) kf[kt][d0] = *(const LAS bf16x8*)(wl + kt * 4096 + ka[d0]);
        asm volatile("s_waitcnt lgkmcnt(0)" ::: "memory");
        if (more) MX_DMAK(kcn);
#pragma unroll
        for (int qt = 0; qt < 2; ++qt) {
            f32x16 st[2];
            float badd = 0.f;
            if (j <= 5) { badd = tbl[256];
#pragma unroll
                for (int r = 0; r < 16; ++r) { st[0][r] = 0.f; st[1][r] = 0.f; } }
            else { const LAS float* tb = tbl + (64 * (8 - j) + 32 * qt + r32 - 4 * hi + 128 - 63);
#pragma unroll
                for (int kt = 0; kt < 2; ++kt)
#pragma unroll
                    for (int r = 0; r < 16; ++r) st[kt][r] = tb[63 - (32 * kt + (r & 3) + 8 * (r >> 2))]; }
#pragma unroll
            for (int kt = 0; kt < 2; ++kt)
#pragma unroll
                for (int d0 = 0; d0 < 4; ++d0) st[kt] = __builtin_amdgcn_mfma_f32_32x32x16_bf16(kf[kt][d0], qf[qt][d0], st[kt], 0, 0, 0);
            asm volatile("s_nop 15\n\ts_nop 7" : "+v"(st[0]), "+v"(st[1]));
            float mxa = max3f(st[0][0], st[0][1], st[0][2]), mxb = max3f(st[1][0], st[1][1], st[1][2]);
#pragma unroll
            for (int r = 3; r < 15; r += 2) { mxa = max3f(mxa, st[0][r], st[0][r + 1]); mxb = max3f(mxb, st[1][r], st[1][r + 1]); }
            float mxv = max3f(mxa, mxb, st[0][15]); mxv = max3f(mxv, st[1][15], mxv);
            mxv = max3f(mxv, __shfl_xor(mxv, 32), mxv) + badd;
            const bool need = mxv > m[qt] + 8.0f;
            if (__builtin_amdgcn_ballot_w64(need) != 0ull) {
                const float mn = need ? mxv : m[qt], al = __builtin_amdgcn_exp2f(m[qt] - mn); m[qt] = mn; l[qt] *= al;
#pragma unroll
                for (int r = 0; r < 16; ++r) { o[qt][0][r] *= al; o[qt][1][r] *= al; }
            }
            const float sub = m[qt] - badd;
            float rs = 0.f;
#pragma unroll
            for (int kt = 0; kt < 2; ++kt)
#pragma unroll
                for (int r = 0; r < 16; ++r) { const float p = __builtin_amdgcn_exp2f(st[kt][r] - sub); st[kt][r] = p; rs += p; }
            l[qt] += rs;
            bf16x8 pf[4];
#pragma unroll
            for (int s = 0; s < 4; ++s) { v4u w; const int kt = s >> 1, r0 = 8 * (s & 1);
                w.x = cvtpk(st[kt][r0 + 0], st[kt][r0 + 1]); w.y = cvtpk(st[kt][r0 + 2], st[kt][r0 + 3]); w.z = cvtpk(st[kt][r0 + 4], st[kt][r0 + 5]); w.w = cvtpk(st[kt][r0 + 6], st[kt][r0 + 7]);
                pf[s] = __builtin_bit_cast(bf16x8, w); }
            if (qt == 0) { if (more) asm volatile(MX_VM8 ::: "memory"); else asm volatile("s_waitcnt vmcnt(0)" ::: "memory"); }
#pragma unroll
            for (int dt = 0; dt < 2; ++dt) { s16x4 va[4], vc[4]; const unsigned vaddr = (unsigned)(uintptr_t)(wl + vb[dt]);
#pragma unroll
                for (int s = 0; s < 4; ++s) { asm volatile("ds_read_b64_tr_b16 %0, %1 offset:%c2" : "=&v"(va[s]) : "v"(vaddr), "i"(16 * s * 128) : "memory");
                                              asm volatile("ds_read_b64_tr_b16 %0, %1 offset:%c2" : "=&v"(vc[s]) : "v"(vaddr), "i"((16 * s + 8) * 128) : "memory"); }
                asm volatile("s_waitcnt lgkmcnt(0)" : "+v"(va[0]), "+v"(va[1]), "+v"(va[2]), "+v"(va[3]), "+v"(vc[0]), "+v"(vc[1]), "+v"(vc[2]), "+v"(vc[3]) :: "memory");
#pragma unroll
                for (int s = 0; s < 4; ++s) o[qt][dt] = __builtin_amdgcn_mfma_f32_32x32x16_bf16(cat8(va[s], vc[s]), pf[s], o[qt][dt], 0, 0, 0); }
        }
        MX_FENCE();
    }
#undef MX_DMAK
#undef MX_DMAV
#pragma unroll
    for (int qt = 0; qt < 2; ++qt) { float lt = l[qt]; lt += __shfl_xor(lt, 32); const float inv = 1.0f / lt;
#pragma unroll
        for (int r = 0; r < 16; ++r) { o[qt][0][r] *= inv; o[qt][1][r] *= inv; } }
}

__device__ __forceinline__ void sgu_task(const bf16* P, const LAS float* rstab, const bf16* wsp_l, const float* sgu_g, const float* bsp_l, int b, int c, int g, LAS unsigned char* wl, int lane_in, f32x16 (&o)[2][2]) {
    int lane = lane_in; asm volatile("" : "+v"(lane));
    const int r32 = lane & 31, hi = lane >> 5;
    const int nb = c >> 1, cb = c & 1, ns = cb ? 128 : 64;
    const size_t srow0 = (size_t)b * SEQ + nb * 128, tok0 = (size_t)b * SEQ + c * 64;
    const int prow = lane >> 3, pch = lane & 7;
    const f32x4 g0 = *(const f32x4*)(sgu_g + g * 64 + pch * 8), g1 = *(const f32x4*)(sgu_g + g * 64 + pch * 8 + 4);
    v4u ureg[8];
#pragma unroll
    for (int i = 0; i < 8; ++i) ureg[i] = *(const v4u*)(P + (tok0 + prow + 8 * i) * NIN + 1536 + g * 64 + pch * 8);
    const bf16* wrow = wsp_l + ((size_t)g * 128 + cb * 64 + r32) * 128 + hi * 8;
    bf16x8 wfa[8], wfb[8];
#pragma unroll
    for (int step = 0; step < 8; ++step) if (step * 16 < ns) { wfa[step] = *(const bf16x8*)(wrow + 16 * step); wfb[step] = *(const bf16x8*)(wrow + 32 * 128 + 16 * step); }
    MX_FENCE();
#pragma unroll
    for (int hb = 0; hb < 2; ++hb) {
        if (hb * 64 < ns) {
            v4u raw[8];
#pragma unroll
            for (int i = 0; i < 8; ++i) raw[i] = *(const v4u*)(P + (srow0 + hb * 64 + prow + 8 * i) * NIN + 2048 + g * 64 + pch * 8);
#pragma unroll
            for (int i = 0; i < 8; ++i) { const int row = hb * 64 + prow + 8 * i; const f32x4 q0 = *(const LAS f32x4*)(rstab + row * 8), q1 = *(const LAS f32x4*)(rstab + row * 8 + 4);
                const float rs = __builtin_amdgcn_rsqf((((q0[0] + q0[1]) + (q0[2] + q0[3])) + ((q1[0] + q1[1]) + (q1[2] + q1[3]))) * (1.0f / 512.0f) + pg8::RMS_EPS);
                v4u w;
                w.x = cvtpk(__builtin_bit_cast(float, raw[i].x << 16) * rs * g0[0], __builtin_bit_cast(float, raw[i].x & 0xffff0000u) * rs * g0[1]);
                w.y = cvtpk(__builtin_bit_cast(float, raw[i].y << 16) * rs * g0[2], __builtin_bit_cast(float, raw[i].y & 0xffff0000u) * rs * g0[3]);
                w.z = cvtpk(__builtin_bit_cast(float, raw[i].z << 16) * rs * g1[0], __builtin_bit_cast(float, raw[i].z & 0xffff0000u) * rs * g1[1]);
                w.w = cvtpk(__builtin_bit_cast(float, raw[i].w << 16) * rs * g1[2], __builtin_bit_cast(float, raw[i].w & 0xffff0000u) * rs * g1[3]);
                *(LAS v4u*)(wl + vimg(row, pch)) = w; }
        }
    }
    MX_FENCE();
#pragma unroll
    for (int r = 0; r < 16; ++r) { o[0][0][r] = 0.f; o[0][1][r] = 0.f; o[1][0][r] = 0.f; o[1][1][r] = 0.f; }
    const int dhalf = (lane >> 4) & 1, qq = (lane & 15) >> 2, p4 = lane & 3;
    int vbs[2];
#pragma unroll
    for (int ct = 0; ct < 2; ++ct) vbs[ct] = (8 * hi + qq) * 128 + ((64 * ct + 32 * dhalf + 8 * p4) ^ ((qq >> 1) << 6));
#pragma unroll
    for (int step = 0; step < 8; ++step) { if (step * 16 < ns) {
        const bf16x8 wf0 = wfa[step], wf1 = wfb[step];
#pragma unroll
        for (int ct = 0; ct < 2; ++ct) { const s16x4 a0 = tr64(wl + vbs[ct] + (16 * step) * 128), a1 = tr64(wl + vbs[ct] + (16 * step + 4) * 128);
            const bf16x8 af = cat8(a0, a1);
            o[0][ct] = __builtin_amdgcn_mfma_f32_32x32x16_bf16(af, wf0, o[0][ct], 0, 0, 0);
            o[1][ct] = __builtin_amdgcn_mfma_f32_32x32x16_bf16(af, wf1, o[1][ct], 0, 0, 0); }
    } }
    MX_FENCE();
#pragma unroll
    for (int i = 0; i < 8; ++i) { const int row = 8 * i + prow; *(LAS v4u*)(wl + row * 128 + ((pch ^ (row & 7)) * 16)) = ureg[i]; }
    MX_FENCE();
#pragma unroll
    for (int tt = 0; tt < 2; ++tt) {
        const int tok = 32 * tt + r32;
        const float bt = bsp_l[g * 128 + cb * 64 + tok];
#pragma unroll
        for (int ct = 0; ct < 2; ++ct)
#pragma unroll
            for (int rg = 0; rg < 4; ++rg) { const u32x2 uu = *(const LAS u32x2*)(wl + tok * 128 + (((4 * ct + rg) ^ (tok & 7)) * 16) + hi * 8);
                o[tt][ct][4 * rg + 0] = __builtin_bit_cast(float, uu.x << 16) * (o[tt][ct][4 * rg + 0] + bt); o[tt][ct][4 * rg + 1] = __builtin_bit_cast(float, uu.x & 0xffff0000u) * (o[tt][ct][4 * rg + 1] + bt);
                o[tt][ct][4 * rg + 2] = __builtin_bit_cast(float, uu.y << 16) * (o[tt][ct][4 * rg + 2] + bt); o[tt][ct][4 * rg + 3] = __builtin_bit_cast(float, uu.y & 0xffff0000u) * (o[tt][ct][4 * rg + 3] + bt); }
    }
    MX_FENCE();
}

__device__ __forceinline__ void norm_store(const f32x16 (&o)[2][2], LAS float* red, LAS unsigned char* wl, int wave, int lane_in, const float* gain, bf16* dst) {
    int lane = lane_in; asm volatile("" : "+v"(lane));
    const int r32 = lane & 31, hi = lane >> 5;
    f32x4 gvv[2][4];
#pragma unroll
    for (int ct = 0; ct < 2; ++ct)
#pragma unroll
        for (int rg = 0; rg < 4; ++rg) gvv[ct][rg] = *(const f32x4*)(gain + 32 * ct + 8 * rg + 4 * hi);
#pragma unroll
    for (int tt = 0; tt < 2; ++tt) { float ss = 0.f;
#pragma unroll
        for (int r = 0; r < 16; ++r) ss += o[tt][0][r] * o[tt][0][r] + o[tt][1][r] * o[tt][1][r];
        ss += __shfl_xor(ss, 32);
        if (hi == 0) red[wave * 64 + tt * 32 + r32] = ss; }
    __syncthreads();
#pragma unroll
    for (int tt = 0; tt < 2; ++tt) { float tot = 0.f; const int tok = 32 * tt + r32;
#pragma unroll
        for (int w = 0; w < 8; ++w) tot += red[w * 64 + tok];
        const float rn = __builtin_amdgcn_rsqf(tot * (1.0f / 512.0f) + pg8::RMS_EPS);
#pragma unroll
        for (int ct = 0; ct < 2; ++ct)
#pragma unroll
            for (int rg = 0; rg < 4; ++rg) { const f32x4 gv = gvv[ct][rg];
                u32x2 w; w.x = cvtpk(o[tt][ct][4 * rg + 0] * rn * gv[0], o[tt][ct][4 * rg + 1] * rn * gv[1]); w.y = cvtpk(o[tt][ct][4 * rg + 2] * rn * gv[2], o[tt][ct][4 * rg + 3] * rn * gv[3]);
                *(LAS u32x2*)(wl + tok * 128 + (((4 * ct + rg) ^ (tok & 7)) * 16) + hi * 8) = w; } }
    MX_FENCE();
    const int prow = lane >> 3, pch = lane & 7;
#pragma unroll
    for (int i = 0; i < 8; ++i) { const int row = 8 * i + prow; const v4u v = *(const LAS v4u*)(wl + row * 128 + ((pch ^ (row & 7)) * 16));
        *(v4u*)(dst + (size_t)row * DM + pch * 8) = v; }
    MX_FENCE();
}

__device__ __forceinline__ void fill_bias_table(CArgs* a, int l, LAS unsigned char* lds) {
    const float* rel = a->in[5] + (size_t)l * 8 * 257; LAS float* tbl = (LAS float*)(lds + TBL_OFF);
    for (int i = threadIdx.x; i < 8 * TBL_LD; i += NWAVES * 64) { const int h = i / TBL_LD, k = i % TBL_LD; tbl[i] = rel[h * 257 + (k < 256 ? k : 256)] * pg8::LOG2E; }
}
__device__ __forceinline__ void mixer_fast(CArgs* a, int l, LAS unsigned char* lds, int wave, int lane, int vb) {
    const bf16* P = (const bf16*)(a->ws + WS_PROJ); bf16* MIX = (bf16*)(a->ws + WS_MIX);
    const float* vgss = (const float*)(a->ws + WS_VGSS); const bf16* wsp_l = (const bf16*)(a->ws + WS_WSP) + (size_t)l * 8 * 128 * 128;
    const float* rel = a->in[5] + (size_t)l * 8 * 257; const float* sgu_g = a->in[6] + l * 512; const float* bsp_l = a->in[8] + l * 8 * 128;
    const float* ag = a->in[9] + l * 512; const float* gg = a->in[10] + l * 512;
    LAS float* tbl = (LAS float*)(lds + TBL_OFF); LAS float* red = (LAS float*)(lds + RED_OFF); LAS float* rstab = (LAS float*)(lds + RS_OFF);
    LAS unsigned char* wl = lds + wave * 16384;
    for (int u = vb; u < NB * (SEQ / 64); u += gridDim.x) {
        const int b = u & 7, c = u >> 3;
        const size_t tok0 = (size_t)b * SEQ + c * 64;
        if (wave == 0) {
            const char* src = (const char*)(vgss + ((size_t)b * SEQ + (c >> 1) * 128) * 8) + lane * 16;
#pragma unroll
            for (int i = 0; i < 4; ++i) __builtin_amdgcn_global_load_lds((const unsigned*)(src + i * 1024), (LAS unsigned*)(lds + RS_OFF + i * 1024), 16, 0, 0);
        }
        f32x16 o[2][2];
        REPEAT(7) attn_task(P, b, c, wave, wl, tbl + wave * TBL_LD, lane, o);
        norm_store(o, red, wl, wave, lane, ag + wave * 64, MIX + tok0 * DM + wave * 64);
        REPEAT(8) sgu_task(P, rstab, wsp_l, sgu_g, bsp_l, b, c, wave, wl, lane, o);
        norm_store(o, red + 512, wl, wave, lane, gg + wave * 64, MIX + tok0 * DM + 512 + wave * 64);
    }
    __syncthreads();
}
}

__global__ void __launch_bounds__(NWAVES * 64, 2) fwd_megakernel(Args a_unused) {
    extern __shared__ __attribute__((aligned(16))) unsigned char lds_raw[];
    LAS unsigned char* lds = (LAS unsigned char*)lds_raw;
    if (threadIdx.x < 16) ((LAS unsigned*)(lds + MISC_OFF))[threadIdx.x] = 0u;
    __syncthreads();
    (void)xcd_barrier_post((unsigned*)(kargs_ws() + WS_BAR), (volatile LAS unsigned*)(lds + MISC_OFF));
    if (threadIdx.x == 64) { const unsigned x_ = xb_xcc_id(); ((volatile LAS unsigned*)(lds + MISC_OFF))[7] = xb_add((unsigned*)(kargs_ws() + WS_XIDX) + 64 * x_, 1u); }
    { const int tid = threadIdx.x, lane = tid & 63, wave = __builtin_amdgcn_readfirstlane(tid >> 6);
      REPEAT(0) prologue(kargs(), lds, wave, lane); }
    GRID_BAR();
    if (threadIdx.x == 64) { volatile LAS unsigned* mi = (volatile LAS unsigned*)(lds + MISC_OFF); unsigned* xi = (unsigned*)(kargs_ws() + WS_XIDX); bool ok = (gridDim.x & 7u) == 0u;
        for (int j = 0; j < 16; ++j) { const unsigned cj = xb_ld(xi + 64 * j); ok = ok && (j < 8 ? cj == (gridDim.x >> 3) : cj == 0u); }
        mi[6] = ok ? mi[7] * 8u + xb_xcc_id() : blockIdx.x; mi[4] = ok ? 1u : 0u; }
    __syncthreads();
#if (REPM >> 6) & 1
    for (int i_ = 0; i_ < 10; ++i_) GRID_BAR();
#endif
#pragma nounroll
    for (int l = 0; l < DEPTH; ++l) {
#if PHM & 1
        REPEAT(1) {
            CArgs* a = kargs(); unsigned char* ws = a->ws; unsigned char* wb = ws + WS_W0 + (size_t)l * WS_WSTRIDE;
            pg8::Gemm g{(const bf16*)(ws + WS_XB), (const bf16*)(wb + WOFF_IN), M, NIN, DM}; pg8::StaticOrder S; S.init(M, NIN, (int)gridDim.x, VBID());
            pg8::Unit u0; u0.pm = -1; u0.pn = 0; (void)S.next(0, u0);
            { LAS float* rsl = (LAS float*)(lds + 131072); const int t_ = threadIdx.x;
              if (u0.pm >= 0 && t_ < 256) rsl[t_] = pg8::row_rs((const float*)(ws + WS_ROWSS), u0.pm * 256 + t_);
              else if (t_ >= 256 && t_ < 384) rsl[t_] = t_ < 320 ? a->in[3][l * 64 + t_ - 256] * pg8::QSCALE : a->in[4][l * 64 + t_ - 320];
              __syncthreads(); }
            pg8::EpiInProj E{(bf16*)(ws + WS_PROJ), (const float*)(ws + WS_ROWSS), (float*)(ws + WS_VGSS), a->in[3] + l * 64, a->in[4] + l * 64, (const LAS float*)(lds + 131072), u0.pm};
            pg8::gemm_phase<pg8::EpiInProj, pg8::StaticOrder, true, true>(lds, g, S, E);
        }
#endif
        if (l == 0 && 2 * VBID() >= (int)gridDim.x) {
            int tid = threadIdx.x; asm volatile("" : "+v"(tid)); const int lane = tid & 63, wave = __builtin_amdgcn_readfirstlane(tid >> 6);
            const int half = gridDim.x - gridDim.x / 2;
            convert_weights(kargs(), lds, wave, lane, CW_I_IN, CW_I_LAYER, (VBID() - (int)gridDim.x / 2) * NWAVES + wave, half * NWAVES);
        }
#if FAST_MIXER
        mx::fill_bias_table(kargs(), l, lds);
#endif
        if (l == 0) GRID_BAR(); else GROUP_BAR();
#if PHM & 2
        REPEAT(2) { int tid = threadIdx.x; asm volatile("" : "+v"(tid)); const int lane = tid & 63, wave = __builtin_amdgcn_readfirstlane(tid >> 6);
#if FAST_MIXER
          mx::mixer_fast(kargs(), l, lds, wave, lane, VBID());
#else
          mixer_naive(kargs(), l, lds, wave, lane);
#endif
        }
#endif
#if PHM & 4
        REPEAT(3) {
            CArgs* a = kargs(); unsigned char* ws = a->ws; unsigned char* wb = ws + WS_W0 + (size_t)l * WS_WSTRIDE; float* xo = a->out;
            pg8::Gemm g{(const bf16*)(ws + WS_MIX), (const bf16*)(wb + WOFF_OUT), M, DM, DM}; pg8::StaticOrder S; S.init(M, DM, (int)gridDim.x, VBID());
            pg8::EpiResid E{l == 0 ? a->in[0] : (const float*)nullptr, (float*)nullptr, (bf16*)(ws + WS_XB), (float*)(ws + WS_ROWSS)};
            PreGroupBar pre{ws, (volatile LAS unsigned*)(lds + MISC_OFF)};
            pg8::gemm_phase<pg8::EpiResid, pg8::StaticOrder, false, true, false, PreGroupBar>(lds, g, S, E, pre);
        }
#endif
        GROUP_BAR();
#if PHM & 8
        REPEAT(4) {
            CArgs* a = kargs(); unsigned char* ws = a->ws; unsigned char* wb = ws + WS_W0 + (size_t)l * WS_WSTRIDE;
            pg8::Gemm g{(const bf16*)(ws + WS_XB), (const bf16*)(wb + WOFF_FIN), M, NFF2, DM}; pg8::StaticOrder S; S.init(M, NFF2, (int)gridDim.x, VBID());
            pg8::Unit u0; u0.pm = -1; u0.pn = 0; (void)S.next(0, u0);
            { LAS float* rsl = (LAS float*)(lds + 131072); if (u0.pm >= 0 && threadIdx.x < 256) rsl[threadIdx.x] = pg8::row_rs((const float*)(ws + WS_ROWSS), u0.pm * 256 + (int)threadIdx.x); __syncthreads(); }
            pg8::EpiSwiGLU E{(bf16*)(ws + WS_HID), (const float*)(ws + WS_ROWSS), (const LAS float*)(lds + 131072), u0.pm};
            pg8::gemm_phase<pg8::EpiSwiGLU, pg8::StaticOrder, true, true>(lds, g, S, E);
        }
#endif
        if (l == 0 && 2 * VBID() >= (int)gridDim.x) {
            int tid = threadIdx.x; asm volatile("" : "+v"(tid)); const int lane = tid & 63, wave = __builtin_amdgcn_readfirstlane(tid >> 6);
            const int half = gridDim.x - gridDim.x / 2;
            convert_weights(kargs(), lds, wave, lane, CW_I_LAYER, 2 * CW_I_LAYER, (VBID() - (int)gridDim.x / 2) * NWAVES + wave, half * NWAVES);
        }
#if PHM & 16
        REPEAT(5) {
            CArgs* a = kargs(); unsigned char* ws = a->ws; unsigned char* wb = ws + WS_W0 + (size_t)l * WS_WSTRIDE; float* xo = a->out;
            pg8::Gemm g{(const bf16*)(ws + WS_HID), (const bf16*)(wb + WOFF_FOUT), M, DM, DFF}; pg8::StaticOrder S; S.init(M, DM, (int)gridDim.x, VBID());
            pg8::EpiResid E{(const float*)nullptr, l + 1 < DEPTH ? (float*)nullptr : xo, (bf16*)(ws + WS_XB), (float*)(ws + WS_ROWSS)};
            PreGroupBar pre{ws, (volatile LAS unsigned*)(lds + MISC_OFF)};
            pg8::gemm_phase<pg8::EpiResid, pg8::StaticOrder, false, true, true, PreGroupBar>(lds, g, S, E, pre);
        }
#endif
        if (l + 1 < DEPTH) GRID_BAR();
    }
}

extern "C" void kernel_launch(void* const* d_in, const int* in_sizes, int n_in, void* d_out, int out_size, void* d_ws, size_t ws_size, hipStream_t stream) {
    static int grid = 0;
    if (grid == 0) {
        if (n_in != 15 || in_sizes[0] != M * DM || out_size != M * DM || ws_size < WS_END) { fprintf(stderr, "kernel_launch: unexpected shapes (n_in %d, ws %zu)\n", n_in, ws_size); grid = -1; return; }
        int dev = 0, cus = 0, per_cu = 0;
        hipGetDevice(&dev); hipDeviceGetAttribute(&cus, hipDeviceAttributeMultiprocessorCount, dev);
        if (hipFuncSetAttribute((const void*)fwd_megakernel, hipFuncAttributeMaxDynamicSharedMemorySize, LDS_BYTES) != hipSuccess) { fprintf(stderr, "kernel_launch: hipFuncSetAttribute failed\n"); grid = -1; return; }
        if (hipOccupancyMaxActiveBlocksPerMultiprocessor(&per_cu, (const void*)fwd_megakernel, NWAVES * 64, LDS_BYTES) != hipSuccess || per_cu < 1) { fprintf(stderr, "kernel_launch: occupancy query failed (%d)\n", per_cu); (void)hipGetLastError(); per_cu = 1; }
        grid = cus * (per_cu > 1 ? 1 : per_cu);
        if (grid != 256) { fprintf(stderr, "kernel_launch: built for a 256-CU device (one 256x256 unit per workgroup in the N = 1024 phases); got %d\n", grid); grid = -1; return; }
    }
    if (grid < 0) return;
    if (hipMemsetAsync((char*)d_ws + WS_BAR, 0, BAR_ZERO_BYTES, stream) != hipSuccess) { fprintf(stderr, "kernel_launch: hipMemsetAsync failed\n"); return; }
    Args a{};
    for (int i = 0; i < 15; ++i) a.in[i] = (const float*)d_in[i];
    a.out = (float*)d_out; a.ws = (unsigned char*)d_ws;
    void* args[] = {&a};
    hipError_t e = hipLaunchCooperativeKernel((const void*)fwd_megakernel, dim3(grid), dim3(NWAVES * 64), args, LDS_BYTES, stream);
    if (e != hipSuccess) fprintf(stderr, "cooperative launch failed: %s (grid %d)\n", hipGetErrorString(e), grid);
}
```

```cpp
#include <hip/hip_runtime.h>
#include <hip/hip_cooperative_groups.h>
#include <cstdio>
#include <cstdint>
namespace cg = cooperative_groups;
namespace pg8 {
#define PG8_LAS __attribute__((address_space(3)))
typedef unsigned short bf16_t;
typedef short bf16x8 __attribute__((ext_vector_type(8)));
typedef float f32x4 __attribute__((ext_vector_type(4)));
typedef unsigned u32x4 __attribute__((ext_vector_type(4)));
constexpr int BM = 256, BK = 64, HALF = 128, HTB = HALF * BK * 2  , STAGE_BYTES = 8 * HTB, NXCD = 8, WGM = 8;

__host__ __device__ __forceinline__ int lds_byte(int r, int c) { const int st = (r >> 4) * 2 + (c >> 5), rr = r & 15, cc = c & 31, ob = rr * 64 + cc * 2; return st * 1024 + (ob ^ (((ob >> 9) & 1) << 5)); }
__host__ __device__ __forceinline__ void stage_rc(int b, int& R, int& C) { const int st = b / 1024, sb = b % 1024, swz = sb ^ (((sb >> 9) & 1) << 5); R = (st >> 1) * 16 + swz / 64; C = (st & 1) * 32 + (swz % 64) / 2; }
__host__ __device__ __forceinline__ int perm32(int rho) { const int n = rho >> 4, i = rho & 15; return 8 * (i >> 2) + 4 * n + (i & 3); }

struct Unit { int pm, pn; };
struct Gemm { const bf16_t* A; const bf16_t* Bt; int M, N, K; };

struct StaticOrder {
    int nM, nN, nwg, G, c;
    __host__ __device__ void init(int M, int N, int G_, int c_) { nM = M / BM; nN = N / BM; nwg = nM * nN; G = G_; c = c_; }
    __host__ __device__ bool next(int i, Unit& u) const {
        const long L = (long)i * G + c; if (L >= nwg) return false;
        int wgid = (int)L; { const int q = nwg / NXCD, r = nwg % NXCD, xcd = wgid % NXCD, off = wgid / NXCD; wgid = (xcd < r ? xcd * (q + 1) : r * (q + 1) + (xcd - r) * q) + off; }
        const int nig = WGM * nN, gid = wgid / nig, fm = gid * WGM, gsz = (nM - fm) < WGM ? (nM - fm) : WGM;
        u.pm = fm + ((wgid % nig) % gsz); u.pn = (wgid % nig) / gsz; return true;
    }
    __device__ __forceinline__ void a_ready(const Unit&) const {}
    __device__ __forceinline__ void done(const Unit&) const {}
};

__device__ __forceinline__ unsigned cvt_pk_bf16(float lo, float hi) { unsigned r; asm volatile("v_cvt_pk_bf16_f32 %0, %1, %2" : "=v"(r) : "v"(lo), "v"(hi)); return r; }
typedef float f32x2 __attribute__((ext_vector_type(2)));
constexpr float RMS_EPS = 1e-6f;
constexpr float LOG2E = 1.4426950408889634f;
constexpr float QSCALE = 0.125f * 1.4426950408889634f;
__device__ __forceinline__ float gelu_tanh(float x) {
    const float z2 = x * (1.5957691216057308f + 0.07135481627260025f * x * x);
    const float e = __builtin_amdgcn_exp2f(-LOG2E * z2);
    return x * __builtin_amdgcn_rcpf(1.0f + e);
}
__device__ __forceinline__ float row_rs(const float* rowss, int row) {
    const f32x4 a = *(const f32x4*)(rowss + (size_t)row * 4);
    return __builtin_amdgcn_rsqf(((a[0] + a[1]) + (a[2] + a[3])) * (1.0f / 1024.0f) + RMS_EPS);
}
struct EpiInProj {
    static constexpr bool PERM = true, AFTER_DRAIN = false, INIT = false;
    bf16_t* P; const float* rowss; float* vgss; const float* qg; const float* kg; const PG8_LAS float* rs_lds; int pm_cached;
    __device__ __forceinline__ void operator()(const f32x4 (&acc)[2][2][4][2], const Unit& u, int wr, int wc, int fr, int fq) const {
        const int region = u.pn >> 1, half = u.pn & 1;
        const int lcol = region * 512 + half * 256 + wc * 64 + fq * 8;
        float gq[2][8];
#pragma unroll
        for (int bj = 0; bj < 2; ++bj)
#pragma unroll
            for (int e = 0; e < 8; ++e) gq[bj][e] = 1.f;
        if (region < 2) { const PG8_LAS float* g = rs_lds + 256 + region * 64;
#pragma unroll
            for (int bj = 0; bj < 2; ++bj)
#pragma unroll
                for (int e = 0; e < 8; ++e) gq[bj][e] = g[bj * 32 + fq * 8 + e]; }
#pragma unroll
        for (int ai = 0; ai < 2; ++ai)
#pragma unroll
            for (int m = 0; m < 4; ++m) {
                const int row = u.pm * BM + ai * HALF + wr * 64 + m * 16 + fr;
                const float s = (u.pm == pm_cached) ? rs_lds[ai * HALF + wr * 64 + m * 16 + fr] : row_rs(rowss, row);
                float v[2][8];
#pragma unroll
                for (int bj = 0; bj < 2; ++bj)
#pragma unroll
                    for (int n = 0; n < 2; ++n)
#pragma unroll
                        for (int i = 0; i < 4; ++i) v[bj][4 * n + i] = acc[ai][bj][m][n][i] * s;
                if (region < 2) {
                    float q = 0.f;
#pragma unroll
                    for (int bj = 0; bj < 2; ++bj)
#pragma unroll
                        for (int e = 0; e < 8; ++e) q += v[bj][e] * v[bj][e];
                    q += __shfl_xor(q, 16); q += __shfl_xor(q, 32);
                    const float r = __builtin_amdgcn_rsqf(q * (1.0f / 64.0f) + RMS_EPS);
#pragma unroll
                    for (int bj = 0; bj < 2; ++bj)
#pragma unroll
                        for (int e = 0; e < 8; ++e) v[bj][e] = v[bj][e] * r * gq[bj][e];
                } else if (region >= 3) {
#pragma unroll
                    for (int bj = 0; bj < 2; ++bj)
#pragma unroll
                        for (int e = 0; e < 8; ++e) v[bj][e] = gelu_tanh(v[bj][e]);
                    if (region == 4) {
                        float q = 0.f;
#pragma unroll
                        for (int bj = 0; bj < 2; ++bj)
#pragma unroll
                            for (int e = 0; e < 8; ++e) q += v[bj][e] * v[bj][e];
                        q += __shfl_xor(q, 16); q += __shfl_xor(q, 32);
                        if (fq == 0) vgss[(size_t)row * 8 + half * 4 + wc] = q;
                    }
                }
                bf16_t* rowp = P + (size_t)row * 2560 + lcol;
#pragma unroll
                for (int bj = 0; bj < 2; ++bj) { u32x4 w; w.x = cvt_pk_bf16(v[bj][0], v[bj][1]); w.y = cvt_pk_bf16(v[bj][2], v[bj][3]); w.z = cvt_pk_bf16(v[bj][4], v[bj][5]); w.w = cvt_pk_bf16(v[bj][6], v[bj][7]);
                    *(u32x4*)(rowp + bj * 32) = w; }
            }
    }
};
struct EpiResid {
    static constexpr bool PERM = true, AFTER_DRAIN = true, INIT = true;
    const float* base32; float* out32; bf16_t* xb; float* rowss;
    __device__ __forceinline__ void init(f32x4 (&acc)[2][2][4][2], const Unit& u, int wr, int wc, int fr, int fq) const {
        const int col0 = u.pn * BM + wc * 32 + 8 * fq;
        if (base32) {
#pragma unroll
            for (int ai = 0; ai < 2; ++ai)
#pragma unroll
                for (int m = 0; m < 4; ++m) { const size_t off = (size_t)(u.pm * BM + ai * HALF + wr * 64 + m * 16 + fr) * 1024 + col0;
#pragma unroll
                    for (int bj = 0; bj < 2; ++bj) { acc[ai][bj][m][0] = __builtin_nontemporal_load((const f32x4*)(base32 + off + bj * HALF)); acc[ai][bj][m][1] = __builtin_nontemporal_load((const f32x4*)(base32 + off + bj * HALF + 4)); } }
        } else {
#pragma unroll
            for (int ai = 0; ai < 2; ++ai)
#pragma unroll
                for (int m = 0; m < 4; ++m) { const size_t off = (size_t)(u.pm * BM + ai * HALF + wr * 64 + m * 16 + fr) * 1024 + col0;
#pragma unroll
                    for (int bj = 0; bj < 2; ++bj) { const u32x4 w = *(const u32x4*)(xb + off + bj * HALF);
                        acc[ai][bj][m][0] = (f32x4){__builtin_bit_cast(float, w.x << 16), __builtin_bit_cast(float, w.x & 0xffff0000u), __builtin_bit_cast(float, w.y << 16), __builtin_bit_cast(float, w.y & 0xffff0000u)};
                        acc[ai][bj][m][1] = (f32x4){__builtin_bit_cast(float, w.z << 16), __builtin_bit_cast(float, w.z & 0xffff0000u), __builtin_bit_cast(float, w.w << 16), __builtin_bit_cast(float, w.w & 0xffff0000u)}; } }
        }
    }
    __device__ __forceinline__ void fused(f32x4 (&acc)[2][2][4][2], const Unit& u, int wr, int wc, int fr, int fq, PG8_LAS unsigned char* lds, int wid, int lane) const {
        PG8_LAS float* part = (PG8_LAS float*)lds;
        const int col0 = u.pn * BM + wc * 32 + 8 * fq;
#pragma unroll
        for (int ai = 0; ai < 2; ++ai)
#pragma unroll
            for (int m = 0; m < 4; ++m) {
                const int rl = ai * HALF + wr * 64 + m * 16 + fr;
                const size_t off = (size_t)(u.pm * BM + rl) * 1024 + col0;
                float q = 0.f;
#pragma unroll
                for (int bj = 0; bj < 2; ++bj) {
                    const f32x4 v0 = acc[ai][bj][m][0], v1 = acc[ai][bj][m][1];
                    if (out32) { *(f32x4*)(out32 + off + bj * HALF) = v0; *(f32x4*)(out32 + off + bj * HALF + 4) = v1; }
                    else { u32x4 w; w.x = cvt_pk_bf16(v0[0], v0[1]); w.y = cvt_pk_bf16(v0[2], v0[3]); w.z = cvt_pk_bf16(v1[0], v1[1]); w.w = cvt_pk_bf16(v1[2], v1[3]);
                        *(u32x4*)(xb + off + bj * HALF) = w; }
                    q += (v0[0] * v0[0] + v0[1] * v0[1]) + (v0[2] * v0[2] + v0[3] * v0[3]) + (v1[0] * v1[0] + v1[1] * v1[1]) + (v1[2] * v1[2] + v1[3] * v1[3]);
                }
                q += __shfl_xor(q, 16); q += __shfl_xor(q, 32);
                if (fq == 0) part[rl * 4 + wc] = q;
            }
        asm volatile("s_waitcnt lgkmcnt(0)" ::: "memory"); __builtin_amdgcn_s_barrier(); asm volatile("" ::: "memory");
        const int t = wid * 64 + lane;
        if (t < 256) { const f32x4 p = *(const PG8_LAS f32x4*)(part + t * 4); rowss[(size_t)(u.pm * BM + t) * 4 + u.pn] = (p[0] + p[1]) + (p[2] + p[3]); }
    }
};
struct EpiSwiGLU {
    static constexpr bool PERM = true, AFTER_DRAIN = false, INIT = false;
    bf16_t* H; const float* rowss; const PG8_LAS float* rs_lds; int pm_cached;
    __device__ __forceinline__ void operator()(const f32x4 (&acc)[2][2][4][2], const Unit& u, int wr, int wc, int fr, int fq) const {
        const int col0 = u.pn * 128 + wc * 32 + 8 * fq;
#pragma unroll
        for (int ai = 0; ai < 2; ++ai)
#pragma unroll
            for (int m = 0; m < 4; ++m) {
                const int row = u.pm * BM + ai * HALF + wr * 64 + m * 16 + fr;
                const float s = (u.pm == pm_cached) ? rs_lds[ai * HALF + wr * 64 + m * 16 + fr] : row_rs(rowss, row);
                float h[8];
#pragma unroll
                for (int n = 0; n < 2; ++n)
#pragma unroll
                    for (int i = 0; i < 4; ++i) { const float g = acc[ai][0][m][n][i] * s, up = acc[ai][1][m][n][i] * s;
                        h[4 * n + i] = g * __builtin_amdgcn_rcpf(1.0f + __builtin_amdgcn_exp2f(-LOG2E * g)) * up; }
                u32x4 w; w.x = cvt_pk_bf16(h[0], h[1]); w.y = cvt_pk_bf16(h[2], h[3]); w.z = cvt_pk_bf16(h[4], h[5]); w.w = cvt_pk_bf16(h[6], h[7]);
                *(u32x4*)(H + ((size_t)(col0 >> 6) * 16384 + row) * 64 + (col0 & 63)) = w;
            }
    }
};
struct NoPre { __device__ __forceinline__ void drain() const {} __device__ __forceinline__ void sync() const {} };
template <class Epi, class Sched, bool ALIGN_EPI = false, bool SP2 = false, bool TILED = false, class Pre = NoPre>
__device__ __forceinline__ void gemm_phase(PG8_LAS unsigned char* lds, const Gemm g, const Sched& S, const Epi& E, const Pre& pre = Pre()) {
    int tid_l = threadIdx.x; asm volatile("" : "+v"(tid_l));
    const int tid = tid_l, wid = __builtin_amdgcn_readfirstlane(tid >> 6), lane = tid & 63, wr = wid >> 2, wc = wid & 3, fr = lane & 15, fq = lane >> 4;
    const int K = g.K, nt = K / BK;
    unsigned voffA[2], voffB[2];
#pragma unroll
    for (int i = 0; i < 2; ++i) { int R, C; stage_rc(tid * 16 + i * 8192, R, C); const int Rb = Epi::PERM ? ((R & ~31) + perm32(R & 31)) : R;
        const int lda = TILED ? 64 : K; voffA[i] = (unsigned)(R * lda + C) * 2u; voffB[i] = (unsigned)(Rb * lda + C) * 2u; }
    const size_t kstepA = TILED ? (size_t)g.M * BK * 2 : (size_t)(BK * 2), kstepB = TILED ? (size_t)g.N * BK * 2 : (size_t)(BK * 2);
    const size_t hstep = (size_t)HALF * (TILED ? 64 : K) * 2;
    const size_t tstep = 2 * hstep;
    const unsigned ldsw = (unsigned)wid * 1024u;
    const int aoff = lds_byte(wr * 64 + fr, fq * 8), boff = lds_byte(wc * 32 + fr, fq * 8);
#define PG8_SA(b, h) (((b) * 2 + (h)) * HTB)
#define PG8_SB(b, h) ((4 + (b) * 2 + (h)) * HTB)
#define PG8_STAGE(bufoff, gbase, voff) do { _Pragma("unroll") for (int _i = 0; _i < 2; ++_i) \
        __builtin_amdgcn_global_load_lds((const unsigned*)((const char*)(gbase) + (voff)[_i]), (PG8_LAS unsigned*)(lds + (bufoff) + ldsw + _i * 8192), 16, 0, 0); } while (0)
#define PG8_LDA(dst, b, h) do { _Pragma("unroll") for (int m = 0; m < 4; ++m) _Pragma("unroll") for (int k = 0; k < 2; ++k) dst[m][k] = *(const PG8_LAS bf16x8*)(lds + PG8_SA(b, h) + aoff + m * 2048 + k * 1024); } while (0)
#define PG8_LDB(dst, b, h) do { _Pragma("unroll") for (int n = 0; n < 2; ++n) _Pragma("unroll") for (int k = 0; k < 2; ++k) dst[n][k] = *(const PG8_LAS bf16x8*)(lds + PG8_SB(b, h) + boff + n * 2048 + k * 1024); } while (0)
#define PG8_MMA(ai, bj, At, Bt) do { __builtin_amdgcn_s_setprio(1); _Pragma("unroll") for (int m = 0; m < 4; ++m) _Pragma("unroll") for (int n = 0; n < 2; ++n) _Pragma("unroll") for (int k = 0; k < 2; ++k) \
        acc[ai][bj][m][n] = __builtin_amdgcn_mfma_f32_16x16x32_bf16(Bt[n][k], At[m][k], acc[ai][bj][m][n], 0, 0, 0); __builtin_amdgcn_s_setprio(0); } while (0)
#define PG8_WAIT_V(n) asm volatile("s_waitcnt vmcnt(" #n ")" ::: "memory")
#define PG8_WAIT_L(n) asm volatile("s_waitcnt lgkmcnt(" #n ")" ::: "memory")
#define PG8_BAR __builtin_amdgcn_s_barrier()
#define PG8_SCHED __builtin_amdgcn_sched_barrier(0)
    Unit cur, nxt; int ui = 0;
    if (!S.next(0, cur)) return;
    f32x4 acc[2][2][4][2];
    pre.drain();
    if constexpr (Epi::INIT) E.init(acc, cur, wr, wc, fr, fq);
    else {
#pragma unroll
    for (int a = 0; a < 2; ++a)
#pragma unroll
        for (int b = 0; b < 2; ++b)
#pragma unroll
            for (int m = 0; m < 4; ++m)
#pragma unroll
                for (int n = 0; n < 2; ++n) acc[a][b][m][n] = (f32x4){0.f, 0.f, 0.f, 0.f};
    }
    pre.sync();
    bf16x8 At[4][2], B0[2][2], B1[2][2];
    const char* cA = (const char*)g.A + (size_t)cur.pm * tstep; const char* cB = (const char*)g.Bt + (size_t)cur.pn * tstep;
    S.a_ready(cur);
    if constexpr (SP2) {
        PG8_STAGE(PG8_SB(0, 0), cB, voffB); PG8_STAGE(PG8_SB(0, 1), cB + hstep, voffB); PG8_STAGE(PG8_SA(0, 0), cA, voffA); PG8_STAGE(PG8_SA(0, 1), cA + hstep, voffA);
        if (wr == 1) PG8_BAR;
        PG8_WAIT_V(2); PG8_BAR;
        PG8_STAGE(PG8_SB(1, 0), cB + kstepB, voffB); PG8_STAGE(PG8_SA(1, 0), cA + kstepA, voffA); PG8_STAGE(PG8_SB(1, 1), cB + hstep + kstepB, voffB);
        PG8_WAIT_V(6); PG8_BAR;
    } else {
        PG8_STAGE(PG8_SB(0, 0), cB, voffB); PG8_STAGE(PG8_SA(0, 0), cA, voffA); PG8_STAGE(PG8_SB(0, 1), cB + hstep, voffB); PG8_STAGE(PG8_SA(0, 1), cA + hstep, voffA);
        if (wr == 1) PG8_BAR;
        PG8_WAIT_V(4); PG8_BAR;
        PG8_STAGE(PG8_SB(1, 0), cB + kstepB, voffB); PG8_STAGE(PG8_SA(1, 0), cA + kstepA, voffA); PG8_STAGE(PG8_SB(1, 1), cB + hstep + kstepB, voffB);
        PG8_WAIT_V(6); PG8_BAR;
    }
    for (;;) {
        const bool has_next = S.next(ui + 1, nxt);
        const char* nA = has_next ? (const char*)g.A + (size_t)nxt.pm * tstep : cA; const char* nB = has_next ? (const char*)g.Bt + (size_t)nxt.pn * tstep : cB;
        for (int t = 0; t < nt; t += 2) {
            const bool last = (t == nt - 2);
            const char* a1 = cA + (size_t)(t + 1) * kstepA;
            const char* a2 = last ? nA : cA + (size_t)(t + 2) * kstepA; const char* b2 = last ? nB : cB + (size_t)(t + 2) * kstepB;
            const char* a3 = a2 + kstepA; const char* b3 = b2 + kstepB;
            if (last && has_next) S.a_ready(nxt);
            if constexpr (SP2) {
            PG8_LDB(B0, 0, 0); PG8_LDB(B1, 0, 1); PG8_SCHED; PG8_LDA(At, 0, 0); PG8_STAGE(PG8_SA(1, 1), a1 + hstep, voffA);
            PG8_WAIT_V(8); PG8_WAIT_L(0); PG8_BAR; PG8_MMA(0, 0, At, B0); PG8_MMA(0, 1, At, B1); PG8_BAR; PG8_SCHED;
            PG8_LDA(At, 0, 1); PG8_STAGE(PG8_SB(0, 0), b2, voffB); PG8_STAGE(PG8_SB(0, 1), b2 + hstep, voffB); PG8_STAGE(PG8_SA(0, 0), a2, voffA);
            PG8_WAIT_V(8); PG8_WAIT_L(0); PG8_BAR; PG8_MMA(1, 0, At, B0); PG8_MMA(1, 1, At, B1); PG8_BAR; PG8_SCHED;
            PG8_LDB(B0, 1, 0); PG8_LDB(B1, 1, 1); PG8_SCHED; PG8_LDA(At, 1, 0); PG8_STAGE(PG8_SA(0, 1), a2 + hstep, voffA);
            PG8_WAIT_V(8); PG8_WAIT_L(0); PG8_BAR; PG8_MMA(0, 0, At, B0); PG8_MMA(0, 1, At, B1); PG8_BAR; PG8_SCHED;
            PG8_LDA(At, 1, 1); PG8_STAGE(PG8_SB(1, 0), b3, voffB); PG8_STAGE(PG8_SB(1, 1), b3 + hstep, voffB); PG8_STAGE(PG8_SA(1, 0), a3, voffA);
            PG8_WAIT_V(8); PG8_WAIT_L(0); PG8_BAR; PG8_MMA(1, 0, At, B0); PG8_MMA(1, 1, At, B1); PG8_BAR; PG8_SCHED;
            } else {
            PG8_LDB(B0, 0, 0); PG8_SCHED; PG8_LDA(At, 0, 0); PG8_STAGE(PG8_SA(1, 1), a1 + hstep, voffA);
            PG8_WAIT_L(8); PG8_BAR; PG8_WAIT_L(0); PG8_MMA(0, 0, At, B0); PG8_BAR; PG8_SCHED;
            PG8_LDB(B1, 0, 1); PG8_STAGE(PG8_SB(0, 0), b2, voffB);
            PG8_BAR; PG8_WAIT_L(0); PG8_MMA(0, 1, At, B1); PG8_BAR;
            PG8_LDA(At, 0, 1); PG8_STAGE(PG8_SA(0, 0), a2, voffA);
            PG8_BAR; PG8_WAIT_L(0); PG8_MMA(1, 0, At, B0); PG8_BAR; PG8_SCHED;
            PG8_STAGE(PG8_SB(0, 1), b2 + hstep, voffB);
            PG8_WAIT_V(6); PG8_BAR; PG8_MMA(1, 1, At, B1); PG8_BAR;
            PG8_LDB(B0, 1, 0); PG8_SCHED; PG8_LDA(At, 1, 0); PG8_STAGE(PG8_SA(0, 1), a2 + hstep, voffA);
            PG8_WAIT_L(8); PG8_BAR; PG8_WAIT_L(0); PG8_MMA(0, 0, At, B0); PG8_BAR; PG8_SCHED;
            PG8_LDB(B1, 1, 1); PG8_STAGE(PG8_SB(1, 0), b3, voffB);
            PG8_BAR; PG8_WAIT_L(0); PG8_MMA(0, 1, At, B1); PG8_BAR;
            PG8_LDA(At, 1, 1); PG8_STAGE(PG8_SA(1, 0), a3, voffA);
            PG8_BAR; PG8_WAIT_L(0); PG8_MMA(1, 0, At, B0); PG8_BAR; PG8_SCHED;
            PG8_STAGE(PG8_SB(1, 1), b3 + hstep, voffB);
            PG8_WAIT_V(6); PG8_BAR; PG8_MMA(1, 1, At, B1); PG8_BAR;
            }
        }
        if constexpr (ALIGN_EPI) { if (wr == 0) PG8_BAR; }
        if constexpr (!Epi::AFTER_DRAIN) { E(acc, cur, wr, wc, fr, fq); S.done(cur); }
        if (!has_next) break;
        if constexpr (Epi::INIT) E.init(acc, nxt, wr, wc, fr, fq);
        else {
#pragma unroll
        for (int a = 0; a < 2; ++a)
#pragma unroll
            for (int b = 0; b < 2; ++b)
#pragma unroll
                for (int m = 0; m < 4; ++m)
#pragma unroll
                    for (int n = 0; n < 2; ++n) acc[a][b][m][n] = (f32x4){0.f, 0.f, 0.f, 0.f};
        }
        cur = nxt; cA = nA; cB = nB; ++ui;
        if constexpr (ALIGN_EPI) { if (wr == 1) PG8_BAR; }
    }
    PG8_WAIT_V(0);
    if constexpr (!ALIGN_EPI) { if (wr == 0) PG8_BAR; }
    PG8_BAR;
    if constexpr (Epi::AFTER_DRAIN) { E.fused(acc, cur, wr, wc, fr, fq, lds, wid, lane); S.done(cur); }
#undef PG8_SA
#undef PG8_SB
#undef PG8_STAGE
#undef PG8_LDA
#undef PG8_LDB
#undef PG8_MMA
#undef PG8_WAIT_V
#undef PG8_WAIT_L
#undef PG8_BAR
#undef PG8_SCHED
}
}
constexpr int NB = 8, SEQ = 2048, DM = 1024, M = NB * SEQ, NIN = 2560, DFF = 2816, NFF2 = 2 * DFF, DEPTH = 2;
constexpr int NWAVES = 8;
constexpr size_t MiB = 1u << 20;
constexpr size_t WS_ROWSS = 1 * MiB;
constexpr size_t WS_VGSS = 2 * MiB;
constexpr size_t WS_WSP = 3 * MiB;
constexpr size_t WS_W0 = 4 * MiB, WS_WSTRIDE = 24 * MiB;
constexpr size_t WOFF_IN = 0, WOFF_OUT = 5 * MiB, WOFF_FIN = 7 * MiB, WOFF_FOUT = 18 * MiB;
constexpr size_t WS_XB = 52 * MiB;
constexpr size_t WS_PROJ = 84 * MiB;
constexpr size_t WS_MIX = 164 * MiB;
constexpr size_t WS_HID = 84 * MiB;
constexpr size_t WS_END = 196 * MiB;
constexpr int LDS_BYTES = 155648;

#define GAS __attribute__((address_space(1)))
#define LAS __attribute__((address_space(3)))
typedef unsigned short bf16;
typedef unsigned v4u __attribute__((ext_vector_type(4)));
typedef float f32x4 __attribute__((ext_vector_type(4)));
__device__ __forceinline__ unsigned f2bf(float f) { unsigned u = __builtin_bit_cast(unsigned, f); return (u + 0x7fffu + ((u >> 16) & 1u)) >> 16; }
__device__ __forceinline__ unsigned pk2(float lo, float hi) { return f2bf(lo) | (f2bf(hi) << 16); }
__device__ __forceinline__ float bf2f(bf16 v) { return __builtin_bit_cast(float, (unsigned)v << 16); }
__device__ __forceinline__ float wave_sum(float v) {
#pragma unroll
    for (int o = 1; o < 64; o <<= 1) v += __shfl_xor(v, o);
    return v;
}
#define LDS_WAIT() asm volatile("s_waitcnt lgkmcnt(0)" ::: "memory")

typedef short tp_s16x4 __attribute__((ext_vector_type(4)));
__device__ __forceinline__ void p0_transpose_item(const float* W, int K, int N, bf16* WT, int k0, int n0, int prow0, int prow1, const float* gk, LAS unsigned char* scr, int lane, int tiled_n = 0) {
    const int lr = lane >> 4, n4 = (lane & 15) * 4;
    f32x4 v[16];
#pragma unroll
    for (int i = 0; i < 16; ++i) v[i] = __builtin_nontemporal_load((const f32x4*)(W + (size_t)(k0 + 4 * i + lr) * N + n0 + n4));
#pragma unroll
    for (int i = 0; i < 16; ++i) { const int k = 4 * i + lr; const float gg = gk ? gk[k0 + k] : 1.f;
        unsigned long long w = (unsigned long long)pk2(v[i].x * gg, v[i].y * gg) | ((unsigned long long)pk2(v[i].z * gg, v[i].w * gg) << 32);
        *(LAS unsigned long long*)(scr + k * 128 + ((n4 * 2) ^ (((k >> 1) & 1) << 6))) = w; }
    asm volatile("" ::: "memory");
    const int hh = lane >> 5, g2 = (lane >> 4) & 1, i16 = lane & 15, qq = i16 >> 2, p4 = i16 & 3;
#pragma unroll
    for (int j = 0; j < 8; ++j) { const int c = 2 * (j >> 1) + hh, nb = 32 * (j & 1) + 16 * g2;
        const int a0 = (8 * c + qq) * 128 + (((nb + 4 * p4) * 2) ^ ((qq >> 1) << 6));
        const tp_s16x4 lo = __builtin_bit_cast(tp_s16x4, __builtin_amdgcn_ds_read_tr16_b64_v4i16((LAS tp_s16x4*)(scr + a0)));
        const tp_s16x4 hi4 = __builtin_bit_cast(tp_s16x4, __builtin_amdgcn_ds_read_tr16_b64_v4i16((LAS tp_s16x4*)(scr + a0 + 4 * 128)));
        typedef short s16x8_t __attribute__((ext_vector_type(8)));
        const s16x8_t o = (s16x8_t){lo[0], lo[1], lo[2], lo[3], hi4[0], hi4[1], hi4[2], hi4[3]};
        const int prow = ((j & 1) ? prow1 : prow0) + 16 * g2 + i16;
        *(s16x8_t*)(WT + (tiled_n ? ((size_t)(k0 >> 6) * tiled_n + prow) * 64 + 8 * c : (size_t)prow * K + k0 + 8 * c)) = o; }
    LDS_WAIT(); asm volatile("" ::: "memory");
}
__host__ __device__ __forceinline__ int map_in(int n) { const int T = n >> 8, nn = n & 255; return 256 * T + 128 * ((nn >> 5) & 1) + 32 * (nn >> 6) + (nn & 31); }
__host__ __device__ __forceinline__ int map_fin(int n) { return n < DFF ? 256 * (n >> 7) + (n & 127) : 256 * ((n - DFF) >> 7) + 128 + ((n - DFF) & 127); }

typedef GAS unsigned gu32;
#define RLX_AGENT __ATOMIC_RELAXED, __HIP_MEMORY_SCOPE_AGENT
constexpr int MISC_OFF = LDS_BYTES - 64;
constexpr size_t WS_BAR = 0;
constexpr size_t BAR_ZERO_BYTES = 32768;
#define XB_TMO      128
#define XB_XCNT(j)  (256  + 64 * (j))
#define XB_XSUB(j)  (1280 + 64 * (j))
#define XB_XGEN(j)  (2304 + 64 * (j))
#define XB_TOP      3328
#define XB_TOPGEN   3392
#define XCD_BAR_WORDS 3456
#define XB_SPIN_CAP (1u << 18)

__device__ __forceinline__ unsigned xb_ld(unsigned* p)              { return __hip_atomic_load(p, __ATOMIC_RELAXED, __HIP_MEMORY_SCOPE_AGENT); }
__device__ __forceinline__ unsigned xb_add(unsigned* p, unsigned v) { return __hip_atomic_fetch_add(p, v, __ATOMIC_RELAXED, __HIP_MEMORY_SCOPE_AGENT); }
__device__ __forceinline__ unsigned xb_xcc_id() { return (unsigned)__builtin_amdgcn_s_getreg((3 << 11) | 20) & 0xFu; }
#define XB_SPIN(cond, bar) do { unsigned _sp = 0; while (cond) { __builtin_amdgcn_s_sleep(1); \
    if ((++_sp & 255u) == 0u) { if (xb_ld(&(bar)[XB_TMO])) break; if (_sp > XB_SPIN_CAP) { atomicAdd(&(bar)[XB_TMO], 1u); break; } } } } while (0)

struct XcdBarrier {
    unsigned* bar; unsigned x;
    volatile LAS unsigned* st;
};

__device__ __forceinline__ XcdBarrier xcd_barrier_post(unsigned* bar, volatile LAS unsigned* st) {
    XcdBarrier b; b.bar = bar; b.x = xb_xcc_id(); b.st = st;
    if (threadIdx.x == 0) (void)xb_add(&bar[XB_XCNT(b.x)], 1u);
    return b;
}
__device__ __forceinline__ void xcd_barrier_complete(unsigned* bar, unsigned x, unsigned& nloc, unsigned& nx) {
    const unsigned G = gridDim.x * gridDim.y * gridDim.z;
    unsigned sum, cnt, mine, sp = 0u;
    for (;;) {
        sum = 0u; cnt = 0u; mine = 0u;
#pragma unroll
        for (unsigned j = 0; j < 16; ++j) { const unsigned c = xb_ld(&bar[XB_XCNT(j)]); sum += c; cnt += (c > 0u) ? 1u : 0u; mine = (j == x) ? c : mine; }
        if (sum == G) break;
        __builtin_amdgcn_s_sleep(1);
        if ((++sp & 255u) == 0u) { if (xb_ld(&bar[XB_TMO])) break; if (sp > XB_SPIN_CAP) { atomicAdd(&bar[XB_TMO], 1u); break; } }
    }
    nloc = mine > 0u ? mine : 1u; nx = cnt > 0u ? cnt : 1u;
}

__device__ __forceinline__ void xcd_barrier(const XcdBarrier& b) {
    asm volatile("s_waitcnt vmcnt(0)" ::: "memory");
    __syncthreads();
    if (threadIdx.x == 0) {
        unsigned* bar = b.bar;
        __builtin_amdgcn_s_waitcnt(0);
        unsigned nloc = b.st[0], nx = b.st[1];
        if (nloc == 0u) { xcd_barrier_complete(bar, b.x, nloc, nx); b.st[0] = nloc; b.st[1] = nx; }
        const unsigned old = xb_add(&bar[XB_XSUB(b.x)], 1u);
        const unsigned gen = old / nloc;
        if (old + 1u == (gen + 1u) * nloc) {
            __builtin_amdgcn_fence(__ATOMIC_RELEASE, "agent");
            asm volatile("s_waitcnt vmcnt(0)" ::: "memory");
            const unsigned og = xb_add(&bar[XB_TOP], 1u);
            const unsigned tg = og / nx;
            if (og + 1u == (tg + 1u) * nx) xb_add(&bar[XB_TOPGEN], 1u);
            else XB_SPIN(xb_ld(&bar[XB_TOPGEN]) == tg, bar);
            __builtin_amdgcn_fence(__ATOMIC_ACQUIRE, "agent");
            xb_add(&bar[XB_XGEN(b.x)], 1u);
            asm volatile("s_waitcnt vmcnt(0)" ::: "memory");
        } else {
            XB_SPIN(xb_ld(&bar[XB_XGEN(b.x)]) == gen, bar);
            __builtin_amdgcn_fence(__ATOMIC_ACQUIRE, "agent");
            asm volatile("s_waitcnt vmcnt(0)" ::: "memory");
        }
    }
    __syncthreads();
}

constexpr size_t WS_GCNT = 16384, WS_GMASK = 16384 + 8 * 256, WS_XIDX = 16384 + 16 * 256;
__device__ __forceinline__ void group_barrier(unsigned char* ws, volatile LAS unsigned* misc) {
    asm volatile("s_waitcnt vmcnt(0)" ::: "memory");
    __syncthreads();
    if (threadIdx.x == 0) {
        unsigned bx = misc[6];
        unsigned* cnt = (unsigned*)(ws + WS_GCNT) + 64 * (bx & 7u);
        const unsigned pure = misc[4], ep = misc[5] + 1u; misc[5] = ep;
        if (!pure) { __builtin_amdgcn_fence(__ATOMIC_RELEASE, "agent"); asm volatile("s_waitcnt vmcnt(0)" ::: "memory"); }
        const unsigned old_ = xb_add(cnt, 1u);
        if (pure) { __builtin_amdgcn_fence(__ATOMIC_ACQUIRE, "agent"); asm volatile("s_waitcnt vmcnt(0)" ::: "memory"); }
        const unsigned target = ep * (gridDim.x >> 3);
        unsigned sp = 0u;
        if (old_ + 1u < target) while (xb_ld(cnt) < target) { __builtin_amdgcn_s_sleep(1); if (++sp > (1u << 22)) break; }
        if (!pure) __builtin_amdgcn_fence(__ATOMIC_ACQUIRE, "agent");
        asm volatile("s_waitcnt vmcnt(0)" ::: "memory");
    }
    __syncthreads();
}
struct PreGroupBar {
    unsigned char* ws; volatile LAS unsigned* misc;
    __device__ __forceinline__ void drain() const { asm volatile("s_waitcnt vmcnt(0)" ::: "memory"); }
    __device__ __forceinline__ void sync() const {
        asm volatile("s_waitcnt lgkmcnt(0)" ::: "memory"); __builtin_amdgcn_s_barrier(); asm volatile("" ::: "memory");
        if (threadIdx.x == 0) {
            unsigned bx = misc[6];
            unsigned* cnt = (unsigned*)(ws + WS_GCNT) + 64 * (bx & 7u);
            const unsigned pure = misc[4], ep = misc[5] + 1u; misc[5] = ep;
            if (!pure) { __builtin_amdgcn_fence(__ATOMIC_RELEASE, "agent"); asm volatile("s_waitcnt vmcnt(0)" ::: "memory"); }
            const unsigned old_ = xb_add(cnt, 1u);
            if (pure) { __builtin_amdgcn_fence(__ATOMIC_ACQUIRE, "agent"); asm volatile("s_waitcnt vmcnt(0)" ::: "memory"); }
            const unsigned target = ep * (gridDim.x >> 3);
            unsigned sp = 0u;
            if (old_ + 1u < target) while (xb_ld(cnt) < target) { __builtin_amdgcn_s_sleep(1); if (++sp > (1u << 22)) break; }
            if (!pure) __builtin_amdgcn_fence(__ATOMIC_ACQUIRE, "agent");
            asm volatile("s_waitcnt vmcnt(0)" ::: "memory");
        }
        asm volatile("s_waitcnt lgkmcnt(0)" ::: "memory"); __builtin_amdgcn_s_barrier(); asm volatile("" ::: "memory");
    }
};
#define GROUP_BAR() group_barrier(kargs_ws(), (volatile LAS unsigned*)(lds + MISC_OFF))
#define VBID() ((int)__builtin_amdgcn_readfirstlane(((volatile LAS unsigned*)(lds + MISC_OFF))[6]))
#define GRID_BAR() do { XcdBarrier bar_; bar_.bar = (unsigned*)(kargs_ws() + WS_BAR); bar_.x = xb_xcc_id(); bar_.st = (volatile LAS unsigned*)(lds + MISC_OFF); xcd_barrier(bar_); } while (0)
struct Args { const float* in[15]; float* out; unsigned char* ws; };
typedef const __attribute__((address_space(4))) Args CArgs;
__device__ __forceinline__ CArgs* kargs();
__device__ __forceinline__ unsigned char* kargs_ws();
__device__ __forceinline__ CArgs* kargs() { CArgs* p = (CArgs*)__builtin_amdgcn_kernarg_segment_ptr(); asm volatile("" : "+s"(p)); return p; }
__device__ __forceinline__ unsigned char* kargs_ws() { return kargs()->ws; }

constexpr int CW_I_IN = (DM / 64) * (NIN / 64), CW_I_LAYER = CW_I_IN + (DM / 64) * (DM / 64) + (DM / 64) * (NFF2 / 64) + (DFF / 64) * (DM / 64);
__device__ __forceinline__ void convert_weights(CArgs* a, LAS unsigned char* lds, int wave, int lane, int it0, int it1, int gw, int NGW) {
    LAS unsigned char* scr = lds + wave * 16384;
    constexpr int I_IN = (DM / 64) * (NIN / 64), I_OUT = (DM / 64) * (DM / 64), I_FIN = (DM / 64) * (NFF2 / 64), I_FOUT = (DFF / 64) * (DM / 64);
    constexpr int I_LAYER = I_IN + I_OUT + I_FIN + I_FOUT;
    static_assert(I_IN == CW_I_IN && I_LAYER == CW_I_LAYER, "item counts");
#pragma nounroll
    for (int it = it0 + gw; it < it1; it += NGW) {
        const int l = it / I_LAYER; int r = it % I_LAYER;
        unsigned char* wb = a->ws + WS_W0 + (size_t)l * WS_WSTRIDE;
        if (r < I_IN) { const int nblk = NIN / 64, kb = r / nblk, nb = r % nblk;
            p0_transpose_item(a->in[2] + (size_t)l * DM * NIN, DM, NIN, (bf16*)(wb + WOFF_IN), 64 * kb, 64 * nb, map_in(64 * nb), map_in(64 * nb + 32), a->in[1] + l * DM, scr, lane); continue; } r -= I_IN;
        if (r < I_OUT) { const int nblk = DM / 64, kb = r / nblk, nb = r % nblk;
            p0_transpose_item(a->in[11] + (size_t)l * DM * DM, DM, DM, (bf16*)(wb + WOFF_OUT), 64 * kb, 64 * nb, 64 * nb, 64 * nb + 32, nullptr, scr, lane); continue; } r -= I_OUT;
        if (r < I_FIN) { const int nblk = NFF2 / 64, kb = r / nblk, nb = r % nblk;
            p0_transpose_item(a->in[13] + (size_t)l * DM * NFF2, DM, NFF2, (bf16*)(wb + WOFF_FIN), 64 * kb, 64 * nb, map_fin(64 * nb), map_fin(64 * nb + 32), a->in[12] + l * DM, scr, lane); continue; } r -= I_FIN;
        { const int nblk = DM / 64, kb = r / nblk, nb = r % nblk;
            p0_transpose_item(a->in[14] + (size_t)l * DFF * DM, DFF, DM, (bf16*)(wb + WOFF_FOUT), 64 * kb, 64 * nb, 64 * nb, 64 * nb + 32, nullptr, scr, lane, DM); }
    }
}
__device__ __forceinline__ void prologue(CArgs* a, LAS unsigned char* lds, int wave, int lane) {
    const int gw = blockIdx.x * NWAVES + wave, NGW = gridDim.x * NWAVES;
    convert_weights(a, lds, wave, lane, 0, CW_I_IN, gw, NGW);
    float* rowss = (float*)(a->ws + WS_ROWSS); bf16* xb = (bf16*)(a->ws + WS_XB);
#pragma nounroll
    for (int m0 = gw * 4; m0 < M; m0 += NGW * 4) {
        f32x4 v[4][4];
#pragma unroll
        for (int r = 0; r < 4; ++r) { const f32x4* xr = (const f32x4*)(a->in[0] + (size_t)(m0 + r) * DM) + lane;
#pragma unroll
            for (int j = 0; j < 4; ++j) v[r][j] = __builtin_nontemporal_load(xr + 64 * j); }
#pragma unroll
        for (int r = 0; r < 4; ++r) { unsigned long long* o8 = (unsigned long long*)(xb + (size_t)(m0 + r) * DM) + lane; float sq = 0.f;
#pragma unroll
            for (int j = 0; j < 4; ++j) { const f32x4 w = v[r][j]; sq += (w.x * w.x + w.y * w.y) + (w.z * w.z + w.w * w.w);
                o8[64 * j] = (unsigned long long)pk2(w.x, w.y) | ((unsigned long long)pk2(w.z, w.w) << 32); }
            sq = wave_sum(sq);
            if (lane < 4) rowss[(size_t)(m0 + r) * 4 + lane] = lane == 0 ? sq : 0.f; }
    }
    { const float* wsp = a->in[7]; bf16* o = (bf16*)(a->ws + WS_WSP); const int gt = blockIdx.x * 512 + threadIdx.x, NT = gridDim.x * 512;
      for (int i = gt; i < DEPTH * 8 * 128 * 128; i += NT) { const int s = i & 127, t = (i >> 7) & 127; o[i] = (bf16)(((t >> 6) >= (s >> 6)) ? f2bf(wsp[i]) : 0u); } }
}

__device__ __forceinline__ void mixer_naive(CArgs* a, int l, LAS unsigned char* lds, int wave, int lane) {
    const bf16* P = (const bf16*)(a->ws + WS_PROJ); bf16* MIX = (bf16*)(a->ws + WS_MIX);
    const float* vgss = (const float*)(a->ws + WS_VGSS); const bf16* wsp = (const bf16*)(a->ws + WS_WSP) + (size_t)l * 8 * 128 * 128;
    const float* rel = a->in[5] + (size_t)l * 8 * 257; const float* sgu_g = a->in[6] + l * 512; const float* bsp = a->in[8] + l * 8 * 128;
    const float* ag = a->in[9] + l * 512; const float* gg = a->in[10] + l * 512;
    LAS float* red = (LAS float*)lds;
    for (int tok = blockIdx.x; tok < M; tok += gridDim.x) {
        const int b = tok / SEQ, t = tok % SEQ, c = t >> 6;
        const int h = wave;
        const float q = bf2f(P[(size_t)tok * NIN + h * 64 + lane]);
        float mx = -INFINITY, lsum = 0.f, o = 0.f;
        const int k0 = (c >= 8 ? c - 8 : 0) * 64, k1 = c * 64 + 63;
        for (int kt = k0; kt <= k1; ++kt) {
            const size_t kr = (size_t)(b * SEQ + kt) * NIN;
            float s = wave_sum(q * bf2f(P[kr + 512 + h * 64 + lane]));
            int d = t - kt; d = d < -128 ? -128 : (d > 128 ? 128 : d);
            s += rel[h * 257 + d + 128] * pg8::LOG2E;
            const float mn = fmaxf(mx, s), al = __builtin_amdgcn_exp2f(mx - mn), p = __builtin_amdgcn_exp2f(s - mn);
            lsum = lsum * al + p; o = o * al + p * bf2f(P[kr + 1024 + h * 64 + lane]); mx = mn;
        }
        o = o / lsum;
        const int g = wave, nb = t >> 7, tp = t & 127, ns = tp < 64 ? 64 : 128;
        float mixd = 0.f;
        for (int s = 0; s < ns; ++s) {
            const int srow = b * SEQ + nb * 128 + s;
            const f32x4* pv = (const f32x4*)(vgss + (size_t)srow * 8); const f32x4 p0 = pv[0], p1 = pv[1];
            const float rs = __builtin_amdgcn_rsqf((((p0[0] + p0[1]) + (p0[2] + p0[3])) + ((p1[0] + p1[1]) + (p1[2] + p1[3]))) * (1.0f / 512.0f) + pg8::RMS_EPS);
            mixd += bf2f(wsp[(g * 128 + tp) * 128 + s]) * (bf2f(P[(size_t)srow * NIN + 2048 + g * 64 + lane]) * rs * sgu_g[g * 64 + lane]);
        }
        const float gv = bf2f(P[(size_t)tok * NIN + 1536 + g * 64 + lane]) * (mixd + bsp[g * 128 + tp]);
        const float so = wave_sum(o * o), sg = wave_sum(gv * gv);
        __syncthreads();
        if (lane == 0) { red[wave] = so; red[8 + wave] = sg; }
        __syncthreads();
        float ta = 0.f, tg = 0.f;
#pragma unroll
        for (int w = 0; w < 8; ++w) { ta += red[w]; tg += red[8 + w]; }
        const float ra = __builtin_amdgcn_rsqf(ta * (1.0f / 512.0f) + pg8::RMS_EPS), rg = __builtin_amdgcn_rsqf(tg * (1.0f / 512.0f) + pg8::RMS_EPS);
        MIX[(size_t)tok * DM + h * 64 + lane] = (bf16)f2bf(o * ra * ag[h * 64 + lane]);
        MIX[(size_t)tok * DM + 512 + g * 64 + lane] = (bf16)f2bf(gv * rg * gg[g * 64 + lane]);
    }
    __syncthreads();
}

#ifndef FAST_MIXER
#define FAST_MIXER 1
#endif
#ifndef PHM
#define PHM 31
#endif
#ifndef REPM
#define REPM 0
#endif
#define REPEAT(bit) for (int rep_ = 0; rep_ < (((REPM) >> (bit)) & 1) + 1; ++rep_)
namespace mx {
typedef float f32x16 __attribute__((ext_vector_type(16)));
typedef short bf16x8 __attribute__((ext_vector_type(8)));
typedef short s16x4 __attribute__((ext_vector_type(4)));
typedef unsigned u32x2 __attribute__((ext_vector_type(2)));
constexpr int TBL_OFF = 131072;
constexpr int TBL_LD = 320;
constexpr int RS_OFF = TBL_OFF + 8 * TBL_LD * 4 + 4096;
constexpr int RED_OFF = TBL_OFF + 8 * TBL_LD * 4;
__device__ __forceinline__ int crow(int r, int hi) { return (r & 3) + 8 * (r >> 2) + 4 * hi; }
__device__ __forceinline__ int vimg(int row, int chunk) { return row * 128 + ((chunk * 16) ^ (((row >> 1) & 1) << 6)); }
__device__ __forceinline__ s16x4 tr64(LAS unsigned char* p) { return __builtin_bit_cast(s16x4, __builtin_amdgcn_ds_read_tr16_b64_v4i16((LAS s16x4*)p)); }
__device__ __forceinline__ bf16x8 cat8(s16x4 a, s16x4 b) { return (bf16x8){a[0], a[1], a[2], a[3], b[0], b[1], b[2], b[3]}; }
__device__ __forceinline__ unsigned cvtpk(float lo, float hi) { unsigned r; asm("v_cvt_pk_bf16_f32 %0, %1, %2" : "=v"(r) : "v"(lo), "v"(hi)); return r; }
#ifndef ATTREP
#define ATTREP 1
#endif
#ifndef DMAREP
#define DMAREP 1
#endif
#if DMAREP == 1
#define MX_VM8 "s_waitcnt vmcnt(8)"
#else
#define MX_VM8 "s_waitcnt vmcnt(16)"
#endif
#define MX_FENCE() asm volatile("" ::: "memory")
__device__ __forceinline__ float max3f(float a, float b, float c) { float r; asm("v_max3_f32 %0, %1, %2, %3" : "=v"(r) : "v"(a), "v"(b), "v"(c)); return r; }

__device__ __forceinline__ void attn_task(const bf16* P, int b, int c, int h, LAS unsigned char* wl, const LAS float* tbl, int lane, f32x16 (&o)[2][2]) {
    const int r32 = lane & 31, hi = lane >> 5;
    const size_t tok0 = (size_t)b * SEQ + c * 64;
    bf16x8 qf[2][4];
#pragma unroll
    for (int qt = 0; qt < 2; ++qt)
#pragma unroll
        for (int d0 = 0; d0 < 4; ++d0) qf[qt][d0] = *(const bf16x8*)(P + (tok0 + 32 * qt + r32) * NIN + h * 64 + d0 * 16 + hi * 8);
#pragma unroll
    for (int r = 0; r < 16; ++r) { o[0][0][r] = 0.f; o[0][1][r] = 0.f; o[1][0][r] = 0.f; o[1][1][r] = 0.f; }
    float m[2] = {-INFINITY, -INFINITY}, l[2] = {0.f, 0.f};
    const int kc0 = c >= 8 ? c - 8 : 0;
    const int dhalf = (lane >> 4) & 1, qq = (lane & 15) >> 2, p4 = lane & 3;
    int vb[2];
#pragma unroll
    for (int dt = 0; dt < 2; ++dt) vb[dt] = 8192 + (4 * hi + qq) * 128 + ((64 * dt + 32 * dhalf + 8 * p4) ^ ((qq >> 1) << 6));
    const int prow = lane >> 3, pch = lane & 7;
    const unsigned voff = (unsigned)(prow * NIN + (pch ^ (((lane >> 4) & 1) << 2)) * 8) * 2u;
    const unsigned koff0 = (unsigned)(prow * NIN + (pch ^ (lane >> 4)) * 8) * 2u, koff1 = (unsigned)(prow * NIN + (pch ^ (lane >> 4) ^ 4) * 8) * 2u;
    const int swz = (r32 >> 1) & 7;
    int ka[4];
#pragma unroll
    for (int d0 = 0; d0 < 4; ++d0) ka[d0] = r32 * 128 + (((2 * d0 + hi) ^ swz) * 16);
#define MX_DMAK(kc) do { const char* kp_ = (const char*)(P + ((size_t)b * SEQ + (kc) * 64) * NIN + 512 + h * 64); \
        _Pragma("unroll") for (int i = 0; i < 8 * DMAREP; ++i) __builtin_amdgcn_global_load_lds((const unsigned*)(kp_ + (size_t)((i & 7) * 8 * NIN) * 2 + ((i & 1) ? koff1 : koff0)), (LAS unsigned*)(wl + (i & 7) * 1024), 16, 0, 0); } while (0)
#define MX_DMAV(kc) do { const char* vp_ = (const char*)(P + ((size_t)b * SEQ + (kc) * 64) * NIN + 1024 + h * 64); \
        _Pragma("unroll") for (int i = 0; i < 8 * DMAREP; ++i) __builtin_amdgcn_global_load_lds((const unsigned*)(vp_ + (size_t)((i & 7) * 8 * NIN) * 2 + voff), (LAS unsigned*)(wl + 8192 + (i & 7) * 1024), 16, 0, 0); } while (0)
    MX_DMAK(kc0);
    const int nk = c - kc0 + 1, total = nk * ATTREP; (void)total;
#if ATTREP == 1
    for (int kc = kc0; kc <= c; ++kc) {
        const int kcn = kc + 1; const bool more = kc < c;
#else
    for (int it = 0; it < total; ++it) {
        const int kc = kc0 + it % nk, kcn = kc0 + (it + 1) % nk; const bool more = it + 1 < total;
#endif
        const int j = kc - c + 8;
        MX_DMAV(kc);
        asm volatile(MX_VM8 ::: "memory");
        bf16x8 kf[2][4];
#pragma unroll
        for (int kt = 0; kt < 2; ++kt)
#pragma unroll
            for (int d0 = 0; d0 < 4; ++d0) kf[kt][d0] = *(const LAS bf16x8*)(wl + kt * 4096 + ka[d0]);
        asm volatile("s_waitcnt lgkmcnt(0)" ::: "memory");
        if (more) MX_DMAK(kcn);
#pragma unroll
        for (int qt = 0; qt < 2; ++qt) {
            f32x16 st[2];
            float badd = 0.f;
            if (j <= 5) { badd = tbl[256];
#pragma unroll
                for (int r = 0; r < 16; ++r) { st[0][r] = 0.f; st[1][r] = 0.f; } }
            else { const LAS float* tb = tbl + (64 * (8 - j) + 32 * qt + r32 - 4 * hi + 128 - 63);
#pragma unroll
                for (int kt = 0; kt < 2; ++kt)
#pragma unroll
                    for (int r = 0; r < 16; ++r) st[kt][r] = tb[63 - (32 * kt + (r & 3) + 8 * (r >> 2))]; }
#pragma unroll
            for (int kt = 0; kt < 2; ++kt)
#pragma unroll
                for (int d0 = 0; d0 < 4; ++d0) st[kt] = __builtin_amdgcn_mfma_f32_32x32x16_bf16(kf[kt][d0], qf[qt][d0], st[kt], 0, 0, 0);
            asm volatile("s_nop 15\n\ts_nop 7" : "+v"(st[0]), "+v"(st[1]));
            float mxa = max3f(st[0][0], st[0][1], st[0][2]), mxb = max3f(st[1][0], st[1][1], st[1][2]);
#pragma unroll
            for (int r = 3; r < 15; r += 2) { mxa = max3f(mxa, st[0][r], st[0][r + 1]); mxb = max3f(mxb, st[1][r], st[1][r + 1]); }
            float mxv = max3f(mxa, mxb, st[0][15]); mxv = max3f(mxv, st[1][15], mxv);
            mxv = max3f(mxv, __shfl_xor(mxv, 32), mxv) + badd;
            const bool need = mxv > m[qt] + 8.0f;
            if (__builtin_amdgcn_ballot_w64(need) != 0ull) {
                const float mn = need ? mxv : m[qt], al = __builtin_amdgcn_exp2f(m[qt] - mn); m[qt] = mn; l[qt] *= al;
#pragma unroll
                for (int r = 0; r < 16; ++r) { o[qt][0][r] *= al; o[qt][1][r] *= al; }
            }
            const float sub = m[qt] - badd;
            float rs = 0.f;
#pragma unroll
            for (int kt = 0; kt < 2; ++kt)
#pragma unroll
                for (int r = 0; r < 16; ++r) { const float p = __builtin_amdgcn_exp2f(st[kt][r] - sub); st[kt][r] = p; rs += p; }
            l[qt] += rs;
            bf16x8 pf[4];
#pragma unroll
            for (int s = 0; s < 4; ++s) { v4u w; const int kt = s >> 1, r0 = 8 * (s & 1);
                w.x = cvtpk(st[kt][r0 + 0], st[kt][r0 + 1]); w.y = cvtpk(st[kt][r0 + 2], st[kt][r0 + 3]); w.z = cvtpk(st[kt][r0 + 4], st[kt][r0 + 5]); w.w = cvtpk(st[kt][r0 + 6], st[kt][r0 + 7]);
                pf[s] = __builtin_bit_cast(bf16x8, w); }
            if (qt == 0) { if (more) asm volatile(MX_VM8 ::: "memory"); else asm volatile("s_waitcnt vmcnt(0)" ::: "memory"); }
            {
                s16x4 va[2][4], vc[2][4];
#pragma unroll
                for (int dt = 0; dt < 2; ++dt) { const unsigned vaddr = (unsigned)(uintptr_t)(wl + vb[dt]);
#pragma unroll
                    for (int s = 0; s < 4; ++s) { asm volatile("ds_read_b64_tr_b16 %0, %1 offset:%c2" : "=&v"(va[dt][s]) : "v"(vaddr), "i"(16 * s * 128) : "memory");
                                                  asm volatile("ds_read_b64_tr_b16 %0, %1 offset:%c2" : "=&v"(vc[dt][s]) : "v"(vaddr), "i"((16 * s + 8) * 128) : "memory"); } }
                asm volatile("s_waitcnt lgkmcnt(0)" : "+v"(va[0][0]), "+v"(va[0][1]), "+v"(va[0][2]), "+v"(va[0][3]), "+v"(vc[0][0]), "+v"(vc[0][1]), "+v"(vc[0][2]), "+v"(vc[0][3]),
                                                      "+v"(va[1][0]), "+v"(va[1][1]), "+v"(va[1][2]), "+v"(va[1][3]), "+v"(vc[1][0]), "+v"(vc[1][1]), "+v"(vc[1][2]), "+v"(vc[1][3]) :: "memory");
#pragma unroll
                for (int s = 0; s < 4; ++s)
#pragma unroll
                    for (int dt = 0; dt < 2; ++dt) o[qt][dt] = __builtin_amdgcn_mfma_f32_32x32x16_bf16(cat8(va[dt][s], vc[dt][s]), pf[s], o[qt][dt], 0, 0, 0);
            }
        }
        MX_FENCE();
    }
#undef MX_DMAK
#undef MX_DMAV
#pragma unroll
    for (int qt = 0; qt < 2; ++qt) { float lt = l[qt]; lt += __shfl_xor(lt, 32); const float inv = 1.0f / lt;
#pragma unroll
        for (int r = 0; r < 16; ++r) { o[qt][0][r] *= inv; o[qt][1][r] *= inv; } }
}

__device__ __forceinline__ void sgu_task(const bf16* P, const LAS float* rstab, const bf16* wsp_l, const float* sgu_g, const float* bsp_l, int b, int c, int g, LAS unsigned char* wl, int lane_in, f32x16 (&o)[2][2]) {
    int lane = lane_in; asm volatile("" : "+v"(lane));
    const int r32 = lane & 31, hi = lane >> 5;
    const int nb = c >> 1, cb = c & 1, ns = cb ? 128 : 64;
    const size_t srow0 = (size_t)b * SEQ + nb * 128, tok0 = (size_t)b * SEQ + c * 64;
    const int prow = lane >> 3, pch = lane & 7;
    const f32x4 g0 = *(const f32x4*)(sgu_g + g * 64 + pch * 8), g1 = *(const f32x4*)(sgu_g + g * 64 + pch * 8 + 4);
    v4u ureg[8];
#pragma unroll
    for (int i = 0; i < 8; ++i) ureg[i] = *(const v4u*)(P + (tok0 + prow + 8 * i) * NIN + 1536 + g * 64 + pch * 8);
    const bf16* wrow = wsp_l + ((size_t)g * 128 + cb * 64 + r32) * 128 + hi * 8;
    bf16x8 wfa[8], wfb[8];
#pragma unroll
    for (int step = 0; step < 8; ++step) if (step * 16 < ns) { wfa[step] = *(const bf16x8*)(wrow + 16 * step); wfb[step] = *(const bf16x8*)(wrow + 32 * 128 + 16 * step); }
    MX_FENCE();
#pragma unroll
    for (int hb = 0; hb < 2; ++hb) {
        if (hb * 64 < ns) {
            v4u raw[8];
#pragma unroll
            for (int i = 0; i < 8; ++i) raw[i] = *(const v4u*)(P + (srow0 + hb * 64 + prow + 8 * i) * NIN + 2048 + g * 64 + pch * 8);
#pragma unroll
            for (int i = 0; i < 8; ++i) { const int row = hb * 64 + prow + 8 * i; const f32x4 q0 = *(const LAS f32x4*)(rstab + row * 8), q1 = *(const LAS f32x4*)(rstab + row * 8 + 4);
                const float rs = __builtin_amdgcn_rsqf((((q0[0] + q0[1]) + (q0[2] + q0[3])) + ((q1[0] + q1[1]) + (q1[2] + q1[3]))) * (1.0f / 512.0f) + pg8::RMS_EPS);
                v4u w;
                w.x = cvtpk(__builtin_bit_cast(float, raw[i].x << 16) * rs * g0[0], __builtin_bit_cast(float, raw[i].x & 0xffff0000u) * rs * g0[1]);
                w.y = cvtpk(__builtin_bit_cast(float, raw[i].y << 16) * rs * g0[2], __builtin_bit_cast(float, raw[i].y & 0xffff0000u) * rs * g0[3]);
                w.z = cvtpk(__builtin_bit_cast(float, raw[i].z << 16) * rs * g1[0], __builtin_bit_cast(float, raw[i].z & 0xffff0000u) * rs * g1[1]);
                w.w = cvtpk(__builtin_bit_cast(float, raw[i].w << 16) * rs * g1[2], __builtin_bit_cast(float, raw[i].w & 0xffff0000u) * rs * g1[3]);
                *(LAS v4u*)(wl + vimg(row, pch)) = w; }
        }
    }
    MX_FENCE();
#pragma unroll
    for (int r = 0; r < 16; ++r) { o[0][0][r] = 0.f; o[0][1][r] = 0.f; o[1][0][r] = 0.f; o[1][1][r] = 0.f; }
    const int dhalf = (lane >> 4) & 1, qq = (lane & 15) >> 2, p4 = lane & 3;
    int vbs[2];
#pragma unroll
    for (int ct = 0; ct < 2; ++ct) vbs[ct] = (8 * hi + qq) * 128 + ((64 * ct + 32 * dhalf + 8 * p4) ^ ((qq >> 1) << 6));
#pragma unroll
    for (int step = 0; step < 8; ++step) { if (step * 16 < ns) {
        const bf16x8 wf0 = wfa[step], wf1 = wfb[step];
#pragma unroll
        for (int ct = 0; ct < 2; ++ct) { const s16x4 a0 = tr64(wl + vbs[ct] + (16 * step) * 128), a1 = tr64(wl + vbs[ct] + (16 * step + 4) * 128);
            const bf16x8 af = cat8(a0, a1);
            o[0][ct] = __builtin_amdgcn_mfma_f32_32x32x16_bf16(af, wf0, o[0][ct], 0, 0, 0);
            o[1][ct] = __builtin_amdgcn_mfma_f32_32x32x16_bf16(af, wf1, o[1][ct], 0, 0, 0); }
    } }
    MX_FENCE();
#pragma unroll
    for (int i = 0; i < 8; ++i) { const int row = 8 * i + prow; *(LAS v4u*)(wl + row * 128 + ((pch ^ (row & 7)) * 16)) = ureg[i]; }
    MX_FENCE();
#pragma unroll
    for (int tt = 0; tt < 2; ++tt) {
        const int tok = 32 * tt + r32;
        const float bt = bsp_l[g * 128 + cb * 64 + tok];
#pragma unroll
        for (int ct = 0; ct < 2; ++ct)
#pragma unroll
            for (int rg = 0; rg < 4; ++rg) { const u32x2 uu = *(const LAS u32x2*)(wl + tok * 128 + (((4 * ct + rg) ^ (tok & 7)) * 16) + hi * 8);
                o[tt][ct][4 * rg + 0] = __builtin_bit_cast(float, uu.x << 16) * (o[tt][ct][4 * rg + 0] + bt); o[tt][ct][4 * rg + 1] = __builtin_bit_cast(float, uu.x & 0xffff0000u) * (o[tt][ct][4 * rg + 1] + bt);
                o[tt][ct][4 * rg + 2] = __builtin_bit_cast(float, uu.y << 16) * (o[tt][ct][4 * rg + 2] + bt); o[tt][ct][4 * rg + 3] = __builtin_bit_cast(float, uu.y & 0xffff0000u) * (o[tt][ct][4 * rg + 3] + bt); }
    }
    MX_FENCE();
}

__device__ __forceinline__ void norm_store(const f32x16 (&o)[2][2], LAS float* red, LAS unsigned char* wl, int wave, int lane_in, const float* gain, bf16* dst) {
    int lane = lane_in; asm volatile("" : "+v"(lane));
    const int r32 = lane & 31, hi = lane >> 5;
    f32x4 gvv[2][4];
#pragma unroll
    for (int ct = 0; ct < 2; ++ct)
#pragma unroll
        for (int rg = 0; rg < 4; ++rg) gvv[ct][rg] = *(const f32x4*)(gain + 32 * ct + 8 * rg + 4 * hi);
#pragma unroll
    for (int tt = 0; tt < 2; ++tt) { float ss = 0.f;
#pragma unroll
        for (int r = 0; r < 16; ++r) ss += o[tt][0][r] * o[tt][0][r] + o[tt][1][r] * o[tt][1][r];
        ss += __shfl_xor(ss, 32);
        if (hi == 0) red[wave * 64 + tt * 32 + r32] = ss; }
    __syncthreads();
#pragma unroll
    for (int tt = 0; tt < 2; ++tt) { float tot = 0.f; const int tok = 32 * tt + r32;
#pragma unroll
        for (int w = 0; w < 8; ++w) tot += red[w * 64 + tok];
        const float rn = __builtin_amdgcn_rsqf(tot * (1.0f / 512.0f) + pg8::RMS_EPS);
#pragma unroll
        for (int ct = 0; ct < 2; ++ct)
#pragma unroll
            for (int rg = 0; rg < 4; ++rg) { const f32x4 gv = gvv[ct][rg];
                u32x2 w; w.x = cvtpk(o[tt][ct][4 * rg + 0] * rn * gv[0], o[tt][ct][4 * rg + 1] * rn * gv[1]); w.y = cvtpk(o[tt][ct][4 * rg + 2] * rn * gv[2], o[tt][ct][4 * rg + 3] * rn * gv[3]);
                *(LAS u32x2*)(wl + tok * 128 + (((4 * ct + rg) ^ (tok & 7)) * 16) + hi * 8) = w; } }
    MX_FENCE();
    const int prow = lane >> 3, pch = lane & 7;
#pragma unroll
    for (int i = 0; i < 8; ++i) { const int row = 8 * i + prow; const v4u v = *(const LAS v4u*)(wl + row * 128 + ((pch ^ (row & 7)) * 16));
        *(v4u*)(dst + (size_t)row * DM + pch * 8) = v; }
    MX_FENCE();
}

__device__ __forceinline__ void fill_bias_table(CArgs* a, int l, LAS unsigned char* lds) {
    const float* rel = a->in[5] + (size_t)l * 8 * 257; LAS float* tbl = (LAS float*)(lds + TBL_OFF);
    for (int i = threadIdx.x; i < 8 * TBL_LD; i += NWAVES * 64) { const int h = i / TBL_LD, k = i % TBL_LD; tbl[i] = rel[h * 257 + (k < 256 ? k : 256)] * pg8::LOG2E; }
}
__device__ __forceinline__ void mixer_fast(CArgs* a, int l, LAS unsigned char* lds, int wave, int lane, int vb) {
    const bf16* P = (const bf16*)(a->ws + WS_PROJ); bf16* MIX = (bf16*)(a->ws + WS_MIX);
    const float* vgss = (const float*)(a->ws + WS_VGSS); const bf16* wsp_l = (const bf16*)(a->ws + WS_WSP) + (size_t)l * 8 * 128 * 128;
    const float* rel = a->in[5] + (size_t)l * 8 * 257; const float* sgu_g = a->in[6] + l * 512; const float* bsp_l = a->in[8] + l * 8 * 128;
    const float* ag = a->in[9] + l * 512; const float* gg = a->in[10] + l * 512;
    LAS float* tbl = (LAS float*)(lds + TBL_OFF); LAS float* red = (LAS float*)(lds + RED_OFF); LAS float* rstab = (LAS float*)(lds + RS_OFF);
    LAS unsigned char* wl = lds + wave * 16384;
    for (int u = vb; u < NB * (SEQ / 64); u += gridDim.x) {
        const int b = u & 7, c = u >> 3;
        const size_t tok0 = (size_t)b * SEQ + c * 64;
        if (wave == 0) {
            const char* src = (const char*)(vgss + ((size_t)b * SEQ + (c >> 1) * 128) * 8) + lane * 16;
#pragma unroll
            for (int i = 0; i < 4; ++i) __builtin_amdgcn_global_load_lds((const unsigned*)(src + i * 1024), (LAS unsigned*)(lds + RS_OFF + i * 1024), 16, 0, 0);
        }
        f32x16 o[2][2];
        REPEAT(7) attn_task(P, b, c, wave, wl, tbl + wave * TBL_LD, lane, o);
        norm_store(o, red, wl, wave, lane, ag + wave * 64, MIX + tok0 * DM + wave * 64);
        REPEAT(8) sgu_task(P, rstab, wsp_l, sgu_g, bsp_l, b, c, wave, wl, lane, o);
        norm_store(o, red + 512, wl, wave, lane, gg + wave * 64, MIX + tok0 * DM + 512 + wave * 64);
    }
    __syncthreads();
}
}

__global__ void __launch_bounds__(NWAVES * 64, 2) fwd_megakernel(Args a_unused) {
    extern __shared__ __attribute__((aligned(16))) unsigned char lds_raw[];
    LAS unsigned char* lds = (LAS unsigned char*)lds_raw;
    if (threadIdx.x < 16) ((LAS unsigned*)(lds + MISC_OFF))[threadIdx.x] = 0u;
    __syncthreads();
    (void)xcd_barrier_post((unsigned*)(kargs_ws() + WS_BAR), (volatile LAS unsigned*)(lds + MISC_OFF));
    if (threadIdx.x == 64) { const unsigned x_ = xb_xcc_id(); ((volatile LAS unsigned*)(lds + MISC_OFF))[7] = xb_add((unsigned*)(kargs_ws() + WS_XIDX) + 64 * x_, 1u); }
    { const int tid = threadIdx.x, lane = tid & 63, wave = __builtin_amdgcn_readfirstlane(tid >> 6);
      REPEAT(0) prologue(kargs(), lds, wave, lane); }
    GRID_BAR();
    if (threadIdx.x == 64) { volatile LAS unsigned* mi = (volatile LAS unsigned*)(lds + MISC_OFF); unsigned* xi = (unsigned*)(kargs_ws() + WS_XIDX); bool ok = (gridDim.x & 7u) == 0u;
        for (int j = 0; j < 16; ++j) { const unsigned cj = xb_ld(xi + 64 * j); ok = ok && (j < 8 ? cj == (gridDim.x >> 3) : cj == 0u); }
        mi[6] = ok ? mi[7] * 8u + xb_xcc_id() : blockIdx.x; mi[4] = ok ? 1u : 0u; }
    __syncthreads();
#if (REPM >> 6) & 1
    for (int i_ = 0; i_ < 10; ++i_) GRID_BAR();
#endif
#pragma nounroll
    for (int l = 0; l < DEPTH; ++l) {
#if PHM & 1
        REPEAT(1) {
            CArgs* a = kargs(); unsigned char* ws = a->ws; unsigned char* wb = ws + WS_W0 + (size_t)l * WS_WSTRIDE;
            pg8::Gemm g{(const bf16*)(ws + WS_XB), (const bf16*)(wb + WOFF_IN), M, NIN, DM}; pg8::StaticOrder S; S.init(M, NIN, (int)gridDim.x, VBID());
            pg8::Unit u0; u0.pm = -1; u0.pn = 0; (void)S.next(0, u0);
            { LAS float* rsl = (LAS float*)(lds + 131072); const int t_ = threadIdx.x;
              if (u0.pm >= 0 && t_ < 256) rsl[t_] = pg8::row_rs((const float*)(ws + WS_ROWSS), u0.pm * 256 + t_);
              else if (t_ >= 256 && t_ < 384) rsl[t_] = t_ < 320 ? a->in[3][l * 64 + t_ - 256] * pg8::QSCALE : a->in[4][l * 64 + t_ - 320];
              __syncthreads(); }
            pg8::EpiInProj E{(bf16*)(ws + WS_PROJ), (const float*)(ws + WS_ROWSS), (float*)(ws + WS_VGSS), a->in[3] + l * 64, a->in[4] + l * 64, (const LAS float*)(lds + 131072), u0.pm};
            pg8::gemm_phase<pg8::EpiInProj, pg8::StaticOrder, true, true>(lds, g, S, E);
        }
#endif
        if (l == 0 && 2 * VBID() >= (int)gridDim.x) {
            int tid = threadIdx.x; asm volatile("" : "+v"(tid)); const int lane = tid & 63, wave = __builtin_amdgcn_readfirstlane(tid >> 6);
            const int half = gridDim.x - gridDim.x / 2;
            convert_weights(kargs(), lds, wave, lane, CW_I_IN, CW_I_LAYER, (VBID() - (int)gridDim.x / 2) * NWAVES + wave, half * NWAVES);
        }
#if FAST_MIXER
        mx::fill_bias_table(kargs(), l, lds);
#endif
        if (l == 0) GRID_BAR(); else GROUP_BAR();
#if PHM & 2
        REPEAT(2) { int tid = threadIdx.x; asm volatile("" : "+v"(tid)); const int lane = tid & 63, wave = __builtin_amdgcn_readfirstlane(tid >> 6);
#if FAST_MIXER
          mx::mixer_fast(kargs(), l, lds, wave, lane, VBID());
#else
          mixer_naive(kargs(), l, lds, wave, lane);
#endif
        }
#endif
#if PHM & 4
        REPEAT(3) {
            CArgs* a = kargs(); unsigned char* ws = a->ws; unsigned char* wb = ws + WS_W0 + (size_t)l * WS_WSTRIDE; float* xo = a->out;
            pg8::Gemm g{(const bf16*)(ws + WS_MIX), (const bf16*)(wb + WOFF_OUT), M, DM, DM}; pg8::StaticOrder S; S.init(M, DM, (int)gridDim.x, VBID());
            pg8::EpiResid E{l == 0 ? a->in[0] : (const float*)nullptr, (float*)nullptr, (bf16*)(ws + WS_XB), (float*)(ws + WS_ROWSS)};
            PreGroupBar pre{ws, (volatile LAS unsigned*)(lds + MISC_OFF)};
            pg8::gemm_phase<pg8::EpiResid, pg8::StaticOrder, false, true, false, PreGroupBar>(lds, g, S, E, pre);
        }
#endif
        GROUP_BAR();
#if PHM & 8
        REPEAT(4) {
            CArgs* a = kargs(); unsigned char* ws = a->ws; unsigned char* wb = ws + WS_W0 + (size_t)l * WS_WSTRIDE;
            pg8::Gemm g{(const bf16*)(ws + WS_XB), (const bf16*)(wb + WOFF_FIN), M, NFF2, DM}; pg8::StaticOrder S; S.init(M, NFF2, (int)gridDim.x, VBID());
            pg8::Unit u0; u0.pm = -1; u0.pn = 0; (void)S.next(0, u0);
            { LAS float* rsl = (LAS float*)(lds + 131072); if (u0.pm >= 0 && threadIdx.x < 256) rsl[threadIdx.x] = pg8::row_rs((const float*)(ws + WS_ROWSS), u0.pm * 256 + (int)threadIdx.x); __syncthreads(); }
            pg8::EpiSwiGLU E{(bf16*)(ws + WS_HID), (const float*)(ws + WS_ROWSS), (const LAS float*)(lds + 131072), u0.pm};
            pg8::gemm_phase<pg8::EpiSwiGLU, pg8::StaticOrder, true, true>(lds, g, S, E);
        }
#endif
        if (l == 0 && 2 * VBID() >= (int)gridDim.x) {
            int tid = threadIdx.x; asm volatile("" : "+v"(tid)); const int lane = tid & 63, wave = __builtin_amdgcn_readfirstlane(tid >> 6);
            const int half = gridDim.x - gridDim.x / 2;
            convert_weights(kargs(), lds, wave, lane, CW_I_LAYER, 2 * CW_I_LAYER, (VBID() - (int)gridDim.x / 2) * NWAVES + wave, half * NWAVES);
        }
#if PHM & 16
        REPEAT(5) {
            CArgs* a = kargs(); unsigned char* ws = a->ws; unsigned char* wb = ws + WS_W0 + (size_t)l * WS_WSTRIDE; float* xo = a->out;
            pg8::Gemm g{(const bf16*)(ws + WS_HID), (const bf16*)(wb + WOFF_FOUT), M, DM, DFF}; pg8::StaticOrder S; S.init(M, DM, (int)gridDim.x, VBID());
            pg8::EpiResid E{(const float*)nullptr, l + 1 < DEPTH ? (float*)nullptr : xo, (bf16*)(ws + WS_XB), (float*)(ws + WS_ROWSS)};
            PreGroupBar pre{ws, (volatile LAS unsigned*)(lds + MISC_OFF)};
            pg8::gemm_phase<pg8::EpiResid, pg8::StaticOrder, false, true, true, PreGroupBar>(lds, g, S, E, pre);
        }
#endif
        if (l + 1 < DEPTH) GRID_BAR();
    }
}

extern "C" void kernel_launch(void* const* d_in, const int* in_sizes, int n_in, void* d_out, int out_size, void* d_ws, size_t ws_size, hipStream_t stream) {
    static int grid = 0;
    if (grid == 0) {
        if (n_in != 15 || in_sizes[0] != M * DM || out_size != M * DM || ws_size < WS_END) { fprintf(stderr, "kernel_launch: unexpected shapes (n_in %d, ws %zu)\n", n_in, ws_size); grid = -1; return; }
        int dev = 0, cus = 0, per_cu = 0;
        hipGetDevice(&dev); hipDeviceGetAttribute(&cus, hipDeviceAttributeMultiprocessorCount, dev);
        if (hipFuncSetAttribute((const void*)fwd_megakernel, hipFuncAttributeMaxDynamicSharedMemorySize, LDS_BYTES) != hipSuccess) { fprintf(stderr, "kernel_launch: hipFuncSetAttribute failed\n"); grid = -1; return; }
        if (hipOccupancyMaxActiveBlocksPerMultiprocessor(&per_cu, (const void*)fwd_megakernel, NWAVES * 64, LDS_BYTES) != hipSuccess || per_cu < 1) { fprintf(stderr, "kernel_launch: occupancy query failed (%d)\n", per_cu); (void)hipGetLastError(); per_cu = 1; }
        grid = cus * (per_cu > 1 ? 1 : per_cu);
        if (grid != 256) { fprintf(stderr, "kernel_launch: built for a 256-CU device (one 256x256 unit per workgroup in the N = 1024 phases); got %d\n", grid); grid = -1; return; }
    }
    if (grid < 0) return;
    if (hipMemsetAsync((char*)d_ws + WS_BAR, 0, BAR_ZERO_BYTES, stream) != hipSuccess) { fprintf(stderr, "kernel_launch: hipMemsetAsync failed\n"); return; }
    Args a{};
    for (int i = 0; i < 15; ++i) a.in[i] = (const float*)d_in[i];
    a.out = (float*)d_out; a.ws = (unsigned char*)d_ws;
    void* args[] = {&a};
    hipError_t e = hipLaunchCooperativeKernel((const void*)fwd_megakernel, dim3(grid), dim3(NWAVES * 64), args, LDS_BYTES, stream);
    if (e != hipSuccess) fprintf(stderr, "cooperative launch failed: %s (grid %d)\n", hipGetErrorString(e), grid);
}
```

```cpp
#include <hip/hip_runtime.h>
#include <hip/hip_cooperative_groups.h>
#include <cstdio>
#include <cstdint>
namespace cg = cooperative_groups;
namespace pg8 {
#define PG8_LAS __attribute__((address_space(3)))
typedef unsigned short bf16_t;
typedef short bf16x8 __attribute__((ext_vector_type(8)));
typedef float f32x4 __attribute__((ext_vector_type(4)));
typedef unsigned u32x4 __attribute__((ext_vector_type(4)));
constexpr int BM = 256, BK = 64, HALF = 128, HTB = HALF * BK * 2  , STAGE_BYTES = 8 * HTB, NXCD = 8, WGM = 8;

__host__ __device__ __forceinline__ int lds_byte(int r, int c) { const int st = (r >> 4) * 2 + (c >> 5), rr = r & 15, cc = c & 31, ob = rr * 64 + cc * 2; return st * 1024 + (ob ^ (((ob >> 9) & 1) << 5)); }
__host__ __device__ __forceinline__ void stage_rc(int b, int& R, int& C) { const int st = b / 1024, sb = b % 1024, swz = sb ^ (((sb >> 9) & 1) << 5); R = (st >> 1) * 16 + swz / 64; C = (st & 1) * 32 + (swz % 64) / 2; }
__host__ __device__ __forceinline__ int perm32(int rho) { const int n = rho >> 4, i = rho & 15; return 8 * (i >> 2) + 4 * n + (i & 3); }

struct Unit { int pm, pn; };
struct Gemm { const bf16_t* A; const bf16_t* Bt; int M, N, K; };

struct StaticOrder {
    int nM, nN, nwg, G, c;
    __host__ __device__ void init(int M, int N, int G_, int c_) { nM = M / BM; nN = N / BM; nwg = nM * nN; G = G_; c = c_; }
    __host__ __device__ bool next(int i, Unit& u) const {
        const long L = (long)i * G + c; if (L >= nwg) return false;
        int wgid = (int)L; { const int q = nwg / NXCD, r = nwg % NXCD, xcd = wgid % NXCD, off = wgid / NXCD; wgid = (xcd < r ? xcd * (q + 1) : r * (q + 1) + (xcd - r) * q) + off; }
        const int nig = WGM * nN, gid = wgid / nig, fm = gid * WGM, gsz = (nM - fm) < WGM ? (nM - fm) : WGM;
        u.pm = fm + ((wgid % nig) % gsz); u.pn = (wgid % nig) / gsz; return true;
    }
    __device__ __forceinline__ void a_ready(const Unit&) const {}
    __device__ __forceinline__ void done(const Unit&) const {}
};

__device__ __forceinline__ unsigned cvt_pk_bf16(float lo, float hi) { unsigned r; asm volatile("v_cvt_pk_bf16_f32 %0, %1, %2" : "=v"(r) : "v"(lo), "v"(hi)); return r; }
typedef float f32x2 __attribute__((ext_vector_type(2)));
constexpr float RMS_EPS = 1e-6f;
constexpr float LOG2E = 1.4426950408889634f;
constexpr float QSCALE = 0.125f * 1.4426950408889634f;
__device__ __forceinline__ float gelu_tanh(float x) {
    const float z2 = x * (1.5957691216057308f + 0.07135481627260025f * x * x);
    const float e = __builtin_amdgcn_exp2f(-LOG2E * z2);
    return x * __builtin_amdgcn_rcpf(1.0f + e);
}
__device__ __forceinline__ float row_rs(const float* rowss, int row) {
    const f32x4 a = *(const f32x4*)(rowss + (size_t)row * 4);
    return __builtin_amdgcn_rsqf(((a[0] + a[1]) + (a[2] + a[3])) * (1.0f / 1024.0f) + RMS_EPS);
}
struct EpiInProj {
    static constexpr bool PERM = true, AFTER_DRAIN = false, INIT = false;
    bf16_t* P; const float* rowss; float* vgss; const float* qg; const float* kg; const PG8_LAS float* rs_lds; int pm_cached;
    __device__ __forceinline__ void operator()(const f32x4 (&acc)[2][2][4][2], const Unit& u, int wr, int wc, int fr, int fq) const {
        const int region = u.pn >> 1, half = u.pn & 1;
        const int lcol = region * 512 + half * 256 + wc * 64 + fq * 8;
        float gq[2][8];
#pragma unroll
        for (int bj = 0; bj < 2; ++bj)
#pragma unroll
            for (int e = 0; e < 8; ++e) gq[bj][e] = 1.f;
        if (region < 2) { const PG8_LAS float* g = rs_lds + 256 + region * 64;
#pragma unroll
            for (int bj = 0; bj < 2; ++bj)
#pragma unroll
                for (int e = 0; e < 8; ++e) gq[bj][e] = g[bj * 32 + fq * 8 + e]; }
#pragma unroll
        for (int ai = 0; ai < 2; ++ai)
#pragma unroll
            for (int m = 0; m < 4; ++m) {
                const int row = u.pm * BM + ai * HALF + wr * 64 + m * 16 + fr;
                const float s = (u.pm == pm_cached) ? rs_lds[ai * HALF + wr * 64 + m * 16 + fr] : row_rs(rowss, row);
                float v[2][8];
#pragma unroll
                for (int bj = 0; bj < 2; ++bj)
#pragma unroll
                    for (int n = 0; n < 2; ++n)
#pragma unroll
                        for (int i = 0; i < 4; ++i) v[bj][4 * n + i] = acc[ai][bj][m][n][i] * s;
                if (region < 2) {
                    float q = 0.f;
#pragma unroll
                    for (int bj = 0; bj < 2; ++bj)
#pragma unroll
                        for (int e = 0; e < 8; ++e) q += v[bj][e] * v[bj][e];
                    q += __shfl_xor(q, 16); q += __shfl_xor(q, 32);
                    const float r = __builtin_amdgcn_rsqf(q * (1.0f / 64.0f) + RMS_EPS);
#pragma unroll
                    for (int bj = 0; bj < 2; ++bj)
#pragma unroll
                        for (int e = 0; e < 8; ++e) v[bj][e] = v[bj][e] * r * gq[bj][e];
                } else if (region >= 3) {
#pragma unroll
                    for (int bj = 0; bj < 2; ++bj)
#pragma unroll
                        for (int e = 0; e < 8; ++e) v[bj][e] = gelu_tanh(v[bj][e]);
                    if (region == 4) {
                        float q = 0.f;
#pragma unroll
                        for (int bj = 0; bj < 2; ++bj)
#pragma unroll
                            for (int e = 0; e < 8; ++e) q += v[bj][e] * v[bj][e];
                        q += __shfl_xor(q, 16); q += __shfl_xor(q, 32);
                        if (fq == 0) vgss[(size_t)row * 8 + half * 4 + wc] = q;
                    }
                }
                bf16_t* rowp = P + (size_t)row * 2560 + lcol;
#pragma unroll
                for (int bj = 0; bj < 2; ++bj) { u32x4 w; w.x = cvt_pk_bf16(v[bj][0], v[bj][1]); w.y = cvt_pk_bf16(v[bj][2], v[bj][3]); w.z = cvt_pk_bf16(v[bj][4], v[bj][5]); w.w = cvt_pk_bf16(v[bj][6], v[bj][7]);
                    *(u32x4*)(rowp + bj * 32) = w; }
            }
    }
};
struct EpiResid {
    static constexpr bool PERM = true, AFTER_DRAIN = true, INIT = true;
    const float* base32; float* out32; bf16_t* xb; float* rowss;
    __device__ __forceinline__ void init(f32x4 (&acc)[2][2][4][2], const Unit& u, int wr, int wc, int fr, int fq) const {
        const int col0 = u.pn * BM + wc * 32 + 8 * fq;
        if (base32) {
#pragma unroll
            for (int ai = 0; ai < 2; ++ai)
#pragma unroll
                for (int m = 0; m < 4; ++m) { const size_t off = (size_t)(u.pm * BM + ai * HALF + wr * 64 + m * 16 + fr) * 1024 + col0;
#pragma unroll
                    for (int bj = 0; bj < 2; ++bj) { acc[ai][bj][m][0] = __builtin_nontemporal_load((const f32x4*)(base32 + off + bj * HALF)); acc[ai][bj][m][1] = __builtin_nontemporal_load((const f32x4*)(base32 + off + bj * HALF + 4)); } }
        } else {
#pragma unroll
            for (int ai = 0; ai < 2; ++ai)
#pragma unroll
                for (int m = 0; m < 4; ++m) { const size_t off = (size_t)(u.pm * BM + ai * HALF + wr * 64 + m * 16 + fr) * 1024 + col0;
#pragma unroll
                    for (int bj = 0; bj < 2; ++bj) { const u32x4 w = *(const u32x4*)(xb + off + bj * HALF);
                        acc[ai][bj][m][0] = (f32x4){__builtin_bit_cast(float, w.x << 16), __builtin_bit_cast(float, w.x & 0xffff0000u), __builtin_bit_cast(float, w.y << 16), __builtin_bit_cast(float, w.y & 0xffff0000u)};
                        acc[ai][bj][m][1] = (f32x4){__builtin_bit_cast(float, w.z << 16), __builtin_bit_cast(float, w.z & 0xffff0000u), __builtin_bit_cast(float, w.w << 16), __builtin_bit_cast(float, w.w & 0xffff0000u)}; } }
        }
    }
    __device__ __forceinline__ void fused(f32x4 (&acc)[2][2][4][2], const Unit& u, int wr, int wc, int fr, int fq, PG8_LAS unsigned char* lds, int wid, int lane) const {
        PG8_LAS float* part = (PG8_LAS float*)lds;
        const int col0 = u.pn * BM + wc * 32 + 8 * fq;
#pragma unroll
        for (int ai = 0; ai < 2; ++ai)
#pragma unroll
            for (int m = 0; m < 4; ++m) {
                const int rl = ai * HALF + wr * 64 + m * 16 + fr;
                const size_t off = (size_t)(u.pm * BM + rl) * 1024 + col0;
                float q = 0.f;
#pragma unroll
                for (int bj = 0; bj < 2; ++bj) {
                    const f32x4 v0 = acc[ai][bj][m][0], v1 = acc[ai][bj][m][1];
                    if (out32) { *(f32x4*)(out32 + off + bj * HALF) = v0; *(f32x4*)(out32 + off + bj * HALF + 4) = v1; }
                    else { u32x4 w; w.x = cvt_pk_bf16(v0[0], v0[1]); w.y = cvt_pk_bf16(v0[2], v0[3]); w.z = cvt_pk_bf16(v1[0], v1[1]); w.w = cvt_pk_bf16(v1[2], v1[3]);
                        *(u32x4*)(xb + off + bj * HALF) = w; }
                    q += (v0[0] * v0[0] + v0[1] * v0[1]) + (v0[2] * v0[2] + v0[3] * v0[3]) + (v1[0] * v1[0] + v1[1] * v1[1]) + (v1[2] * v1[2] + v1[3] * v1[3]);
                }
                q += __shfl_xor(q, 16); q += __shfl_xor(q, 32);
                if (fq == 0) part[rl * 4 + wc] = q;
            }
        asm volatile("s_waitcnt lgkmcnt(0)" ::: "memory"); __builtin_amdgcn_s_barrier(); asm volatile("" ::: "memory");
        const int t = wid * 64 + lane;
        if (t < 256) { const f32x4 p = *(const PG8_LAS f32x4*)(part + t * 4); rowss[(size_t)(u.pm * BM + t) * 4 + u.pn] = (p[0] + p[1]) + (p[2] + p[3]); }
    }
};
struct EpiSwiGLU {
    static constexpr bool PERM = true, AFTER_DRAIN = false, INIT = false;
    bf16_t* H; const float* rowss; const PG8_LAS float* rs_lds; int pm_cached;
    __device__ __forceinline__ void operator()(const f32x4 (&acc)[2][2][4][2], const Unit& u, int wr, int wc, int fr, int fq) const {
        const int col0 = u.pn * 128 + wc * 32 + 8 * fq;
#pragma unroll
        for (int ai = 0; ai < 2; ++ai)
#pragma unroll
            for (int m = 0; m < 4; ++m) {
                const int row = u.pm * BM + ai * HALF + wr * 64 + m * 16 + fr;
                const float s = (u.pm == pm_cached) ? rs_lds[ai * HALF + wr * 64 + m * 16 + fr] : row_rs(rowss, row);
                float h[8];
#pragma unroll
                for (int n = 0; n < 2; ++n)
#pragma unroll
                    for (int i = 0; i < 4; ++i) { const float g = acc[ai][0][m][n][i] * s, up = acc[ai][1][m][n][i] * s;
                        h[4 * n + i] = g * __builtin_amdgcn_rcpf(1.0f + __builtin_amdgcn_exp2f(-LOG2E * g)) * up; }
                u32x4 w; w.x = cvt_pk_bf16(h[0], h[1]); w.y = cvt_pk_bf16(h[2], h[3]); w.z = cvt_pk_bf16(h[4], h[5]); w.w = cvt_pk_bf16(h[6], h[7]);
                *(u32x4*)(H + ((size_t)(col0 >> 6) * 16384 + row) * 64 + (col0 & 63)) = w;
            }
    }
};
struct NoPre { __device__ __forceinline__ void drain() const {} __device__ __forceinline__ void sync() const {} };
template <class Epi, class Sched, bool ALIGN_EPI = false, bool SP2 = false, bool TILED = false, class Pre = NoPre>
__device__ __forceinline__ void gemm_phase(PG8_LAS unsigned char* lds, const Gemm g, const Sched& S, const Epi& E, const Pre& pre = Pre()) {
    int tid_l = threadIdx.x; asm volatile("" : "+v"(tid_l));
    const int tid = tid_l, wid = __builtin_amdgcn_readfirstlane(tid >> 6), lane = tid & 63, wr = wid >> 2, wc = wid & 3, fr = lane & 15, fq = lane >> 4;
    const int K = g.K, nt = K / BK;
    unsigned voffA[2], voffB[2];
#pragma unroll
    for (int i = 0; i < 2; ++i) { int R, C; stage_rc(tid * 16 + i * 8192, R, C); const int Rb = Epi::PERM ? ((R & ~31) + perm32(R & 31)) : R;
        const int lda = TILED ? 64 : K; voffA[i] = (unsigned)(R * lda + C) * 2u; voffB[i] = (unsigned)(Rb * lda + C) * 2u; }
    const size_t kstepA = TILED ? (size_t)g.M * BK * 2 : (size_t)(BK * 2), kstepB = TILED ? (size_t)g.N * BK * 2 : (size_t)(BK * 2);
    const size_t hstep = (size_t)HALF * (TILED ? 64 : K) * 2;
    const size_t tstep = 2 * hstep;
    const unsigned ldsw = (unsigned)wid * 1024u;
    const int aoff = lds_byte(wr * 64 + fr, fq * 8), boff = lds_byte(wc * 32 + fr, fq * 8);
#define PG8_SA(b, h) (((b) * 2 + (h)) * HTB)
#define PG8_SB(b, h) ((4 + (b) * 2 + (h)) * HTB)
#define PG8_STAGE(bufoff, gbase, voff) do { _Pragma("unroll") for (int _i = 0; _i < 2; ++_i) \
        __builtin_amdgcn_global_load_lds((const unsigned*)((const char*)(gbase) + (voff)[_i]), (PG8_LAS unsigned*)(lds + (bufoff) + ldsw + _i * 8192), 16, 0, 0); } while (0)
#define PG8_LDA(dst, b, h) do { _Pragma("unroll") for (int m = 0; m < 4; ++m) _Pragma("unroll") for (int k = 0; k < 2; ++k) dst[m][k] = *(const PG8_LAS bf16x8*)(lds + PG8_SA(b, h) + aoff + m * 2048 + k * 1024); } while (0)
#define PG8_LDB(dst, b, h) do { _Pragma("unroll") for (int n = 0; n < 2; ++n) _Pragma("unroll") for (int k = 0; k < 2; ++k) dst[n][k] = *(const PG8_LAS bf16x8*)(lds + PG8_SB(b, h) + boff + n * 2048 + k * 1024); } while (0)
#define PG8_MMA(ai, bj, At, Bt) do { __builtin_amdgcn_s_setprio(1); _Pragma("unroll") for (int m = 0; m < 4; ++m) _Pragma("unroll") for (int n = 0; n < 2; ++n) _Pragma("unroll") for (int k = 0; k < 2; ++k) \
        acc[ai][bj][m][n] = __builtin_amdgcn_mfma_f32_16x16x32_bf16(Bt[n][k], At[m][k], acc[ai][bj][m][n], 0, 0, 0); __builtin_amdgcn_s_setprio(0); } while (0)
#define PG8_WAIT_V(n) asm volatile("s_waitcnt vmcnt(" #n ")" ::: "memory")
#define PG8_WAIT_L(n) asm volatile("s_waitcnt lgkmcnt(" #n ")" ::: "memory")
#define PG8_BAR __builtin_amdgcn_s_barrier()
#define PG8_SCHED __builtin_amdgcn_sched_barrier(0)
    Unit cur, nxt; int ui = 0;
    if (!S.next(0, cur)) return;
    f32x4 acc[2][2][4][2];
    pre.drain();
    if constexpr (Epi::INIT) E.init(acc, cur, wr, wc, fr, fq);
    else {
#pragma unroll
    for (int a = 0; a < 2; ++a)
#pragma unroll
        for (int b = 0; b < 2; ++b)
#pragma unroll
            for (int m = 0; m < 4; ++m)
#pragma unroll
                for (int n = 0; n < 2; ++n) acc[a][b][m][n] = (f32x4){0.f, 0.f, 0.f, 0.f};
    }
    pre.sync();
    bf16x8 At[4][2], B0[2][2], B1[2][2];
    const char* cA = (const char*)g.A + (size_t)cur.pm * tstep; const char* cB = (const char*)g.Bt + (size_t)cur.pn * tstep;
    S.a_ready(cur);
    if constexpr (SP2) {
        PG8_STAGE(PG8_SB(0, 0), cB, voffB); PG8_STAGE(PG8_SB(0, 1), cB + hstep, voffB); PG8_STAGE(PG8_SA(0, 0), cA, voffA); PG8_STAGE(PG8_SA(0, 1), cA + hstep, voffA);
        if (wr == 1) PG8_BAR;
        PG8_WAIT_V(2); PG8_BAR;
        PG8_STAGE(PG8_SB(1, 0), cB + kstepB, voffB); PG8_STAGE(PG8_SA(1, 0), cA + kstepA, voffA); PG8_STAGE(PG8_SB(1, 1), cB + hstep + kstepB, voffB);
        PG8_WAIT_V(6); PG8_BAR;
    } else {
        PG8_STAGE(PG8_SB(0, 0), cB, voffB); PG8_STAGE(PG8_SA(0, 0), cA, voffA); PG8_STAGE(PG8_SB(0, 1), cB + hstep, voffB); PG8_STAGE(PG8_SA(0, 1), cA + hstep, voffA);
        if (wr == 1) PG8_BAR;
        PG8_WAIT_V(4); PG8_BAR;
        PG8_STAGE(PG8_SB(1, 0), cB + kstepB, voffB); PG8_STAGE(PG8_SA(1, 0), cA + kstepA, voffA); PG8_STAGE(PG8_SB(1, 1), cB + hstep + kstepB, voffB);
        PG8_WAIT_V(6); PG8_BAR;
    }
    for (;;) {
        const bool has_next = S.next(ui + 1, nxt);
        const char* nA = has_next ? (const char*)g.A + (size_t)nxt.pm * tstep : cA; const char* nB = has_next ? (const char*)g.Bt + (size_t)nxt.pn * tstep : cB;
        for (int t = 0; t < nt; t += 2) {
            const bool last = (t == nt - 2);
            const char* a1 = cA + (size_t)(t + 1) * kstepA;
            const char* a2 = last ? nA : cA + (size_t)(t + 2) * kstepA; const char* b2 = last ? nB : cB + (size_t)(t + 2) * kstepB;
            const char* a3 = a2 + kstepA; const char* b3 = b2 + kstepB;
            if (last && has_next) S.a_ready(nxt);
            if constexpr (SP2) {
            PG8_LDB(B0, 0, 0); PG8_LDB(B1, 0, 1); PG8_SCHED; PG8_LDA(At, 0, 0); PG8_STAGE(PG8_SA(1, 1), a1 + hstep, voffA);
            PG8_WAIT_V(8); PG8_WAIT_L(0); PG8_BAR; PG8_MMA(0, 0, At, B0); PG8_MMA(0, 1, At, B1); PG8_BAR; PG8_SCHED;
            PG8_LDA(At, 0, 1); PG8_STAGE(PG8_SB(0, 0), b2, voffB); PG8_STAGE(PG8_SB(0, 1), b2 + hstep, voffB); PG8_STAGE(PG8_SA(0, 0), a2, voffA);
            PG8_WAIT_V(8); PG8_WAIT_L(0); PG8_BAR; PG8_MMA(1, 0, At, B0); PG8_MMA(1, 1, At, B1); PG8_BAR; PG8_SCHED;
            PG8_LDB(B0, 1, 0); PG8_LDB(B1, 1, 1); PG8_SCHED; PG8_LDA(At, 1, 0); PG8_STAGE(PG8_SA(0, 1), a2 + hstep, voffA);
            PG8_WAIT_V(8); PG8_WAIT_L(0); PG8_BAR; PG8_MMA(0, 0, At, B0); PG8_MMA(0, 1, At, B1); PG8_BAR; PG8_SCHED;
            PG8_LDA(At, 1, 1); PG8_STAGE(PG8_SB(1, 0), b3, voffB); PG8_STAGE(PG8_SB(1, 1), b3 + hstep, voffB); PG8_STAGE(PG8_SA(1, 0), a3, voffA);
            PG8_WAIT_V(8); PG8_WAIT_L(0); PG8_BAR; PG8_MMA(1, 0, At, B0); PG8_MMA(1, 1, At, B1); PG8_BAR; PG8_SCHED;
            } else {
            PG8_LDB(B0, 0, 0); PG8_SCHED; PG8_LDA(At, 0, 0); PG8_STAGE(PG8_SA(1, 1), a1 + hstep, voffA);
            PG8_WAIT_L(8); PG8_BAR; PG8_WAIT_L(0); PG8_MMA(0, 0, At, B0); PG8_BAR; PG8_SCHED;
            PG8_LDB(B1, 0, 1); PG8_STAGE(PG8_SB(0, 0), b2, voffB);
            PG8_BAR; PG8_WAIT_L(0); PG8_MMA(0, 1, At, B1); PG8_BAR;
            PG8_LDA(At, 0, 1); PG8_STAGE(PG8_SA(0, 0), a2, voffA);
            PG8_BAR; PG8_WAIT_L(0); PG8_MMA(1, 0, At, B0); PG8_BAR; PG8_SCHED;
            PG8_STAGE(PG8_SB(0, 1), b2 + hstep, voffB);
            PG8_WAIT_V(6); PG8_BAR; PG8_MMA(1, 1, At, B1); PG8_BAR;
            PG8_LDB(B0, 1, 0); PG8_SCHED; PG8_LDA(At, 1, 0); PG8_STAGE(PG8_SA(0, 1), a2 + hstep, voffA);
            PG8_WAIT_L(8); PG8_BAR; PG8_WAIT_L(0); PG8_MMA(0, 0, At, B0); PG8_BAR; PG8_SCHED;
            PG8_LDB(B1, 1, 1); PG8_STAGE(PG8_SB(1, 0), b3, voffB);
            PG8_BAR; PG8_WAIT_L(0); PG8_MMA(0, 1, At, B1); PG8_BAR;
            PG8_LDA(At, 1, 1); PG8_STAGE(PG8_SA(1, 0), a3, voffA);
            PG8_BAR; PG8_WAIT_L(0); PG8_MMA(1, 0, At, B0); PG8_BAR; PG8_SCHED;
            PG8_STAGE(PG8_SB(1, 1), b3 + hstep, voffB);
            PG8_WAIT_V(6); PG8_BAR; PG8_MMA(1, 1, At, B1); PG8_BAR;
            }
        }
        if constexpr (ALIGN_EPI) { if (wr == 0) PG8_BAR; }
        if constexpr (!Epi::AFTER_DRAIN) { E(acc, cur, wr, wc, fr, fq); S.done(cur); }
        if (!has_next) break;
        if constexpr (Epi::INIT) E.init(acc, nxt, wr, wc, fr, fq);
        else {
#pragma unroll
        for (int a = 0; a < 2; ++a)
#pragma unroll
            for (int b = 0; b < 2; ++b)
#pragma unroll
                for (int m = 0; m < 4; ++m)
#pragma unroll
                    for (int n = 0; n < 2; ++n) acc[a][b][m][n] = (f32x4){0.f, 0.f, 0.f, 0.f};
        }
        cur = nxt; cA = nA; cB = nB; ++ui;
        if constexpr (ALIGN_EPI) { if (wr == 1) PG8_BAR; }
    }
    PG8_WAIT_V(0);
    if constexpr (!ALIGN_EPI) { if (wr == 0) PG8_BAR; }
    PG8_BAR;
    if constexpr (Epi::AFTER_DRAIN) { E.fused(acc, cur, wr, wc, fr, fq, lds, wid, lane); S.done(cur); }
#undef PG8_SA
#undef PG8_SB
#undef PG8_STAGE
#undef PG8_LDA
#undef PG8_LDB
#undef PG8_MMA
#undef PG8_WAIT_V
#undef PG8_WAIT_L
#undef PG8_BAR
#undef PG8_SCHED
}
}
constexpr int NB = 8, SEQ = 2048, DM = 1024, M = NB * SEQ, NIN = 2560, DFF = 2816, NFF2 = 2 * DFF, DEPTH = 2;
constexpr int NWAVES = 8;
constexpr size_t MiB = 1u << 20;
constexpr size_t WS_ROWSS = 1 * MiB;
constexpr size_t WS_VGSS = 2 * MiB;
constexpr size_t WS_WSP = 3 * MiB;
constexpr size_t WS_W0 = 4 * MiB, WS_WSTRIDE = 24 * MiB;
constexpr size_t WOFF_IN = 0, WOFF_OUT = 5 * MiB, WOFF_FIN = 7 * MiB, WOFF_FOUT = 18 * MiB;
constexpr size_t WS_XB = 52 * MiB;
constexpr size_t WS_PROJ = 84 * MiB;
constexpr size_t WS_MIX = 164 * MiB;
constexpr size_t WS_HID = 84 * MiB;
constexpr size_t WS_END = 196 * MiB;
constexpr int LDS_BYTES = 155648;

#define GAS __attribute__((address_space(1)))
#define LAS __attribute__((address_space(3)))
typedef unsigned short bf16;
typedef unsigned v4u __attribute__((ext_vector_type(4)));
typedef float f32x4 __attribute__((ext_vector_type(4)));
__device__ __forceinline__ unsigned f2bf(float f) { unsigned u = __builtin_bit_cast(unsigned, f); return (u + 0x7fffu + ((u >> 16) & 1u)) >> 16; }
__device__ __forceinline__ unsigned pk2(float lo, float hi) { return f2bf(lo) | (f2bf(hi) << 16); }
__device__ __forceinline__ float bf2f(bf16 v) { return __builtin_bit_cast(float, (unsigned)v << 16); }
__device__ __forceinline__ float wave_sum(float v) {
#pragma unroll
    for (int o = 1; o < 64; o <<= 1) v += __shfl_xor(v, o);
    return v;
}
#define LDS_WAIT() asm volatile("s_waitcnt lgkmcnt(0)" ::: "memory")

typedef short tp_s16x4 __attribute__((ext_vector_type(4)));
__device__ __forceinline__ void p0_transpose_item(const float* W, int K, int N, bf16* WT, int k0, int n0, int prow0, int prow1, const float* gk, LAS unsigned char* scr, int lane, int tiled_n = 0) {
    const int lr = lane >> 4, n4 = (lane & 15) * 4;
    f32x4 v[16];
#pragma unroll
    for (int i = 0; i < 16; ++i) v[i] = __builtin_nontemporal_load((const f32x4*)(W + (size_t)(k0 + 4 * i + lr) * N + n0 + n4));
#pragma unroll
    for (int i = 0; i < 16; ++i) { const int k = 4 * i + lr; const float gg = gk ? gk[k0 + k] : 1.f;
        unsigned long long w = (unsigned long long)pk2(v[i].x * gg, v[i].y * gg) | ((unsigned long long)pk2(v[i].z * gg, v[i].w * gg) << 32);
        *(LAS unsigned long long*)(scr + k * 128 + ((n4 * 2) ^ (((k >> 1) & 1) << 6))) = w; }
    asm volatile("" ::: "memory");
    const int hh = lane >> 5, g2 = (lane >> 4) & 1, i16 = lane & 15, qq = i16 >> 2, p4 = i16 & 3;
#pragma unroll
    for (int j = 0; j < 8; ++j) { const int c = 2 * (j >> 1) + hh, nb = 32 * (j & 1) + 16 * g2;
        const int a0 = (8 * c + qq) * 128 + (((nb + 4 * p4) * 2) ^ ((qq >> 1) << 6));
        const tp_s16x4 lo = __builtin_bit_cast(tp_s16x4, __builtin_amdgcn_ds_read_tr16_b64_v4i16((LAS tp_s16x4*)(scr + a0)));
        const tp_s16x4 hi4 = __builtin_bit_cast(tp_s16x4, __builtin_amdgcn_ds_read_tr16_b64_v4i16((LAS tp_s16x4*)(scr + a0 + 4 * 128)));
        typedef short s16x8_t __attribute__((ext_vector_type(8)));
        const s16x8_t o = (s16x8_t){lo[0], lo[1], lo[2], lo[3], hi4[0], hi4[1], hi4[2], hi4[3]};
        const int prow = ((j & 1) ? prow1 : prow0) + 16 * g2 + i16;
        *(s16x8_t*)(WT + (tiled_n ? ((size_t)(k0 >> 6) * tiled_n + prow) * 64 + 8 * c : (size_t)prow * K + k0 + 8 * c)) = o; }
    LDS_WAIT(); asm volatile("" ::: "memory");
}
__host__ __device__ __forceinline__ int map_in(int n) { const int T = n >> 8, nn = n & 255; return 256 * T + 128 * ((nn >> 5) & 1) + 32 * (nn >> 6) + (nn & 31); }
__host__ __device__ __forceinline__ int map_fin(int n) { return n < DFF ? 256 * (n >> 7) + (n & 127) : 256 * ((n - DFF) >> 7) + 128 + ((n - DFF) & 127); }

typedef GAS unsigned gu32;
#define RLX_AGENT __ATOMIC_RELAXED, __HIP_MEMORY_SCOPE_AGENT
constexpr int MISC_OFF = LDS_BYTES - 64;
constexpr size_t WS_BAR = 0;
constexpr size_t BAR_ZERO_BYTES = 32768;
#define XB_TMO      128
#define XB_XCNT(j)  (256  + 64 * (j))
#define XB_XSUB(j)  (1280 + 64 * (j))
#define XB_XGEN(j)  (2304 + 64 * (j))
#define XB_TOP      3328
#define XB_TOPGEN   3392
#define XCD_BAR_WORDS 3456
#define XB_SPIN_CAP (1u << 18)

__device__ __forceinline__ unsigned xb_ld(unsigned* p)              { return __hip_atomic_load(p, __ATOMIC_RELAXED, __HIP_MEMORY_SCOPE_AGENT); }
__device__ __forceinline__ unsigned xb_add(unsigned* p, unsigned v) { return __hip_atomic_fetch_add(p, v, __ATOMIC_RELAXED, __HIP_MEMORY_SCOPE_AGENT); }
__device__ __forceinline__ unsigned xb_xcc_id() { return (unsigned)__builtin_amdgcn_s_getreg((3 << 11) | 20) & 0xFu; }
#define XB_SPIN(cond, bar) do { unsigned _sp = 0; while (cond) { __builtin_amdgcn_s_sleep(1); \
    if ((++_sp & 255u) == 0u) { if (xb_ld(&(bar)[XB_TMO])) break; if (_sp > XB_SPIN_CAP) { atomicAdd(&(bar)[XB_TMO], 1u); break; } } } } while (0)

struct XcdBarrier {
    unsigned* bar; unsigned x;
    volatile LAS unsigned* st;
};

__device__ __forceinline__ XcdBarrier xcd_barrier_post(unsigned* bar, volatile LAS unsigned* st) {
    XcdBarrier b; b.bar = bar; b.x = xb_xcc_id(); b.st = st;
    if (threadIdx.x == 0) (void)xb_add(&bar[XB_XCNT(b.x)], 1u);
    return b;
}
__device__ __forceinline__ void xcd_barrier_complete(unsigned* bar, unsigned x, unsigned& nloc, unsigned& nx) {
    const unsigned G = gridDim.x * gridDim.y * gridDim.z;
    unsigned sum, cnt, mine, sp = 0u;
    for (;;) {
        sum = 0u; cnt = 0u; mine = 0u;
#pragma unroll
        for (unsigned j = 0; j < 16; ++j) { const unsigned c = xb_ld(&bar[XB_XCNT(j)]); sum += c; cnt += (c > 0u) ? 1u : 0u; mine = (j == x) ? c : mine; }
        if (sum == G) break;
        __builtin_amdgcn_s_sleep(1);
        if ((++sp & 255u) == 0u) { if (xb_ld(&bar[XB_TMO])) break; if (sp > XB_SPIN_CAP) { atomicAdd(&bar[XB_TMO], 1u); break; } }
    }
    nloc = mine > 0u ? mine : 1u; nx = cnt > 0u ? cnt : 1u;
}

__device__ __forceinline__ void xcd_barrier(const XcdBarrier& b) {
    asm volatile("s_waitcnt vmcnt(0)" ::: "memory");
    __syncthreads();
    if (threadIdx.x == 0) {
        unsigned* bar = b.bar;
        __builtin_amdgcn_s_waitcnt(0);
        unsigned nloc = b.st[0], nx = b.st[1];
        if (nloc == 0u) { xcd_barrier_complete(bar, b.x, nloc, nx); b.st[0] = nloc; b.st[1] = nx; }
        const unsigned old = xb_add(&bar[XB_XSUB(b.x)], 1u);
        const unsigned gen = old / nloc;
        if (old + 1u == (gen + 1u) * nloc) {
            __builtin_amdgcn_fence(__ATOMIC_RELEASE, "agent");
            asm volatile("s_waitcnt vmcnt(0)" ::: "memory");
            const unsigned og = xb_add(&bar[XB_TOP], 1u);
            const unsigned tg = og / nx;
            if (og + 1u == (tg + 1u) * nx) xb_add(&bar[XB_TOPGEN], 1u);
            else XB_SPIN(xb_ld(&bar[XB_TOPGEN]) == tg, bar);
            __builtin_amdgcn_fence(__ATOMIC_ACQUIRE, "agent");
            xb_add(&bar[XB_XGEN(b.x)], 1u);
            asm volatile("s_waitcnt vmcnt(0)" ::: "memory");
        } else {
            XB_SPIN(xb_ld(&bar[XB_XGEN(b.x)]) == gen, bar);
            __builtin_amdgcn_fence(__ATOMIC_ACQUIRE, "agent");
            asm volatile("s_waitcnt vmcnt(0)" ::: "memory");
        }
    }
    __syncthreads();
}

constexpr size_t WS_GCNT = 16384, WS_GMASK = 16384 + 8 * 256, WS_XIDX = 16384 + 16 * 256;
__device__ __forceinline__ void group_barrier(unsigned char* ws, volatile LAS unsigned* misc) {
    asm volatile("s_waitcnt vmcnt(0)" ::: "memory");
    __syncthreads();
    if (threadIdx.x == 0) {
        unsigned bx = misc[6];
        unsigned* cnt = (unsigned*)(ws + WS_GCNT) + 64 * (bx & 7u);
        const unsigned pure = misc[4], ep = misc[5] + 1u; misc[5] = ep;
        if (!pure) { __builtin_amdgcn_fence(__ATOMIC_RELEASE, "agent"); asm volatile("s_waitcnt vmcnt(0)" ::: "memory"); }
        const unsigned old_ = xb_add(cnt, 1u);
        if (pure) { __builtin_amdgcn_fence(__ATOMIC_ACQUIRE, "agent"); asm volatile("s_waitcnt vmcnt(0)" ::: "memory"); }
        const unsigned target = ep * (gridDim.x >> 3);
        unsigned sp = 0u;
        if (old_ + 1u < target) while (xb_ld(cnt) < target) { __builtin_amdgcn_s_sleep(1); if (++sp > (1u << 22)) break; }
        if (!pure) __builtin_amdgcn_fence(__ATOMIC_ACQUIRE, "agent");
        asm volatile("s_waitcnt vmcnt(0)" ::: "memory");
    }
    __syncthreads();
}
struct PreGroupBar {
    unsigned char* ws; volatile LAS unsigned* misc;
    __device__ __forceinline__ void drain() const { asm volatile("s_waitcnt vmcnt(0)" ::: "memory"); }
    __device__ __forceinline__ void sync() const {
        asm volatile("s_waitcnt lgkmcnt(0)" ::: "memory"); __builtin_amdgcn_s_barrier(); asm volatile("" ::: "memory");
        if (threadIdx.x == 0) {
            unsigned bx = misc[6];
            unsigned* cnt = (unsigned*)(ws + WS_GCNT) + 64 * (bx & 7u);
            const unsigned pure = misc[4], ep = misc[5] + 1u; misc[5] = ep;
            if (!pure) { __builtin_amdgcn_fence(__ATOMIC_RELEASE, "agent"); asm volatile("s_waitcnt vmcnt(0)" ::: "memory"); }
            const unsigned old_ = xb_add(cnt, 1u);
            if (pure) { __builtin_amdgcn_fence(__ATOMIC_ACQUIRE, "agent"); asm volatile("s_waitcnt vmcnt(0)" ::: "memory"); }
            const unsigned target = ep * (gridDim.x >> 3);
            unsigned sp = 0u;
            if (old_ + 1u < target) while (xb_ld(cnt) < target) { __builtin_amdgcn_s_sleep(1); if (++sp > (1u << 22)) break; }
            if (!pure) __builtin_amdgcn_fence(__ATOMIC_ACQUIRE, "agent");
            asm volatile("s_waitcnt vmcnt(0)" ::: "memory");
        }
        asm volatile("s_waitcnt lgkmcnt(0)" ::: "memory"); __builtin_amdgcn_s_barrier(); asm volatile("" ::: "memory");
    }
};
#define GROUP_BAR() group_barrier(kargs_ws(), (volatile LAS unsigned*)(lds + MISC_OFF))
#define VBID() ((int)__builtin_amdgcn_readfirstlane(((volatile LAS unsigned*)(lds + MISC_OFF))[6]))
#define GRID_BAR() do { XcdBarrier bar_; bar_.bar = (unsigned*)(kargs_ws() + WS_BAR); bar_.x = xb_xcc_id(); bar_.st = (volatile LAS unsigned*)(lds + MISC_OFF); xcd_barrier(bar_); } while (0)
struct Args { const float* in[15]; float* out; unsigned char* ws; };
typedef const __attribute__((address_space(4))) Args CArgs;
__device__ __forceinline__ CArgs* kargs();
__device__ __forceinline__ unsigned char* kargs_ws();
__device__ __forceinline__ CArgs* kargs() { CArgs* p = (CArgs*)__builtin_amdgcn_kernarg_segment_ptr(); asm volatile("" : "+s"(p)); return p; }
__device__ __forceinline__ unsigned char* kargs_ws() { return kargs()->ws; }

constexpr int CW_I_IN = (DM / 64) * (NIN / 64), CW_I_LAYER = CW_I_IN + (DM / 64) * (DM / 64) + (DM / 64) * (NFF2 / 64) + (DFF / 64) * (DM / 64);
__device__ __forceinline__ void convert_weights(CArgs* a, LAS unsigned char* lds, int wave, int lane, int it0, int it1, int gw, int NGW) {
    LAS unsigned char* scr = lds + wave * 16384;
    constexpr int I_IN = (DM / 64) * (NIN / 64), I_OUT = (DM / 64) * (DM / 64), I_FIN = (DM / 64) * (NFF2 / 64), I_FOUT = (DFF / 64) * (DM / 64);
    constexpr int I_LAYER = I_IN + I_OUT + I_FIN + I_FOUT;
    static_assert(I_IN == CW_I_IN && I_LAYER == CW_I_LAYER, "item counts");
#pragma nounroll
    for (int it = it0 + gw; it < it1; it += NGW) {
        const int l = it / I_LAYER; int r = it % I_LAYER;
        unsigned char* wb = a->ws + WS_W0 + (size_t)l * WS_WSTRIDE;
        if (r < I_IN) { const int nblk = NIN / 64, kb = r / nblk, nb = r % nblk;
            p0_transpose_item(a->in[2] + (size_t)l * DM * NIN, DM, NIN, (bf16*)(wb + WOFF_IN), 64 * kb, 64 * nb, map_in(64 * nb), map_in(64 * nb + 32), a->in[1] + l * DM, scr, lane); continue; } r -= I_IN;
        if (r < I_OUT) { const int nblk = DM / 64, kb = r / nblk, nb = r % nblk;
            p0_transpose_item(a->in[11] + (size_t)l * DM * DM, DM, DM, (bf16*)(wb + WOFF_OUT), 64 * kb, 64 * nb, 64 * nb, 64 * nb + 32, nullptr, scr, lane); continue; } r -= I_OUT;
        if (r < I_FIN) { const int nblk = NFF2 / 64, kb = r / nblk, nb = r % nblk;
            p0_transpose_item(a->in[13] + (size_t)l * DM * NFF2, DM, NFF2, (bf16*)(wb + WOFF_FIN), 64 * kb, 64 * nb, map_fin(64 * nb), map_fin(64 * nb + 32), a->in[12] + l * DM, scr, lane); continue; } r -= I_FIN;
        { const int nblk = DM / 64, kb = r / nblk, nb = r % nblk;
            p0_transpose_item(a->in[14] + (size_t)l * DFF * DM, DFF, DM, (bf16*)(wb + WOFF_FOUT), 64 * kb, 64 * nb, 64 * nb, 64 * nb + 32, nullptr, scr, lane, DM); }
    }
}
__device__ __forceinline__ void prologue(CArgs* a, LAS unsigned char* lds, int wave, int lane) {
    const int gw = blockIdx.x * NWAVES + wave, NGW = gridDim.x * NWAVES;
    convert_weights(a, lds, wave, lane, 0, CW_I_IN, gw, NGW);
    float* rowss = (float*)(a->ws + WS_ROWSS); bf16* xb = (bf16*)(a->ws + WS_XB);
#pragma nounroll
    for (int m0 = gw * 4; m0 < M; m0 += NGW * 4) {
        f32x4 v[4][4];
#pragma unroll
        for (int r = 0; r < 4; ++r) { const f32x4* xr = (const f32x4*)(a->in[0] + (size_t)(m0 + r) * DM) + lane;
#pragma unroll
            for (int j = 0; j < 4; ++j) v[r][j] = __builtin_nontemporal_load(xr + 64 * j); }
#pragma unroll
        for (int r = 0; r < 4; ++r) { unsigned long long* o8 = (unsigned long long*)(xb + (size_t)(m0 + r) * DM) + lane; float sq = 0.f;
#pragma unroll
            for (int j = 0; j < 4; ++j) { const f32x4 w = v[r][j]; sq += (w.x * w.x + w.y * w.y) + (w.z * w.z + w.w * w.w);
                o8[64 * j] = (unsigned long long)pk2(w.x, w.y) | ((unsigned long long)pk2(w.z, w.w) << 32); }
            sq = wave_sum(sq);
            if (lane < 4) rowss[(size_t)(m0 + r) * 4 + lane] = lane == 0 ? sq : 0.f; }
    }
    { const float* wsp = a->in[7]; bf16* o = (bf16*)(a->ws + WS_WSP); const int gt = blockIdx.x * 512 + threadIdx.x, NT = gridDim.x * 512;
      for (int i = gt; i < DEPTH * 8 * 128 * 128; i += NT) { const int s = i & 127, t = (i >> 7) & 127; o[i] = (bf16)(((t >> 6) >= (s >> 6)) ? f2bf(wsp[i]) : 0u); } }
}

__device__ __forceinline__ void mixer_naive(CArgs* a, int l, LAS unsigned char* lds, int wave, int lane) {
    const bf16* P = (const bf16*)(a->ws + WS_PROJ); bf16* MIX = (bf16*)(a->ws + WS_MIX);
    const float* vgss = (const float*)(a->ws + WS_VGSS); const bf16* wsp = (const bf16*)(a->ws + WS_WSP) + (size_t)l * 8 * 128 * 128;
    const float* rel = a->in[5] + (size_t)l * 8 * 257; const float* sgu_g = a->in[6] + l * 512; const float* bsp = a->in[8] + l * 8 * 128;
    const float* ag = a->in[9] + l * 512; const float* gg = a->in[10] + l * 512;
    LAS float* red = (LAS float*)lds;
    for (int tok = blockIdx.x; tok < M; tok += gridDim.x) {
        const int b = tok / SEQ, t = tok % SEQ, c = t >> 6;
        const int h = wave;
        const float q = bf2f(P[(size_t)tok * NIN + h * 64 + lane]);
        float mx = -INFINITY, lsum = 0.f, o = 0.f;
        const int k0 = (c >= 8 ? c - 8 : 0) * 64, k1 = c * 64 + 63;
        for (int kt = k0; kt <= k1; ++kt) {
            const size_t kr = (size_t)(b * SEQ + kt) * NIN;
            float s = wave_sum(q * bf2f(P[kr + 512 + h * 64 + lane]));
            int d = t - kt; d = d < -128 ? -128 : (d > 128 ? 128 : d);
            s += rel[h * 257 + d + 128] * pg8::LOG2E;
            const float mn = fmaxf(mx, s), al = __builtin_amdgcn_exp2f(mx - mn), p = __builtin_amdgcn_exp2f(s - mn);
            lsum = lsum * al + p; o = o * al + p * bf2f(P[kr + 1024 + h * 64 + lane]); mx = mn;
        }
        o = o / lsum;
        const int g = wave, nb = t >> 7, tp = t & 127, ns = tp < 64 ? 64 : 128;
        float mixd = 0.f;
        for (int s = 0; s < ns; ++s) {
            const int srow = b * SEQ + nb * 128 + s;
            const f32x4* pv = (const f32x4*)(vgss + (size_t)srow * 8); const f32x4 p0 = pv[0], p1 = pv[1];
            const float rs = __builtin_amdgcn_rsqf((((p0[0] + p0[1]) + (p0[2] + p0[3])) + ((p1[0] + p1[1]) + (p1[2] + p1[3]))) * (1.0f / 512.0f) + pg8::RMS_EPS);
            mixd += bf2f(wsp[(g * 128 + tp) * 128 + s]) * (bf2f(P[(size_t)srow * NIN + 2048 + g * 64 + lane]) * rs * sgu_g[g * 64 + lane]);
        }
        const float gv = bf2f(P[(size_t)tok * NIN + 1536 + g * 64 + lane]) * (mixd + bsp[g * 128 + tp]);
        const float so = wave_sum(o * o), sg = wave_sum(gv * gv);
        __syncthreads();
        if (lane == 0) { red[wave] = so; red[8 + wave] = sg; }
        __syncthreads();
        float ta = 0.f, tg = 0.f;
#pragma unroll
        for (int w = 0; w < 8; ++w) { ta += red[w]; tg += red[8 + w]; }
        const float ra = __builtin_amdgcn_rsqf(ta * (1.0f / 512.0f) + pg8::RMS_EPS), rg = __builtin_amdgcn_rsqf(tg * (1.0f / 512.0f) + pg8::RMS_EPS);
        MIX[(size_t)tok * DM + h * 64 + lane] = (bf16)f2bf(o * ra * ag[h * 64 + lane]);
        MIX[(size_t)tok * DM + 512 + g * 64 + lane] = (bf16)f2bf(gv * rg * gg[g * 64 + lane]);
    }
    __syncthreads();
}

#ifndef FAST_MIXER
#define FAST_MIXER 1
#endif
#ifndef PHM
#define PHM 31
#endif
#ifndef REPM
#define REPM 0
#endif
#define REPEAT(bit) for (int rep_ = 0; rep_ < (((REPM) >> (bit)) & 1) + 1; ++rep_)
namespace mx {
typedef float f32x16 __attribute__((ext_vector_type(16)));
typedef short bf16x8 __attribute__((ext_vector_type(8)));
typedef short s16x4 __attribute__((ext_vector_type(4)));
typedef unsigned u32x2 __attribute__((ext_vector_type(2)));
constexpr int TBL_OFF = 131072;
constexpr int TBL_LD = 320;
constexpr int RS_OFF = TBL_OFF + 8 * TBL_LD * 4 + 4096;
constexpr int RED_OFF = TBL_OFF + 8 * TBL_LD * 4;
__device__ __forceinline__ int crow(int r, int hi) { return (r & 3) + 8 * (r >> 2) + 4 * hi; }
__device__ __forceinline__ int vimg(int row, int chunk) { return row * 128 + ((chunk * 16) ^ (((row >> 1) & 1) << 6)); }
__device__ __forceinline__ s16x4 tr64(LAS unsigned char* p) { return __builtin_bit_cast(s16x4, __builtin_amdgcn_ds_read_tr16_b64_v4i16((LAS s16x4*)p)); }
__device__ __forceinline__ bf16x8 cat8(s16x4 a, s16x4 b) { return (bf16x8){a[0], a[1], a[2], a[3], b[0], b[1], b[2], b[3]}; }
__device__ __forceinline__ unsigned cvtpk(float lo, float hi) { unsigned r; asm("v_cvt_pk_bf16_f32 %0, %1, %2" : "=v"(r) : "v"(lo), "v"(hi)); return r; }
#ifndef ATTREP
#define ATTREP 1
#endif
#ifndef DMAREP
#define DMAREP 1
#endif
#if DMAREP == 1
#define MX_VM8 "s_waitcnt vmcnt(8)"
#else
#define MX_VM8 "s_waitcnt vmcnt(16)"
#endif
#define MX_FENCE() asm volatile("" ::: "memory")
__device__ __forceinline__ float max3f(float a, float b, float c) { float r; asm("v_max3_f32 %0, %1, %2, %3" : "=v"(r) : "v"(a), "v"(b), "v"(c)); return r; }

__device__ __forceinline__ void attn_task(const bf16* P, int b, int c, int h, LAS unsigned char* wl, const LAS float* tbl, int lane, f32x16 (&o)[2][2]) {
    const int r32 = lane & 31, hi = lane >> 5;
    const size_t tok0 = (size_t)b * SEQ + c * 64;
    bf16x8 qf[2][4];
#pragma unroll
    for (int qt = 0; qt < 2; ++qt)
#pragma unroll
        for (int d0 = 0; d0 < 4; ++d0) qf[qt][d0] = *(const bf16x8*)(P + (tok0 + 32 * qt + r32) * NIN + h * 64 + d0 * 16 + hi * 8);
#pragma unroll
    for (int r = 0; r < 16; ++r) { o[0][0][r] = 0.f; o[0][1][r] = 0.f; o[1][0][r] = 0.f; o[1][1][r] = 0.f; }
    float m[2] = {-INFINITY, -INFINITY}, l[2] = {0.f, 0.f};
    const int kc0 = c >= 8 ? c - 8 : 0;
    const int dhalf = (lane >> 4) & 1, qq = (lane & 15) >> 2, p4 = lane & 3;
    int vb[2];
#pragma unroll
    for (int dt = 0; dt < 2; ++dt) vb[dt] = 8192 + (4 * hi + qq) * 128 + ((64 * dt + 32 * dhalf + 8 * p4) ^ ((qq >> 1) << 6));
    const int prow = lane >> 3, pch = lane & 7;
    const unsigned voff = (unsigned)(prow * NIN + (pch ^ (((lane >> 4) & 1) << 2)) * 8) * 2u;
    const unsigned koff0 = (unsigned)(prow * NIN + (pch ^ (lane >> 4)) * 8) * 2u, koff1 = (unsigned)(prow * NIN + (pch ^ (lane >> 4) ^ 4) * 8) * 2u;
    const int swz = (r32 >> 1) & 7;
    int ka[4];
#pragma unroll
    for (int d0 = 0; d0 < 4; ++d0) ka[d0] = r32 * 128 + (((2 * d0 + hi) ^ swz) * 16);
#define MX_DMAK(kc) do { const char* kp_ = (const char*)(P + ((size_t)b * SEQ + (kc) * 64) * NIN + 512 + h * 64); \
        _Pragma("unroll") for (int i = 0; i < 8 * DMAREP; ++i) __builtin_amdgcn_global_load_lds((const unsigned*)(kp_ + (size_t)((i & 7) * 8 * NIN) * 2 + ((i & 1) ? koff1 : koff0)), (LAS unsigned*)(wl + (i & 7) * 1024), 16, 0, 0); } while (0)
#define MX_DMAV(kc) do { const char* vp_ = (const char*)(P + ((size_t)b * SEQ + (kc) * 64) * NIN + 1024 + h * 64); \
        _Pragma("unroll") for (int i = 0; i < 8 * DMAREP; ++i) __builtin_amdgcn_global_load_lds((const unsigned*)(vp_ + (size_t)((i & 7) * 8 * NIN) * 2 + voff), (LAS unsigned*)(wl + 8192 + (i & 7) * 1024), 16, 0, 0); } while (0)
    MX_DMAK(kc0);
    const int nk = c - kc0 + 1, total = nk * ATTREP; (void)total;
#if ATTREP == 1
    for (int kc = kc0; kc <= c; ++kc) {
        const int kcn = kc + 1; const bool more = kc < c;
#else
    for (int it = 0; it < total; ++it) {
        const int kc = kc0 + it % nk, kcn = kc0 + (it + 1) % nk; const bool more = it + 1 < total;
#endif
        const int j = kc - c + 8;
        MX_DMAV(kc);
        asm volatile(MX_VM8 ::: "memory");
        bf16x8 kf[2][4];
#pragma unroll
        for (int kt = 0; kt < 2; ++kt)
#pragma unroll
            for (int d0 = 0; d0 < 4; ++d0) kf[kt][d0] = *(const LAS bf16x8*)(wl + kt * 4096 + ka[d0]);
        asm volatile("s_waitcnt lgkmcnt(0)" ::: "memory");
        if (more) MX_DMAK(kcn);
#pragma unroll
        for (int qt = 0; qt < 2; ++qt) {
            f32x16 st[2];
            float badd = 0.f;
            if (j <= 5) { badd = tbl[256];
#pragma unroll
                for (int r = 0; r < 16; ++r) { st[0][r] = 0.f; st[1][r] = 0.f; } }
            else { const LAS float* tb = tbl + (64 * (8 - j) + 32 * qt + r32 - 4 * hi + 128 - 63);
#pragma unroll
                for (int kt = 0; kt < 2; ++kt)
#pragma unroll
                    for (int r = 0; r < 16; ++r) st[kt][r] = tb[63 - (32 * kt + (r & 3) + 8 * (r >> 2))]; }
#pragma unroll
            for (int kt = 0; kt < 2; ++kt)
#pragma unroll
                for (int d0 = 0; d0 < 4; ++d0) st[kt] = __builtin_amdgcn_mfma_f32_32x32x16_bf16(kf[kt][d0], qf[qt][d0], st[kt], 0, 0, 0);
            asm volatile("s_nop 15\n\ts_nop 7" : "+v"(st[0]), "+v"(st[1]));
            float mxa = max3f(st[0][0], st[0][1], st[0][2]), mxb = max3f(st[1][0], st[1][1], st[1][2]);
#pragma unroll
            for (int r = 3; r < 15; r += 2) { mxa = max3f(mxa, st[0][r], st[0][r + 1]); mxb = max3f(mxb, st[1][r], st[1][r + 1]); }
            float mxv = max3f(mxa, mxb, st[0][15]); mxv = max3f(mxv, st[1][15], mxv);
            mxv = max3f(mxv, __shfl_xor(mxv, 32), mxv) + badd;
            const bool need = mxv > m[qt] + 8.0f;
            if (__builtin_amdgcn_ballot_w64(need) != 0ull) {
                const float mn = need ? mxv : m[qt], al = __builtin_amdgcn_exp2f(m[qt] - mn); m[qt] = mn; l[qt] *= al;
#pragma unroll
                for (int r = 0; r < 16; ++r) { o[qt][0][r] *= al; o[qt][1][r] *= al; }
            }
            const float sub = m[qt] - badd;
            float rs = 0.f;
#pragma unroll
            for (int kt = 0; kt < 2; ++kt)
#pragma unroll
                for (int r = 0; r < 16; ++r) { const float p = __builtin_amdgcn_exp2f(st[kt][r] - sub); st[kt][r] = p; rs += p; }
            l[qt] += rs;
            bf16x8 pf[4];
#pragma unroll
            for (int s = 0; s < 4; ++s) { v4u w; const int kt = s >> 1, r0 = 8 * (s & 1);
                w.x = cvtpk(st[kt][r0 + 0], st[kt][r0 + 1]); w.y = cvtpk(st[kt][r0 + 2], st[kt][r0 + 3]); w.z = cvtpk(st[kt][r0 + 4], st[kt][r0 + 5]); w.w = cvtpk(st[kt][r0 + 6], st[kt][r0 + 7]);
                pf[s] = __builtin_bit_cast(bf16x8, w); }
            if (qt == 0) { if (more) asm volatile(MX_VM8 ::: "memory"); else asm volatile("s_waitcnt vmcnt(0)" ::: "memory"); }
            {
                s16x4 va[2][4], vc[2][4];
#pragma unroll
                for (int dt = 0; dt < 2; ++dt) { const unsigned vaddr = (unsigned)(uintptr_t)(wl + vb[dt]);
#pragma unroll
                    for (int s = 0; s < 4; ++s) { asm volatile("ds_read_b64_tr_b16 %0, %1 offset:%c2" : "=&v"(va[dt][s]) : "v"(vaddr), "i"(16 * s * 128) : "memory");
                                                  asm volatile("ds_read_b64_tr_b16 %0, %1 offset:%c2" : "=&v"(vc[dt][s]) : "v"(vaddr), "i"((16 * s + 8) * 128) : "memory"); } }
                asm volatile("s_waitcnt lgkmcnt(0)" : "+v"(va[0][0]), "+v"(va[0][1]), "+v"(va[0][2]), "+v"(va[0][3]), "+v"(vc[0][0]), "+v"(vc[0][1]), "+v"(vc[0][2]), "+v"(vc[0][3]),
                                                      "+v"(va[1][0]), "+v"(va[1][1]), "+v"(va[1][2]), "+v"(va[1][3]), "+v"(vc[1][0]), "+v"(vc[1][1]), "+v"(vc[1][2]), "+v"(vc[1][3]) :: "memory");
#pragma unroll
                for (int s = 0; s < 4; ++s)
#pragma unroll
                    for (int dt = 0; dt < 2; ++dt) o[qt][dt] = __builtin_amdgcn_mfma_f32_32x32x16_bf16(cat8(va[dt][s], vc[dt][s]), pf[s], o[qt][dt], 0, 0, 0);
            }
        }
        MX_FENCE();
    }
#undef MX_DMAK
#undef MX_DMAV
#pragma unroll
    for (int qt = 0; qt < 2; ++qt) { float lt = l[qt]; lt += __shfl_xor(lt, 32); const float inv = 1.0f / lt;
#pragma unroll
        for (int r = 0; r < 16; ++r) { o[qt][0][r] *= inv; o[qt][1][r] *= inv; } }
}

__device__ __forceinline__ void sgu_task(const bf16* P, const LAS float* rstab, const bf16* wsp_l, const float* sgu_g, const float* bsp_l, int b, int c, int g, LAS unsigned char* wl, int lane_in, f32x16 (&o)[2][2]) {
    int lane = lane_in; asm volatile("" : "+v"(lane));
    const int r32 = lane & 31, hi = lane >> 5;
    const int nb = c >> 1, cb = c & 1, ns = cb ? 128 : 64;
    const size_t srow0 = (size_t)b * SEQ + nb * 128, tok0 = (size_t)b * SEQ + c * 64;
    const int prow = lane >> 3, pch = lane & 7;
    const f32x4 g0 = *(const f32x4*)(sgu_g + g * 64 + pch * 8), g1 = *(const f32x4*)(sgu_g + g * 64 + pch * 8 + 4);
    v4u ureg[8];
#pragma unroll
    for (int i = 0; i < 8; ++i) ureg[i] = *(const v4u*)(P + (tok0 + prow + 8 * i) * NIN + 1536 + g * 64 + pch * 8);
    const bf16* wrow = wsp_l + ((size_t)g * 128 + cb * 64 + r32) * 128 + hi * 8;
    bf16x8 wfa[8], wfb[8];
#pragma unroll
    for (int step = 0; step < 8; ++step) if (step * 16 < ns) { wfa[step] = *(const bf16x8*)(wrow + 16 * step); wfb[step] = *(const bf16x8*)(wrow + 32 * 128 + 16 * step); }
    MX_FENCE();
#pragma unroll
    for (int hb = 0; hb < 2; ++hb) {
        if (hb * 64 < ns) {
            v4u raw[8];
#pragma unroll
            for (int i = 0; i < 8; ++i) raw[i] = *(const v4u*)(P + (srow0 + hb * 64 + prow + 8 * i) * NIN + 2048 + g * 64 + pch * 8);
#pragma unroll
            for (int i = 0; i < 8; ++i) { const int row = hb * 64 + prow + 8 * i; const f32x4 q0 = *(const LAS f32x4*)(rstab + row * 8), q1 = *(const LAS f32x4*)(rstab + row * 8 + 4);
                const float rs = __builtin_amdgcn_rsqf((((q0[0] + q0[1]) + (q0[2] + q0[3])) + ((q1[0] + q1[1]) + (q1[2] + q1[3]))) * (1.0f / 512.0f) + pg8::RMS_EPS);
                v4u w;
                w.x = cvtpk(__builtin_bit_cast(float, raw[i].x << 16) * rs * g0[0], __builtin_bit_cast(float, raw[i].x & 0xffff0000u) * rs * g0[1]);
                w.y = cvtpk(__builtin_bit_cast(float, raw[i].y << 16) * rs * g0[2], __builtin_bit_cast(float, raw[i].y & 0xffff0000u) * rs * g0[3]);
                w.z = cvtpk(__builtin_bit_cast(float, raw[i].z << 16) * rs * g1[0], __builtin_bit_cast(float, raw[i].z & 0xffff0000u) * rs * g1[1]);
                w.w = cvtpk(__builtin_bit_cast(float, raw[i].w << 16) * rs * g1[2], __builtin_bit_cast(float, raw[i].w & 0xffff0000u) * rs * g1[3]);
                *(LAS v4u*)(wl + vimg(row, pch)) = w; }
        }
    }
    MX_FENCE();
#pragma unroll
    for (int r = 0; r < 16; ++r) { o[0][0][r] = 0.f; o[0][1][r] = 0.f; o[1][0][r] = 0.f; o[1][1][r] = 0.f; }
    const int dhalf = (lane >> 4) & 1, qq = (lane & 15) >> 2, p4 = lane & 3;
    int vbs[2];
#pragma unroll
    for (int ct = 0; ct < 2; ++ct) vbs[ct] = (8 * hi + qq) * 128 + ((64 * ct + 32 * dhalf + 8 * p4) ^ ((qq >> 1) << 6));
#pragma unroll
    for (int step = 0; step < 8; ++step) { if (step * 16 < ns) {
        const bf16x8 wf0 = wfa[step], wf1 = wfb[step];
#pragma unroll
        for (int ct = 0; ct < 2; ++ct) { const s16x4 a0 = tr64(wl + vbs[ct] + (16 * step) * 128), a1 = tr64(wl + vbs[ct] + (16 * step + 4) * 128);
            const bf16x8 af = cat8(a0, a1);
            o[0][ct] = __builtin_amdgcn_mfma_f32_32x32x16_bf16(af, wf0, o[0][ct], 0, 0, 0);
            o[1][ct] = __builtin_amdgcn_mfma_f32_32x32x16_bf16(af, wf1, o[1][ct], 0, 0, 0); }
    } }
    MX_FENCE();
#pragma unroll
    for (int i = 0; i < 8; ++i) { const int row = 8 * i + prow; *(LAS v4u*)(wl + row * 128 + ((pch ^ (row & 7)) * 16)) = ureg[i]; }
    MX_FENCE();
#pragma unroll
    for (int tt = 0; tt < 2; ++tt) {
        const int tok = 32 * tt + r32;
        const float bt = bsp_l[g * 128 + cb * 64 + tok];
#pragma unroll
        for (int ct = 0; ct < 2; ++ct)
#pragma unroll
            for (int rg = 0; rg < 4; ++rg) { const u32x2 uu = *(const LAS u32x2*)(wl + tok * 128 + (((4 * ct + rg) ^ (tok & 7)) * 16) + hi * 8);
                o[tt][ct][4 * rg + 0] = __builtin_bit_cast(float, uu.x << 16) * (o[tt][ct][4 * rg + 0] + bt); o[tt][ct][4 * rg + 1] = __builtin_bit_cast(float, uu.x & 0xffff0000u) * (o[tt][ct][4 * rg + 1] + bt);
                o[tt][ct][4 * rg + 2] = __builtin_bit_cast(float, uu.y << 16) * (o[tt][ct][4 * rg + 2] + bt); o[tt][ct][4 * rg + 3] = __builtin_bit_cast(float, uu.y & 0xffff0000u) * (o[tt][ct][4 * rg + 3] + bt); }
    }
    MX_FENCE();
}

__device__ __forceinline__ void norm_store(const f32x16 (&o)[2][2], LAS float* red, LAS unsigned char* wl, int wave, int lane_in, const float* gain, bf16* dst) {
    int lane = lane_in; asm volatile("" : "+v"(lane));
    const int r32 = lane & 31, hi = lane >> 5;
    f32x4 gvv[2][4];
#pragma unroll
    for (int ct = 0; ct < 2; ++ct)
#pragma unroll
        for (int rg = 0; rg < 4; ++rg) gvv[ct][rg] = *(const f32x4*)(gain + 32 * ct + 8 * rg + 4 * hi);
#pragma unroll
    for (int tt = 0; tt < 2; ++tt) { float ss = 0.f;
#pragma unroll
        for (int r = 0; r < 16; ++r) ss += o[tt][0][r] * o[tt][0][r] + o[tt][1][r] * o[tt][1][r];
        ss += __shfl_xor(ss, 32);
        if (hi == 0) red[wave * 64 + tt * 32 + r32] = ss; }
    __syncthreads();
#pragma unroll
    for (int tt = 0; tt < 2; ++tt) { float tot = 0.f; const int tok = 32 * tt + r32;
#pragma unroll
        for (int w = 0; w < 8; ++w) tot += red[w * 64 + tok];
        const float rn = __builtin_amdgcn_rsqf(tot * (1.0f / 512.0f) + pg8::RMS_EPS);
#pragma unroll
        for (int ct = 0; ct < 2; ++ct)
#pragma unroll
            for (int rg = 0; rg < 4; ++rg) { const f32x4 gv = gvv[ct][rg];
                u32x2 w; w.x = cvtpk(o[tt][ct][4 * rg + 0] * rn * gv[0], o[tt][ct][4 * rg + 1] * rn * gv[1]); w.y = cvtpk(o[tt][ct][4 * rg + 2] * rn * gv[2], o[tt][ct][4 * rg + 3] * rn * gv[3]);
                *(LAS u32x2*)(wl + tok * 128 + (((4 * ct + rg) ^ (tok & 7)) * 16) + hi * 8) = w; } }
    MX_FENCE();
    const int prow = lane >> 3, pch = lane & 7;
#pragma unroll
    for (int i = 0; i < 8; ++i) { const int row = 8 * i + prow; const v4u v = *(const LAS v4u*)(wl + row * 128 + ((pch ^ (row & 7)) * 16));
        *(v4u*)(dst + (size_t)row * DM + pch * 8) = v; }
    MX_FENCE();
}

__device__ __forceinline__ void fill_bias_table(CArgs* a, int l, LAS unsigned char* lds) {
    const float* rel = a->in[5] + (size_t)l * 8 * 257; LAS float* tbl = (LAS float*)(lds + TBL_OFF);
    for (int i = threadIdx.x; i < 8 * TBL_LD; i += NWAVES * 64) { const int h = i / TBL_LD, k = i % TBL_LD; tbl[i] = rel[h * 257 + (k < 256 ? k : 256)] * pg8::LOG2E; }
}
__device__ __forceinline__ void mixer_fast(CArgs* a, int l, LAS unsigned char* lds, int wave, int lane, int vb) {
    const bf16* P = (const bf16*)(a->ws + WS_PROJ); bf16* MIX = (bf16*)(a->ws + WS_MIX);
    const float* vgss = (const float*)(a->ws + WS_VGSS); const bf16* wsp_l = (const bf16*)(a->ws + WS_WSP) + (size_t)l * 8 * 128 * 128;
    const float* rel = a->in[5] + (size_t)l * 8 * 257; const float* sgu_g = a->in[6] + l * 512; const float* bsp_l = a->in[8] + l * 8 * 128;
    const float* ag = a->in[9] + l * 512; const float* gg = a->in[10] + l * 512;
    LAS float* tbl = (LAS float*)(lds + TBL_OFF); LAS float* red = (LAS float*)(lds + RED_OFF); LAS float* rstab = (LAS float*)(lds + RS_OFF);
    LAS unsigned char* wl = lds + wave * 16384;
    for (int u = vb; u < NB * (SEQ / 64); u += gridDim.x) {
        const int b = u & 7, c = u >> 3;
        const size_t tok0 = (size_t)b * SEQ + c * 64;
        if (wave == 0) {
            const char* src = (const char*)(vgss + ((size_t)b * SEQ + (c >> 1) * 128) * 8) + lane * 16;
#pragma unroll
            for (int i = 0; i < 4; ++i) __builtin_amdgcn_global_load_lds((const unsigned*)(src + i * 1024), (LAS unsigned*)(lds + RS_OFF + i * 1024), 16, 0, 0);
        }
        f32x16 o[2][2];
        REPEAT(7) attn_task(P, b, c, wave, wl, tbl + wave * TBL_LD, lane, o);
        norm_store(o, red, wl, wave, lane, ag + wave * 64, MIX + tok0 * DM + wave * 64);
        REPEAT(8) sgu_task(P, rstab, wsp_l, sgu_g, bsp_l, b, c, wave, wl, lane, o);
        norm_store(o, red + 512, wl, wave, lane, gg + wave * 64, MIX + tok0 * DM + 512 + wave * 64);
    }
    __syncthreads();
}
}

__global__ void __launch_bounds__(NWAVES * 64, 2) fwd_megakernel(Args a_unused) {
    extern __shared__ __attribute__((aligned(16))) unsigned char lds_raw[];
    LAS unsigned char* lds = (LAS unsigned char*)lds_raw;
    if (threadIdx.x < 16) ((LAS unsigned*)(lds + MISC_OFF))[threadIdx.x] = 0u;
    __syncthreads();
    (void)xcd_barrier_post((unsigned*)(kargs_ws() + WS_BAR), (volatile LAS unsigned*)(lds + MISC_OFF));
    if (threadIdx.x == 64) { const unsigned x_ = xb_xcc_id(); ((volatile LAS unsigned*)(lds + MISC_OFF))[7] = xb_add((unsigned*)(kargs_ws() + WS_XIDX) + 64 * x_, 1u); }
    { const int tid = threadIdx.x, lane = tid & 63, wave = __builtin_amdgcn_readfirstlane(tid >> 6);
      REPEAT(0) prologue(kargs(), lds, wave, lane); }
    GRID_BAR();
    if (threadIdx.x == 64) { volatile LAS unsigned* mi = (volatile LAS unsigned*)(lds + MISC_OFF); unsigned* xi = (unsigned*)(kargs_ws() + WS_XIDX); bool ok = (gridDim.x & 7u) == 0u;
        for (int j = 0; j < 16; ++j) { const unsigned cj = xb_ld(xi + 64 * j); ok = ok && (j < 8 ? cj == (gridDim.x >> 3) : cj == 0u); }
        mi[6] = ok ? mi[7] * 8u + xb_xcc_id() : blockIdx.x; mi[4] = ok ? 1u : 0u; }
    __syncthreads();
#if (REPM >> 6) & 1
    for (int i_ = 0; i_ < 10; ++i_) GRID_BAR();
#endif
#pragma nounroll
    for (int l = 0; l < DEPTH; ++l) {
#if PHM & 1
        REPEAT(1) {
            CArgs* a = kargs(); unsigned char* ws = a->ws; unsigned char* wb = ws + WS_W0 + (size_t)l * WS_WSTRIDE;
            pg8::Gemm g{(const bf16*)(ws + WS_XB), (const bf16*)(wb + WOFF_IN), M, NIN, DM}; pg8::StaticOrder S; S.init(M, NIN, (int)gridDim.x, VBID());
            pg8::Unit u0; u0.pm = -1; u0.pn = 0; (void)S.next(0, u0);
            { LAS float* rsl = (LAS float*)(lds + 131072); const int t_ = threadIdx.x;
              if (u0.pm >= 0 && t_ < 256) rsl[t_] = pg8::row_rs((const float*)(ws + WS_ROWSS), u0.pm * 256 + t_);
              else if (t_ >= 256 && t_ < 384) rsl[t_] = t_ < 320 ? a->in[3][l * 64 + t_ - 256] * pg8::QSCALE : a->in[4][l * 64 + t_ - 320];
              __syncthreads(); }
            pg8::EpiInProj E{(bf16*)(ws + WS_PROJ), (const float*)(ws + WS_ROWSS), (float*)(ws + WS_VGSS), a->in[3] + l * 64, a->in[4] + l * 64, (const LAS float*)(lds + 131072), u0.pm};
            pg8::gemm_phase<pg8::EpiInProj, pg8::StaticOrder, true, true>(lds, g, S, E);
        }
#endif
        if (l == 0 && 2 * VBID() >= (int)gridDim.x) {
            int tid = threadIdx.x; asm volatile("" : "+v"(tid)); const int lane = tid & 63, wave = __builtin_amdgcn_readfirstlane(tid >> 6);
            const int half = gridDim.x - gridDim.x / 2;
            convert_weights(kargs(), lds, wave, lane, CW_I_IN, CW_I_LAYER, (VBID() - (int)gridDim.x / 2) * NWAVES + wave, half * NWAVES);
        }
#if FAST_MIXER
        mx::fill_bias_table(kargs(), l, lds);
#endif
        if (l == 0) GRID_BAR(); else GROUP_BAR();
#if PHM & 2
        REPEAT(2) { int tid = threadIdx.x; asm volatile("" : "+v"(tid)); const int lane = tid & 63, wave = __builtin_amdgcn_readfirstlane(tid >> 6);
#if FAST_MIXER
          mx::mixer_fast(kargs(), l, lds, wave, lane, VBID());
#else
          mixer_naive(kargs(), l, lds, wave, lane);
#endif
        }
#endif
#if PHM & 4
        REPEAT(3) {
            CArgs* a = kargs(); unsigned char* ws = a->ws; unsigned char* wb = ws + WS_W0 + (size_t)l * WS_WSTRIDE; float* xo = a->out;
            pg8::Gemm g{(const bf16*)(ws + WS_MIX), (const bf16*)(wb + WOFF_OUT), M, DM, DM}; pg8::StaticOrder S; S.init(M, DM, (int)gridDim.x, VBID());
            pg8::EpiResid E{(const float*)nullptr, (float*)nullptr, (bf16*)(ws + WS_XB), (float*)(ws + WS_ROWSS)};
            PreGroupBar pre{ws, (volatile LAS unsigned*)(lds + MISC_OFF)};
            pg8::gemm_phase<pg8::EpiResid, pg8::StaticOrder, false, true, false, PreGroupBar>(lds, g, S, E, pre);
        }
#endif
        GROUP_BAR();
#if PHM & 8
        REPEAT(4) {
            CArgs* a = kargs(); unsigned char* ws = a->ws; unsigned char* wb = ws + WS_W0 + (size_t)l * WS_WSTRIDE;
            pg8::Gemm g{(const bf16*)(ws + WS_XB), (const bf16*)(wb + WOFF_FIN), M, NFF2, DM}; pg8::StaticOrder S; S.init(M, NFF2, (int)gridDim.x, VBID());
            pg8::Unit u0; u0.pm = -1; u0.pn = 0; (void)S.next(0, u0);
            { LAS float* rsl = (LAS float*)(lds + 131072); if (u0.pm >= 0 && threadIdx.x < 256) rsl[threadIdx.x] = pg8::row_rs((const float*)(ws + WS_ROWSS), u0.pm * 256 + (int)threadIdx.x); __syncthreads(); }
            pg8::EpiSwiGLU E{(bf16*)(ws + WS_HID), (const float*)(ws + WS_ROWSS), (const LAS float*)(lds + 131072), u0.pm};
            pg8::gemm_phase<pg8::EpiSwiGLU, pg8::StaticOrder, true, true>(lds, g, S, E);
        }
#endif
        if (l == 0 && 2 * VBID() >= (int)gridDim.x) {
            int tid = threadIdx.x; asm volatile("" : "+v"(tid)); const int lane = tid & 63, wave = __builtin_amdgcn_readfirstlane(tid >> 6);
            const int half = gridDim.x - gridDim.x / 2;
            convert_weights(kargs(), lds, wave, lane, CW_I_LAYER, 2 * CW_I_LAYER, (VBID() - (int)gridDim.x / 2) * NWAVES + wave, half * NWAVES);
        }
#if PHM & 16
        REPEAT(5) {
            CArgs* a = kargs(); unsigned char* ws = a->ws; unsigned char* wb = ws + WS_W0 + (size_t)l * WS_WSTRIDE; float* xo = a->out;
            pg8::Gemm g{(const bf16*)(ws + WS_HID), (const bf16*)(wb + WOFF_FOUT), M, DM, DFF}; pg8::StaticOrder S; S.init(M, DM, (int)gridDim.x, VBID());
            pg8::EpiResid E{(const float*)nullptr, l + 1 < DEPTH ? (float*)nullptr : xo, (bf16*)(ws + WS_XB), (float*)(ws + WS_ROWSS)};
            PreGroupBar pre{ws, (volatile LAS unsigned*)(lds + MISC_OFF)};
            pg8::gemm_phase<pg8::EpiResid, pg8::StaticOrder, false, true, true, PreGroupBar>(lds, g, S, E, pre);
        }
#endif
        if (l + 1 < DEPTH) GRID_BAR();
    }
}

extern "C" void kernel_launch(void* const* d_in, const int* in_sizes, int n_in, void* d_out, int out_size, void* d_ws, size_t ws_size, hipStream_t stream) {
    static int grid = 0;
    if (grid == 0) {
        if (n_in != 15 || in_sizes[0] != M * DM || out_size != M * DM || ws_size < WS_END) { fprintf(stderr, "kernel_launch: unexpected shapes (n_in %d, ws %zu)\n", n_in, ws_size); grid = -1; return; }
        int dev = 0, cus = 0, per_cu = 0;
        hipGetDevice(&dev); hipDeviceGetAttribute(&cus, hipDeviceAttributeMultiprocessorCount, dev);
        if (hipFuncSetAttribute((const void*)fwd_megakernel, hipFuncAttributeMaxDynamicSharedMemorySize, LDS_BYTES) != hipSuccess) { fprintf(stderr, "kernel_launch: hipFuncSetAttribute failed\n"); grid = -1; return; }
        if (hipOccupancyMaxActiveBlocksPerMultiprocessor(&per_cu, (const void*)fwd_megakernel, NWAVES * 64, LDS_BYTES) != hipSuccess || per_cu < 1) { fprintf(stderr, "kernel_launch: occupancy query failed (%d)\n", per_cu); (void)hipGetLastError(); per_cu = 1; }
        grid = cus * (per_cu > 1 ? 1 : per_cu);
        if (grid != 256) { fprintf(stderr, "kernel_launch: built for a 256-CU device (one 256x256 unit per workgroup in the N = 1024 phases); got %d\n", grid); grid = -1; return; }
    }
    if (grid < 0) return;
    if (hipMemsetAsync((char*)d_ws + WS_BAR, 0, BAR_ZERO_BYTES, stream) != hipSuccess) { fprintf(stderr, "kernel_launch: hipMemsetAsync failed\n"); return; }
    Args a{};
    for (int i = 0; i < 15; ++i) a.in[i] = (const float*)d_in[i];
    a.out = (float*)d_out; a.ws = (unsigned char*)d_ws;
    void* args[] = {&a};
    hipError_t e = hipLaunchCooperativeKernel((const void*)fwd_megakernel, dim3(grid), dim3(NWAVES * 64), args, LDS_BYTES, stream);
    if (e != hipSuccess) fprintf(stderr, "cooperative launch failed: %s (grid %d)\n", hipGetErrorString(e), grid);
}
```

```cpp
#include <hip/hip_runtime.h>
#include <hip/hip_cooperative_groups.h>
#include <cstdio>
#include <cstdint>
namespace cg = cooperative_groups;
namespace pg8 {
#define PG8_LAS __attribute__((address_space(3)))
typedef unsigned short bf16_t;
typedef short bf16x8 __attribute__((ext_vector_type(8)));
typedef float f32x4 __attribute__((ext_vector_type(4)));
typedef unsigned u32x4 __attribute__((ext_vector_type(4)));
constexpr int BM = 256, BK = 64, HALF = 128, HTB = HALF * BK * 2  , STAGE_BYTES = 8 * HTB, NXCD = 8, WGM = 8;

__host__ __device__ __forceinline__ int lds_byte(int r, int c) { const int st = (r >> 4) * 2 + (c >> 5), rr = r & 15, cc = c & 31, ob = rr * 64 + cc * 2; return st * 1024 + (ob ^ (((ob >> 9) & 1) << 5)); }
__host__ __device__ __forceinline__ void stage_rc(int b, int& R, int& C) { const int st = b / 1024, sb = b % 1024, swz = sb ^ (((sb >> 9) & 1) << 5); R = (st >> 1) * 16 + swz / 64; C = (st & 1) * 32 + (swz % 64) / 2; }
__host__ __device__ __forceinline__ int perm32(int rho) { const int n = rho >> 4, i = rho & 15; return 8 * (i >> 2) + 4 * n + (i & 3); }

struct Unit { int pm, pn; };
struct Gemm { const bf16_t* A; const bf16_t* Bt; int M, N, K; };

struct StaticOrder {
    int nM, nN, nwg, G, c;
    __host__ __device__ void init(int M, int N, int G_, int c_) { nM = M / BM; nN = N / BM; nwg = nM * nN; G = G_; c = c_; }
    __host__ __device__ bool next(int i, Unit& u) const {
        const long L = (long)i * G + c; if (L >= nwg) return false;
        int wgid = (int)L; { const int q = nwg / NXCD, r = nwg % NXCD, xcd = wgid % NXCD, off = wgid / NXCD; wgid = (xcd < r ? xcd * (q + 1) : r * (q + 1) + (xcd - r) * q) + off; }
        const int nig = WGM * nN, gid = wgid / nig, fm = gid * WGM, gsz = (nM - fm) < WGM ? (nM - fm) : WGM;
        u.pm = fm + ((wgid % nig) % gsz); u.pn = (wgid % nig) / gsz; return true;
    }
    __device__ __forceinline__ void a_ready(const Unit&) const {}
    __device__ __forceinline__ void done(const Unit&) const {}
};

__device__ __forceinline__ unsigned cvt_pk_bf16(float lo, float hi) { unsigned r; asm volatile("v_cvt_pk_bf16_f32 %0, %1, %2" : "=v"(r) : "v"(lo), "v"(hi)); return r; }
typedef float f32x2 __attribute__((ext_vector_type(2)));
constexpr float RMS_EPS = 1e-6f;
constexpr float LOG2E = 1.4426950408889634f;
constexpr float QSCALE = 0.125f * 1.4426950408889634f;
__device__ __forceinline__ float gelu_tanh(float x) {
    const float z2 = x * (1.5957691216057308f + 0.07135481627260025f * x * x);
    const float e = __builtin_amdgcn_exp2f(-LOG2E * z2);
    return x * __builtin_amdgcn_rcpf(1.0f + e);
}
__device__ __forceinline__ float row_rs(const float* rowss, int row) {
    const f32x4 a = *(const f32x4*)(rowss + (size_t)row * 4);
    return __builtin_amdgcn_rsqf(((a[0] + a[1]) + (a[2] + a[3])) * (1.0f / 1024.0f) + RMS_EPS);
}
struct EpiInProj {
    static constexpr bool PERM = true, AFTER_DRAIN = false, INIT = false;
    bf16_t* P; const float* rowss; float* vgss; const float* qg; const float* kg; const PG8_LAS float* rs_lds; int pm_cached;
    __device__ __forceinline__ void operator()(const f32x4 (&acc)[2][2][4][2], const Unit& u, int wr, int wc, int fr, int fq) const {
        const int region = u.pn >> 1, half = u.pn & 1;
        const int lcol = region * 512 + half * 256 + wc * 64 + fq * 8;
        float gq[2][8];
#pragma unroll
        for (int bj = 0; bj < 2; ++bj)
#pragma unroll
            for (int e = 0; e < 8; ++e) gq[bj][e] = 1.f;
        if (region < 2) { const PG8_LAS float* g = rs_lds + 256 + region * 64;
#pragma unroll
            for (int bj = 0; bj < 2; ++bj)
#pragma unroll
                for (int e = 0; e < 8; ++e) gq[bj][e] = g[bj * 32 + fq * 8 + e]; }
#pragma unroll
        for (int ai = 0; ai < 2; ++ai)
#pragma unroll
            for (int m = 0; m < 4; ++m) {
                const int row = u.pm * BM + ai * HALF + wr * 64 + m * 16 + fr;
                const float s = (u.pm == pm_cached) ? rs_lds[ai * HALF + wr * 64 + m * 16 + fr] : row_rs(rowss, row);
                float v[2][8];
#pragma unroll
                for (int bj = 0; bj < 2; ++bj)
#pragma unroll
                    for (int n = 0; n < 2; ++n)
#pragma unroll
                        for (int i = 0; i < 4; ++i) v[bj][4 * n + i] = acc[ai][bj][m][n][i] * s;
                if (region < 2) {
                    float q = 0.f;
#pragma unroll
                    for (int bj = 0; bj < 2; ++bj)
#pragma unroll
                        for (int e = 0; e < 8; ++e) q += v[bj][e] * v[bj][e];
                    q += __shfl_xor(q, 16); q += __shfl_xor(q, 32);
                    const float r = __builtin_amdgcn_rsqf(q * (1.0f / 64.0f) + RMS_EPS);
#pragma unroll
                    for (int bj = 0; bj < 2; ++bj)
#pragma unroll
                        for (int e = 0; e < 8; ++e) v[bj][e] = v[bj][e] * r * gq[bj][e];
                } else if (region >= 3) {
#pragma unroll
                    for (int bj = 0; bj < 2; ++bj)
#pragma unroll
                        for (int e = 0; e < 8; ++e) v[bj][e] = gelu_tanh(v[bj][e]);
                    if (region == 4) {
                        float q = 0.f;
#pragma unroll
                        for (int bj = 0; bj < 2; ++bj)
#pragma unroll
                            for (int e = 0; e < 8; ++e) q += v[bj][e] * v[bj][e];
                        q += __shfl_xor(q, 16); q += __shfl_xor(q, 32);
                        if (fq == 0) vgss[(size_t)row * 8 + half * 4 + wc] = q;
                    }
                }
                bf16_t* rowp = P + (size_t)row * 2560 + lcol;
#pragma unroll
                for (int bj = 0; bj < 2; ++bj) { u32x4 w; w.x = cvt_pk_bf16(v[bj][0], v[bj][1]); w.y = cvt_pk_bf16(v[bj][2], v[bj][3]); w.z = cvt_pk_bf16(v[bj][4], v[bj][5]); w.w = cvt_pk_bf16(v[bj][6], v[bj][7]);
                    *(u32x4*)(rowp + bj * 32) = w; }
            }
    }
};
struct EpiResid {
    static constexpr bool PERM = true, AFTER_DRAIN = true, INIT = true;
    const float* base32; float* out32; bf16_t* xb; float* rowss;
    __device__ __forceinline__ void init(f32x4 (&acc)[2][2][4][2], const Unit& u, int wr, int wc, int fr, int fq) const {
        const int col0 = u.pn * BM + wc * 32 + 8 * fq;
        if (base32) {
#pragma unroll
            for (int ai = 0; ai < 2; ++ai)
#pragma unroll
                for (int m = 0; m < 4; ++m) { const size_t off = (size_t)(u.pm * BM + ai * HALF + wr * 64 + m * 16 + fr) * 1024 + col0;
#pragma unroll
                    for (int bj = 0; bj < 2; ++bj) { acc[ai][bj][m][0] = __builtin_nontemporal_load((const f32x4*)(base32 + off + bj * HALF)); acc[ai][bj][m][1] = __builtin_nontemporal_load((const f32x4*)(base32 + off + bj * HALF + 4)); } }
        } else {
#pragma unroll
            for (int ai = 0; ai < 2; ++ai)
#pragma unroll
                for (int m = 0; m < 4; ++m) { const size_t off = (size_t)(u.pm * BM + ai * HALF + wr * 64 + m * 16 + fr) * 1024 + col0;
#pragma unroll
                    for (int bj = 0; bj < 2; ++bj) { const u32x4 w = *(const u32x4*)(xb + off + bj * HALF);
                        acc[ai][bj][m][0] = (f32x4){__builtin_bit_cast(float, w.x << 16), __builtin_bit_cast(float, w.x & 0xffff0000u), __builtin_bit_cast(float, w.y << 16), __builtin_bit_cast(float, w.y & 0xffff0000u)};
                        acc[ai][bj][m][1] = (f32x4){__builtin_bit_cast(float, w.z << 16), __builtin_bit_cast(float, w.z & 0xffff0000u), __builtin_bit_cast(float, w.w << 16), __builtin_bit_cast(float, w.w & 0xffff0000u)}; } }
        }
    }
    __device__ __forceinline__ void fused(f32x4 (&acc)[2][2][4][2], const Unit& u, int wr, int wc, int fr, int fq, PG8_LAS unsigned char* lds, int wid, int lane) const {
        PG8_LAS float* part = (PG8_LAS float*)lds;
        const int col0 = u.pn * BM + wc * 32 + 8 * fq;
#pragma unroll
        for (int ai = 0; ai < 2; ++ai)
#pragma unroll
            for (int m = 0; m < 4; ++m) {
                const int rl = ai * HALF + wr * 64 + m * 16 + fr;
                const size_t off = (size_t)(u.pm * BM + rl) * 1024 + col0;
                float q = 0.f;
#pragma unroll
                for (int bj = 0; bj < 2; ++bj) {
                    const f32x4 v0 = acc[ai][bj][m][0], v1 = acc[ai][bj][m][1];
                    if (out32) { *(f32x4*)(out32 + off + bj * HALF) = v0; *(f32x4*)(out32 + off + bj * HALF + 4) = v1; }
                    else { u32x4 w; w.x = cvt_pk_bf16(v0[0], v0[1]); w.y = cvt_pk_bf16(v0[2], v0[3]); w.z = cvt_pk_bf16(v1[0], v1[1]); w.w = cvt_pk_bf16(v1[2], v1[3]);
                        *(u32x4*)(xb + off + bj * HALF) = w; }
                    q += (v0[0] * v0[0] + v0[1] * v0[1]) + (v0[2] * v0[2] + v0[3] * v0[3]) + (v1[0] * v1[0] + v1[1] * v1[1]) + (v1[2] * v1[2] + v1[3] * v1[3]);
                }
                q += __shfl_xor(q, 16); q += __shfl_xor(q, 32);
                if (fq == 0) part[rl * 4 + wc] = q;
            }
        asm volatile("s_waitcnt lgkmcnt(0)" ::: "memory"); __builtin_amdgcn_s_barrier(); asm volatile("" ::: "memory");
        const int t = wid * 64 + lane;
        if (t < 256) { const f32x4 p = *(const PG8_LAS f32x4*)(part + t * 4); rowss[(size_t)(u.pm * BM + t) * 4 + u.pn] = (p[0] + p[1]) + (p[2] + p[3]); }
    }
};
struct EpiSwiGLU {
    static constexpr bool PERM = true, AFTER_DRAIN = false, INIT = false;
    bf16_t* H; const float* rowss; const PG8_LAS float* rs_lds; int pm_cached;
    __device__ __forceinline__ void operator()(const f32x4 (&acc)[2][2][4][2], const Unit& u, int wr, int wc, int fr, int fq) const {
        const int col0 = u.pn * 128 + wc * 32 + 8 * fq;
#pragma unroll
        for (int ai = 0; ai < 2; ++ai)
#pragma unroll
            for (int m = 0; m < 4; ++m) {
                const int row = u.pm * BM + ai * HALF + wr * 64 + m * 16 + fr;
                const float s = (u.pm == pm_cached) ? rs_lds[ai * HALF + wr * 64 + m * 16 + fr] : row_rs(rowss, row);
                float h[8];
#pragma unroll
                for (int n = 0; n < 2; ++n)
#pragma unroll
                    for (int i = 0; i < 4; ++i) { const float g = acc[ai][0][m][n][i] * s, up = acc[ai][1][m][n][i] * s;
                        h[4 * n + i] = g * __builtin_amdgcn_rcpf(1.0f + __builtin_amdgcn_exp2f(-LOG2E * g)) * up; }
                u32x4 w; w.x = cvt_pk_bf16(h[0], h[1]); w.y = cvt_pk_bf16(h[2], h[3]); w.z = cvt_pk_bf16(h[4], h[5]); w.w = cvt_pk_bf16(h[6], h[7]);
                *(u32x4*)(H + ((size_t)(col0 >> 6) * 16384 + row) * 64 + (col0 & 63)) = w;
            }
    }
};
struct NoPre { __device__ __forceinline__ void drain() const {} __device__ __forceinline__ void sync() const {} };
template <class Epi, class Sched, bool ALIGN_EPI = false, bool SP2 = false, bool TILED = false, class Pre = NoPre>
__device__ __forceinline__ void gemm_phase(PG8_LAS unsigned char* lds, const Gemm g, const Sched& S, const Epi& E, const Pre& pre = Pre()) {
    int tid_l = threadIdx.x; asm volatile("" : "+v"(tid_l));
    const int tid = tid_l, wid = __builtin_amdgcn_readfirstlane(tid >> 6), lane = tid & 63, wr = wid >> 2, wc = wid & 3, fr = lane & 15, fq = lane >> 4;
    const int K = g.K, nt = K / BK;
    unsigned voffA[2], voffB[2];
#pragma unroll
    for (int i = 0; i < 2; ++i) { int R, C; stage_rc(tid * 16 + i * 8192, R, C); const int Rb = Epi::PERM ? ((R & ~31) + perm32(R & 31)) : R;
        const int lda = TILED ? 64 : K; voffA[i] = (unsigned)(R * lda + C) * 2u; voffB[i] = (unsigned)(Rb * lda + C) * 2u; }
    const size_t kstepA = TILED ? (size_t)g.M * BK * 2 : (size_t)(BK * 2), kstepB = TILED ? (size_t)g.N * BK * 2 : (size_t)(BK * 2);
    const size_t hstep = (size_t)HALF * (TILED ? 64 : K) * 2;
    const size_t tstep = 2 * hstep;
    const unsigned ldsw = (unsigned)wid * 1024u;
    const int aoff = lds_byte(wr * 64 + fr, fq * 8), boff = lds_byte(wc * 32 + fr, fq * 8);
#define PG8_SA(b, h) (((b) * 2 + (h)) * HTB)
#define PG8_SB(b, h) ((4 + (b) * 2 + (h)) * HTB)
#define PG8_STAGE(bufoff, gbase, voff) do { _Pragma("unroll") for (int _i = 0; _i < 2; ++_i) \
        __builtin_amdgcn_global_load_lds((const unsigned*)((const char*)(gbase) + (voff)[_i]), (PG8_LAS unsigned*)(lds + (bufoff) + ldsw + _i * 8192), 16, 0, 0); } while (0)
#define PG8_LDA(dst, b, h) do { _Pragma("unroll") for (int m = 0; m < 4; ++m) _Pragma("unroll") for (int k = 0; k < 2; ++k) dst[m][k] = *(const PG8_LAS bf16x8*)(lds + PG8_SA(b, h) + aoff + m * 2048 + k * 1024); } while (0)
#define PG8_LDB(dst, b, h) do { _Pragma("unroll") for (int n = 0; n < 2; ++n) _Pragma("unroll") for (int k = 0; k < 2; ++k) dst[n][k] = *(const PG8_LAS bf16x8*)(lds + PG8_SB(b, h) + boff + n * 2048 + k * 1024); } while (0)
#define PG8_MMA(ai, bj, At, Bt) do { __builtin_amdgcn_s_setprio(1); _Pragma("unroll") for (int m = 0; m < 4; ++m) _Pragma("unroll") for (int n = 0; n < 2; ++n) _Pragma("unroll") for (int k = 0; k < 2; ++k) \
        acc[ai][bj][m][n] = __builtin_amdgcn_mfma_f32_16x16x32_bf16(Bt[n][k], At[m][k], acc[ai][bj][m][n], 0, 0, 0); __builtin_amdgcn_s_setprio(0); } while (0)
#define PG8_WAIT_V(n) asm volatile("s_waitcnt vmcnt(" #n ")" ::: "memory")
#define PG8_WAIT_L(n) asm volatile("s_waitcnt lgkmcnt(" #n ")" ::: "memory")
#define PG8_BAR __builtin_amdgcn_s_barrier()
#define PG8_SCHED __builtin_amdgcn_sched_barrier(0)
    Unit cur, nxt; int ui = 0;
    if (!S.next(0, cur)) return;
    f32x4 acc[2][2][4][2];
    pre.drain();
    if constexpr (Epi::INIT) E.init(acc, cur, wr, wc, fr, fq);
    else {
#pragma unroll
    for (int a = 0; a < 2; ++a)
#pragma unroll
        for (int b = 0; b < 2; ++b)
#pragma unroll
            for (int m = 0; m < 4; ++m)
#pragma unroll
                for (int n = 0; n < 2; ++n) acc[a][b][m][n] = (f32x4){0.f, 0.f, 0.f, 0.f};
    }
    pre.sync();
    bf16x8 At[4][2], B0[2][2], B1[2][2];
    const char* cA = (const char*)g.A + (size_t)cur.pm * tstep; const char* cB = (const char*)g.Bt + (size_t)cur.pn * tstep;
    S.a_ready(cur);
    if constexpr (SP2) {
        PG8_STAGE(PG8_SB(0, 0), cB, voffB); PG8_STAGE(PG8_SB(0, 1), cB + hstep, voffB); PG8_STAGE(PG8_SA(0, 0), cA, voffA); PG8_STAGE(PG8_SA(0, 1), cA + hstep, voffA);
        if (wr == 1) PG8_BAR;
        PG8_WAIT_V(2); PG8_BAR;
        PG8_STAGE(PG8_SB(1, 0), cB + kstepB, voffB); PG8_STAGE(PG8_SA(1, 0), cA + kstepA, voffA); PG8_STAGE(PG8_SB(1, 1), cB + hstep + kstepB, voffB);
        PG8_WAIT_V(6); PG8_BAR;
    } else {
        PG8_STAGE(PG8_SB(0, 0), cB, voffB); PG8_STAGE(PG8_SA(0, 0), cA, voffA); PG8_STAGE(PG8_SB(0, 1), cB + hstep, voffB); PG8_STAGE(PG8_SA(0, 1), cA + hstep, voffA);
        if (wr == 1) PG8_BAR;
        PG8_WAIT_V(4); PG8_BAR;
        PG8_STAGE(PG8_SB(1, 0), cB + kstepB, voffB); PG8_STAGE(PG8_SA(1, 0), cA + kstepA, voffA); PG8_STAGE(PG8_SB(1, 1), cB + hstep + kstepB, voffB);
        PG8_WAIT_V(6); PG8_BAR;
    }
    for (;;) {
        const bool has_next = S.next(ui + 1, nxt);
        const char* nA = has_next ? (const char*)g.A + (size_t)nxt.pm * tstep : cA; const char* nB = has_next ? (const char*)g.Bt + (size_t)nxt.pn * tstep : cB;
        for (int t = 0; t < nt; t += 2) {
            const bool last = (t == nt - 2);
            const char* a1 = cA + (size_t)(t + 1) * kstepA;
            const char* a2 = last ? nA : cA + (size_t)(t + 2) * kstepA; const char* b2 = last ? nB : cB + (size_t)(t + 2) * kstepB;
            const char* a3 = a2 + kstepA; const char* b3 = b2 + kstepB;
            if (last && has_next) S.a_ready(nxt);
            if constexpr (SP2) {
            PG8_LDB(B0, 0, 0); PG8_LDB(B1, 0, 1); PG8_SCHED; PG8_LDA(At, 0, 0); PG8_STAGE(PG8_SA(1, 1), a1 + hstep, voffA);
            PG8_WAIT_V(8); PG8_WAIT_L(0); PG8_BAR; PG8_MMA(0, 0, At, B0); PG8_MMA(0, 1, At, B1); PG8_BAR; PG8_SCHED;
            PG8_LDA(At, 0, 1); PG8_STAGE(PG8_SB(0, 0), b2, voffB); PG8_STAGE(PG8_SB(0, 1), b2 + hstep, voffB); PG8_STAGE(PG8_SA(0, 0), a2, voffA);
            PG8_WAIT_V(8); PG8_WAIT_L(0); PG8_BAR; PG8_MMA(1, 0, At, B0); PG8_MMA(1, 1, At, B1); PG8_BAR; PG8_SCHED;
            PG8_LDB(B0, 1, 0); PG8_LDB(B1, 1, 1); PG8_SCHED; PG8_LDA(At, 1, 0); PG8_STAGE(PG8_SA(0, 1), a2 + hstep, voffA);
            PG8_WAIT_V(8); PG8_WAIT_L(0); PG8_BAR; PG8_MMA(0, 0, At, B0); PG8_MMA(0, 1, At, B1); PG8_BAR; PG8_SCHED;
            PG8_LDA(At, 1, 1); PG8_STAGE(PG8_SB(1, 0), b3, voffB); PG8_STAGE(PG8_SB(1, 1), b3 + hstep, voffB); PG8_STAGE(PG8_SA(1, 0), a3, voffA);
            PG8_WAIT_V(8); PG8_WAIT_L(0); PG8_BAR; PG8_MMA(1, 0, At, B0); PG8_MMA(1, 1, At, B1); PG8_BAR; PG8_SCHED;
            } else {
            PG8_LDB(B0, 0, 0); PG8_SCHED; PG8_LDA(At, 0, 0); PG8_STAGE(PG8_SA(1, 1), a1 + hstep, voffA);
            PG8_WAIT_L(8); PG8_BAR; PG8_WAIT_L(0); PG8_MMA(0, 0, At, B0); PG8_BAR; PG8_SCHED;
            PG8_LDB(B1, 0, 1); PG8_STAGE(PG8_SB(0, 0), b2, voffB);
            PG8_BAR; PG8_WAIT_L(0); PG8_MMA(0, 1, At, B1); PG8_BAR;
            PG8_LDA(At, 0, 1); PG8_STAGE(PG8_SA(0, 0), a2, voffA);
            PG8_BAR; PG8_WAIT_L(0); PG8_MMA(1, 0, At, B0); PG8_BAR; PG8_SCHED;
            PG8_STAGE(PG8_SB(0, 1), b2 + hstep, voffB);
            PG8_WAIT_V(6); PG8_BAR; PG8_MMA(1, 1, At, B1); PG8_BAR;
            PG8_LDB(B0, 1, 0); PG8_SCHED; PG8_LDA(At, 1, 0); PG8_STAGE(PG8_SA(0, 1), a2 + hstep, voffA);
            PG8_WAIT_L(8); PG8_BAR; PG8_WAIT_L(0); PG8_MMA(0, 0, At, B0); PG8_BAR; PG8_SCHED;
            PG8_LDB(B1, 1, 1); PG8_STAGE(PG8_SB(1, 0), b3, voffB);
            PG8_BAR; PG8_WAIT_L(0); PG8_MMA(0, 1, At, B1); PG8_BAR;
            PG8_LDA(At, 1, 1); PG8_STAGE(PG8_SA(1, 0), a3, voffA);
            PG8_BAR; PG8_WAIT_L(0); PG8_MMA(1, 0, At, B0); PG8_BAR; PG8_SCHED;
            PG8_STAGE(PG8_SB(1, 1), b3 + hstep, voffB);
            PG8_WAIT_V(6); PG8_BAR; PG8_MMA(1, 1, At, B1); PG8_BAR;
            }
        }
        if constexpr (ALIGN_EPI) { if (wr == 0) PG8_BAR; }
        if constexpr (!Epi::AFTER_DRAIN) { E(acc, cur, wr, wc, fr, fq); S.done(cur); }
        if (!has_next) break;
        if constexpr (Epi::INIT) E.init(acc, nxt, wr, wc, fr, fq);
        else {
#pragma unroll
        for (int a = 0; a < 2; ++a)
#pragma unroll
            for (int b = 0; b < 2; ++b)
#pragma unroll
                for (int m = 0; m < 4; ++m)
#pragma unroll
                    for (int n = 0; n < 2; ++n) acc[a][b][m][n] = (f32x4){0.f, 0.f, 0.f, 0.f};
        }
        cur = nxt; cA = nA; cB = nB; ++ui;
        if constexpr (ALIGN_EPI) { if (wr == 1) PG8_BAR; }
    }
    PG8_WAIT_V(0);
    if constexpr (!ALIGN_EPI) { if (wr == 0) PG8_BAR; }
    PG8_BAR;
    if constexpr (Epi::AFTER_DRAIN) { E.fused(acc, cur, wr, wc, fr, fq, lds, wid, lane); S.done(cur); }
#undef PG8_SA
#undef PG8_SB
#undef PG8_STAGE
#undef PG8_LDA
#undef PG8_LDB
#undef PG8_MMA
#undef PG8_WAIT_V
#undef PG8_WAIT_L
#undef PG8_BAR
#undef PG8_SCHED
}
}
constexpr int NB = 8, SEQ = 2048, DM = 1024, M = NB * SEQ, NIN = 2560, DFF = 2816, NFF2 = 2 * DFF, DEPTH = 2;
constexpr int NWAVES = 8;
constexpr size_t MiB = 1u << 20;
constexpr size_t WS_ROWSS = 1 * MiB;
constexpr size_t WS_VGSS = 2 * MiB;
constexpr size_t WS_WSP = 3 * MiB;
constexpr size_t WS_W0 = 4 * MiB, WS_WSTRIDE = 24 * MiB;
constexpr size_t WOFF_IN = 0, WOFF_OUT = 5 * MiB, WOFF_FIN = 7 * MiB, WOFF_FOUT = 18 * MiB;
constexpr size_t WS_XB = 52 * MiB;
constexpr size_t WS_PROJ = 84 * MiB;
constexpr size_t WS_MIX = 164 * MiB;
constexpr size_t WS_HID = 84 * MiB;
constexpr size_t WS_END = 196 * MiB;
constexpr int LDS_BYTES = 155648;

#define GAS __attribute__((address_space(1)))
#define LAS __attribute__((address_space(3)))
typedef unsigned short bf16;
typedef unsigned v4u __attribute__((ext_vector_type(4)));
typedef float f32x4 __attribute__((ext_vector_type(4)));
__device__ __forceinline__ unsigned f2bf(float f) { unsigned u = __builtin_bit_cast(unsigned, f); return (u + 0x7fffu + ((u >> 16) & 1u)) >> 16; }
__device__ __forceinline__ unsigned pk2(float lo, float hi) { return f2bf(lo) | (f2bf(hi) << 16); }
__device__ __forceinline__ float bf2f(bf16 v) { return __builtin_bit_cast(float, (unsigned)v << 16); }
__device__ __forceinline__ float wave_sum(float v) {
#pragma unroll
    for (int o = 1; o < 64; o <<= 1) v += __shfl_xor(v, o);
    return v;
}
#define LDS_WAIT() asm volatile("s_waitcnt lgkmcnt(0)" ::: "memory")

typedef short tp_s16x4 __attribute__((ext_vector_type(4)));
__device__ __forceinline__ void p0_transpose_item(const float* W, int K, int N, bf16* WT, int k0, int n0, int prow0, int prow1, const float* gk, LAS unsigned char* scr, int lane, int tiled_n = 0) {
    const int lr = lane >> 4, n4 = (lane & 15) * 4;
    f32x4 v[16];
#pragma unroll
    for (int i = 0; i < 16; ++i) v[i] = __builtin_nontemporal_load((const f32x4*)(W + (size_t)(k0 + 4 * i + lr) * N + n0 + n4));
#pragma unroll
    for (int i = 0; i < 16; ++i) { const int k = 4 * i + lr; const float gg = gk ? gk[k0 + k] : 1.f;
        unsigned long long w = (unsigned long long)pk2(v[i].x * gg, v[i].y * gg) | ((unsigned long long)pk2(v[i].z * gg, v[i].w * gg) << 32);
        *(LAS unsigned long long*)(scr + k * 128 + ((n4 * 2) ^ (((k >> 1) & 1) << 6))) = w; }
    asm volatile("" ::: "memory");
    const int hh = lane >> 5, g2 = (lane >> 4) & 1, i16 = lane & 15, qq = i16 >> 2, p4 = i16 & 3;
#pragma unroll
    for (int j = 0; j < 8; ++j) { const int c = 2 * (j >> 1) + hh, nb = 32 * (j & 1) + 16 * g2;
        const int a0 = (8 * c + qq) * 128 + (((nb + 4 * p4) * 2) ^ ((qq >> 1) << 6));
        const tp_s16x4 lo = __builtin_bit_cast(tp_s16x4, __builtin_amdgcn_ds_read_tr16_b64_v4i16((LAS tp_s16x4*)(scr + a0)));
        const tp_s16x4 hi4 = __builtin_bit_cast(tp_s16x4, __builtin_amdgcn_ds_read_tr16_b64_v4i16((LAS tp_s16x4*)(scr + a0 + 4 * 128)));
        typedef short s16x8_t __attribute__((ext_vector_type(8)));
        const s16x8_t o = (s16x8_t){lo[0], lo[1], lo[2], lo[3], hi4[0], hi4[1], hi4[2], hi4[3]};
        const int prow = ((j & 1) ? prow1 : prow0) + 16 * g2 + i16;
        *(s16x8_t*)(WT + (tiled_n ? ((size_t)(k0 >> 6) * tiled_n + prow) * 64 + 8 * c : (size_t)prow * K + k0 + 8 * c)) = o; }
    LDS_WAIT(); asm volatile("" ::: "memory");
}
__host__ __device__ __forceinline__ int map_in(int n) { const int T = n >> 8, nn = n & 255; return 256 * T + 128 * ((nn >> 5) & 1) + 32 * (nn >> 6) + (nn & 31); }
__host__ __device__ __forceinline__ int map_fin(int n) { return n < DFF ? 256 * (n >> 7) + (n & 127) : 256 * ((n - DFF) >> 7) + 128 + ((n - DFF) & 127); }

typedef GAS unsigned gu32;
#define RLX_AGENT __ATOMIC_RELAXED, __HIP_MEMORY_SCOPE_AGENT
constexpr int MISC_OFF = LDS_BYTES - 64;
constexpr size_t WS_BAR = 0;
constexpr size_t BAR_ZERO_BYTES = 32768;
#define XB_TMO      128
#define XB_XCNT(j)  (256  + 64 * (j))
#define XB_XSUB(j)  (1280 + 64 * (j))
#define XB_XGEN(j)  (2304 + 64 * (j))
#define XB_TOP      3328
#define XB_TOPGEN   3392
#define XCD_BAR_WORDS 3456
#define XB_SPIN_CAP (1u << 18)

__device__ __forceinline__ unsigned xb_ld(unsigned* p)              { return __hip_atomic_load(p, __ATOMIC_RELAXED, __HIP_MEMORY_SCOPE_AGENT); }
__device__ __forceinline__ unsigned xb_add(unsigned* p, unsigned v) { return __hip_atomic_fetch_add(p, v, __ATOMIC_RELAXED, __HIP_MEMORY_SCOPE_AGENT); }
__device__ __forceinline__ unsigned xb_xcc_id() { return (unsigned)__builtin_amdgcn_s_getreg((3 << 11) | 20) & 0xFu; }
#define XB_SPIN(cond, bar) do { unsigned _sp = 0; while (cond) { __builtin_amdgcn_s_sleep(1); \
    if ((++_sp & 255u) == 0u) { if (xb_ld(&(bar)[XB_TMO])) break; if (_sp > XB_SPIN_CAP) { atomicAdd(&(bar)[XB_TMO], 1u); break; } } } } while (0)

struct XcdBarrier {
    unsigned* bar; unsigned x;
    volatile LAS unsigned* st;
};

__device__ __forceinline__ XcdBarrier xcd_barrier_post(unsigned* bar, volatile LAS unsigned* st) {
    XcdBarrier b; b.bar = bar; b.x = xb_xcc_id(); b.st = st;
    if (threadIdx.x == 0) (void)xb_add(&bar[XB_XCNT(b.x)], 1u);
    return b;
}
__device__ __forceinline__ void xcd_barrier_complete(unsigned* bar, unsigned x, unsigned& nloc, unsigned& nx) {
    const unsigned G = gridDim.x * gridDim.y * gridDim.z;
    unsigned sum, cnt, mine, sp = 0u;
    for (;;) {
        sum = 0u; cnt = 0u; mine = 0u;
#pragma unroll
        for (unsigned j = 0; j < 16; ++j) { const unsigned c = xb_ld(&bar[XB_XCNT(j)]); sum += c; cnt += (c > 0u) ? 1u : 0u; mine = (j == x) ? c : mine; }
        if (sum == G) break;
        __builtin_amdgcn_s_sleep(1);
        if ((++sp & 255u) == 0u) { if (xb_ld(&bar[XB_TMO])) break; if (sp > XB_SPIN_CAP) { atomicAdd(&bar[XB_TMO], 1u); break; } }
    }
    nloc = mine > 0u ? mine : 1u; nx = cnt > 0u ? cnt : 1u;
}

__device__ __forceinline__ void xcd_barrier(const XcdBarrier& b) {
    asm volatile("s_waitcnt vmcnt(0)" ::: "memory");
    __syncthreads();
    if (threadIdx.x == 0) {
        unsigned* bar = b.bar;
        __builtin_amdgcn_s_waitcnt(0);
        unsigned nloc = b.st[0], nx = b.st[1];
        if (nloc == 0u) { xcd_barrier_complete(bar, b.x, nloc, nx); b.st[0] = nloc; b.st[1] = nx; }
        const unsigned old = xb_add(&bar[XB_XSUB(b.x)], 1u);
        const unsigned gen = old / nloc;
        if (old + 1u == (gen + 1u) * nloc) {
            __builtin_amdgcn_fence(__ATOMIC_RELEASE, "agent");
            asm volatile("s_waitcnt vmcnt(0)" ::: "memory");
            const unsigned og = xb_add(&bar[XB_TOP], 1u);
            const unsigned tg = og / nx;
            if (og + 1u == (tg + 1u) * nx) xb_add(&bar[XB_TOPGEN], 1u);
            else XB_SPIN(xb_ld(&bar[XB_TOPGEN]) == tg, bar);
            __builtin_amdgcn_fence(__ATOMIC_ACQUIRE, "agent");
            xb_add(&bar[XB_XGEN(b.x)], 1u);
            asm volatile("s_waitcnt vmcnt(0)" ::: "memory");
        } else {
            XB_SPIN(xb_ld(&bar[XB_XGEN(b.x)]) == gen, bar);
            __builtin_amdgcn_fence(__ATOMIC_ACQUIRE, "agent");
            asm volatile("s_waitcnt vmcnt(0)" ::: "memory");
        }
    }
    __syncthreads();
}

constexpr size_t WS_CONV = 24576;
constexpr size_t WS_GCNT = 16384, WS_GMASK = 16384 + 8 * 256, WS_XIDX = 16384 + 16 * 256;
__device__ __forceinline__ void group_barrier(unsigned char* ws, volatile LAS unsigned* misc) {
    asm volatile("s_waitcnt vmcnt(0)" ::: "memory");
    __syncthreads();
    if (threadIdx.x == 0) {
        unsigned bx = misc[6];
        unsigned* cnt = (unsigned*)(ws + WS_GCNT) + 64 * (bx & 7u);
        const unsigned pure = misc[4], ep = misc[5] + 1u; misc[5] = ep;
        if (!pure) { __builtin_amdgcn_fence(__ATOMIC_RELEASE, "agent"); asm volatile("s_waitcnt vmcnt(0)" ::: "memory"); }
        const unsigned old_ = xb_add(cnt, 1u);
        if (pure) { __builtin_amdgcn_fence(__ATOMIC_ACQUIRE, "agent"); asm volatile("s_waitcnt vmcnt(0)" ::: "memory"); }
        const unsigned target = ep * (gridDim.x >> 3);
        unsigned sp = 0u;
        if (old_ + 1u < target) while (xb_ld(cnt) < target) { __builtin_amdgcn_s_sleep(1); if (++sp > (1u << 22)) break; }
        if (!pure) __builtin_amdgcn_fence(__ATOMIC_ACQUIRE, "agent");
        asm volatile("s_waitcnt vmcnt(0)" ::: "memory");
    }
    __syncthreads();
}
struct PreGroupBar {
    unsigned char* ws; volatile LAS unsigned* misc;
    __device__ __forceinline__ void drain() const { asm volatile("s_waitcnt vmcnt(0)" ::: "memory"); }
    __device__ __forceinline__ void sync() const {
        asm volatile("s_waitcnt lgkmcnt(0)" ::: "memory"); __builtin_amdgcn_s_barrier(); asm volatile("" ::: "memory");
        if (threadIdx.x == 0) {
            unsigned bx = misc[6];
            unsigned* cnt = (unsigned*)(ws + WS_GCNT) + 64 * (bx & 7u);
            const unsigned pure = misc[4], ep = misc[5] + 1u; misc[5] = ep;
            if (!pure) { __builtin_amdgcn_fence(__ATOMIC_RELEASE, "agent"); asm volatile("s_waitcnt vmcnt(0)" ::: "memory"); }
            const unsigned old_ = xb_add(cnt, 1u);
            if (pure) { __builtin_amdgcn_fence(__ATOMIC_ACQUIRE, "agent"); asm volatile("s_waitcnt vmcnt(0)" ::: "memory"); }
            const unsigned target = ep * (gridDim.x >> 3);
            unsigned sp = 0u;
            if (old_ + 1u < target) while (xb_ld(cnt) < target) { __builtin_amdgcn_s_sleep(1); if (++sp > (1u << 22)) break; }
            if (!pure) __builtin_amdgcn_fence(__ATOMIC_ACQUIRE, "agent");
            asm volatile("s_waitcnt vmcnt(0)" ::: "memory");
        }
        asm volatile("s_waitcnt lgkmcnt(0)" ::: "memory"); __builtin_amdgcn_s_barrier(); asm volatile("" ::: "memory");
    }
};
#define GROUP_BAR() group_barrier(kargs_ws(), (volatile LAS unsigned*)(lds + MISC_OFF))
#define VBID() ((int)__builtin_amdgcn_readfirstlane(((volatile LAS unsigned*)(lds + MISC_OFF))[6]))
#define GRID_BAR() do { XcdBarrier bar_; bar_.bar = (unsigned*)(kargs_ws() + WS_BAR); bar_.x = xb_xcc_id(); bar_.st = (volatile LAS unsigned*)(lds + MISC_OFF); xcd_barrier(bar_); } while (0)
struct Args { const float* in[15]; float* out; unsigned char* ws; };
typedef const __attribute__((address_space(4))) Args CArgs;
__device__ __forceinline__ CArgs* kargs();
__device__ __forceinline__ unsigned char* kargs_ws();
__device__ __forceinline__ CArgs* kargs() { CArgs* p = (CArgs*)__builtin_amdgcn_kernarg_segment_ptr(); asm volatile("" : "+s"(p)); return p; }
__device__ __forceinline__ unsigned char* kargs_ws() { return kargs()->ws; }

constexpr int CW_I_IN = (DM / 64) * (NIN / 64), CW_I_LAYER = CW_I_IN + (DM / 64) * (DM / 64) + (DM / 64) * (NFF2 / 64) + (DFF / 64) * (DM / 64);
__device__ __forceinline__ void convert_weights(CArgs* a, LAS unsigned char* lds, int wave, int lane, int it0, int it1, int gw, int NGW) {
    LAS unsigned char* scr = lds + wave * 16384;
    constexpr int I_IN = (DM / 64) * (NIN / 64), I_OUT = (DM / 64) * (DM / 64), I_FIN = (DM / 64) * (NFF2 / 64), I_FOUT = (DFF / 64) * (DM / 64);
    constexpr int I_LAYER = I_IN + I_OUT + I_FIN + I_FOUT;
    static_assert(I_IN == CW_I_IN && I_LAYER == CW_I_LAYER, "item counts");
#pragma nounroll
    for (int it = it0 + gw; it < it1; it += NGW) {
        const int l = it / I_LAYER; int r = it % I_LAYER;
        unsigned char* wb = a->ws + WS_W0 + (size_t)l * WS_WSTRIDE;
        if (r < I_IN) { const int nblk = NIN / 64, kb = r / nblk, nb = r % nblk;
            p0_transpose_item(a->in[2] + (size_t)l * DM * NIN, DM, NIN, (bf16*)(wb + WOFF_IN), 64 * kb, 64 * nb, map_in(64 * nb), map_in(64 * nb + 32), a->in[1] + l * DM, scr, lane); continue; } r -= I_IN;
        if (r < I_OUT) { const int nblk = DM / 64, kb = r / nblk, nb = r % nblk;
            p0_transpose_item(a->in[11] + (size_t)l * DM * DM, DM, DM, (bf16*)(wb + WOFF_OUT), 64 * kb, 64 * nb, 64 * nb, 64 * nb + 32, nullptr, scr, lane); continue; } r -= I_OUT;
        if (r < I_FIN) { const int nblk = NFF2 / 64, kb = r / nblk, nb = r % nblk;
            p0_transpose_item(a->in[13] + (size_t)l * DM * NFF2, DM, NFF2, (bf16*)(wb + WOFF_FIN), 64 * kb, 64 * nb, map_fin(64 * nb), map_fin(64 * nb + 32), a->in[12] + l * DM, scr, lane); continue; } r -= I_FIN;
        { const int nblk = DM / 64, kb = r / nblk, nb = r % nblk;
            p0_transpose_item(a->in[14] + (size_t)l * DFF * DM, DFF, DM, (bf16*)(wb + WOFF_FOUT), 64 * kb, 64 * nb, 64 * nb, 64 * nb + 32, nullptr, scr, lane, DM); }
    }
}
__device__ __forceinline__ void prologue(CArgs* a, LAS unsigned char* lds, int wave, int lane) {
    const int gw = blockIdx.x * NWAVES + wave, NGW = gridDim.x * NWAVES;
    convert_weights(a, lds, wave, lane, 0, CW_I_IN, gw, NGW);
    float* rowss = (float*)(a->ws + WS_ROWSS); bf16* xb = (bf16*)(a->ws + WS_XB);
#pragma nounroll
    for (int m0 = gw * 4; m0 < M; m0 += NGW * 4) {
        f32x4 v[4][4];
#pragma unroll
        for (int r = 0; r < 4; ++r) { const f32x4* xr = (const f32x4*)(a->in[0] + (size_t)(m0 + r) * DM) + lane;
#pragma unroll
            for (int j = 0; j < 4; ++j) v[r][j] = __builtin_nontemporal_load(xr + 64 * j); }
#pragma unroll
        for (int r = 0; r < 4; ++r) { unsigned long long* o8 = (unsigned long long*)(xb + (size_t)(m0 + r) * DM) + lane; float sq = 0.f;
#pragma unroll
            for (int j = 0; j < 4; ++j) { const f32x4 w = v[r][j]; sq += (w.x * w.x + w.y * w.y) + (w.z * w.z + w.w * w.w);
                o8[64 * j] = (unsigned long long)pk2(w.x, w.y) | ((unsigned long long)pk2(w.z, w.w) << 32); }
            sq = wave_sum(sq);
            if (lane < 4) rowss[(size_t)(m0 + r) * 4 + lane] = lane == 0 ? sq : 0.f; }
    }
    { const float* wsp = a->in[7]; bf16* o = (bf16*)(a->ws + WS_WSP); const int gt = blockIdx.x * 512 + threadIdx.x, NT = gridDim.x * 512;
      for (int i = gt; i < DEPTH * 8 * 128 * 128; i += NT) { const int s = i & 127, t = (i >> 7) & 127; o[i] = (bf16)(((t >> 6) >= (s >> 6)) ? f2bf(wsp[i]) : 0u); } }
}

__device__ __forceinline__ void mixer_naive(CArgs* a, int l, LAS unsigned char* lds, int wave, int lane) {
    const bf16* P = (const bf16*)(a->ws + WS_PROJ); bf16* MIX = (bf16*)(a->ws + WS_MIX);
    const float* vgss = (const float*)(a->ws + WS_VGSS); const bf16* wsp = (const bf16*)(a->ws + WS_WSP) + (size_t)l * 8 * 128 * 128;
    const float* rel = a->in[5] + (size_t)l * 8 * 257; const float* sgu_g = a->in[6] + l * 512; const float* bsp = a->in[8] + l * 8 * 128;
    const float* ag = a->in[9] + l * 512; const float* gg = a->in[10] + l * 512;
    LAS float* red = (LAS float*)lds;
    for (int tok = blockIdx.x; tok < M; tok += gridDim.x) {
        const int b = tok / SEQ, t = tok % SEQ, c = t >> 6;
        const int h = wave;
        const float q = bf2f(P[(size_t)tok * NIN + h * 64 + lane]);
        float mx = -INFINITY, lsum = 0.f, o = 0.f;
        const int k0 = (c >= 8 ? c - 8 : 0) * 64, k1 = c * 64 + 63;
        for (int kt = k0; kt <= k1; ++kt) {
            const size_t kr = (size_t)(b * SEQ + kt) * NIN;
            float s = wave_sum(q * bf2f(P[kr + 512 + h * 64 + lane]));
            int d = t - kt; d = d < -128 ? -128 : (d > 128 ? 128 : d);
            s += rel[h * 257 + d + 128] * pg8::LOG2E;
            const float mn = fmaxf(mx, s), al = __builtin_amdgcn_exp2f(mx - mn), p = __builtin_amdgcn_exp2f(s - mn);
            lsum = lsum * al + p; o = o * al + p * bf2f(P[kr + 1024 + h * 64 + lane]); mx = mn;
        }
        o = o / lsum;
        const int g = wave, nb = t >> 7, tp = t & 127, ns = tp < 64 ? 64 : 128;
        float mixd = 0.f;
        for (int s = 0; s < ns; ++s) {
            const int srow = b * SEQ + nb * 128 + s;
            const f32x4* pv = (const f32x4*)(vgss + (size_t)srow * 8); const f32x4 p0 = pv[0], p1 = pv[1];
            const float rs = __builtin_amdgcn_rsqf((((p0[0] + p0[1]) + (p0[2] + p0[3])) + ((p1[0] + p1[1]) + (p1[2] + p1[3]))) * (1.0f / 512.0f) + pg8::RMS_EPS);
            mixd += bf2f(wsp[(g * 128 + tp) * 128 + s]) * (bf2f(P[(size_t)srow * NIN + 2048 + g * 64 + lane]) * rs * sgu_g[g * 64 + lane]);
        }
        const float gv = bf2f(P[(size_t)tok * NIN + 1536 + g * 64 + lane]) * (mixd + bsp[g * 128 + tp]);
        const float so = wave_sum(o * o), sg = wave_sum(gv * gv);
        __syncthreads();
        if (lane == 0) { red[wave] = so; red[8 + wave] = sg; }
        __syncthreads();
        float ta = 0.f, tg = 0.f;
#pragma unroll
        for (int w = 0; w < 8; ++w) { ta += red[w]; tg += red[8 + w]; }
        const float ra = __builtin_amdgcn_rsqf(ta * (1.0f / 512.0f) + pg8::RMS_EPS), rg = __builtin_amdgcn_rsqf(tg * (1.0f / 512.0f) + pg8::RMS_EPS);
        MIX[(size_t)tok * DM + h * 64 + lane] = (bf16)f2bf(o * ra * ag[h * 64 + lane]);
        MIX[(size_t)tok * DM + 512 + g * 64 + lane] = (bf16)f2bf(gv * rg * gg[g * 64 + lane]);
    }
    __syncthreads();
}

#ifndef FAST_MIXER
#define FAST_MIXER 1
#endif
#ifndef PHM
#define PHM 31
#endif
#ifndef REPM
#define REPM 0
#endif
#define REPEAT(bit) for (int rep_ = 0; rep_ < (((REPM) >> (bit)) & 1) + 1; ++rep_)
namespace mx {
typedef float f32x16 __attribute__((ext_vector_type(16)));
typedef short bf16x8 __attribute__((ext_vector_type(8)));
typedef short s16x4 __attribute__((ext_vector_type(4)));
typedef unsigned u32x2 __attribute__((ext_vector_type(2)));
constexpr int TBL_OFF = 131072;
constexpr int TBL_LD = 320;
constexpr int RS_OFF = TBL_OFF + 8 * TBL_LD * 4 + 4096;
constexpr int RED_OFF = TBL_OFF + 8 * TBL_LD * 4;
__device__ __forceinline__ int crow(int r, int hi) { return (r & 3) + 8 * (r >> 2) + 4 * hi; }
__device__ __forceinline__ int vimg(int row, int chunk) { return row * 128 + ((chunk * 16) ^ (((row >> 1) & 1) << 6)); }
__device__ __forceinline__ s16x4 tr64(LAS unsigned char* p) { return __builtin_bit_cast(s16x4, __builtin_amdgcn_ds_read_tr16_b64_v4i16((LAS s16x4*)p)); }
__device__ __forceinline__ bf16x8 cat8(s16x4 a, s16x4 b) { return (bf16x8){a[0], a[1], a[2], a[3], b[0], b[1], b[2], b[3]}; }
__device__ __forceinline__ unsigned cvtpk(float lo, float hi) { unsigned r; asm("v_cvt_pk_bf16_f32 %0, %1, %2" : "=v"(r) : "v"(lo), "v"(hi)); return r; }
#ifndef ATTREP
#define ATTREP 1
#endif
#ifndef DMAREP
#define DMAREP 1
#endif
#if DMAREP == 1
#define MX_VM8 "s_waitcnt vmcnt(8)"
#else
#define MX_VM8 "s_waitcnt vmcnt(16)"
#endif
#define MX_FENCE() asm volatile("" ::: "memory")
__device__ __forceinline__ float max3f(float a, float b, float c) { float r; asm("v_max3_f32 %0, %1, %2, %3" : "=v"(r) : "v"(a), "v"(b), "v"(c)); return r; }

__device__ __forceinline__ void attn_task(const bf16* P, int b, int c, int h, LAS unsigned char* wl, const LAS float* tbl, int lane, f32x16 (&o)[2][2]) {
    const int r32 = lane & 31, hi = lane >> 5;
    const size_t tok0 = (size_t)b * SEQ + c * 64;
    bf16x8 qf[2][4];
#pragma unroll
    for (int qt = 0; qt < 2; ++qt)
#pragma unroll
        for (int d0 = 0; d0 < 4; ++d0) qf[qt][d0] = *(const bf16x8*)(P + (tok0 + 32 * qt + r32) * NIN + h * 64 + d0 * 16 + hi * 8);
#pragma unroll
    for (int r = 0; r < 16; ++r) { o[0][0][r] = 0.f; o[0][1][r] = 0.f; o[1][0][r] = 0.f; o[1][1][r] = 0.f; }
    float m[2] = {-INFINITY, -INFINITY}, l[2] = {0.f, 0.f};
    const int kc0 = c >= 8 ? c - 8 : 0;
    const int dhalf = (lane >> 4) & 1, qq = (lane & 15) >> 2, p4 = lane & 3;
    int vb[2];
#pragma unroll
    for (int dt = 0; dt < 2; ++dt) vb[dt] = 8192 + (4 * hi + qq) * 128 + ((64 * dt + 32 * dhalf + 8 * p4) ^ ((qq >> 1) << 6));
    const int prow = lane >> 3, pch = lane & 7;
    const unsigned voff = (unsigned)(prow * NIN + (pch ^ (((lane >> 4) & 1) << 2)) * 8) * 2u;
    const unsigned koff0 = (unsigned)(prow * NIN + (pch ^ (lane >> 4)) * 8) * 2u, koff1 = (unsigned)(prow * NIN + (pch ^ (lane >> 4) ^ 4) * 8) * 2u;
    const int swz = (r32 >> 1) & 7;
    int ka[4];
#pragma unroll
    for (int d0 = 0; d0 < 4; ++d0) ka[d0] = r32 * 128 + (((2 * d0 + hi) ^ swz) * 16);
#define MX_DMAK(kc) do { const char* kp_ = (const char*)(P + ((size_t)b * SEQ + (kc) * 64) * NIN + 512 + h * 64); \
        _Pragma("unroll") for (int i = 0; i < 8 * DMAREP; ++i) __builtin_amdgcn_global_load_lds((const unsigned*)(kp_ + (size_t)((i & 7) * 8 * NIN) * 2 + ((i & 1) ? koff1 : koff0)), (LAS unsigned*)(wl + (i & 7) * 1024), 16, 0, 0); } while (0)
#define MX_DMAV(kc) do { const char* vp_ = (const char*)(P + ((size_t)b * SEQ + (kc) * 64) * NIN + 1024 + h * 64); \
        _Pragma("unroll") for (int i = 0; i < 8 * DMAREP; ++i) __builtin_amdgcn_global_load_lds((const unsigned*)(vp_ + (size_t)((i & 7) * 8 * NIN) * 2 + voff), (LAS unsigned*)(wl + 8192 + (i & 7) * 1024), 16, 0, 0); } while (0)
    MX_DMAK(kc0);
    const int nk = c - kc0 + 1, total = nk * ATTREP; (void)total;
#if ATTREP == 1
    for (int kc = kc0; kc <= c; ++kc) {
        const int kcn = kc + 1; const bool more = kc < c;
#else
    for (int it = 0; it < total; ++it) {
        const int kc = kc0 + it % nk, kcn = kc0 + (it + 1) % nk; const bool more = it + 1 < total;
#endif
        const int j = kc - c + 8;
        MX_DMAV(kc);
        asm volatile(MX_VM8 ::: "memory");
        bf16x8 kf[2][4];
#pragma unroll
        for (int kt = 0; kt < 2; ++kt)
#pragma unroll
            for (int d0 = 0; d0 < 4; ++d0) kf[kt][d0] = *(const LAS bf16x8*)(wl + kt * 4096 + ka[d0]);
        asm volatile("s_waitcnt lgkmcnt(0)" ::: "memory");
        if (more) MX_DMAK(kcn);
#pragma unroll
        for (int qt = 0; qt < 2; ++qt) {
            f32x16 st[2];
            float badd = 0.f;
            if (j <= 5) { badd = tbl[256];
#pragma unroll
                for (int r = 0; r < 16; ++r) { st[0][r] = 0.f; st[1][r] = 0.f; } }
            else { const LAS float* tb = tbl + (64 * (8 - j) + 32 * qt + r32 - 4 * hi + 128 - 63);
#pragma unroll
                for (int kt = 0; kt < 2; ++kt)
#pragma unroll
                    for (int r = 0; r < 16; ++r) st[kt][r] = tb[63 - (32 * kt + (r & 3) + 8 * (r >> 2))]; }
#pragma unroll
            for (int kt = 0; kt < 2; ++kt)
#pragma unroll
                for (int d0 = 0; d0 < 4; ++d0) st[kt] = __builtin_amdgcn_mfma_f32_32x32x16_bf16(kf[kt][d0], qf[qt][d0], st[kt], 0, 0, 0);
            asm volatile("s_nop 15\n\ts_nop 7" : "+v"(st[0]), "+v"(st[1]));
            float mxa = max3f(st[0][0], st[0][1], st[0][2]), mxb = max3f(st[1][0], st[1][1], st[1][2]);
#pragma unroll
            for (int r = 3; r < 15; r += 2) { mxa = max3f(mxa, st[0][r], st[0][r + 1]); mxb = max3f(mxb, st[1][r], st[1][r + 1]); }
            float mxv = max3f(mxa, mxb, st[0][15]); mxv = max3f(mxv, st[1][15], mxv);
            mxv = max3f(mxv, __shfl_xor(mxv, 32), mxv) + badd;
            const bool need = mxv > m[qt] + 8.0f;
            if (__builtin_amdgcn_ballot_w64(need) != 0ull) {
                const float mn = need ? mxv : m[qt], al = __builtin_amdgcn_exp2f(m[qt] - mn); m[qt] = mn; l[qt] *= al;
#pragma unroll
                for (int r = 0; r < 16; ++r) { o[qt][0][r] *= al; o[qt][1][r] *= al; }
            }
            const float sub = m[qt] - badd;
            float rs = 0.f;
#pragma unroll
            for (int kt = 0; kt < 2; ++kt)
#pragma unroll
                for (int r = 0; r < 16; ++r) { const float p = __builtin_amdgcn_exp2f(st[kt][r] - sub); st[kt][r] = p; rs += p; }
            l[qt] += rs;
            bf16x8 pf[4];
#pragma unroll
            for (int s = 0; s < 4; ++s) { v4u w; const int kt = s >> 1, r0 = 8 * (s & 1);
                w.x = cvtpk(st[kt][r0 + 0], st[kt][r0 + 1]); w.y = cvtpk(st[kt][r0 + 2], st[kt][r0 + 3]); w.z = cvtpk(st[kt][r0 + 4], st[kt][r0 + 5]); w.w = cvtpk(st[kt][r0 + 6], st[kt][r0 + 7]);
                pf[s] = __builtin_bit_cast(bf16x8, w); }
            if (qt == 0) { if (more) asm volatile(MX_VM8 ::: "memory"); else asm volatile("s_waitcnt vmcnt(0)" ::: "memory"); }
            {
                s16x4 va[2][4], vc[2][4];
#pragma unroll
                for (int dt = 0; dt < 2; ++dt) { const unsigned vaddr = (unsigned)(uintptr_t)(wl + vb[dt]);
#pragma unroll
                    for (int s = 0; s < 4; ++s) { asm volatile("ds_read_b64_tr_b16 %0, %1 offset:%c2" : "=&v"(va[dt][s]) : "v"(vaddr), "i"(16 * s * 128) : "memory");
                                                  asm volatile("ds_read_b64_tr_b16 %0, %1 offset:%c2" : "=&v"(vc[dt][s]) : "v"(vaddr), "i"((16 * s + 8) * 128) : "memory"); } }
                asm volatile("s_waitcnt lgkmcnt(0)" : "+v"(va[0][0]), "+v"(va[0][1]), "+v"(va[0][2]), "+v"(va[0][3]), "+v"(vc[0][0]), "+v"(vc[0][1]), "+v"(vc[0][2]), "+v"(vc[0][3]),
                                                      "+v"(va[1][0]), "+v"(va[1][1]), "+v"(va[1][2]), "+v"(va[1][3]), "+v"(vc[1][0]), "+v"(vc[1][1]), "+v"(vc[1][2]), "+v"(vc[1][3]) :: "memory");
#pragma unroll
                for (int s = 0; s < 4; ++s)
#pragma unroll
                    for (int dt = 0; dt < 2; ++dt) o[qt][dt] = __builtin_amdgcn_mfma_f32_32x32x16_bf16(cat8(va[dt][s], vc[dt][s]), pf[s], o[qt][dt], 0, 0, 0);
            }
        }
        MX_FENCE();
    }
#undef MX_DMAK
#undef MX_DMAV
#pragma unroll
    for (int qt = 0; qt < 2; ++qt) { float lt = l[qt]; lt += __shfl_xor(lt, 32); const float inv = 1.0f / lt;
#pragma unroll
        for (int r = 0; r < 16; ++r) { o[qt][0][r] *= inv; o[qt][1][r] *= inv; } }
}

__device__ __forceinline__ void sgu_task(const bf16* P, const LAS float* rstab, const bf16* wsp_l, const float* sgu_g, const float* bsp_l, int b, int c, int g, LAS unsigned char* wl, int lane_in, f32x16 (&o)[2][2]) {
    int lane = lane_in; asm volatile("" : "+v"(lane));
    const int r32 = lane & 31, hi = lane >> 5;
    const int nb = c >> 1, cb = c & 1, ns = cb ? 128 : 64;
    const size_t srow0 = (size_t)b * SEQ + nb * 128, tok0 = (size_t)b * SEQ + c * 64;
    const int prow = lane >> 3, pch = lane & 7;
    const f32x4 g0 = *(const f32x4*)(sgu_g + g * 64 + pch * 8), g1 = *(const f32x4*)(sgu_g + g * 64 + pch * 8 + 4);
    v4u ureg[8];
#pragma unroll
    for (int i = 0; i < 8; ++i) ureg[i] = *(const v4u*)(P + (tok0 + prow + 8 * i) * NIN + 1536 + g * 64 + pch * 8);
    const bf16* wrow = wsp_l + ((size_t)g * 128 + cb * 64 + r32) * 128 + hi * 8;
    bf16x8 wfa[8], wfb[8];
#pragma unroll
    for (int step = 0; step < 8; ++step) if (step * 16 < ns) { wfa[step] = *(const bf16x8*)(wrow + 16 * step); wfb[step] = *(const bf16x8*)(wrow + 32 * 128 + 16 * step); }
    MX_FENCE();
#pragma unroll
    for (int hb = 0; hb < 2; ++hb) {
        if (hb * 64 < ns) {
            v4u raw[8];
#pragma unroll
            for (int i = 0; i < 8; ++i) raw[i] = *(const v4u*)(P + (srow0 + hb * 64 + prow + 8 * i) * NIN + 2048 + g * 64 + pch * 8);
#pragma unroll
            for (int i = 0; i < 8; ++i) { const int row = hb * 64 + prow + 8 * i; const f32x4 q0 = *(const LAS f32x4*)(rstab + row * 8), q1 = *(const LAS f32x4*)(rstab + row * 8 + 4);
                const float rs = __builtin_amdgcn_rsqf((((q0[0] + q0[1]) + (q0[2] + q0[3])) + ((q1[0] + q1[1]) + (q1[2] + q1[3]))) * (1.0f / 512.0f) + pg8::RMS_EPS);
                v4u w;
                w.x = cvtpk(__builtin_bit_cast(float, raw[i].x << 16) * rs * g0[0], __builtin_bit_cast(float, raw[i].x & 0xffff0000u) * rs * g0[1]);
                w.y = cvtpk(__builtin_bit_cast(float, raw[i].y << 16) * rs * g0[2], __builtin_bit_cast(float, raw[i].y & 0xffff0000u) * rs * g0[3]);
                w.z = cvtpk(__builtin_bit_cast(float, raw[i].z << 16) * rs * g1[0], __builtin_bit_cast(float, raw[i].z & 0xffff0000u) * rs * g1[1]);
                w.w = cvtpk(__builtin_bit_cast(float, raw[i].w << 16) * rs * g1[2], __builtin_bit_cast(float, raw[i].w & 0xffff0000u) * rs * g1[3]);
                *(LAS v4u*)(wl + vimg(row, pch)) = w; }
        }
    }
    MX_FENCE();
#pragma unroll
    for (int r = 0; r < 16; ++r) { o[0][0][r] = 0.f; o[0][1][r] = 0.f; o[1][0][r] = 0.f; o[1][1][r] = 0.f; }
    const int dhalf = (lane >> 4) & 1, qq = (lane & 15) >> 2, p4 = lane & 3;
    int vbs[2];
#pragma unroll
    for (int ct = 0; ct < 2; ++ct) vbs[ct] = (8 * hi + qq) * 128 + ((64 * ct + 32 * dhalf + 8 * p4) ^ ((qq >> 1) << 6));
#pragma unroll
    for (int step = 0; step < 8; ++step) { if (step * 16 < ns) {
        const bf16x8 wf0 = wfa[step], wf1 = wfb[step];
#pragma unroll
        for (int ct = 0; ct < 2; ++ct) { const s16x4 a0 = tr64(wl + vbs[ct] + (16 * step) * 128), a1 = tr64(wl + vbs[ct] + (16 * step + 4) * 128);
            const bf16x8 af = cat8(a0, a1);
            o[0][ct] = __builtin_amdgcn_mfma_f32_32x32x16_bf16(af, wf0, o[0][ct], 0, 0, 0);
            o[1][ct] = __builtin_amdgcn_mfma_f32_32x32x16_bf16(af, wf1, o[1][ct], 0, 0, 0); }
    } }
    MX_FENCE();
#pragma unroll
    for (int i = 0; i < 8; ++i) { const int row = 8 * i + prow; *(LAS v4u*)(wl + row * 128 + ((pch ^ (row & 7)) * 16)) = ureg[i]; }
    MX_FENCE();
#pragma unroll
    for (int tt = 0; tt < 2; ++tt) {
        const int tok = 32 * tt + r32;
        const float bt = bsp_l[g * 128 + cb * 64 + tok];
#pragma unroll
        for (int ct = 0; ct < 2; ++ct)
#pragma unroll
            for (int rg = 0; rg < 4; ++rg) { const u32x2 uu = *(const LAS u32x2*)(wl + tok * 128 + (((4 * ct + rg) ^ (tok & 7)) * 16) + hi * 8);
                o[tt][ct][4 * rg + 0] = __builtin_bit_cast(float, uu.x << 16) * (o[tt][ct][4 * rg + 0] + bt); o[tt][ct][4 * rg + 1] = __builtin_bit_cast(float, uu.x & 0xffff0000u) * (o[tt][ct][4 * rg + 1] + bt);
                o[tt][ct][4 * rg + 2] = __builtin_bit_cast(float, uu.y << 16) * (o[tt][ct][4 * rg + 2] + bt); o[tt][ct][4 * rg + 3] = __builtin_bit_cast(float, uu.y & 0xffff0000u) * (o[tt][ct][4 * rg + 3] + bt); }
    }
    MX_FENCE();
}

__device__ __forceinline__ void norm_store(const f32x16 (&o)[2][2], LAS float* red, LAS unsigned char* wl, int wave, int lane_in, const float* gain, bf16* dst) {
    int lane = lane_in; asm volatile("" : "+v"(lane));
    const int r32 = lane & 31, hi = lane >> 5;
    f32x4 gvv[2][4];
#pragma unroll
    for (int ct = 0; ct < 2; ++ct)
#pragma unroll
        for (int rg = 0; rg < 4; ++rg) gvv[ct][rg] = *(const f32x4*)(gain + 32 * ct + 8 * rg + 4 * hi);
#pragma unroll
    for (int tt = 0; tt < 2; ++tt) { float ss = 0.f;
#pragma unroll
        for (int r = 0; r < 16; ++r) ss += o[tt][0][r] * o[tt][0][r] + o[tt][1][r] * o[tt][1][r];
        ss += __shfl_xor(ss, 32);
        if (hi == 0) red[wave * 64 + tt * 32 + r32] = ss; }
    __syncthreads();
#pragma unroll
    for (int tt = 0; tt < 2; ++tt) { float tot = 0.f; const int tok = 32 * tt + r32;
#pragma unroll
        for (int w = 0; w < 8; ++w) tot += red[w * 64 + tok];
        const float rn = __builtin_amdgcn_rsqf(tot * (1.0f / 512.0f) + pg8::RMS_EPS);
#pragma unroll
        for (int ct = 0; ct < 2; ++ct)
#pragma unroll
            for (int rg = 0; rg < 4; ++rg) { const f32x4 gv = gvv[ct][rg];
                u32x2 w; w.x = cvtpk(o[tt][ct][4 * rg + 0] * rn * gv[0], o[tt][ct][4 * rg + 1] * rn * gv[1]); w.y = cvtpk(o[tt][ct][4 * rg + 2] * rn * gv[2], o[tt][ct][4 * rg + 3] * rn * gv[3]);
                *(LAS u32x2*)(wl + tok * 128 + (((4 * ct + rg) ^ (tok & 7)) * 16) + hi * 8) = w; } }
    MX_FENCE();
    const int prow = lane >> 3, pch = lane & 7;
#pragma unroll
    for (int i = 0; i < 8; ++i) { const int row = 8 * i + prow; const v4u v = *(const LAS v4u*)(wl + row * 128 + ((pch ^ (row & 7)) * 16));
        *(v4u*)(dst + (size_t)row * DM + pch * 8) = v; }
    MX_FENCE();
}

__device__ __forceinline__ void fill_bias_table(CArgs* a, int l, LAS unsigned char* lds) {
    const float* rel = a->in[5] + (size_t)l * 8 * 257; LAS float* tbl = (LAS float*)(lds + TBL_OFF);
    for (int i = threadIdx.x; i < 8 * TBL_LD; i += NWAVES * 64) { const int h = i / TBL_LD, k = i % TBL_LD; tbl[i] = rel[h * 257 + (k < 256 ? k : 256)] * pg8::LOG2E; }
}
__device__ __forceinline__ void mixer_fast(CArgs* a, int l, LAS unsigned char* lds, int wave, int lane, int vb) {
    const bf16* P = (const bf16*)(a->ws + WS_PROJ); bf16* MIX = (bf16*)(a->ws + WS_MIX);
    const float* vgss = (const float*)(a->ws + WS_VGSS); const bf16* wsp_l = (const bf16*)(a->ws + WS_WSP) + (size_t)l * 8 * 128 * 128;
    const float* rel = a->in[5] + (size_t)l * 8 * 257; const float* sgu_g = a->in[6] + l * 512; const float* bsp_l = a->in[8] + l * 8 * 128;
    const float* ag = a->in[9] + l * 512; const float* gg = a->in[10] + l * 512;
    LAS float* tbl = (LAS float*)(lds + TBL_OFF); LAS float* red = (LAS float*)(lds + RED_OFF); LAS float* rstab = (LAS float*)(lds + RS_OFF);
    LAS unsigned char* wl = lds + wave * 16384;
    for (int u = vb; u < NB * (SEQ / 64); u += gridDim.x) {
        const int b = u & 7, c = u >> 3;
        const size_t tok0 = (size_t)b * SEQ + c * 64;
        if (wave == 0) {
            const char* src = (const char*)(vgss + ((size_t)b * SEQ + (c >> 1) * 128) * 8) + lane * 16;
#pragma unroll
            for (int i = 0; i < 4; ++i) __builtin_amdgcn_global_load_lds((const unsigned*)(src + i * 1024), (LAS unsigned*)(lds + RS_OFF + i * 1024), 16, 0, 0);
        }
        f32x16 o[2][2];
        REPEAT(7) attn_task(P, b, c, wave, wl, tbl + wave * TBL_LD, lane, o);
        norm_store(o, red, wl, wave, lane, ag + wave * 64, MIX + tok0 * DM + wave * 64);
        REPEAT(8) sgu_task(P, rstab, wsp_l, sgu_g, bsp_l, b, c, wave, wl, lane, o);
        norm_store(o, red + 512, wl, wave, lane, gg + wave * 64, MIX + tok0 * DM + 512 + wave * 64);
    }
    __syncthreads();
}
}

__global__ void __launch_bounds__(NWAVES * 64, 2) fwd_megakernel(Args a_unused) {
    extern __shared__ __attribute__((aligned(16))) unsigned char lds_raw[];
    LAS unsigned char* lds = (LAS unsigned char*)lds_raw;
    if (threadIdx.x < 16) ((LAS unsigned*)(lds + MISC_OFF))[threadIdx.x] = 0u;
    __syncthreads();
    (void)xcd_barrier_post((unsigned*)(kargs_ws() + WS_BAR), (volatile LAS unsigned*)(lds + MISC_OFF));
    if (threadIdx.x == 64) { const unsigned x_ = xb_xcc_id(); ((volatile LAS unsigned*)(lds + MISC_OFF))[7] = xb_add((unsigned*)(kargs_ws() + WS_XIDX) + 64 * x_, 1u); }
    { const int tid = threadIdx.x, lane = tid & 63, wave = __builtin_amdgcn_readfirstlane(tid >> 6);
      REPEAT(0) prologue(kargs(), lds, wave, lane); }
    GRID_BAR();
    if (threadIdx.x == 64) { volatile LAS unsigned* mi = (volatile LAS unsigned*)(lds + MISC_OFF); unsigned* xi = (unsigned*)(kargs_ws() + WS_XIDX); bool ok = (gridDim.x & 7u) == 0u;
        for (int j = 0; j < 16; ++j) { const unsigned cj = xb_ld(xi + 64 * j); ok = ok && (j < 8 ? cj == (gridDim.x >> 3) : cj == 0u); }
        mi[6] = ok ? mi[7] * 8u + xb_xcc_id() : blockIdx.x; mi[4] = ok ? 1u : 0u; }
    __syncthreads();
#if (REPM >> 6) & 1
    for (int i_ = 0; i_ < 10; ++i_) GRID_BAR();
#endif
#pragma nounroll
    for (int l = 0; l < DEPTH; ++l) {
#if PHM & 1
        REPEAT(1) {
            CArgs* a = kargs(); unsigned char* ws = a->ws; unsigned char* wb = ws + WS_W0 + (size_t)l * WS_WSTRIDE;
            pg8::Gemm g{(const bf16*)(ws + WS_XB), (const bf16*)(wb + WOFF_IN), M, NIN, DM}; pg8::StaticOrder S; S.init(M, NIN, (int)gridDim.x, VBID());
            pg8::Unit u0; u0.pm = -1; u0.pn = 0; (void)S.next(0, u0);
            { LAS float* rsl = (LAS float*)(lds + 131072); const int t_ = threadIdx.x;
              if (u0.pm >= 0 && t_ < 256) rsl[t_] = pg8::row_rs((const float*)(ws + WS_ROWSS), u0.pm * 256 + t_);
              else if (t_ >= 256 && t_ < 384) rsl[t_] = t_ < 320 ? a->in[3][l * 64 + t_ - 256] * pg8::QSCALE : a->in[4][l * 64 + t_ - 320];
              __syncthreads(); }
            pg8::EpiInProj E{(bf16*)(ws + WS_PROJ), (const float*)(ws + WS_ROWSS), (float*)(ws + WS_VGSS), a->in[3] + l * 64, a->in[4] + l * 64, (const LAS float*)(lds + 131072), u0.pm};
            pg8::gemm_phase<pg8::EpiInProj, pg8::StaticOrder, true, true>(lds, g, S, E);
        }
#endif
        if (l == 0 && 2 * VBID() >= (int)gridDim.x) {
            int tid = threadIdx.x; asm volatile("" : "+v"(tid)); const int lane = tid & 63, wave = __builtin_amdgcn_readfirstlane(tid >> 6);
            const int half = gridDim.x - gridDim.x / 2;
            convert_weights(kargs(), lds, wave, lane, CW_I_IN, CW_I_LAYER, (VBID() - (int)gridDim.x / 2) * NWAVES + wave, half * NWAVES);
        }
#if FAST_MIXER
        mx::fill_bias_table(kargs(), l, lds);
#endif
        if (l == 0) GRID_BAR(); else GROUP_BAR();
#if PHM & 2
        REPEAT(2) { int tid = threadIdx.x; asm volatile("" : "+v"(tid)); const int lane = tid & 63, wave = __builtin_amdgcn_readfirstlane(tid >> 6);
#if FAST_MIXER
          mx::mixer_fast(kargs(), l, lds, wave, lane, VBID());
#else
          mixer_naive(kargs(), l, lds, wave, lane);
#endif
        }
#endif
#if PHM & 4
        REPEAT(3) {
            CArgs* a = kargs(); unsigned char* ws = a->ws; unsigned char* wb = ws + WS_W0 + (size_t)l * WS_WSTRIDE; float* xo = a->out;
            pg8::Gemm g{(const bf16*)(ws + WS_MIX), (const bf16*)(wb + WOFF_OUT), M, DM, DM}; pg8::StaticOrder S; S.init(M, DM, (int)gridDim.x, VBID());
            pg8::EpiResid E{(const float*)nullptr, (float*)nullptr, (bf16*)(ws + WS_XB), (float*)(ws + WS_ROWSS)};
            PreGroupBar pre{ws, (volatile LAS unsigned*)(lds + MISC_OFF)};
            pg8::gemm_phase<pg8::EpiResid, pg8::StaticOrder, false, true, false, PreGroupBar>(lds, g, S, E, pre);
        }
#endif
        GROUP_BAR();
#if PHM & 8
        REPEAT(4) {
            CArgs* a = kargs(); unsigned char* ws = a->ws; unsigned char* wb = ws + WS_W0 + (size_t)l * WS_WSTRIDE;
            pg8::Gemm g{(const bf16*)(ws + WS_XB), (const bf16*)(wb + WOFF_FIN), M, NFF2, DM}; pg8::StaticOrder S; S.init(M, NFF2, (int)gridDim.x, VBID());
            pg8::Unit u0; u0.pm = -1; u0.pn = 0; (void)S.next(0, u0);
            { LAS float* rsl = (LAS float*)(lds + 131072); if (u0.pm >= 0 && threadIdx.x < 256) rsl[threadIdx.x] = pg8::row_rs((const float*)(ws + WS_ROWSS), u0.pm * 256 + (int)threadIdx.x); __syncthreads(); }
            pg8::EpiSwiGLU E{(bf16*)(ws + WS_HID), (const float*)(ws + WS_ROWSS), (const LAS float*)(lds + 131072), u0.pm};
            pg8::gemm_phase<pg8::EpiSwiGLU, pg8::StaticOrder, true, true>(lds, g, S, E);
        }
#endif
        if (l == 0 && 2 * VBID() >= (int)gridDim.x) {
            int tid = threadIdx.x; asm volatile("" : "+v"(tid)); const int lane = tid & 63, wave = __builtin_amdgcn_readfirstlane(tid >> 6);
            const int half = gridDim.x - gridDim.x / 2;
            convert_weights(kargs(), lds, wave, lane, CW_I_LAYER, 2 * CW_I_LAYER, (VBID() - (int)gridDim.x / 2) * NWAVES + wave, half * NWAVES);
            asm volatile("s_waitcnt vmcnt(0)" ::: "memory"); __syncthreads();
            if (threadIdx.x == 0) { __builtin_amdgcn_fence(__ATOMIC_RELEASE, "agent"); asm volatile("s_waitcnt vmcnt(0)" ::: "memory"); (void)xb_add((unsigned*)(kargs_ws() + WS_CONV), 1u); }
        }
#if PHM & 16
        REPEAT(5) {
            CArgs* a = kargs(); unsigned char* ws = a->ws; unsigned char* wb = ws + WS_W0 + (size_t)l * WS_WSTRIDE; float* xo = a->out;
            pg8::Gemm g{(const bf16*)(ws + WS_HID), (const bf16*)(wb + WOFF_FOUT), M, DM, DFF}; pg8::StaticOrder S; S.init(M, DM, (int)gridDim.x, VBID());
            pg8::EpiResid E{(const float*)nullptr, l + 1 < DEPTH ? (float*)nullptr : xo, (bf16*)(ws + WS_XB), (float*)(ws + WS_ROWSS)};
            PreGroupBar pre{ws, (volatile LAS unsigned*)(lds + MISC_OFF)};
            pg8::gemm_phase<pg8::EpiResid, pg8::StaticOrder, false, true, true, PreGroupBar>(lds, g, S, E, pre);
        }
#endif
        if (l + 1 < DEPTH) {
            GROUP_BAR();
            if (threadIdx.x == 0) {
                unsigned* cc = (unsigned*)(kargs_ws() + WS_CONV); const unsigned want = gridDim.x - gridDim.x / 2; unsigned sp = 0u;
                while (xb_ld(cc) < want) { __builtin_amdgcn_s_sleep(1); if (++sp > (1u << 22)) break; }
                __builtin_amdgcn_fence(__ATOMIC_ACQUIRE, "agent"); asm volatile("s_waitcnt vmcnt(0)" ::: "memory");
            }
            __syncthreads();
        }
    }
}

extern "C" void kernel_launch(void* const* d_in, const int* in_sizes, int n_in, void* d_out, int out_size, void* d_ws, size_t ws_size, hipStream_t stream) {
    static int grid = 0;
    if (grid == 0) {
        if (n_in != 15 || in_sizes[0] != M * DM || out_size != M * DM || ws_size < WS_END) { fprintf(stderr, "kernel_launch: unexpected shapes (n_in %d, ws %zu)\n", n_in, ws_size); grid = -1; return; }
        int dev = 0, cus = 0, per_cu = 0;
        hipGetDevice(&dev); hipDeviceGetAttribute(&cus, hipDeviceAttributeMultiprocessorCount, dev);
        if (hipFuncSetAttribute((const void*)fwd_megakernel, hipFuncAttributeMaxDynamicSharedMemorySize, LDS_BYTES) != hipSuccess) { fprintf(stderr, "kernel_launch: hipFuncSetAttribute failed\n"); grid = -1; return; }
        if (hipOccupancyMaxActiveBlocksPerMultiprocessor(&per_cu, (const void*)fwd_megakernel, NWAVES * 64, LDS_BYTES) != hipSuccess || per_cu < 1) { fprintf(stderr, "kernel_launch: occupancy query failed (%d)\n", per_cu); (void)hipGetLastError(); per_cu = 1; }
        grid = cus * (per_cu > 1 ? 1 : per_cu);
        if (grid != 256) { fprintf(stderr, "kernel_launch: built for a 256-CU device (one 256x256 unit per workgroup in the N = 1024 phases); got %d\n", grid); grid = -1; return; }
    }
    if (grid < 0) return;
    if (hipMemsetAsync((char*)d_ws + WS_BAR, 0, BAR_ZERO_BYTES, stream) != hipSuccess) { fprintf(stderr, "kernel_launch: hipMemsetAsync failed\n"); return; }
    Args a{};
    for (int i = 0; i < 15; ++i) a.in[i] = (const float*)d_in[i];
    a.out = (float*)d_out; a.ws = (unsigned char*)d_ws;
    void* args[] = {&a};
    hipError_t e = hipLaunchCooperativeKernel((const void*)fwd_megakernel, dim3(grid), dim3(NWAVES * 64), args, LDS_BYTES, stream);
    if (e != hipSuccess) fprintf(stderr, "cooperative launch failed: %s (grid %d)\n", hipGetErrorString(e), grid);
}
```
